# Optimizing an MI355X kernel written in HIP

```python
import math
import jax
import jax.numpy as jnp
from jax import lax
import numpy as np


D_MODEL = 1024
BATCH = 16
SEQ = 2048
DEPTH = 2

GRID_W = 64

N_BRANCH = 4
BRANCH_W = D_MODEL // 2
HEAD_DIM = 64
HEADS = BRANCH_W // HEAD_DIM
RMS_EPS = 1e-6

SSD_GROUPS = 2
SSD_STATE = 128
SSD_CHUNK = 128
SSD_CONV = 5
SSD_CONV_CH = BRANCH_W + 2 * SSD_GROUPS * SSD_STATE
SSD_DT_MIN = 1e-3
SSD_DT_MAX = 1e-1

RWKV_DECAY_RANK = 64
RWKV_ICLR_RANK = 64
RWKV_SHIFT_CH = 3 * BRANCH_W + 2 * (RWKV_DECAY_RANK + RWKV_ICLR_RANK)
RWKV_GN_EPS = 64e-5

GQA_KV_HEADS = 2
ROPE_THETA = 10000.0
Q_BLOCK = 128

NA_WIN_H = 8
NA_WIN_W = 16

IN_SIZES = (
    BRANCH_W,
    SSD_CONV_CH,
    2 * HEADS,
    RWKV_SHIFT_CH,
    BRANCH_W,
    BRANCH_W + 2 * GQA_KV_HEADS * HEAD_DIM,
    BRANCH_W,
    3 * BRANCH_W,
    BRANCH_W,
    N_BRANCH * D_MODEL,
)
N_IN = sum(IN_SIZES)

kernel_name = "hybrid_bidir_ssd_rwkv7_gqa_natten_block"


def rms_norm(x, w, eps=RMS_EPS):
    xf = x.astype(jnp.float32)
    y = xf * lax.rsqrt(jnp.mean(xf * xf, axis=-1, keepdims=True) + eps)
    return (y * w.astype(jnp.float32)).astype(x.dtype)


def depthwise_conv_centred(x, w):
    k_w, ch = w.shape
    pad = (k_w - 1) // 2
    return lax.conv_general_dilated(
        x, w[:, None, :].astype(x.dtype), window_strides=(1,),
        padding=[(pad, k_w - 1 - pad)],
        dimension_numbers=('NWC', 'WIO', 'NWC'), feature_group_count=ch)


def ssd_scan(x, dt, a_neg, b, c):
    bsz, L, H, P = x.shape
    G, N = b.shape[2], b.shape[3]
    R = H // G
    Q = SSD_CHUNK
    nc = L // Q
    xdt = (x * dt[..., None]).reshape(bsz, nc, Q, G, R, P)
    la = jnp.moveaxis((dt * a_neg).reshape(bsz, nc, Q, G, R), 2, -1)
    cum = jnp.cumsum(la, axis=-1)
    bc = b.reshape(bsz, nc, Q, G, N)
    cc = c.reshape(bsz, nc, Q, G, N)
    lower = jnp.tril(jnp.ones((Q, Q), dtype=bool))
    seg = jnp.exp(jnp.where(lower, cum[..., :, None] - cum[..., None, :], -jnp.inf))
    cb = jnp.einsum('bcqgn,bckgn->bcgqk', cc, bc)
    y_diag = jnp.einsum('bcgrqk,bckgrp->bcqgrp', cb[:, :, :, None] * seg, xdt)
    decay_end = jnp.exp(cum[..., -1:] - cum)
    states = jnp.einsum('bcqgn,bcgrq,bcqgrp->bcgrpn', bc, decay_end, xdt)
    chunk_decay = jnp.exp(cum[..., -1])

    def carry(s, inp):
        st, dec = inp
        return s * dec[..., None, None] + st, s

    _, s_in = lax.scan(carry, jnp.zeros_like(states[:, 0]),
                       (jnp.moveaxis(states, 1, 0), jnp.moveaxis(chunk_decay, 1, 0)))
    s_in = jnp.moveaxis(s_in, 0, 1)
    y_off = jnp.einsum('bcqgn,bcgrpn,bcgrq->bcqgrp', cc, s_in, jnp.exp(cum))
    return (y_diag + y_off).reshape(bsz, L, H, P)


def mamba2_branch(z, xbc, dt_raw, conv_w, conv_b, dt_bias, a_log, d_skip, norm_w):
    bsz, L, _ = z.shape
    f32 = jnp.float32
    xbc = jax.nn.silu(depthwise_conv_centred(xbc, conv_w).astype(f32) + conv_b)
    xs, b, c = jnp.split(xbc, [BRANCH_W, BRANCH_W + SSD_GROUPS * SSD_STATE], axis=-1)
    xs = xs.reshape(bsz, L, HEADS, HEAD_DIM)
    b = b.reshape(bsz, L, SSD_GROUPS, SSD_STATE)
    c = c.reshape(bsz, L, SSD_GROUPS, SSD_STATE)
    dt = jax.nn.softplus(dt_raw.astype(f32).reshape(bsz, L, 2, HEADS) + dt_bias)
    a_neg = -jnp.exp(a_log.astype(f32))
    flip = lambda t: jnp.flip(t, axis=1)
    y_f = ssd_scan(xs, dt[:, :, 0], a_neg[0], b, c)
    y_b = flip(ssd_scan(flip(xs), flip(dt[:, :, 1]), a_neg[1], flip(b), flip(c)))
    y = y_f + y_b + xs * d_skip[:, None]
    y = y.reshape(bsz, L, BRANCH_W) * jax.nn.silu(z.astype(f32))
    y = y.reshape(bsz, L, SSD_GROUPS, BRANCH_W // SSD_GROUPS)
    y = y * lax.rsqrt(jnp.mean(y * y, axis=-1, keepdims=True) + RMS_EPS)
    return (y.reshape(bsz, L, BRANCH_W) * norm_w).astype(z.dtype)


def rwkv7_branch(slab, gate, shift_mu, w0, w_up, a0, a_up, k_k, k_a, r_k, lnx_w, lnx_b):
    bsz, L, _ = slab.shape
    f32 = jnp.float32
    W = BRANCH_W
    s = slab.astype(f32)
    prev = jnp.pad(s, ((0, 0), (1, 0), (0, 0)))[:, :-1]
    nxt = jnp.pad(s, ((0, 0), (0, 1), (0, 0)))[:, 1:]
    s = s + shift_mu[0] * (prev - s) + shift_mu[1] * (nxt - s)
    r, k, v, wd, ad = jnp.split(s, [W, 2 * W, 3 * W, 3 * W + 2 * RWKV_DECAY_RANK], axis=-1)
    wd = wd.reshape(bsz, L, 2, RWKV_DECAY_RANK)
    ad = ad.reshape(bsz, L, 2, RWKV_ICLR_RANK)
    w_raw = w0 + jnp.einsum('blzr,zrc->blzc', jnp.tanh(wd), w_up)
    decay = jnp.exp(-jnp.exp(-jax.nn.softplus(-w_raw) - 0.5))
    a = jax.nn.sigmoid(a0 + jnp.einsum('blzr,zrc->blzc', ad, a_up))
    kk = (k * k_k).reshape(bsz, L, HEADS, HEAD_DIM)
    kk = kk * lax.rsqrt(jnp.maximum(jnp.sum(kk * kk, axis=-1, keepdims=True), 1e-24))
    k_dir = k[:, :, None] * (1.0 + (a - 1.0) * k_a)
    r_h = r.reshape(bsz, L, HEADS, HEAD_DIM)
    v_h = v.reshape(bsz, L, HEADS, HEAD_DIM)

    def heads(t):
        return t.reshape(bsz, L, 2, HEADS, HEAD_DIM)

    def per_dir(t):
        t = jnp.stack([t[:, :, 0], jnp.flip(t[:, :, 1], axis=1)], axis=0)
        return jnp.moveaxis(t, 2, 0)

    def shared(t):
        return jnp.moveaxis(jnp.stack([t, jnp.flip(t, axis=1)], axis=0), 2, 0)

    k_heads = heads(k_dir)
    seq_inputs = (shared(r_h), per_dir(heads(decay)), per_dir(k_heads),
                  shared(v_h), shared(kk), per_dir(heads(a)))

    def step(S, inp):
        r_t, w_t, k_t, v_t, kk_t, a_t = inp
        sa = jnp.einsum('zbhvk,zbhk->zbhv', S, kk_t)
        S = (S * w_t[..., None, :] - sa[..., :, None] * (kk_t * a_t)[..., None, :]
             + v_t[..., :, None] * k_t[..., None, :])
        return S, jnp.einsum('zbhvk,zbhk->zbhv', S, r_t)

    S0 = jnp.zeros((2, bsz, HEADS, HEAD_DIM, HEAD_DIM), f32)
    _, ys = lax.scan(step, S0, seq_inputs)
    y = jnp.moveaxis(ys[:, 0] + jnp.flip(ys[:, 1], axis=0), 0, 1)
    mu = jnp.mean(y, axis=-1, keepdims=True)
    var = jnp.mean(jnp.square(y - mu), axis=-1, keepdims=True)
    y = ((y - mu) * lax.rsqrt(var + RWKV_GN_EPS)).reshape(bsz, L, W) * lnx_w + lnx_b
    coef = jnp.sum(r_h[:, :, None] * k_heads * r_k, axis=(2, 4))
    y = y + (coef[..., None] * v_h).reshape(bsz, L, W)
    return (y * jax.nn.silu(gate.astype(f32))).astype(slab.dtype)


def rope_2d(L):
    f32 = jnp.float32
    pos = jnp.arange(L)
    row = (pos // GRID_W).astype(f32)
    col = (pos % GRID_W).astype(f32)
    n_freq = HEAD_DIM // 4
    inv = ROPE_THETA ** (-jnp.arange(n_freq, dtype=f32) / n_freq)
    ang = jnp.concatenate([row[:, None] * inv, col[:, None] * inv], axis=-1)
    return jnp.cos(ang), jnp.sin(ang)


def apply_rope_2d(x, cos, sin):
    x = x.astype(jnp.float32)
    half = HEAD_DIM // 2
    x1, x2 = x[..., :half], x[..., half:]
    c, s = cos[:, None], sin[:, None]
    return jnp.concatenate([x1 * c - x2 * s, x2 * c + x1 * s], axis=-1)


def gqa_branch(qkv, gate, q_norm_w, k_norm_w, cos, sin):
    bsz, L, _ = qkv.shape
    dt = qkv.dtype
    q, k, v = jnp.split(qkv, [BRANCH_W, BRANCH_W + GQA_KV_HEADS * HEAD_DIM], axis=-1)
    q = q.reshape(bsz, L, HEADS, HEAD_DIM)
    k = k.reshape(bsz, L, GQA_KV_HEADS, HEAD_DIM)
    v = v.reshape(bsz, L, GQA_KV_HEADS, HEAD_DIM)
    q = apply_rope_2d(rms_norm(q, q_norm_w), cos, sin).astype(dt)
    k = apply_rope_2d(rms_norm(k, k_norm_w), cos, sin).astype(dt)
    rep = HEADS // GQA_KV_HEADS
    nb = L // Q_BLOCK
    qb = jnp.moveaxis(q.reshape(bsz, nb, Q_BLOCK, GQA_KV_HEADS, rep, HEAD_DIM), 1, 0)
    scale = HEAD_DIM ** -0.5

    def attend(q_blk):
        s = jnp.einsum('bqgrd,bkgd->bgrqk', q_blk, k).astype(jnp.float32) * scale
        p = jax.nn.softmax(s, axis=-1).astype(v.dtype)
        return jnp.einsum('bgrqk,bkgd->bqgrd', p, v)

    o = jnp.moveaxis(lax.map(attend, qb), 0, 1).reshape(bsz, L, BRANCH_W)
    return (o.astype(jnp.float32) * jax.nn.silu(gate.astype(jnp.float32))).astype(dt)


def na_tables(L):
    rows = L // GRID_W
    wh = min(NA_WIN_H, rows)
    t = jnp.arange(L)
    qr, qc = t // GRID_W, t % GRID_W
    rs = jnp.clip(qr - wh // 2, 0, rows - wh)
    cs = jnp.clip(qc - NA_WIN_W // 2, 0, GRID_W - NA_WIN_W)
    m = jnp.arange(wh * NA_WIN_W)
    kr = rs[:, None] + m // NA_WIN_W
    kc = cs[:, None] + m % NA_WIN_W
    idx = kr * GRID_W + kc
    rel = ((kr - qr[:, None] + NA_WIN_H - 1) * (2 * NA_WIN_W - 1)
           + (kc - qc[:, None] + NA_WIN_W - 1))
    return idx.astype(jnp.int32), rel.astype(jnp.int32)


def na_branch(qkv, gate, rpb, idx, rel):
    bsz, L, _ = qkv.shape
    dt = qkv.dtype
    q, k, v = jnp.split(qkv, [BRANCH_W, 2 * BRANCH_W], axis=-1)
    q = q.reshape(bsz, L, HEADS, HEAD_DIM)
    k = k.reshape(bsz, L, HEADS, HEAD_DIM)
    v = v.reshape(bsz, L, HEADS, HEAD_DIM)
    rows = L // GRID_W
    n_keys = idx.shape[-1]
    q_rows = jnp.moveaxis(q.reshape(bsz, rows, GRID_W, HEADS, HEAD_DIM), 1, 0)
    idx_rows = idx.reshape(rows, GRID_W, n_keys)
    rel_rows = rel.reshape(rows, GRID_W, n_keys)
    table = rpb.reshape(HEADS, -1)
    scale = HEAD_DIM ** -0.5

    def attend(args):
        q_blk, i_blk, r_blk = args
        kg = k[:, i_blk]
        vg = v[:, i_blk]
        s = jnp.einsum('bqhd,bqkhd->bhqk', q_blk, kg).astype(jnp.float32) * scale
        s = s + table[:, r_blk].astype(jnp.float32)
        p = jax.nn.softmax(s, axis=-1).astype(vg.dtype)
        return jnp.einsum('bhqk,bqkhd->bqhd', p, vg)

    o = lax.map(attend, (q_rows, idx_rows, rel_rows))
    o = jnp.moveaxis(o, 0, 1).reshape(bsz, L, BRANCH_W)
    return (o.astype(jnp.float32) * jax.nn.silu(gate.astype(jnp.float32))).astype(dt)


def hybrid_layer(x, pre_norm_w, w_in, ssd_conv_w, ssd_conv_b, ssd_dt_bias, ssd_a_log, ssd_d,
                 ssd_norm_w, rwkv_shift_mu, rwkv_w0, rwkv_w_up, rwkv_a0, rwkv_a_up, rwkv_k_k,
                 rwkv_k_a, rwkv_r_k, rwkv_lnx_w, rwkv_lnx_b, attn_q_norm_w, attn_k_norm_w,
                 na_rpb, w_branch, w_out, post_norm_w, cos, sin, na_idx, na_rel):
    bsz, L, _ = x.shape
    h = rms_norm(x, pre_norm_w)
    proj = jnp.einsum('bld,dn->bln', h, w_in)
    splits = []
    acc = 0
    for size in IN_SIZES[:-1]:
        acc += size
        splits.append(acc)
    (z_a, xbc_a, dt_a, slab_b, gate_b, qkv_c, gate_c, qkv_d, gate_d,
     merge_logits) = jnp.split(proj, splits, axis=-1)
    y_a = mamba2_branch(z_a, xbc_a, dt_a, ssd_conv_w, ssd_conv_b, ssd_dt_bias, ssd_a_log,
                        ssd_d, ssd_norm_w)
    y_b = rwkv7_branch(slab_b, gate_b, rwkv_shift_mu, rwkv_w0, rwkv_w_up, rwkv_a0, rwkv_a_up,
                       rwkv_k_k, rwkv_k_a, rwkv_r_k, rwkv_lnx_w, rwkv_lnx_b)
    y_c = gqa_branch(qkv_c, gate_c, attn_q_norm_w, attn_k_norm_w, cos, sin)
    y_d = na_branch(qkv_d, gate_d, na_rpb, na_idx, na_rel)
    branches = (y_a, y_b, y_c, y_d)
    gates = jax.nn.sigmoid(merge_logits.astype(jnp.float32)).reshape(bsz, L, N_BRANCH, D_MODEL)
    merged = gates[:, :, 0] * jnp.einsum('blw,wd->bld', branches[0], w_branch[0]).astype(jnp.float32)
    for i in range(1, N_BRANCH):
        merged = merged + gates[:, :, i] * jnp.einsum(
            'blw,wd->bld', branches[i], w_branch[i]).astype(jnp.float32)
    out = jnp.einsum('bld,de->ble', merged.astype(x.dtype), w_out)
    return x + rms_norm(out, post_norm_w)


def setup_inputs(seed: int = 0) -> dict:
    key = jax.random.key(seed)
    ks = jax.random.split(key, 26)
    f32 = jnp.float32

    def nrm(k, shape, scale):
        return scale * jax.random.normal(k, shape, f32)

    x = jax.random.normal(ks[0], (BATCH, SEQ, D_MODEL), f32)
    pre_norm_w = 1.0 + nrm(ks[1], (DEPTH, D_MODEL), 0.02)
    w_in = nrm(ks[2], (DEPTH, D_MODEL, N_IN), D_MODEL ** -0.5)
    ssd_conv_w = nrm(ks[3], (DEPTH, SSD_CONV, SSD_CONV_CH), SSD_CONV ** -0.5)
    ssd_conv_b = nrm(ks[4], (DEPTH, SSD_CONV_CH), 0.01)
    u = jax.random.uniform(ks[5], (DEPTH, 2, HEADS), f32)
    dt0 = jnp.exp(u * (math.log(SSD_DT_MAX) - math.log(SSD_DT_MIN)) + math.log(SSD_DT_MIN))
    ssd_dt_bias = dt0 + jnp.log(-jnp.expm1(-dt0))
    ssd_a_log = jnp.log(jax.random.uniform(ks[6], (DEPTH, 2, HEADS), f32, 1.0, 16.0))
    ssd_d = 1.0 + nrm(ks[7], (DEPTH, HEADS), 0.1)
    ssd_norm_w = 1.0 + nrm(ks[8], (DEPTH, BRANCH_W), 0.02)
    rwkv_shift_mu = jax.random.uniform(ks[9], (DEPTH, 2, RWKV_SHIFT_CH), f32, 0.0, 0.5)
    rwkv_w0 = jax.random.uniform(ks[10], (DEPTH, 2, BRANCH_W), f32, -4.0, 0.0)
    rwkv_w_up = nrm(ks[11], (DEPTH, 2, RWKV_DECAY_RANK, BRANCH_W), 0.1)
    rwkv_a0 = nrm(ks[12], (DEPTH, 2, BRANCH_W), 0.1)
    rwkv_a_up = nrm(ks[13], (DEPTH, 2, RWKV_ICLR_RANK, BRANCH_W), RWKV_ICLR_RANK ** -0.5)
    rwkv_k_k = 0.85 + nrm(ks[14], (DEPTH, BRANCH_W), 0.05)
    rwkv_k_a = 1.0 + nrm(ks[15], (DEPTH, BRANCH_W), 0.05)
    rwkv_r_k = nrm(ks[16], (DEPTH, HEADS, HEAD_DIM), 0.1)
    rwkv_lnx_w = 1.0 + nrm(ks[17], (DEPTH, BRANCH_W), 0.02)
    rwkv_lnx_b = nrm(ks[18], (DEPTH, BRANCH_W), 0.01)
    attn_q_norm_w = 1.0 + nrm(ks[19], (DEPTH, HEAD_DIM), 0.02)
    attn_k_norm_w = 1.0 + nrm(ks[20], (DEPTH, HEAD_DIM), 0.02)
    na_rpb = nrm(ks[21], (DEPTH, HEADS, 2 * NA_WIN_H - 1, 2 * NA_WIN_W - 1), 0.1)
    w_branch = nrm(ks[22], (DEPTH, N_BRANCH, BRANCH_W, D_MODEL), BRANCH_W ** -0.5)
    w_out = nrm(ks[23], (DEPTH, D_MODEL, D_MODEL), D_MODEL ** -0.5)
    post_norm_w = 1.0 + nrm(ks[24], (DEPTH, D_MODEL), 0.02)
    return {
        'x': x, 'pre_norm_w': pre_norm_w, 'w_in': w_in,
        'ssd_conv_w': ssd_conv_w, 'ssd_conv_b': ssd_conv_b, 'ssd_dt_bias': ssd_dt_bias,
        'ssd_a_log': ssd_a_log, 'ssd_d': ssd_d, 'ssd_norm_w': ssd_norm_w,
        'rwkv_shift_mu': rwkv_shift_mu, 'rwkv_w0': rwkv_w0, 'rwkv_w_up': rwkv_w_up,
        'rwkv_a0': rwkv_a0, 'rwkv_a_up': rwkv_a_up, 'rwkv_k_k': rwkv_k_k, 'rwkv_k_a': rwkv_k_a,
        'rwkv_r_k': rwkv_r_k, 'rwkv_lnx_w': rwkv_lnx_w, 'rwkv_lnx_b': rwkv_lnx_b,
        'attn_q_norm_w': attn_q_norm_w, 'attn_k_norm_w': attn_k_norm_w, 'na_rpb': na_rpb,
        'w_branch': w_branch, 'w_out': w_out, 'post_norm_w': post_norm_w,
    }


def reference(x, pre_norm_w, w_in, ssd_conv_w, ssd_conv_b, ssd_dt_bias, ssd_a_log, ssd_d,
              ssd_norm_w, rwkv_shift_mu, rwkv_w0, rwkv_w_up, rwkv_a0, rwkv_a_up, rwkv_k_k,
              rwkv_k_a, rwkv_r_k, rwkv_lnx_w, rwkv_lnx_b, attn_q_norm_w, attn_k_norm_w,
              na_rpb, w_branch, w_out, post_norm_w):
    L = x.shape[1]
    cos, sin = rope_2d(L)
    na_idx, na_rel = na_tables(L)
    for l in range(DEPTH):
        x = hybrid_layer(
            x, pre_norm_w[l], w_in[l], ssd_conv_w[l], ssd_conv_b[l], ssd_dt_bias[l],
            ssd_a_log[l], ssd_d[l], ssd_norm_w[l], rwkv_shift_mu[l], rwkv_w0[l], rwkv_w_up[l],
            rwkv_a0[l], rwkv_a_up[l], rwkv_k_k[l], rwkv_k_a[l], rwkv_r_k[l], rwkv_lnx_w[l],
            rwkv_lnx_b[l], attn_q_norm_w[l], attn_k_norm_w[l], na_rpb[l], w_branch[l],
            w_out[l], post_norm_w[l], cos, sin, na_idx, na_rel)
    return x
```

```cpp
#include <hip/hip_runtime.h>
#include <cstdio>
#include <cstdint>
#include <cmath>
namespace pg8 {
#define PG8_LAS __attribute__((address_space(3)))
typedef unsigned short bf16_t;
typedef short bf16x8 __attribute__((ext_vector_type(8)));
typedef float f32x4 __attribute__((ext_vector_type(4)));
typedef unsigned u32x4 __attribute__((ext_vector_type(4)));
constexpr int BM = 256, BK = 64, HALF = 128, HTB = HALF * BK * 2  , STAGE_BYTES = 8 * HTB, NXCD = 8, WGM = 8;

__host__ __device__ __forceinline__ int lds_byte(int r, int c) { const int st = (r >> 4) * 2 + (c >> 5), rr = r & 15, cc = c & 31, ob = rr * 64 + cc * 2; return st * 1024 + (ob ^ (((ob >> 9) & 1) << 5)); }
__host__ __device__ __forceinline__ void stage_rc(int b, int& R, int& C) { const int st = b / 1024, sb = b % 1024, swz = sb ^ (((sb >> 9) & 1) << 5); R = (st >> 1) * 16 + swz / 64; C = (st & 1) * 32 + (swz % 64) / 2; }
__host__ __device__ __forceinline__ int perm32(int rho) { const int n = rho >> 4, i = rho & 15; return 8 * (i >> 2) + 4 * n + (i & 3); }

struct Unit { int pm, pn; };
struct Gemm { const bf16_t* A; const bf16_t* Bt; int M, N, K, lda; };

struct StaticOrder {
    int nM, nN, nwg, G, c;
    __host__ __device__ void init(int M, int N, int G_, int c_) { nM = M / BM; nN = N / BM; nwg = nM * nN; G = G_; c = c_; }
    __host__ __device__ bool next(int i, Unit& u) const {
        const long L = (long)i * G + c; if (L >= nwg) return false;
        int wgid = (int)L; { const int q = nwg / NXCD, r = nwg % NXCD, xcd = wgid % NXCD, off = wgid / NXCD; wgid = (xcd < r ? xcd * (q + 1) : r * (q + 1) + (xcd - r) * q) + off; }
        const int nig = WGM * nN, gid = wgid / nig, fm = gid * WGM, gsz = (nM - fm) < WGM ? (nM - fm) : WGM;
        u.pm = fm + ((wgid % nig) % gsz); u.pn = (wgid % nig) / gsz; return true;
    }
    __device__ __forceinline__ void a_ready(const Unit&) const {}
    __device__ __forceinline__ void done(const Unit&) const {}
};

__device__ __forceinline__ unsigned cvt_pk_bf16(float lo, float hi) { unsigned r; asm volatile("v_cvt_pk_bf16_f32 %0, %1, %2" : "=v"(r) : "v"(lo), "v"(hi)); return r; }
typedef float f32x2 __attribute__((ext_vector_type(2)));
__device__ __forceinline__ f32x2 gelu_pk(f32x2 v) {
    const f32x2 av = __builtin_elementwise_abs(v), d = av * 0.2316418882f + 1.0f;
    f32x2 t; t.x = __builtin_amdgcn_rcpf(d.x); t.y = __builtin_amdgcn_rcpf(d.y);
    f32x2 q = t * 0.5307027145f + (-0.7265760135f); q = q * t + 0.7107068705f; q = q * t + (-0.142248368f); q = q * t + 0.127414796f; q = q * t;
    const f32x2 s = (v * v) * (-0.72134752044f);
    f32x2 e; e.x = __builtin_amdgcn_exp2f(s.x); e.y = __builtin_amdgcn_exp2f(s.y);
    const f32x2 m = v * (q * e), r = v - m;
    f32x2 o; o.x = v.x < 0.f ? m.x : r.x; o.y = v.y < 0.f ? m.y : r.y; return o;
}

template <int ACT  > struct EpiBf16 {
    static constexpr bool PERM = true, AFTER_DRAIN = false, FOLD = false; static_assert(ACT >= 0 && ACT <= 2, "EpiBf16: ACT is 0 (none), 1 (gelu_pk) or 2 (1 + exp(-x), the reciprocal sigmoid)");
    bf16_t* O; int ldc; const float* bias; int split_cols; size_t split_stride; float scale0;
    __device__ __forceinline__ void operator()(const f32x4 (&acc)[2][2][4][2], const Unit& u, int wr, int wc, int fr, int fq) const {
        const int row0 = u.pm * BM + wr * 64 + fr; int colt = u.pn * BM; bf16_t* base = O;
        float sc = 1.f; if (split_cols) { const int t = colt / split_cols; base += (size_t)t * split_stride; colt -= t * split_cols; if (t == 0) sc = scale0; }
        const int col0 = colt + wc * 32 + 8 * fq, bcol0 = u.pn * BM + wc * 32 + 8 * fq;
        f32x4 bv[2][2];
#pragma unroll
        for (int bj = 0; bj < 2; ++bj)
#pragma unroll
            for (int n = 0; n < 2; ++n) bv[bj][n] = bias ? *(const f32x4*)(bias + bcol0 + bj * HALF + 4 * n) : (f32x4){0.f, 0.f, 0.f, 0.f};
#pragma unroll
        for (int ai = 0; ai < 2; ++ai)
#pragma unroll
            for (int m = 0; m < 4; ++m) { bf16_t* rowp = base + (size_t)(row0 + ai * HALF + m * 16) * ldc + col0;
#pragma unroll
                for (int bj = 0; bj < 2; ++bj) { f32x4 v0 = acc[ai][bj][m][0] + bv[bj][0], v1 = acc[ai][bj][m][1] + bv[bj][1];
                    if (ACT == 1) { f32x2 a = gelu_pk((f32x2){v0[0], v0[1]}), b = gelu_pk((f32x2){v0[2], v0[3]}), c = gelu_pk((f32x2){v1[0], v1[1]}), d = gelu_pk((f32x2){v1[2], v1[3]});
                        v0 = (f32x4){a.x, a.y, b.x, b.y}; v1 = (f32x4){c.x, c.y, d.x, d.y}; }
                    if (ACT == 2) { _Pragma("unroll") for (int e = 0; e < 4; ++e) { v0[e] = 1.f + __builtin_amdgcn_exp2f(__builtin_fminf(__builtin_fmaxf(v0[e], -60.f), 60.f) * -1.4426950408889634f); v1[e] = 1.f + __builtin_amdgcn_exp2f(__builtin_fminf(__builtin_fmaxf(v1[e], -60.f), 60.f) * -1.4426950408889634f); } }
                    v0 = v0 * sc; v1 = v1 * sc; u32x4 w; w.x = cvt_pk_bf16(v0[0], v0[1]); w.y = cvt_pk_bf16(v0[2], v0[3]); w.z = cvt_pk_bf16(v1[0], v1[1]); w.w = cvt_pk_bf16(v1[2], v1[3]);
                    *(u32x4*)(rowp + bj * HALF) = w; } }
    }
};
template <class Epi, class Sched, bool ALIGN_EPI = false, bool SP2 = false>
__device__ __forceinline__ void gemm_phase(PG8_LAS unsigned char* lds, const Gemm g, const Sched& S, const Epi& E, const int tid) {
    const int wid = __builtin_amdgcn_readfirstlane(tid >> 6), lane = tid & 63, wr = wid >> 2, wc = wid & 3, fr = lane & 15, fq = lane >> 4;
    const int K = g.K, nt = K / BK;
    unsigned voffA[2], voffB[2];
#pragma unroll
    for (int i = 0; i < 2; ++i) { int R, C; stage_rc(tid * 16 + i * 8192, R, C); const int Rb = Epi::PERM ? ((R & ~31) + perm32(R & 31)) : R;
        voffA[i] = (unsigned)(R * g.lda + C) * 2u; voffB[i] = (unsigned)(Rb * K + C) * 2u; }
    const size_t kstep = (size_t)(BK * 2);
    const size_t hstep = (size_t)HALF * K * 2;
    const size_t tstep = 2 * hstep;
    const size_t hstepA = (size_t)HALF * g.lda * 2, tstepA = 2 * hstepA;
    const unsigned ldsw = (unsigned)wid * 1024u;
    const int aoff = lds_byte(wr * 64 + fr, fq * 8), boff = lds_byte(wc * 32 + fr, fq * 8);
#define PG8_SA(b, h) (((b) * 2 + (h)) * HTB)
#define PG8_SB(b, h) ((4 + (b) * 2 + (h)) * HTB)
#define PG8_STAGE(bufoff, gbase, voff) do { _Pragma("unroll") for (int _i = 0; _i < 2; ++_i) \
        __builtin_amdgcn_global_load_lds((const unsigned*)((const char*)(gbase) + (voff)[_i]), (PG8_LAS unsigned*)(lds + (bufoff) + ldsw + _i * 8192), 16, 0, 0); } while (0)
#define PG8_LDA(dst, b, h) do { _Pragma("unroll") for (int m = 0; m < 4; ++m) _Pragma("unroll") for (int k = 0; k < 2; ++k) dst[m][k] = *(const PG8_LAS bf16x8*)(lds + PG8_SA(b, h) + aoff + m * 2048 + k * 1024); } while (0)
#define PG8_LDB(dst, b, h) do { _Pragma("unroll") for (int n = 0; n < 2; ++n) _Pragma("unroll") for (int k = 0; k < 2; ++k) dst[n][k] = *(const PG8_LAS bf16x8*)(lds + PG8_SB(b, h) + boff + n * 2048 + k * 1024); } while (0)
#define PG8_MMA(ai, bj, At, Bt) do { __builtin_amdgcn_s_setprio(1); _Pragma("unroll") for (int m = 0; m < 4; ++m) _Pragma("unroll") for (int n = 0; n < 2; ++n) _Pragma("unroll") for (int k = 0; k < 2; ++k) \
        acc[ai][bj][m][n] = __builtin_amdgcn_mfma_f32_16x16x32_bf16(Bt[n][k], At[m][k], acc[ai][bj][m][n], 0, 0, 0); __builtin_amdgcn_s_setprio(0); } while (0)
#define PG8_WAIT_V(n) asm volatile("s_waitcnt vmcnt(" #n ")" ::: "memory")
#define PG8_WAIT_L(n) asm volatile("s_waitcnt lgkmcnt(" #n ")" ::: "memory")
#define PG8_BAR __builtin_amdgcn_s_barrier()
#define PG8_SCHED __builtin_amdgcn_sched_barrier(0)
    Unit cur, nxt; int ui = 0;
    if (!S.next(0, cur)) return;
    f32x4 acc[2][2][4][2];
#pragma unroll
    for (int a = 0; a < 2; ++a)
#pragma unroll
        for (int b = 0; b < 2; ++b)
#pragma unroll
            for (int m = 0; m < 4; ++m)
#pragma unroll
                for (int n = 0; n < 2; ++n) acc[a][b][m][n] = (f32x4){0.f, 0.f, 0.f, 0.f};
    bf16x8 At[4][2], B0[2][2], B1[2][2];
    const char* cA = (const char*)g.A + (size_t)cur.pm * tstepA; const char* cB = (const char*)g.Bt + (size_t)cur.pn * tstep;
    S.a_ready(cur);
    if constexpr (SP2) {
        PG8_STAGE(PG8_SB(0, 0), cB, voffB); PG8_STAGE(PG8_SB(0, 1), cB + hstep, voffB); PG8_STAGE(PG8_SA(0, 0), cA, voffA); PG8_STAGE(PG8_SA(0, 1), cA + hstepA, voffA);
        if (wr == 1) PG8_BAR;
        PG8_WAIT_V(2); PG8_BAR;
        PG8_STAGE(PG8_SB(1, 0), cB + kstep, voffB); PG8_STAGE(PG8_SA(1, 0), cA + kstep, voffA); PG8_STAGE(PG8_SB(1, 1), cB + hstep + kstep, voffB);
        PG8_WAIT_V(6); PG8_BAR;
    } else {
        PG8_STAGE(PG8_SB(0, 0), cB, voffB); PG8_STAGE(PG8_SA(0, 0), cA, voffA); PG8_STAGE(PG8_SB(0, 1), cB + hstep, voffB); PG8_STAGE(PG8_SA(0, 1), cA + hstepA, voffA);
        if (wr == 1) PG8_BAR;
        PG8_WAIT_V(4); PG8_BAR;
        PG8_STAGE(PG8_SB(1, 0), cB + kstep, voffB); PG8_STAGE(PG8_SA(1, 0), cA + kstep, voffA); PG8_STAGE(PG8_SB(1, 1), cB + hstep + kstep, voffB);
        PG8_WAIT_V(6); PG8_BAR;
    }
    for (;;) {
        const bool has_next = S.next(ui + 1, nxt);
        const char* nA = has_next ? (const char*)g.A + (size_t)nxt.pm * tstepA : cA; const char* nB = has_next ? (const char*)g.Bt + (size_t)nxt.pn * tstep : cB;
        for (int t = 0; t < nt; t += 2) {
            const bool last = (t == nt - 2);
            const char* a1 = cA + (size_t)(t + 1) * kstep;
            const char* a2 = last ? nA : cA + (size_t)(t + 2) * kstep; const char* b2 = last ? nB : cB + (size_t)(t + 2) * kstep;
            const char* a3 = a2 + kstep; const char* b3 = b2 + kstep;
            if (last && has_next) S.a_ready(nxt);
            if constexpr (SP2) {
            PG8_LDB(B0, 0, 0); PG8_LDB(B1, 0, 1); PG8_SCHED; PG8_LDA(At, 0, 0); PG8_STAGE(PG8_SA(1, 1), a1 + hstepA, voffA);
            PG8_WAIT_V(8); PG8_WAIT_L(0); PG8_BAR; PG8_MMA(0, 0, At, B0); PG8_MMA(0, 1, At, B1); PG8_BAR; PG8_SCHED;
            PG8_LDA(At, 0, 1); PG8_STAGE(PG8_SB(0, 0), b2, voffB); PG8_STAGE(PG8_SB(0, 1), b2 + hstep, voffB); PG8_STAGE(PG8_SA(0, 0), a2, voffA);
            PG8_WAIT_V(8); PG8_WAIT_L(0); PG8_BAR; PG8_MMA(1, 0, At, B0); PG8_MMA(1, 1, At, B1); PG8_BAR; PG8_SCHED;
            PG8_LDB(B0, 1, 0); PG8_LDB(B1, 1, 1); PG8_SCHED; PG8_LDA(At, 1, 0); PG8_STAGE(PG8_SA(0, 1), a2 + hstepA, voffA);
            PG8_WAIT_V(8); PG8_WAIT_L(0); PG8_BAR; PG8_MMA(0, 0, At, B0); PG8_MMA(0, 1, At, B1); PG8_BAR; PG8_SCHED;
            PG8_LDA(At, 1, 1); PG8_STAGE(PG8_SB(1, 0), b3, voffB); PG8_STAGE(PG8_SB(1, 1), b3 + hstep, voffB); PG8_STAGE(PG8_SA(1, 0), a3, voffA);
            PG8_WAIT_V(8); PG8_WAIT_L(0); PG8_BAR; PG8_MMA(1, 0, At, B0); PG8_MMA(1, 1, At, B1); PG8_BAR; PG8_SCHED;
            } else {
            PG8_LDB(B0, 0, 0); PG8_SCHED; PG8_LDA(At, 0, 0); PG8_STAGE(PG8_SA(1, 1), a1 + hstepA, voffA);
            PG8_WAIT_L(8); PG8_BAR; PG8_WAIT_L(0); PG8_MMA(0, 0, At, B0); PG8_BAR; PG8_SCHED;
            PG8_LDB(B1, 0, 1); PG8_STAGE(PG8_SB(0, 0), b2, voffB);
            PG8_BAR; PG8_WAIT_L(0); PG8_MMA(0, 1, At, B1); PG8_BAR;
            PG8_LDA(At, 0, 1); PG8_STAGE(PG8_SA(0, 0), a2, voffA);
            PG8_BAR; PG8_WAIT_L(0); PG8_MMA(1, 0, At, B0); PG8_BAR; PG8_SCHED;
            PG8_STAGE(PG8_SB(0, 1), b2 + hstep, voffB);
            PG8_WAIT_V(6); PG8_BAR; PG8_MMA(1, 1, At, B1); PG8_BAR;
            PG8_LDB(B0, 1, 0); PG8_SCHED; PG8_LDA(At, 1, 0); PG8_STAGE(PG8_SA(0, 1), a2 + hstepA, voffA);
            PG8_WAIT_L(8); PG8_BAR; PG8_WAIT_L(0); PG8_MMA(0, 0, At, B0); PG8_BAR; PG8_SCHED;
            PG8_LDB(B1, 1, 1); PG8_STAGE(PG8_SB(1, 0), b3, voffB);
            PG8_BAR; PG8_WAIT_L(0); PG8_MMA(0, 1, At, B1); PG8_BAR;
            PG8_LDA(At, 1, 1); PG8_STAGE(PG8_SA(1, 0), a3, voffA);
            PG8_BAR; PG8_WAIT_L(0); PG8_MMA(1, 0, At, B0); PG8_BAR; PG8_SCHED;
            PG8_STAGE(PG8_SB(1, 1), b3 + hstep, voffB);
            PG8_WAIT_V(6); PG8_BAR; PG8_MMA(1, 1, At, B1); PG8_BAR;
            }
            if constexpr (Epi::FOLD) { if ((((t + 2) & 7) == 0) && !last) E.fold(acc, ((t + 2) >> 3) - 1, cur, wr, wc, fr, fq); }
        }
        if constexpr (ALIGN_EPI) { if (wr == 0) PG8_BAR; }
        if constexpr (!Epi::AFTER_DRAIN) { E(acc, cur, wr, wc, fr, fq); S.done(cur); }
        if (!has_next) break;
#pragma unroll
        for (int a = 0; a < 2; ++a)
#pragma unroll
            for (int b = 0; b < 2; ++b)
#pragma unroll
                for (int m = 0; m < 4; ++m)
#pragma unroll
                    for (int n = 0; n < 2; ++n) acc[a][b][m][n] = (f32x4){0.f, 0.f, 0.f, 0.f};
        cur = nxt; cA = nA; cB = nB; ++ui;
        if constexpr (ALIGN_EPI) { if (wr == 1) PG8_BAR; }
    }
    PG8_WAIT_V(0);
    if constexpr (!ALIGN_EPI) { if (wr == 0) PG8_BAR; }
    PG8_BAR;
    if constexpr (Epi::AFTER_DRAIN) { E.fused(acc, cur, wr, wc, fr, fq, lds, wid, lane); S.done(cur); }
#undef PG8_SA
#undef PG8_SB
#undef PG8_STAGE
#undef PG8_LDA
#undef PG8_LDB
#undef PG8_MMA
#undef PG8_WAIT_V
#undef PG8_WAIT_L
#undef PG8_BAR
#undef PG8_SCHED
}
}
namespace mk {
#define LAS __attribute__((address_space(3)))
#define GAS __attribute__((address_space(1)))
typedef unsigned short bf16;
typedef unsigned v4u __attribute__((ext_vector_type(4)));
typedef unsigned v2u __attribute__((ext_vector_type(2)));
typedef float f32x4 __attribute__((ext_vector_type(4)));
typedef float f32x16 __attribute__((ext_vector_type(16)));
typedef float f32x2v __attribute__((ext_vector_type(2)));
typedef short bf16x8 __attribute__((ext_vector_type(8)));
typedef short s16x4 __attribute__((ext_vector_type(4)));
constexpr int SEQ = 2048, DM = 1024, NIN = 11280;
constexpr int LDP = 7424;
constexpr int PC_SLAB = 0, PC_XBC = 1792, PC_DT = 2816, PC_QKVC = 3072, PC_QKVD = 3840, PC_ZA = 5376, PC_GB = 5888, PC_GC = 6400, PC_GD = 6912;
constexpr int PC_Y = PC_ZA;
constexpr size_t W1T_N = 7424, W2T_N = 4096;
constexpr size_t WOFF_W1 = 0, WOFF_W2 = WOFF_W1 + W1T_N * 1024, WOFF_WB = WOFF_W2 + W2T_N * 1024, WOFF_WO = WOFF_WB + 4ull * 1024 * 512, W_LAYER_ELEMS = WOFF_WO + 1024ull * 1024;
#define LDS_WAIT() asm volatile("s_waitcnt lgkmcnt(0)" ::: "memory")
#define VM_WAIT() asm volatile("s_waitcnt vmcnt(0)" ::: "memory")
__device__ __forceinline__ unsigned f2bf(float f) { unsigned u = __builtin_bit_cast(unsigned, f); return (u + 0x7fffu + ((u >> 16) & 1u)) >> 16; }
__device__ __forceinline__ unsigned pk2(float lo, float hi) { return f2bf(lo) | (f2bf(hi) << 16); }
__device__ __forceinline__ float bf2f(unsigned short b) { return __builtin_bit_cast(float, (unsigned)b << 16); }
__device__ __forceinline__ float bflo(unsigned w) { return __builtin_bit_cast(float, w << 16); }
__device__ __forceinline__ float bfhi(unsigned w) { return __builtin_bit_cast(float, w & 0xffff0000u); }
__device__ __forceinline__ float lane_xor(float v, int lane, int o) { return __builtin_bit_cast(float, __builtin_amdgcn_ds_bpermute((lane ^ o) << 2, __builtin_bit_cast(int, v))); }
#define MK_DPP(x, ctrl) __builtin_bit_cast(float, __builtin_amdgcn_update_dpp(0, __builtin_bit_cast(int, (x)), (ctrl), 0xf, 0xf, true))
__device__ __forceinline__ float sum_l4(float x) { x += MK_DPP(x, 0xB1); x += MK_DPP(x, 0x4E); return x; }
__device__ __forceinline__ float sum_l8(float x) { x = sum_l4(x); x += MK_DPP(x, 0x141); return x; }
__device__ __forceinline__ float sum_l16(float x) { x = sum_l8(x); x += MK_DPP(x, 0x140); return x; }
__device__ __forceinline__ float sum_l32(float x) { x = sum_l16(x); const auto rr = __builtin_amdgcn_permlane16_swap(__float_as_uint(x), __float_as_uint(x), false, false); return __uint_as_float(rr[0]) + __uint_as_float(rr[1]); }
__device__ __forceinline__ float sum_l64(float x) { x = sum_l32(x); const auto rr = __builtin_amdgcn_permlane32_swap(__float_as_uint(x), __float_as_uint(x), false, false); return __uint_as_float(rr[0]) + __uint_as_float(rr[1]); }
__device__ __forceinline__ float wave_sum(float v, int lane) { (void)lane; return sum_l64(v); }
__device__ __forceinline__ float fsilu(float x) { return x / (1.f + __expf(-x)); }
__device__ __forceinline__ float fsigmoid(float x) { return 1.f / (1.f + __expf(-x)); }

__device__ __forceinline__ void transpose_item(const float* W, int ldw, int ldt, int c0, int nvalid, int ntotal, bf16* WT, int r0, LAS float* scr, int item, int lane) {
    const int nblk = ntotal / 32, kb = item / nblk, nb = item % nblk, k0 = 64 * kb, n0 = 32 * nb;
    const bool ok = (n0 + (lane & 31)) < nvalid;
    float wv[32];
#pragma unroll
    for (int i = 0; i < 32; ++i) { const int kk = 2 * i + (lane >> 5); wv[i] = W[(size_t)(k0 + kk) * ldw + c0 + (ok ? n0 + (lane & 31) : 0)]; }
#pragma unroll
    for (int i = 0; i < 32; ++i) { const int kk = 2 * i + (lane >> 5); scr[kk * 33 + (lane & 31)] = ok ? wv[i] : 0.f; }
    LDS_WAIT(); asm volatile("" ::: "memory");
    const int c = lane & 7;
#pragma unroll
    for (int j = 0; j < 4; ++j) { const int n = (lane >> 3) + 8 * j; const LAS float* s = scr + (8 * c) * 33 + n;
        v4u o; o.x = pk2(s[0 * 33], s[1 * 33]); o.y = pk2(s[2 * 33], s[3 * 33]); o.z = pk2(s[4 * 33], s[5 * 33]); o.w = pk2(s[6 * 33], s[7 * 33]);
        *(GAS v4u*)(WT + (size_t)(r0 + n0 + n) * ldt + k0 + 8 * c) = o; }
    LDS_WAIT(); asm volatile("" ::: "memory");
}
struct WSeg { int src, soff, ldw, c0, nvalid, ntotal; unsigned doff; int ldt, r0, ni; };
constexpr int WCONV_NSEG = 15, WCONV_ITEMS = 16 * (7424 / 32) + 16 * (4096 / 32) + 4 * 8 * (1024 / 32) + 16 * (1024 / 32);
__device__ __forceinline__ void ph_wconv(const float* w_in, const float* w_branch, const float* w_out, bf16* Wall, LAS unsigned char* lds, int gw, int ngw, int wave, int lane) {
    LAS float* scr = (LAS float*)(lds + wave * 16384);
    const WSeg segs[WCONV_NSEG] = {
        {0, 0, NIN, 1552, 1792, 1792, (unsigned)WOFF_W1, 1024, 0, 16 * 56}, {0, 0, NIN, 512, 1024, 1024, (unsigned)WOFF_W1, 1024, 1792, 16 * 32}, {0, 0, NIN, 1536, 16, 256, (unsigned)WOFF_W1, 1024, PC_DT, 16 * 8},
        {0, 0, NIN, 3856, 768, 768, (unsigned)WOFF_W1, 1024, PC_QKVC, 16 * 24}, {0, 0, NIN, 5136, 1536, 1536, (unsigned)WOFF_W1, 1024, PC_QKVD, 16 * 48}, {0, 0, NIN, 0, 512, 512, (unsigned)WOFF_W1, 1024, PC_ZA, 16 * 16},
        {0, 0, NIN, 3344, 512, 512, (unsigned)WOFF_W1, 1024, PC_GB, 16 * 16}, {0, 0, NIN, 4624, 512, 512, (unsigned)WOFF_W1, 1024, PC_GC, 16 * 16}, {0, 0, NIN, 6672, 512, 512, (unsigned)WOFF_W1, 1024, PC_GD, 16 * 16},
        {0, 0, NIN, 7184, 4096, 4096, (unsigned)WOFF_W2, 1024, 0, 16 * 128},
        {1, 0 * 512 * 1024, 1024, 0, 1024, 1024, (unsigned)WOFF_WB + 0 * 512, 2048, 0, 8 * 32}, {1, 1 * 512 * 1024, 1024, 0, 1024, 1024, (unsigned)WOFF_WB + 1 * 512, 2048, 0, 8 * 32},
        {1, 2 * 512 * 1024, 1024, 0, 1024, 1024, (unsigned)WOFF_WB + 2 * 512, 2048, 0, 8 * 32}, {1, 3 * 512 * 1024, 1024, 0, 1024, 1024, (unsigned)WOFF_WB + 3 * 512, 2048, 0, 8 * 32},
        {2, 0, 1024, 0, 1024, 1024, (unsigned)WOFF_WO, 1024, 0, 16 * 32}};
#pragma unroll 1
    for (int it0 = gw; it0 < 2 * WCONV_ITEMS; it0 += ngw) { const int l2 = it0 >= WCONV_ITEMS ? 1 : 0; int it = it0 - l2 * WCONV_ITEMS, s = 0;
#pragma unroll 1
        while (it >= segs[s].ni) { it -= segs[s].ni; ++s; }
        const WSeg g = segs[s];
        const float* src = g.src == 0 ? w_in + (size_t)l2 * 1024 * NIN : (g.src == 1 ? w_branch + (size_t)l2 * 4 * 512 * 1024 + g.soff : w_out + (size_t)l2 * 1024 * 1024);
        transpose_item(src, g.ldw, g.ldt, g.c0, g.nvalid, g.ntotal, Wall + (size_t)l2 * W_LAYER_ELEMS + g.doff, g.r0, scr, it, lane); }
}
__device__ __forceinline__ void rms_row_to_bf16(const float* xrow, const float* w, bf16* orow, int lane) {
    const GAS f32x4* xr = (const GAS f32x4*)xrow + lane; const GAS f32x4* wr = (const GAS f32x4*)w + lane;
    f32x4 v[4]; float s = 0.f;
#pragma unroll
    for (int j = 0; j < 4; ++j) { v[j] = xr[64 * j]; s += (v[j].x * v[j].x + v[j].y * v[j].y) + (v[j].z * v[j].z + v[j].w * v[j].w); }
    const float rstd = 1.f / sqrtf(wave_sum(s, lane) * (1.f / 1024.f) + 1e-6f);
    GAS unsigned long long* o8 = (GAS unsigned long long*)orow + lane;
#pragma unroll
    for (int j = 0; j < 4; ++j) { const f32x4 ww = wr[64 * j]; o8[64 * j] = (unsigned long long)pk2(v[j].x * rstd * ww.x, v[j].y * rstd * ww.y) | ((unsigned long long)pk2(v[j].z * rstd * ww.z, v[j].w * rstd * ww.w) << 32); }
}
__device__ __forceinline__ void ph_rmsnorm(const float* x, const float* w, bf16* H, int nrows, int gw, int ngw, int lane) {
    f32x4 wv4[4];
#pragma unroll
    for (int j = 0; j < 4; ++j) wv4[j] = ((const GAS f32x4*)w + lane)[64 * j];
    for (int m = gw; m < nrows; m += 2 * ngw) { const int m2 = m + ngw; const bool two = m2 < nrows;
        const GAS f32x4* xa = (const GAS f32x4*)(x + (size_t)m * 1024) + lane; const GAS f32x4* xb = (const GAS f32x4*)(x + (size_t)(two ? m2 : m) * 1024) + lane;
        f32x4 va[4], vb[4]; float sa = 0.f, sb = 0.f;
#pragma unroll
        for (int j = 0; j < 4; ++j) { va[j] = xa[64 * j]; vb[j] = xb[64 * j]; }
#pragma unroll
        for (int j = 0; j < 4; ++j) { sa += (va[j].x * va[j].x + va[j].y * va[j].y) + (va[j].z * va[j].z + va[j].w * va[j].w); sb += (vb[j].x * vb[j].x + vb[j].y * vb[j].y) + (vb[j].z * vb[j].z + vb[j].w * vb[j].w); }
        const float ra = 1.f / sqrtf(sum_l64(sa) * (1.f / 1024.f) + 1e-6f), rb = 1.f / sqrtf(sum_l64(sb) * (1.f / 1024.f) + 1e-6f);
        GAS unsigned long long* oa = (GAS unsigned long long*)(H + (size_t)m * 1024) + lane; GAS unsigned long long* ob = (GAS unsigned long long*)(H + (size_t)(two ? m2 : m) * 1024) + lane;
#pragma unroll
        for (int j = 0; j < 4; ++j) { const f32x4 ww = wv4[j];
            oa[64 * j] = (unsigned long long)pk2(va[j].x * ra * ww.x, va[j].y * ra * ww.y) | ((unsigned long long)pk2(va[j].z * ra * ww.z, va[j].w * ra * ww.w) << 32);
            if (two) ob[64 * j] = (unsigned long long)pk2(vb[j].x * rb * ww.x, vb[j].y * rb * ww.y) | ((unsigned long long)pk2(vb[j].z * rb * ww.z, vb[j].w * rb * ww.w) << 32); } }
}
__device__ __forceinline__ void ph_gemm_rsigout(LAS unsigned char* lds, const bf16* A, int lda, const bf16* Bt, int M, int N, int K, bf16* O, int ldo, int tid, int bid) {
    pg8::Gemm g{A, Bt, M, N, K, lda}; pg8::StaticOrder S; S.init(M, N, (int)gridDim.x, bid);
    pg8::EpiBf16<2> E{O, ldo, nullptr, 0, 0, 1.f};
    pg8::gemm_phase<pg8::EpiBf16<2>, pg8::StaticOrder, true, true>(lds, g, S, E, tid);
}
struct RangeOrder : pg8::StaticOrder { int first, count;
    __device__ bool next(int i, pg8::Unit& u) const { return i < count && pg8::StaticOrder::next(i + first, u); } };
__device__ __forceinline__ void ph_gemm_bf16out_range(LAS unsigned char* lds, const bf16* A, int lda, const bf16* Bt, int M, int N, int K, bf16* O, int ldo, int first, int count, int tid, int bid) {
    pg8::Gemm g{A, Bt, M, N, K, lda}; RangeOrder S; S.init(M, N, (int)gridDim.x, bid); S.first = first; S.count = count;
    pg8::EpiBf16<0> E{O, ldo, nullptr, 0, 0, 1.f};
    pg8::gemm_phase<pg8::EpiBf16<0>, RangeOrder, true, true>(lds, g, S, E, tid);
}
__device__ __forceinline__ void ph_gemm_bf16out(LAS unsigned char* lds, const bf16* A, int lda, const bf16* Bt, int M, int N, int K, bf16* O, int ldo, int tid, int bid) {
    pg8::Gemm g{A, Bt, M, N, K, lda}; pg8::StaticOrder S; S.init(M, N, (int)gridDim.x, bid);
    pg8::EpiBf16<0> E{O, ldo, nullptr, 0, 0, 1.f};
    pg8::gemm_phase<pg8::EpiBf16<0>, pg8::StaticOrder, true, true>(lds, g, S, E, tid);
}
}
namespace mk {
constexpr float C2 = 0.125f * 1.4426950408889634f;
struct EpiF32 {
    static constexpr bool PERM = false, AFTER_DRAIN = false, FOLD = false;
    float* C; int ldc;
    __device__ __forceinline__ void operator()(const pg8::f32x4 (&acc)[2][2][4][2], const pg8::Unit& u, int wr, int wc, int fr, int fq) const {
        const int row0 = u.pm * 256 + wr * 64 + fr, col0 = u.pn * 256 + wc * 32 + 4 * fq;
#pragma unroll
        for (int ai = 0; ai < 2; ++ai)
#pragma unroll
            for (int m = 0; m < 4; ++m) { float* rowp = C + (size_t)(row0 + ai * 128 + m * 16) * ldc + col0;
#pragma unroll
                for (int bj = 0; bj < 2; ++bj)
#pragma unroll
                    for (int n = 0; n < 2; ++n) *(pg8::f32x4*)(rowp + bj * 128 + n * 16) = acc[ai][bj][m][n]; }
    }
};
template <int MODE> struct EpiMerge {
    static constexpr bool PERM = false, AFTER_DRAIN = false, FOLD = false;
    float* Mf; bf16* Mb; const bf16* G; int ldg;
    __device__ __forceinline__ void operator()(const pg8::f32x4 (&acc)[2][2][4][2], const pg8::Unit& u, int wr, int wc, int fr, int fq) const {
        const int row0 = u.pm * 256 + wr * 64 + fr, col0 = u.pn * 256 + wc * 32 + 4 * fq;
#pragma unroll
        for (int ai = 0; ai < 2; ++ai)
#pragma unroll
            for (int m = 0; m < 4; ++m) { const size_t r = (size_t)(row0 + ai * 128 + m * 16);
#pragma unroll
                for (int bj = 0; bj < 2; ++bj)
#pragma unroll
                    for (int n = 0; n < 2; ++n) { const int c = col0 + bj * 128 + n * 16;
                        const v2u gw = *(const v2u*)(G + r * ldg + c);
                        pg8::f32x4 v = acc[ai][bj][m][n];
                        v[0] *= fsigmoid(bflo(gw.x)); v[1] *= fsigmoid(bfhi(gw.x)); v[2] *= fsigmoid(bflo(gw.y)); v[3] *= fsigmoid(bfhi(gw.y));
                        if (MODE > 0) v += *(const pg8::f32x4*)(Mf + r * 1024 + c);
                        if (MODE < 2) *(pg8::f32x4*)(Mf + r * 1024 + c) = v;
                        else { v2u o; o.x = pk2(v[0], v[1]); o.y = pk2(v[2], v[3]); *(v2u*)(Mb + r * 1024 + c) = o; } } }
    }
};
__device__ __forceinline__ v4u gload16(const void* base, unsigned off) { v4u r; asm volatile("global_load_dwordx4 %0, %1, %2" : "=v"(r) : "v"(off), "s"(base) : "memory"); return r; }
__device__ __forceinline__ void gwait8(v4u& a, v4u& b, v4u& c, v4u& d, v4u& e, v4u& f, v4u& g, v4u& h) { asm volatile("s_waitcnt vmcnt(0)" : "+v"(a), "+v"(b), "+v"(c), "+v"(d), "+v"(e), "+v"(f), "+v"(g), "+v"(h) :: "memory"); }
struct EpiMergeF {
    static constexpr bool PERM = true, AFTER_DRAIN = false, FOLD = true;
    bf16* Mb; const bf16* S; int lds_;
    __device__ __forceinline__ void fold(pg8::f32x4 (&acc)[2][2][4][2], int seg, const pg8::Unit& u, int wr, int wc, int fr, int fq) const {
        unsigned off0 = (unsigned)((u.pm * 256 + wr * 64 + fr) * lds_ + u.pn * 256 + wc * 32 + 8 * fq + seg * 1024) * 2u; asm volatile("" : "+v"(off0));
#pragma unroll
        for (int ai = 0; ai < 2; ++ai)
#pragma unroll
            for (int mh = 0; mh < 2; ++mh) {
                v4u sa[2][2], sb[2][2];
#pragma unroll
                for (int mm = 0; mm < 2; ++mm)
#pragma unroll
                    for (int bj = 0; bj < 2; ++bj) { const unsigned ro = off0 + (unsigned)((ai * 128 + (2 * mh + mm) * 16) * lds_) * 2u + bj * 256; sa[mm][bj] = gload16(S, ro); sb[mm][bj] = gload16(S, ro + 2048); }
                gwait8(sa[0][0], sa[0][1], sa[1][0], sa[1][1], sb[0][0], sb[0][1], sb[1][0], sb[1][1]);
#pragma unroll
                for (int mm = 0; mm < 2; ++mm)
#pragma unroll
                    for (int bj = 0; bj < 2; ++bj) { const unsigned wa[4] = {sa[mm][bj].x, sa[mm][bj].y, sa[mm][bj].z, sa[mm][bj].w}, wb[4] = {sb[mm][bj].x, sb[mm][bj].y, sb[mm][bj].z, sb[mm][bj].w};
#pragma unroll
                        for (int e = 0; e < 4; ++e) { pg8::f32x4& v = acc[ai][bj][2 * mh + mm][e >> 1]; const int o = 2 * (e & 1);
                            v[o] *= bflo(wb[e]) * __builtin_amdgcn_rcpf(bflo(wa[e])); v[o + 1] *= bfhi(wb[e]) * __builtin_amdgcn_rcpf(bfhi(wa[e])); } } }
    }
    __device__ __forceinline__ void operator()(const pg8::f32x4 (&acc)[2][2][4][2], const pg8::Unit& u, int wr, int wc, int fr, int fq) const {
        const int row0 = u.pm * 256 + wr * 64 + fr, col0 = u.pn * 256 + wc * 32 + 8 * fq;
        const unsigned off0 = (unsigned)(row0 * lds_ + col0 + 3 * 1024) * 2u;
#pragma unroll
        for (int ai = 0; ai < 2; ++ai) { v4u sa[4][2];
#pragma unroll
            for (int m = 0; m < 4; ++m)
#pragma unroll
                for (int bj = 0; bj < 2; ++bj) sa[m][bj] = gload16(S, off0 + (unsigned)((ai * 128 + m * 16) * lds_) * 2u + bj * 256);
            gwait8(sa[0][0], sa[0][1], sa[1][0], sa[1][1], sa[2][0], sa[2][1], sa[3][0], sa[3][1]);
#pragma unroll
            for (int m = 0; m < 4; ++m) { const size_t r = (size_t)(row0 + ai * 128 + m * 16);
#pragma unroll
                for (int bj = 0; bj < 2; ++bj) { const int c = col0 + bj * 128; const v4u s4 = sa[m][bj]; const pg8::f32x4 v0 = acc[ai][bj][m][0], v1 = acc[ai][bj][m][1];
                    v4u o; o.x = pk2(v0[0] * __builtin_amdgcn_rcpf(bflo(s4.x)), v0[1] * __builtin_amdgcn_rcpf(bfhi(s4.x))); o.y = pk2(v0[2] * __builtin_amdgcn_rcpf(bflo(s4.y)), v0[3] * __builtin_amdgcn_rcpf(bfhi(s4.y)));
                    o.z = pk2(v1[0] * __builtin_amdgcn_rcpf(bflo(s4.z)), v1[1] * __builtin_amdgcn_rcpf(bfhi(s4.z))); o.w = pk2(v1[2] * __builtin_amdgcn_rcpf(bflo(s4.w)), v1[3] * __builtin_amdgcn_rcpf(bfhi(s4.w)));
                    *(GAS v4u*)(Mb + r * 1024 + c) = o; } } }
    }
};
template <class Epi> __device__ __forceinline__ void run_gemm(LAS unsigned char* lds, const bf16* A, int lda, const bf16* Bt, int M, int N, int K, const Epi& E, int tid, int bid) {
    pg8::Gemm g{A, Bt, M, N, K, lda}; pg8::StaticOrder S; S.init(M, N, (int)gridDim.x, bid);
    pg8::gemm_phase<Epi, pg8::StaticOrder, true, true>(lds, g, S, E, tid);
}
__device__ __forceinline__ void ph_rope_table(float* rope, int gtid, int nthr) {
    for (int i = gtid; i < SEQ * 32; i += nthr) { const int l = i >> 5, j = i & 31; const float inv = __builtin_amdgcn_exp2f(-(float)(j & 15) * 0.83048202372184f);
        const float ang = (float)(j < 16 ? (l >> 6) : (l & 63)) * inv; rope[i] = __cosf(ang); rope[SEQ * 32 + i] = __sinf(ang); }
}
__device__ __forceinline__ void ph_prep_conv(const bf16* P, int T, const float* cw, const float* cb, const float* dtb, bf16* XC, float* DT, int gtid, int nthr) {
    { const int c = (gtid & 127) * 8;
        float wj[5][8], bb[8];
#pragma unroll
        for (int j = 0; j < 5; ++j) { const f32x4 w0 = *(const GAS f32x4*)(cw + j * 1024 + c), w1 = *(const GAS f32x4*)(cw + j * 1024 + c + 4); wj[j][0] = w0.x; wj[j][1] = w0.y; wj[j][2] = w0.z; wj[j][3] = w0.w; wj[j][4] = w1.x; wj[j][5] = w1.y; wj[j][6] = w1.z; wj[j][7] = w1.w; }
        { const f32x4 b0 = *(const GAS f32x4*)(cb + c), b1 = *(const GAS f32x4*)(cb + c + 4); bb[0] = b0.x; bb[1] = b0.y; bb[2] = b0.z; bb[3] = b0.w; bb[4] = b1.x; bb[5] = b1.y; bb[6] = b1.z; bb[7] = b1.w; }
    for (int it = gtid; it < (T >> 3) * 128; it += nthr) { const int t0 = (it >> 7) * 8, l0 = t0 & (SEQ - 1);
        v4u row[12];
#pragma unroll
        for (int r = 0; r < 12; ++r) { const int ll = l0 + r - 2; const bool ok = (ll >= 0) && (ll < SEQ); const v4u z4 = {0u, 0u, 0u, 0u};
            row[r] = ok ? *(const GAS v4u*)(P + (size_t)(t0 + r - 2) * LDP + PC_XBC + c) : z4; }
#pragma unroll
        for (int q = 0; q < 8; ++q) { float a[8];
#pragma unroll
            for (int e = 0; e < 8; ++e) a[e] = bb[e];
#pragma unroll
            for (int j = 0; j < 5; ++j) { const v4u w = row[q + j];
                a[0] += wj[j][0] * bflo(w.x); a[1] += wj[j][1] * bfhi(w.x); a[2] += wj[j][2] * bflo(w.y); a[3] += wj[j][3] * bfhi(w.y); a[4] += wj[j][4] * bflo(w.z); a[5] += wj[j][5] * bfhi(w.z); a[6] += wj[j][6] * bflo(w.w); a[7] += wj[j][7] * bfhi(w.w); }
            v4u o; o.x = pk2(fsilu(a[0]), fsilu(a[1])); o.y = pk2(fsilu(a[2]), fsilu(a[3])); o.z = pk2(fsilu(a[4]), fsilu(a[5])); o.w = pk2(fsilu(a[6]), fsilu(a[7]));
            *(GAS v4u*)(XC + (size_t)(t0 + q) * 1024 + c) = o; } } }
    for (int it = gtid; it < T * 16; it += nthr) { const int t = it >> 4, j = it & 15; const float x = bf2f(P[(size_t)t * LDP + PC_DT + j]) + dtb[j]; DT[it] = x > 20.f ? x : __logf(1.f + __expf(x)); }
}
__device__ __forceinline__ void ph_prep_gqa(const bf16* P, int T, const float* qw, const float* kw, const float* rope, bf16* Qn, bf16* Kn, int gtid, int nthr) {
    { const int j8 = gtid & 7, g8 = gtid >> 3, ng8 = nthr >> 3;
      const f32x4 qw1 = *(const GAS f32x4*)(qw + 4 * j8), qw2 = *(const GAS f32x4*)(qw + 32 + 4 * j8), kw1 = *(const GAS f32x4*)(kw + 4 * j8), kw2 = *(const GAS f32x4*)(kw + 32 + 4 * j8);
      constexpr int GR = 2;
      for (int it0 = g8; it0 < T * 10; it0 += GR * ng8) {
        int tq[GR], hq[GR]; bool okq[GR]; v2u r1[GR], r2[GR]; f32x4 cs[GR], sn[GR];
#pragma unroll
        for (int q = 0; q < GR; ++q) { const int it = it0 + q * ng8; okq[q] = it < T * 10; const int itc = okq[q] ? it : it0; tq[q] = itc / 10; hq[q] = itc - tq[q] * 10; const int l = tq[q] & (SEQ - 1);
            const bf16* src = P + (size_t)tq[q] * LDP + PC_QKVC + hq[q] * 64 + 4 * j8; r1[q] = *(const GAS v2u*)src; r2[q] = *(const GAS v2u*)(src + 32);
            cs[q] = *(const GAS f32x4*)(rope + l * 32 + 4 * j8); sn[q] = *(const GAS f32x4*)(rope + SEQ * 32 + l * 32 + 4 * j8); }
#pragma unroll
        for (int q = 0; q < GR; ++q) { const int t = tq[q], hh = hq[q]; const f32x4 w1 = hh < 8 ? qw1 : kw1, w2 = hh < 8 ? qw2 : kw2;
            const float x1[4] = {bflo(r1[q].x), bfhi(r1[q].x), bflo(r1[q].y), bfhi(r1[q].y)}, x2[4] = {bflo(r2[q].x), bfhi(r2[q].x), bflo(r2[q].y), bfhi(r2[q].y)};
            float ss = 0.f;
#pragma unroll
            for (int e = 0; e < 4; ++e) ss += x1[e] * x1[e] + x2[e] * x2[e];
            const float rs = 1.f / sqrtf(sum_l8(ss) * (1.f / 64.f) + 1e-6f), sc = hh < 8 ? C2 : 1.f; float o1[4], o2[4];
#pragma unroll
            for (int e = 0; e < 4; ++e) { const float y1 = x1[e] * rs * w1[e], y2 = x2[e] * rs * w2[e]; o1[e] = (y1 * cs[q][e] - y2 * sn[q][e]) * sc; o2[e] = (y2 * cs[q][e] + y1 * sn[q][e]) * sc; }
            bf16* dst = (hh < 8 ? Qn + (size_t)t * 512 + hh * 64 : Kn + (size_t)t * 128 + (hh - 8) * 64) + 4 * j8;
            v2u a1, a2; a1.x = pk2(o1[0], o1[1]); a1.y = pk2(o1[2], o1[3]); a2.x = pk2(o2[0], o2[1]); a2.y = pk2(o2[2], o2[3]);
            if (okq[q]) { *(GAS v2u*)dst = a1; *(GAS v2u*)(dst + 32) = a2; } } } }
}
__device__ __forceinline__ void ph_post(bf16* P, int T, const bf16* XC, const bf16* YA  , const float* d_skip, const float* norm_w,
                                        const bf16* YB  , const float* CB  , const bf16* VB  , const float* lnx_w, const float* lnx_b, int gw, int ngw, int lane) {
    const int c = lane * 8, h = lane >> 3;
    const float D = d_skip[c >> 6]; const f32x4 n0 = *(const GAS f32x4*)(norm_w + c), n1 = *(const GAS f32x4*)(norm_w + c + 4);
    const f32x4 lw0 = *(const GAS f32x4*)(lnx_w + c), lw1 = *(const GAS f32x4*)(lnx_w + c + 4), lb0 = *(const GAS f32x4*)(lnx_b + c), lb1 = *(const GAS f32x4*)(lnx_b + c + 4);
    for (int t = gw; t < T; t += ngw) {
        const v4u y0 = *(const GAS v4u*)(YA + (size_t)t * 512 + c), y1 = *(const GAS v4u*)(YA + ((size_t)T + t) * 512 + c), xs = *(const GAS v4u*)(XC + (size_t)t * 1024 + c), zz = *(const GAS v4u*)(P + (size_t)t * LDP + PC_ZA + c);
        const v4u a0 = *(const GAS v4u*)(YB + (size_t)t * 512 + c), a1 = *(const GAS v4u*)(YB + ((size_t)T + t) * 512 + c), vv = *(const GAS v4u*)(VB + (size_t)t * 512 + c), gg = *(const GAS v4u*)(P + (size_t)t * LDP + PC_GB + c);
        const float coef = CB[(size_t)h * T + t] + CB[(size_t)(8 + h) * T + t];
        {
            const unsigned yw0[4] = {y0.x, y0.y, y0.z, y0.w}, yw1[4] = {y1.x, y1.y, y1.z, y1.w}, xw[4] = {xs.x, xs.y, xs.z, xs.w}, zw[4] = {zz.x, zz.y, zz.z, zz.w}; float y[8], ss = 0.f;
#pragma unroll
            for (int e = 0; e < 4; ++e) { y[2 * e] = (bflo(yw0[e]) + bflo(yw1[e]) + bflo(xw[e]) * D) * fsilu(bflo(zw[e])); y[2 * e + 1] = (bfhi(yw0[e]) + bfhi(yw1[e]) + bfhi(xw[e]) * D) * fsilu(bfhi(zw[e])); ss += y[2 * e] * y[2 * e] + y[2 * e + 1] * y[2 * e + 1]; }
            const float r = 1.f / sqrtf(sum_l32(ss) * (1.f / 256.f) + 1e-6f);
            v4u o; o.x = pk2(y[0] * r * n0.x, y[1] * r * n0.y); o.y = pk2(y[2] * r * n0.z, y[3] * r * n0.w); o.z = pk2(y[4] * r * n1.x, y[5] * r * n1.y); o.w = pk2(y[6] * r * n1.z, y[7] * r * n1.w);
            *(GAS v4u*)(P + (size_t)t * LDP + PC_ZA + c) = o; }
        {
            float y[8] = {bflo(a0.x) + bflo(a1.x), bfhi(a0.x) + bfhi(a1.x), bflo(a0.y) + bflo(a1.y), bfhi(a0.y) + bfhi(a1.y), bflo(a0.z) + bflo(a1.z), bfhi(a0.z) + bfhi(a1.z), bflo(a0.w) + bflo(a1.w), bfhi(a0.w) + bfhi(a1.w)};
            const float v[8] = {bflo(vv.x), bfhi(vv.x), bflo(vv.y), bfhi(vv.y), bflo(vv.z), bfhi(vv.z), bflo(vv.w), bfhi(vv.w)};
            const float g[8] = {bflo(gg.x), bfhi(gg.x), bflo(gg.y), bfhi(gg.y), bflo(gg.z), bfhi(gg.z), bflo(gg.w), bfhi(gg.w)};
            float s = 0.f;
#pragma unroll
            for (int e = 0; e < 8; ++e) s += y[e];
            const float mu = sum_l8(s) * (1.f / 64.f); float q = 0.f;
#pragma unroll
            for (int e = 0; e < 8; ++e) { y[e] -= mu; q += y[e] * y[e]; }
            const float rs = 1.f / sqrtf(sum_l8(q) * (1.f / 64.f) + 64e-5f);
            const float lw[8] = {lw0.x, lw0.y, lw0.z, lw0.w, lw1.x, lw1.y, lw1.z, lw1.w}, lb[8] = {lb0.x, lb0.y, lb0.z, lb0.w, lb1.x, lb1.y, lb1.z, lb1.w}; float o[8];
#pragma unroll
            for (int e = 0; e < 8; ++e) o[e] = (y[e] * rs * lw[e] + lb[e] + coef * v[e]) * fsilu(g[e]);
            v4u ov; ov.x = pk2(o[0], o[1]); ov.y = pk2(o[2], o[3]); ov.z = pk2(o[4], o[5]); ov.w = pk2(o[6], o[7]);
            *(GAS v4u*)(P + (size_t)t * LDP + PC_GB + c) = ov; }
    }
}
__device__ __forceinline__ void ph_fin(const float* xin, const float* outf, const float* w, float* xout, const float* wn, bf16* Hn, int nrows, int gw, int ngw, int lane) {
    f32x4 wpost[4], wpre[4];
#pragma unroll
    for (int j = 0; j < 4; ++j) { wpost[j] = ((const GAS f32x4*)w + lane)[64 * j]; wpre[j] = wn ? ((const GAS f32x4*)wn + lane)[64 * j] : (f32x4){0.f, 0.f, 0.f, 0.f}; }
    for (int m = gw; m < nrows; m += 2 * ngw) { const int m2 = (m + ngw < nrows) ? m + ngw : m; const bool two = m2 != m;
        const GAS f32x4* oa = (const GAS f32x4*)(outf + (size_t)m * 1024) + lane; const GAS f32x4* ob = (const GAS f32x4*)(outf + (size_t)m2 * 1024) + lane;
        const GAS f32x4* xa = (const GAS f32x4*)(xin + (size_t)m * 1024) + lane; const GAS f32x4* xb = (const GAS f32x4*)(xin + (size_t)m2 * 1024) + lane;
        f32x4 va[4], vb[4], ya[4], yb[4]; float sa = 0.f, sb = 0.f;
#pragma unroll
        for (int j = 0; j < 4; ++j) { va[j] = oa[64 * j]; vb[j] = ob[64 * j]; ya[j] = xa[64 * j]; yb[j] = xb[64 * j]; }
#pragma unroll
        for (int j = 0; j < 4; ++j) { sa += (va[j].x * va[j].x + va[j].y * va[j].y) + (va[j].z * va[j].z + va[j].w * va[j].w); sb += (vb[j].x * vb[j].x + vb[j].y * vb[j].y) + (vb[j].z * vb[j].z + vb[j].w * vb[j].w); }
        const float ra = 1.f / sqrtf(sum_l64(sa) * (1.f / 1024.f) + 1e-6f), rb = 1.f / sqrtf(sum_l64(sb) * (1.f / 1024.f) + 1e-6f);
        GAS f32x4* pa = (GAS f32x4*)(xout + (size_t)m * 1024) + lane; GAS f32x4* pb = (GAS f32x4*)(xout + (size_t)m2 * 1024) + lane;
        float qa = 0.f, qb = 0.f;
#pragma unroll
        for (int j = 0; j < 4; ++j) { const f32x4 ww = wpost[j]; ya[j] = ya[j] + va[j] * ra * ww; yb[j] = yb[j] + vb[j] * rb * ww; pa[64 * j] = ya[j]; if (two) pb[64 * j] = yb[j];
            qa += (ya[j].x * ya[j].x + ya[j].y * ya[j].y) + (ya[j].z * ya[j].z + ya[j].w * ya[j].w); qb += (yb[j].x * yb[j].x + yb[j].y * yb[j].y) + (yb[j].z * yb[j].z + yb[j].w * yb[j].w); }
        if (wn) { const float na = 1.f / sqrtf(sum_l64(qa) * (1.f / 1024.f) + 1e-6f), nb = 1.f / sqrtf(sum_l64(qb) * (1.f / 1024.f) + 1e-6f);
            GAS unsigned long long* ha = (GAS unsigned long long*)(Hn + (size_t)m * 1024) + lane; GAS unsigned long long* hb = (GAS unsigned long long*)(Hn + (size_t)m2 * 1024) + lane;
#pragma unroll
            for (int j = 0; j < 4; ++j) { const f32x4 ww = wpre[j];
                ha[64 * j] = (unsigned long long)pk2(ya[j].x * na * ww.x, ya[j].y * na * ww.y) | ((unsigned long long)pk2(ya[j].z * na * ww.z, ya[j].w * na * ww.w) << 32);
                if (two) hb[64 * j] = (unsigned long long)pk2(yb[j].x * nb * ww.x, yb[j].y * nb * ww.y) | ((unsigned long long)pk2(yb[j].z * nb * ww.z, yb[j].w * nb * ww.w) << 32); } } }
}
}
namespace mk {
__device__ __forceinline__ void unpack8(const v4u w, float* f) { f[0] = bflo(w.x); f[1] = bfhi(w.x); f[2] = bflo(w.y); f[3] = bfhi(w.y); f[4] = bflo(w.z); f[5] = bfhi(w.z); f[6] = bflo(w.w); f[7] = bfhi(w.w); }
__device__ __forceinline__ void ph_ssd_simple(const bf16* XC, const float* DT, const float* a_log, bf16* YA, int nb, int T, int tid, int bid) {
    if (tid >= 64) return;
    const int i = bid * 64 + tid; if (i >= 2 * nb * 512) return;
    const int p = i % 64, h = (i / 64) % 8, b = (i / 512) % nb, z = i / (512 * nb);
    float s[128];
#pragma unroll
    for (int n = 0; n < 128; ++n) s[n] = 0.f;
    const float an = -expf(a_log[z * 8 + h]); const int g = h >> 2;
    for (int st = 0; st < SEQ; ++st) { const int l = z ? (SEQ - 1 - st) : st; const size_t t = (size_t)b * SEQ + l;
        const float d = DT[t * 16 + z * 8 + h]; const float dec = expf(d * an); const float xd = bf2f(XC[t * 1024 + h * 64 + p]) * d;
        const GAS v4u* Bv = (const GAS v4u*)(XC + t * 1024 + 512 + g * 128); const GAS v4u* Cv = (const GAS v4u*)(XC + t * 1024 + 768 + g * 128);
        float y = 0.f;
#pragma unroll
        for (int n8 = 0; n8 < 16; ++n8) { float bb[8], cc[8]; unpack8(Bv[n8], bb); unpack8(Cv[n8], cc);
#pragma unroll
            for (int e = 0; e < 8; ++e) { s[n8 * 8 + e] = s[n8 * 8 + e] * dec + xd * bb[e]; y += cc[e] * s[n8 * 8 + e]; } }
        YA[((size_t)z * T + t) * 512 + h * 64 + p] = (bf16)f2bf(y); }
}
__device__ __forceinline__ float shiftP(const bf16* P, int t, int ch, const float* mu) {
    const int l = t & (SEQ - 1); const float cur = bf2f(P[(size_t)t * LDP + PC_SLAB + ch]);
    const float prev = l > 0 ? bf2f(P[(size_t)(t - 1) * LDP + PC_SLAB + ch]) : 0.f; const float nxt = l < SEQ - 1 ? bf2f(P[(size_t)(t + 1) * LDP + PC_SLAB + ch]) : 0.f;
    return cur + mu[ch] * (prev - cur) + mu[1792 + ch] * (nxt - cur);
}
struct RwkvS { float *R, *V, *KK, *DEC, *BB, *KD; };
__device__ __forceinline__ void ph_rwkv_prep_simple(const bf16* P, int T, int t0, int Ts, const float* mu, const float* w0, const float* w_up, const float* a0, const float* a_up, const float* k_k, const float* k_a, const float* r_k,
                                                    RwkvS A, bf16* VB, float* CB, int gtid, int nthr) {
    for (int it = gtid; it < Ts * 512; it += nthr) { const int tl = it >> 9, c = it & 511, t = t0 + tl;
        const float r = shiftP(P, t, c, mu), k = shiftP(P, t, 512 + c, mu), v = shiftP(P, t, 1024 + c, mu);
        A.R[it] = r; A.V[it] = v; VB[(size_t)t * 512 + c] = (bf16)f2bf(v);
        const float kx = k * k_k[c]; const float ss = wave_sum(kx * kx, gtid & 63);
        const float kk = kx / sqrtf(fmaxf(ss, 1e-24f)); A.KK[it] = kk;
#pragma unroll 1
        for (int z = 0; z < 2; ++z) { float wr = w0[z * 512 + c], ar = a0[z * 512 + c];
            for (int q = 0; q < 64; ++q) { wr += tanhf(shiftP(P, t, 1536 + z * 64 + q, mu)) * w_up[((size_t)z * 64 + q) * 512 + c]; ar += shiftP(P, t, 1664 + z * 64 + q, mu) * a_up[((size_t)z * 64 + q) * 512 + c]; }
            const float sp = (-wr) > 20.f ? (-wr) : log1pf(expf(-wr)); const float dec = expf(-expf(-sp - 0.5f)); const float a = 1.f / (1.f + expf(-ar));
            const float kd = k * (1.f + (a - 1.f) * k_a[c]);
            A.DEC[(size_t)z * Ts * 512 + it] = dec; A.BB[(size_t)z * Ts * 512 + it] = kk * a; A.KD[(size_t)z * Ts * 512 + it] = kd;
            const float cb = wave_sum(r * kd * r_k[c], gtid & 63); if ((c & 63) == 0) CB[((size_t)(z * 8 + (c >> 6))) * T + t] = cb; } }
}
__device__ __forceinline__ void ph_rwkv_scan_simple(int T, int t0, int nbs, RwkvS A, bf16* YB, int tid, int bid) {
    if (tid >= 64) return;
    const int i = bid * 64 + tid; if (i >= 2 * nbs * 512) return;
    const int v = i % 64, h = (i / 64) % 8, b = (i / 512) % nbs, z = i / (512 * nbs); const int Ts = nbs * SEQ;
    float S[64];
#pragma unroll
    for (int k = 0; k < 64; ++k) S[k] = 0.f;
    for (int st = 0; st < SEQ; ++st) { const int l = z ? (SEQ - 1 - st) : st; const size_t tl = (size_t)b * SEQ + l; const size_t o = tl * 512 + h * 64, oz = ((size_t)z * Ts + tl) * 512 + h * 64;
        float sa = 0.f;
#pragma unroll
        for (int k = 0; k < 64; ++k) sa += S[k] * A.KK[o + k];
        const float vv = A.V[o + v]; float y = 0.f;
#pragma unroll
        for (int k = 0; k < 64; ++k) { S[k] = S[k] * A.DEC[oz + k] - sa * A.BB[oz + k] + vv * A.KD[oz + k]; y += S[k] * A.R[o + k]; }
        YB[((size_t)z * T + t0 + tl) * 512 + h * 64 + v] = (bf16)f2bf(y); }
}
__device__ __forceinline__ void ph_gqa_simple(bf16* P, const bf16* Qn, const bf16* Kn, int nb, int gtid, int nthr) {
    for (int it = gtid; it < nb * 8 * SEQ; it += nthr) { const int ql = it % SEQ, h = (it / SEQ) % 8, b = it / (8 * SEQ), g = h >> 2; const size_t t = (size_t)b * SEQ + ql;
        float q[64], o[64];
#pragma unroll
        for (int d8 = 0; d8 < 8; ++d8) { unpack8(*(const GAS v4u*)(Qn + t * 512 + h * 64 + d8 * 8), q + d8 * 8); }
#pragma unroll
        for (int d = 0; d < 64; ++d) o[d] = 0.f;
        float m = -1e30f, lsum = 0.f;
        for (int k = 0; k < SEQ; ++k) { const size_t tk = (size_t)b * SEQ + k; float s = 0.f;
#pragma unroll
            for (int d8 = 0; d8 < 8; ++d8) { float kf[8]; unpack8(*(const GAS v4u*)(Kn + tk * 128 + g * 64 + d8 * 8), kf);
#pragma unroll
                for (int e = 0; e < 8; ++e) s += q[d8 * 8 + e] * kf[e]; }
            const float mn = fmaxf(m, s); const float al = exp2f(m - mn), p = exp2f(s - mn); m = mn; lsum = lsum * al + p;
#pragma unroll
            for (int d8 = 0; d8 < 8; ++d8) { float vf[8]; unpack8(*(const GAS v4u*)(P + tk * LDP + PC_QKVC + 640 + g * 64 + d8 * 8), vf);
#pragma unroll
                for (int e = 0; e < 8; ++e) o[d8 * 8 + e] = o[d8 * 8 + e] * al + p * vf[e]; } }
        const float il = 1.f / lsum;
#pragma unroll
        for (int d8 = 0; d8 < 8; ++d8) { GAS v4u* dst = (GAS v4u*)(P + t * LDP + PC_GC + h * 64 + d8 * 8); float gf[8]; unpack8(*dst, gf); v4u ov;
            ov.x = pk2(o[d8 * 8 + 0] * il * fsilu(gf[0]), o[d8 * 8 + 1] * il * fsilu(gf[1])); ov.y = pk2(o[d8 * 8 + 2] * il * fsilu(gf[2]), o[d8 * 8 + 3] * il * fsilu(gf[3]));
            ov.z = pk2(o[d8 * 8 + 4] * il * fsilu(gf[4]), o[d8 * 8 + 5] * il * fsilu(gf[5])); ov.w = pk2(o[d8 * 8 + 6] * il * fsilu(gf[6]), o[d8 * 8 + 7] * il * fsilu(gf[7])); *dst = ov; } }
}
__device__ __forceinline__ void ph_na_simple(bf16* P, const float* rpb, int nb, int gtid, int nthr) {
    for (int it = gtid; it < nb * 8 * SEQ; it += nthr) { const int ql = it % SEQ, h = (it / SEQ) % 8, b = it / (8 * SEQ); const size_t t = (size_t)b * SEQ + ql; const int qr = ql >> 6, qc = ql & 63;
        int rs = qr - 4; rs = rs < 0 ? 0 : (rs > 24 ? 24 : rs); int cs = qc - 8; cs = cs < 0 ? 0 : (cs > 48 ? 48 : cs);
        float q[64], o[64];
#pragma unroll
        for (int d8 = 0; d8 < 8; ++d8) { unpack8(*(const GAS v4u*)(P + t * LDP + PC_QKVD + h * 64 + d8 * 8), q + d8 * 8); }
#pragma unroll
        for (int d = 0; d < 64; ++d) { q[d] *= 0.125f; o[d] = 0.f; }
        float m = -1e30f, lsum = 0.f;
        for (int i = 0; i < 128; ++i) { const int kr = rs + (i >> 4), kc = cs + (i & 15); const size_t tk = (size_t)b * SEQ + kr * 64 + kc; float s = 0.f;
#pragma unroll
            for (int d8 = 0; d8 < 8; ++d8) { float kf[8]; unpack8(*(const GAS v4u*)(P + tk * LDP + PC_QKVD + 512 + h * 64 + d8 * 8), kf);
#pragma unroll
                for (int e = 0; e < 8; ++e) s += q[d8 * 8 + e] * kf[e]; }
            s += rpb[h * 465 + (kr - qr + 7) * 31 + (kc - qc + 15)];
            const float mn = fmaxf(m, s); const float al = __expf(m - mn), p = __expf(s - mn); m = mn; lsum = lsum * al + p;
#pragma unroll
            for (int d8 = 0; d8 < 8; ++d8) { float vf[8]; unpack8(*(const GAS v4u*)(P + tk * LDP + PC_QKVD + 1024 + h * 64 + d8 * 8), vf);
#pragma unroll
                for (int e = 0; e < 8; ++e) o[d8 * 8 + e] = o[d8 * 8 + e] * al + p * vf[e]; } }
        const float il = 1.f / lsum;
#pragma unroll
        for (int d8 = 0; d8 < 8; ++d8) { GAS v4u* dst = (GAS v4u*)(P + t * LDP + PC_GD + h * 64 + d8 * 8); float gf[8]; unpack8(*dst, gf); v4u ov;
            ov.x = pk2(o[d8 * 8 + 0] * il * fsilu(gf[0]), o[d8 * 8 + 1] * il * fsilu(gf[1])); ov.y = pk2(o[d8 * 8 + 2] * il * fsilu(gf[2]), o[d8 * 8 + 3] * il * fsilu(gf[3]));
            ov.z = pk2(o[d8 * 8 + 4] * il * fsilu(gf[4]), o[d8 * 8 + 5] * il * fsilu(gf[5])); ov.w = pk2(o[d8 * 8 + 6] * il * fsilu(gf[6]), o[d8 * 8 + 7] * il * fsilu(gf[7])); *dst = ov; } }
}
}
#include <hip/hip_bf16.h>
namespace attn_body {
using bf16=__hip_bfloat16;
using bf16x8=__attribute__((ext_vector_type(8)))short;
using s16x4=__attribute__((ext_vector_type(4)))short;
using f32x16=__attribute__((ext_vector_type(16)))float;
using u32x4=__attribute__((ext_vector_type(4)))unsigned;
constexpr int SEQ=2048,D=64;
constexpr int NW=8,QBLK=32,QB=QBLK*NW,KVBLK=64,NQB=SEQ/QB;
__device__ __forceinline__ int crow(int r,int hi){return (r&3)+8*(r>>2)+4*hi;}
#define SBAR() __builtin_amdgcn_sched_barrier(0)
constexpr int NSLOT=3, SLOTB=8192;
constexpr int LDS_K=0, LDS_V=NSLOT*SLOTB, LDS_WS=2*NSLOT*SLOTB, LDS_OST=LDS_WS+NW*64*4, LDS_RPB=LDS_OST+NW*4096,LDS_BYTES=LDS_RPB+2048;
constexpr float C2=0.125f*1.4426950408889634f;
__device__ __forceinline__ void glds16(const void*gsrc,unsigned lds_dst){unsigned keep;
  asm volatile("s_mov_b32 %0, m0\n\ts_mov_b32 m0, %2\n\ts_nop 0\n\tglobal_load_lds_dwordx4 %1, off\n\ts_mov_b32 m0, %0":"=&s"(keep):"v"(gsrc),"s"(lds_dst):"memory");}
__device__ __forceinline__ float max3f(float a,float b,float c){float r;asm("v_max3_f32 %0, %1, %2, %3":"=v"(r):"v"(a),"v"(b),"v"(c));return r;}
__device__ __forceinline__ float max2f(float a,float b){float r;asm("v_max_f32_e32 %0, %1, %2":"=v"(r):"v"(a),"v"(b));return r;}
__device__ __forceinline__ float fadd_s(float a,float b){float r;asm("v_add_f32_e32 %0, %1, %2":"=v"(r):"v"(a),"v"(b));return r;}
__device__ __forceinline__ float fsub_s(float a,float b){float r;asm("v_sub_f32_e32 %0, %1, %2":"=v"(r):"v"(a),"v"(b));return r;}
typedef float f32x2_t __attribute__((ext_vector_type(2))); typedef __bf16 bf16x2_t __attribute__((ext_vector_type(2)));
__device__ __forceinline__ unsigned cvtpk_s(float lo,float hi){f32x2_t v={lo,hi};bf16x2_t b=__builtin_convertvector(v,bf16x2_t);return __builtin_bit_cast(unsigned,b);}
#define WAIT_BAR(N) asm volatile("s_waitcnt vmcnt(" #N ") lgkmcnt(0)\n\ts_barrier":::"memory")

__device__ __forceinline__ void qkt(f32x16&p0,f32x16&p1,const char*Kslot,const bf16x8*qr,int r32,int hi){ const f32x16 negm=f32x16{};
  const char*kb=Kslot+hi*1024+r32*16;
  #pragma unroll
  for(int d0=0;d0<4;++d0){
    const bf16x8 b0=*reinterpret_cast<const bf16x8*>(kb+d0*2048);
    const bf16x8 b1=*reinterpret_cast<const bf16x8*>(kb+d0*2048+512);
    if(d0==0){p0=__builtin_amdgcn_mfma_f32_32x32x16_bf16(b0,qr[0],negm,0,0,0);p1=__builtin_amdgcn_mfma_f32_32x32x16_bf16(b1,qr[0],negm,0,0,0);}
    else{p0=__builtin_amdgcn_mfma_f32_32x32x16_bf16(b0,qr[d0],p0,0,0,0);p1=__builtin_amdgcn_mfma_f32_32x32x16_bf16(b1,qr[d0],p1,0,0,0);}}
}
typedef __attribute__((address_space(3))) const char* lds_cptr;
typedef short v4i16_t __attribute__((ext_vector_type(4)));
__device__ __forceinline__ void kload8(bf16x8*kf,lds_cptr kp){
  kf[0]=*(const __attribute__((address_space(3))) bf16x8*)(kp);      kf[1]=*(const __attribute__((address_space(3))) bf16x8*)(kp+512);
  kf[2]=*(const __attribute__((address_space(3))) bf16x8*)(kp+2048); kf[3]=*(const __attribute__((address_space(3))) bf16x8*)(kp+2560);
  kf[4]=*(const __attribute__((address_space(3))) bf16x8*)(kp+4096); kf[5]=*(const __attribute__((address_space(3))) bf16x8*)(kp+4608);
  kf[6]=*(const __attribute__((address_space(3))) bf16x8*)(kp+6144); kf[7]=*(const __attribute__((address_space(3))) bf16x8*)(kp+6656);
}
__device__ __forceinline__ void kload2(bf16x8*kf,lds_cptr kp,int j){ kf[2*j]=*(const __attribute__((address_space(3))) bf16x8*)(kp+j*2048); kf[2*j+1]=*(const __attribute__((address_space(3))) bf16x8*)(kp+j*2048+512); }
__device__ __forceinline__ s16x4 vtr(lds_cptr p){ return __builtin_bit_cast(s16x4,__builtin_amdgcn_ds_read_tr16_b64_v4i16((__attribute__((address_space(3))) v4i16_t*)p)); }
__device__ __forceinline__ float rowmax(const f32x16&p0,const f32x16&p1){
  float a=max3f(p0[0],p0[1],p1[0]),b=max3f(p0[2],p0[3],p1[1]);a=max3f(a,p1[2],p1[3]);
  #pragma unroll
  for(int r=4;r<16;r+=4){a=max3f(a,p0[r],p0[r+1]);b=max3f(b,p0[r+2],p0[r+3]);a=max3f(a,p1[r],p1[r+1]);b=max3f(b,p1[r+2],p1[r+3]);}
  const float m=max2f(a,b);
  auto rr=__builtin_amdgcn_permlane32_swap(__float_as_uint(m),__float_as_uint(m),false,false);
  return max2f(__uint_as_float(rr[0]),__uint_as_float(rr[1]));
}
__device__ __forceinline__ void pv(f32x16*o,int vb,bf16x8 pa0,bf16x8 pa1,bf16x8 pa2,bf16x8 pa3){
  #pragma unroll
  for(int d0=0;d0<2;++d0){s16x4 lo[4],hi[4];
    #pragma unroll
    for(int ks=0;ks<4;++ks){
      asm volatile("ds_read_b64_tr_b16 %0,%1 offset:%c2":"=&v"(lo[ks]):"v"(vb),"i"(d0*4096+ks*1024):"memory");
      asm volatile("ds_read_b64_tr_b16 %0,%1 offset:%c2":"=&v"(hi[ks]):"v"(vb),"i"(d0*4096+ks*1024+512):"memory");}
    asm volatile("s_waitcnt lgkmcnt(0)":::"memory");SBAR();
    #define PK(k) (bf16x8){lo[k][0],lo[k][1],lo[k][2],lo[k][3],hi[k][0],hi[k][1],hi[k][2],hi[k][3]}
    o[d0]=__builtin_amdgcn_mfma_f32_32x32x16_bf16(pa0,PK(0),o[d0],0,0,0);
    o[d0]=__builtin_amdgcn_mfma_f32_32x32x16_bf16(pa1,PK(1),o[d0],0,0,0);
    o[d0]=__builtin_amdgcn_mfma_f32_32x32x16_bf16(pa2,PK(2),o[d0],0,0,0);
    o[d0]=__builtin_amdgcn_mfma_f32_32x32x16_bf16(pa3,PK(3),o[d0],0,0,0);
    #undef PK
  }
}

struct AttnP { const bf16* Qw0; const bf16* Kh; const bf16* Vh; bf16* Ow0; int NT; int tbase; int toff; int qr0; float qscale; };
template<int THRL,int MODE,int QP,int KP,int VP,int OP> __device__ __forceinline__ void attn_unit(const AttnP&A,char*shm,const int tid){
  const int lane=tid&63,r32=lane&31,hi=lane>>5; const int wid=__builtin_amdgcn_readfirstlane(tid>>6);
  const bf16*Qw=A.Qw0+(long)(wid*QBLK)*QP;
  const bf16*Kh=A.Kh,*Vh=A.Vh;
  const int NT=A.NT;
  #define TROW(t) ((MODE==1)?(A.tbase+(((t)+A.toff)%NT)):(t))
  const unsigned lds0=(unsigned)(uintptr_t)shm;
  float*wsf=(float*)(shm+LDS_WS)+wid*64;
  const bf16*ksrc=Kh+(long)lane*KP+wid*8;
  const bf16*vsrc=Vh+(long)(16*(wid&3)+(lane>>2))*VP+(wid>>2)*32+(lane&3)*8;
  const unsigned kdst=lds0+LDS_K+wid*1024, vdst=lds0+LDS_V+wid*1024;
  #define DMA_K(t,slot) glds16(ksrc+(long)TROW(t)*KVBLK*KP,(unsigned)__builtin_amdgcn_readfirstlane(kdst+(slot)))
  #define DMA_V(t,slot) glds16(vsrc+(long)TROW(t)*KVBLK*VP,(unsigned)__builtin_amdgcn_readfirstlane(vdst+(slot)))
  const int vb0=(int)(lds0+LDS_V)+((lane>>4)&1)*32+(lane&3)*8+(4*hi+((lane&15)>>2))*64;
  const char*Kbase=shm+LDS_K; bf16x8 kf[8];
  const lds_cptr shm3=(lds_cptr)shm; const lds_cptr kp0=shm3+LDS_K+hi*1024+r32*16; const lds_cptr vp0=shm3+LDS_V+((lane>>4)&1)*32+(lane&3)*8+(4*hi+((lane&15)>>2))*64;
  DMA_K(0,0);DMA_V(0,0);DMA_K(1,SLOTB);
  bf16x8 qr[4];
  #pragma unroll
  for(int d0=0;d0<4;++d0)qr[d0]=*reinterpret_cast<const bf16x8*>(&Qw[(long)r32*QP+d0*16+hi*8]);
  if(MODE==1){
    #pragma unroll
    for(int d0=0;d0<4;++d0){ u32x4 w=__builtin_bit_cast(u32x4,qr[d0]);
      #pragma unroll
      for(int j=0;j<4;++j){ const float lo=__uint_as_float(w[j]<<16)*A.qscale, hv=__uint_as_float(w[j]&0xffff0000u)*A.qscale; w[j]=cvtpk_s(lo,hv);} qr[d0]=__builtin_bit_cast(bf16x8,w);} }
  const int na_qr=A.qr0+(wid>>1), na_qc=32*(wid&1)+r32; int na_rs=na_qr-4; na_rs=na_rs<0?0:(na_rs>24?24:na_rs); int na_cs=na_qc-8; na_cs=na_cs<0?0:(na_cs>48?48:na_cs);
  const float*rpbl=(const float*)(shm+LDS_RPB);
  #define NAMASK(P0,P1,t) do{ if(MODE==1){ const int kr_=TROW(t); const bool wv_=(kr_>=na_rs)&&(kr_<=na_rs+7); const float*tb_=rpbl+(kr_-na_qr+7)*31+(15-na_qc); const float NEG_=-INFINITY; \
      _Pragma("unroll") for(int r=0;r<16;++r){ const int kc_=crow(r,hi); const bool o0_=wv_&&(kc_>=na_cs)&&(kc_<na_cs+16); const bool o1_=wv_&&(kc_+32>=na_cs)&&(kc_+32<na_cs+16); \
        const float b0_=o0_?tb_[kc_]:0.f; const float b1_=o1_?tb_[kc_+32]:0.f; P0[r]=o0_?(P0[r]+b0_):NEG_; P1[r]=o1_?(P1[r]+b1_):NEG_; } } }while(0)
  float mhat=0.f,l_reg=0.f;f32x16 o[2];o[0]=f32x16{};o[1]=f32x16{};
  #define CMASK(P0,P1,t) NAMASK(P0,P1,t)
  bool resc=false;
  #define START(P0,P1) do{ const float rm=rowmax(P0,P1); resc=false; \
    { const float dl=rm; mhat=fadd_s(mhat,dl); \
      _Pragma("unroll") for(int r=0;r<16;++r){P0[r]=fsub_s(P0[r],dl);P1[r]=fsub_s(P1[r],dl);} \
      } \
    _Pragma("unroll") for(int r=0;r<16;++r)P0[r]=__builtin_amdgcn_exp2f(P0[r]); }while(0)
  #define RESC() do{ if(resc){ asm volatile("s_waitcnt lgkmcnt(0)":::"memory"); \
      _Pragma("unroll") for(int d_=0;d_<2;++d_) _Pragma("unroll") for(int r=0;r<16;++r)o[d_][r]*=wsf[crow(r,hi)]; } }while(0)
  f32x16 pA0,pA1,pB0,pB1;
  int sl_prev=0,sl_cur=0,sl_next=SLOTB;
  #define ROT() do{sl_prev=sl_cur;sl_cur=sl_next;sl_next=(sl_next==(NSLOT-1)*SLOTB)?0:sl_next+SLOTB;}while(0)
  DMA_K(2,2*SLOTB);
  WAIT_BAR(3);
  qkt(pA0,pA1,Kbase,qr,r32,hi);asm volatile("s_nop 15\n\ts_nop 7":"+v"(pA0),"+v"(pA1));CMASK(pA0,pA1,0);
  START(pA0,pA1);
  _Pragma("unroll") for(int r=0;r<16;++r)pA1[r]=__builtin_amdgcn_exp2f(pA1[r]);
  WAIT_BAR(0);
  DMA_K(3,0);DMA_V(1,SLOTB);
  ROT();
  kload8(kf,kp0+sl_cur);
  WAIT_BAR(2);
  s16x4 vlo[8],vhi[8]; u32x4 pw0,pw1,pw2,pw3;
  #define PKW(P,B) cvtpk_s(P[B],P[B+1])
  #define PAF(k) __builtin_bit_cast(bf16x8,pw##k)
  #define VFR(i) (bf16x8){vlo[i][0],vlo[i][1],vlo[i][2],vlo[i][3],vhi[i][0],vhi[i][1],vhi[i][2],vhi[i][3]}
  #define PIN(x) asm volatile("":"+v"(x))
  #define MX3(a,b,c) __builtin_fmaxf(__builtin_fmaxf((a),(b)),(c))
  #define GAPA(MF,A0,A1,A2,A3,W0,W1,PW) do{ MF; sacc+=A0; sacc+=A1; sacc+=A2; sacc+=A3; PIN(sacc); W0; W1; PIN(PW); SBAR(); }while(0)
  #define EX(v) __builtin_amdgcn_exp2f(v)
  #define GAPB(MF,X,B) do{ MF; X[B]=EX(X[B]); X[B+1]=EX(X[B+1]); X[B+2]=EX(X[B+2]); X[B+3]=EX(X[B+3]); PIN(X); SBAR(); }while(0)
  #define VRD(i) do{ vlo[i]=vtr(vp_+(((i)>>2)*4096+((i)&3)*1024)); vhi[i]=vtr(vp_+(((i)>>2)*4096+((i)&3)*1024+512)); }while(0)
  #define KRD(G,j) do{ if(G){ kload2(kf,kp0+sl_next,j); SBAR(); } }while(0)
  #define STEP(C0,C1,P0,P1,t,GK,GV,GL) do{ SBAR(); const f32x16 ZC_=f32x16{}; \
    const lds_cptr vp_=vp0+sl_prev; \
    VRD(0); SBAR(); float sacc=(P0[0]+P0[1]); \
    GAPA(C0=__builtin_amdgcn_mfma_f32_32x32x16_bf16(kf[0],qr[0],ZC_,0,0,0), P0[2],P0[3],P0[4],P0[5],     pw0[0]=PKW(P0,0), pw0[1]=PKW(P0,2), pw0); \
    VRD(4); SBAR(); GAPA(C1=__builtin_amdgcn_mfma_f32_32x32x16_bf16(kf[1],qr[0],ZC_,0,0,0), P0[6],P0[7],P0[8],P0[9],     pw0[2]=PKW(P0,4), pw0[3]=PKW(P0,6), pw0); \
    VRD(1); SBAR(); GAPA(C0=__builtin_amdgcn_mfma_f32_32x32x16_bf16(kf[2],qr[1],C0,0,0,0),   P0[10],P0[11],P0[12],P0[13], pw1[0]=PKW(P0,8), pw1[1]=PKW(P0,10), pw1); \
    VRD(5); SBAR(); GAPA(C1=__builtin_amdgcn_mfma_f32_32x32x16_bf16(kf[3],qr[1],C1,0,0,0),   P0[14],P0[15],P1[0],P1[1],   pw1[2]=PKW(P0,12),pw1[3]=PKW(P0,14), pw1); \
    VRD(2); SBAR(); GAPA(C0=__builtin_amdgcn_mfma_f32_32x32x16_bf16(kf[4],qr[2],C0,0,0,0),   P1[2],P1[3],P1[4],P1[5],     pw2[0]=PKW(P1,0), pw2[1]=PKW(P1,2), pw2); \
    VRD(6); SBAR(); GAPA(C1=__builtin_amdgcn_mfma_f32_32x32x16_bf16(kf[5],qr[2],C1,0,0,0),   P1[6],P1[7],P1[8],P1[9],     pw2[2]=PKW(P1,4), pw2[3]=PKW(P1,6), pw2); \
    VRD(3); SBAR(); GAPA(C0=__builtin_amdgcn_mfma_f32_32x32x16_bf16(kf[6],qr[3],C0,0,0,0),   P1[10],P1[11],P1[12],P1[13], pw3[0]=PKW(P1,8), pw3[1]=PKW(P1,10), pw3); \
    VRD(7); SBAR(); GAPA(C1=__builtin_amdgcn_mfma_f32_32x32x16_bf16(kf[7],qr[3],C1,0,0,0),   P1[14],P1[15],0.f,0.f,       pw3[2]=PKW(P1,12),pw3[3]=PKW(P1,14), pw3); \
    l_reg+=sacc; \
    if(GK){DMA_K((t)+3,sl_cur);} if(GV){DMA_V((t)+1,sl_next);} \
    _Pragma("unroll") for(int r=0;r<16;++r){C0[r]-=mhat;C1[r]-=mhat;} \
    CMASK(C0,C1,t); \
    { float a=MX3(C0[0],C0[1],C1[0]),b=MX3(C0[2],C0[3],C1[1]); a=MX3(a,C1[2],C1[3]); \
      _Pragma("unroll") for(int r=4;r<16;r+=4){a=MX3(a,C0[r],C0[r+1]);b=MX3(b,C0[r+2],C0[r+3]);a=MX3(a,C1[r],C1[r+1]);b=MX3(b,C1[r+2],C1[r+3]);} \
      float rm=__builtin_fmaxf(a,b); { auto rr=__builtin_amdgcn_permlane32_swap(__float_as_uint(rm),__float_as_uint(rm),false,false); rm=__builtin_fmaxf(__uint_as_float(rr[0]),__uint_as_float(rr[1])); } \
      resc=false; \
      if(__builtin_expect(__any(rm>(float)THRL),0)){ const float dl=__builtin_fmaxf(rm,0.f); mhat+=dl; \
        _Pragma("unroll") for(int r=0;r<16;++r){C0[r]-=dl;C1[r]-=dl;} \
        const float f=__builtin_amdgcn_exp2f(-dl); l_reg*=f; if(hi==0)wsf[r32]=f; resc=true; } } \
    SBAR(); \
    GAPB(o[0]=__builtin_amdgcn_mfma_f32_32x32x16_bf16(PAF(0),VFR(0),o[0],0,0,0), C0,0); \
    GAPB(o[1]=__builtin_amdgcn_mfma_f32_32x32x16_bf16(PAF(0),VFR(4),o[1],0,0,0), C0,4); \
    KRD(GL,0); GAPB(o[0]=__builtin_amdgcn_mfma_f32_32x32x16_bf16(PAF(1),VFR(1),o[0],0,0,0), C0,8); \
    KRD(GL,1); GAPB(o[1]=__builtin_amdgcn_mfma_f32_32x32x16_bf16(PAF(1),VFR(5),o[1],0,0,0), C0,12); \
    KRD(GL,2); GAPB(o[0]=__builtin_amdgcn_mfma_f32_32x32x16_bf16(PAF(2),VFR(2),o[0],0,0,0), C1,0); \
    KRD(GL,3); GAPB(o[1]=__builtin_amdgcn_mfma_f32_32x32x16_bf16(PAF(2),VFR(6),o[1],0,0,0), C1,4); \
    GAPB(o[0]=__builtin_amdgcn_mfma_f32_32x32x16_bf16(PAF(3),VFR(3),o[0],0,0,0), C1,8); \
    GAPB(o[1]=__builtin_amdgcn_mfma_f32_32x32x16_bf16(PAF(3),VFR(7),o[1],0,0,0), C1,12); \
    }while(0)
  int t=1;
  for(;t+5<NT;t+=2){
    STEP(pB0,pB1,pA0,pA1,t,true,true,true);     WAIT_BAR(2); RESC(); ROT();
    STEP(pA0,pA1,pB0,pB1,t+1,true,true,true);   WAIT_BAR(2); RESC(); ROT();
  }
  #define ENDW(tt) do{ if((tt)+3<NT){WAIT_BAR(2);} else if((tt)+2<NT){WAIT_BAR(1);} else {WAIT_BAR(0);} }while(0)
  for(;t+1<NT;t+=2){
    STEP(pB0,pB1,pA0,pA1,t,(t+3<NT),(t+1<NT),(t+1<NT));       ENDW(t);   RESC(); ROT();
    STEP(pA0,pA1,pB0,pB1,t+1,(t+4<NT),(t+2<NT),(t+2<NT));     ENDW(t+1); RESC(); ROT();
  }
  STEP(pB0,pB1,pA0,pA1,NT-1,false,false,false); RESC();
  { float sacc=pB0[0]+pB0[1]; _Pragma("unroll") for(int r=2;r<16;++r)sacc+=pB0[r]; _Pragma("unroll") for(int r=0;r<16;++r)sacc+=pB1[r]; l_reg+=sacc;
    pw0=(u32x4){PKW(pB0,0),PKW(pB0,2),PKW(pB0,4),PKW(pB0,6)};pw1=(u32x4){PKW(pB0,8),PKW(pB0,10),PKW(pB0,12),PKW(pB0,14)};pw2=(u32x4){PKW(pB1,0),PKW(pB1,2),PKW(pB1,4),PKW(pB1,6)};pw3=(u32x4){PKW(pB1,8),PKW(pB1,10),PKW(pB1,12),PKW(pB1,14)};
    SBAR(); pv(o,vb0+sl_cur,PAF(0),PAF(1),PAF(2),PAF(3)); }
  #undef PKW
  #undef PAF
  #undef VFR
  #undef PIN
  #undef MX3
  #undef GAPA
  #undef GAPB
  #undef EX
  #undef VRD
  #undef KRD
  #undef STEP
  #undef ENDW
  {auto rr=__builtin_amdgcn_permlane32_swap(__float_as_uint(l_reg),__float_as_uint(l_reg),false,false);l_reg=__uint_as_float(rr[0])+__uint_as_float(rr[1]);}
  if(hi==0)wsf[32+r32]=l_reg;asm volatile("s_waitcnt lgkmcnt(0)":::"memory");
  float rli[16];
  #pragma unroll
  for(int r=0;r<16;++r)rli[r]=__builtin_amdgcn_rcpf(wsf[32+crow(r,hi)]);
  bf16*Ow=A.Ow0+(long)(wid*QBLK)*OP;
  { bf16*stg=(bf16*)(shm+LDS_OST)+wid*2048;
    #pragma unroll
    for(int r=0;r<16;++r){const int orow=crow(r,hi);
      #pragma unroll
      for(int d0=0;d0<2;++d0)stg[orow*64+d0*32+r32]=__float2bfloat16(o[d0][r]*rli[r]);}
    asm volatile("s_waitcnt lgkmcnt(0)":::"memory");
    #pragma unroll
    for(int i=0;i<4;++i){const int row=i*8+(lane>>3),ch=lane&7; const u32x4 v=*(const u32x4*)(stg+row*64+ch*8); u32x4*dst=(u32x4*)(Ow+(long)row*OP+ch*8); const u32x4 g=*dst; u32x4 w;
      #pragma unroll
      for(int j=0;j<4;++j){ const float g0=__uint_as_float(g[j]<<16),g1=__uint_as_float(g[j]&0xffff0000u); const float o0=__uint_as_float(v[j]<<16),o1=__uint_as_float(v[j]&0xffff0000u);
        w[j]=cvtpk_s(o0*g0/(1.f+__expf(-g0)),o1*g1/(1.f+__expf(-g1))); }
      *dst=w; } }
  asm volatile("s_waitcnt lgkmcnt(0)\n\ts_barrier":::"memory");
  #undef DMA_K
  #undef DMA_V
  #undef CMASK
  #undef NAMASK
  #undef TROW
  #undef START
  #undef RESC
  #undef ROT
}
constexpr int ATTN_LDS_BYTES=LDS_BYTES;

#undef SBAR
#undef WAIT_BAR
}
namespace mk {
__device__ __forceinline__ void ph_attn(char* shm, bf16* P, const bf16* Qn, const bf16* Kn, const float* rpb, int nb, int tid, unsigned* ticket, volatile LAS unsigned* slot) {
    using attn_body::AttnP; typedef attn_body::bf16 abf;
    const int nunits = nb * 64;
#pragma unroll 1
    for (;;) {
        if (tid == 0) *slot = __hip_atomic_fetch_add(ticket, 1u, __ATOMIC_RELAXED, __HIP_MEMORY_SCOPE_AGENT);
        __syncthreads();
        const int uu = (int)__builtin_amdgcn_readfirstlane((int)*slot);
        __syncthreads();
        if (uu >= 2 * nunits) break;
        if (uu < nunits) { const int u = uu; const int b = u >> 6, h = (u >> 3) & 7, qb = u & 7, g = h >> 2; const size_t rb = (size_t)b * SEQ;
            AttnP A; A.Qw0 = (const abf*)(Qn + (rb + qb * 256) * 512 + h * 64); A.Kh = (const abf*)(Kn + rb * 128 + g * 64);
            A.Vh = (const abf*)(P + rb * LDP + PC_QKVC + 640 + g * 64); A.Ow0 = (abf*)(P + (rb + qb * 256) * LDP + PC_GC + h * 64);
            A.NT = 32; A.tbase = 0; A.toff = 0; A.qr0 = 0; A.qscale = 1.f;
            int tid2 = tid; asm volatile("" : "+v"(tid2)); attn_body::attn_unit<8, 0, 512, 128, LDP, LDP>(A, shm, tid2);
        } else { const int u = uu - nunits; const int b = u >> 6, h = (u >> 3) & 7, qb = u & 7; const size_t rb = (size_t)b * SEQ; const int qr0 = qb * 4;
            { float* tb = (float*)(shm + attn_body::LDS_RPB); for (int i = tid; i < 465; i += 512) tb[i] = rpb[h * 465 + i] * 1.4426950408889634f; }
            int rs0 = qr0 - 4; rs0 = rs0 < 0 ? 0 : (rs0 > 24 ? 24 : rs0); int rs3 = qr0 - 1; rs3 = rs3 < 0 ? 0 : (rs3 > 24 ? 24 : rs3); int NT = rs3 - rs0 + 8; NT += (NT & 1);
            AttnP A; A.Qw0 = (const abf*)(P + (rb + qb * 256) * LDP + PC_QKVD + h * 64); A.Kh = (const abf*)(P + rb * LDP + PC_QKVD + 512 + h * 64);
            A.Vh = (const abf*)(P + rb * LDP + PC_QKVD + 1024 + h * 64); A.Ow0 = (abf*)(P + (rb + qb * 256) * LDP + PC_GD + h * 64);
            A.NT = NT; A.tbase = rs0; A.toff = rs3 - rs0; A.qr0 = qr0; A.qscale = C2;
            int tid2 = tid; asm volatile("" : "+v"(tid2)); attn_body::attn_unit<8, 1, LDP, LDP, LDP, LDP>(A, shm, tid2); }
    }
}
}
namespace mk {
constexpr int RW_CH = 32;
constexpr int RW_P64 = 144, RW_P32 = 80, RW_TA_ROW = 144;
constexpr int RW_CONST = 0;
constexpr int RW_TA_LO = 4 * RW_TA_ROW;
constexpr int RW_PW = RW_CONST + 960 * 4, RW_PWB = 2 * RW_TA_LO + 2 * 4 * 64 * 4;
constexpr int RW_WT = RW_PW + 8 * RW_PWB;
constexpr int RW_WTOT = RW_WT + 2 * 64 * RW_TA_ROW;
constexpr int RW_TAL = RW_WTOT + 8 * 64 * 4;
constexpr int RW_TS = RW_TAL + 32 * RW_P64;
constexpr int O_TRH = 0, O_TBE = O_TRH + 32 * RW_P64, O_TKA = O_TBE + 32 * RW_P64, O_TBP = O_TKA + 32 * RW_P64, O_TKP = O_TBP + 64 * RW_P32, O_VT = O_TKP + 64 * RW_P32, O_GC = O_VT + 64 * RW_P32, RW_TSB = O_GC + 256;
constexpr int RW_S0B = RW_TS + 2 * RW_TSB;
constexpr int RW_UB = RW_S0B + 2 * 64 * RW_P64;
constexpr int RW_RF = RW_UB + 64 * RW_P32;
constexpr int RW_ABF = RW_RF + 64 * 36 * 4;
constexpr int RW_CORR = RW_ABF + 32 * 36 * 4;
constexpr int RW_DUMP = RW_CORR + 64 * 20 * 4;
constexpr int RW_LDS_END = RW_DUMP + 256;
static_assert(RW_LDS_END <= 163840 - 16, "rwkv lds");
#define RW_BAR() do { asm volatile("s_waitcnt lgkmcnt(0)" ::: "memory"); __builtin_amdgcn_s_barrier(); asm volatile("" ::: "memory"); } while (0)
__device__ __forceinline__ float dppf(float x, const int ctrl_sel) {
    const int xi = __builtin_bit_cast(int, x); int r;
    if (ctrl_sel == 0) r = __builtin_amdgcn_update_dpp(0, xi, 0xB1, 0xf, 0xf, true);
    else if (ctrl_sel == 1) r = __builtin_amdgcn_update_dpp(0, xi, 0x4E, 0xf, 0xf, true);
    else if (ctrl_sel == 2) r = __builtin_amdgcn_update_dpp(0, xi, 0x141, 0xf, 0xf, true);
    else r = __builtin_amdgcn_update_dpp(0, xi, 0x140, 0xf, 0xf, true);
    return __builtin_bit_cast(float, r);
}
__device__ __forceinline__ float sum16(float x) { x += dppf(x, 0); x += dppf(x, 1); x += dppf(x, 2); x += dppf(x, 3); return x; }
__device__ __forceinline__ float rw_fma(float a, float b, float c) { float r; asm("v_fma_f32 %0, %1, %2, %3" : "=v"(r) : "v"(a), "v"(b), "v"(c)); return r; }
__device__ __forceinline__ int rwcrow(int r, int hi) { return (r & 3) + 8 * (r >> 2) + 4 * hi; }
__device__ __forceinline__ unsigned rwpk(float lo, float hi) { typedef float f2 __attribute__((ext_vector_type(2))); typedef __bf16 b2 __attribute__((ext_vector_type(2))); f2 v = {lo, hi}; b2 b = __builtin_convertvector(v, b2); return __builtin_bit_cast(unsigned, b); }
__device__ __forceinline__ f32x16 rw_cc(const LAS unsigned char* X, const LAS unsigned char* Y, int r32, int hi) {
    f32x16 d = f32x16{};
#pragma unroll
    for (int s = 0; s < 4; ++s) d = __builtin_amdgcn_mfma_f32_32x32x16_bf16(*(const LAS bf16x8*)(X + r32 * RW_P64 + 32 * s + 16 * hi), *(const LAS bf16x8*)(Y + r32 * RW_P64 + 32 * s + 16 * hi), d, 0, 0, 0);
    return d;
}
__device__ __forceinline__ f32x16 rw_accmul(f32x16 acc, const LAS unsigned char* Lt_row, const f32x16& M, int hi) {
    v4u m0, m1; m0.x = rwpk(M[0], M[1]); m0.y = rwpk(M[2], M[3]); m0.z = rwpk(M[4], M[5]); m0.w = rwpk(M[6], M[7]); m1.x = rwpk(M[8], M[9]); m1.y = rwpk(M[10], M[11]); m1.z = rwpk(M[12], M[13]); m1.w = rwpk(M[14], M[15]);
#pragma unroll
    for (int s = 0; s < 2; ++s) { const LAS unsigned char* p = Lt_row + 2 * (16 * s + 4 * hi); const v2u lo = *(const LAS v2u*)p, hv = *(const LAS v2u*)(p + 16); v4u av; av.x = lo.x; av.y = lo.y; av.z = hv.x; av.w = hv.y;
        acc = __builtin_amdgcn_mfma_f32_32x32x16_bf16(__builtin_bit_cast(bf16x8, av), __builtin_bit_cast(bf16x8, s == 0 ? m0 : m1), acc, 0, 0, 0); }
    return acc;
}
__device__ __forceinline__ void rwkv_item(LAS unsigned char* lds, const bf16* P, int T, int z, int b, int h, const float* mu, const float* w0, const float* w_up, const float* a0, const float* a_up,
                                          const float* k_k, const float* k_a, const float* r_k, bf16* YB, float* CB, bf16* VB, const int tid_in) {
    unsigned mk_ = ~0u; int wv_ = tid_in; asm volatile("" : "+s"(mk_), "+s"(wv_));
    const int tid = wv_ * 64 + (int)__builtin_amdgcn_mbcnt_hi(mk_, __builtin_amdgcn_mbcnt_lo(mk_, 0u));
    const int lane0 = tid & 63, wave = __builtin_amdgcn_readfirstlane(tid >> 6);
    LAS float* CN = (LAS float*)(lds + RW_CONST);
    for (int i = tid; i < 960; i += 512) { float v;
        if (i < 640) { const int m = i / 320, j = i % 320, g = j >> 6, c = j & 63; const int ch = (g < 3 ? g * 512 + h * 64 : (g == 3 ? 1536 + z * 64 : 1664 + z * 64)) + c; v = mu[m * 1792 + ch]; }
        else { const int j = i - 640, g = j >> 6, c = j & 63; v = g == 0 ? w0[z * 512 + h * 64 + c] : g == 1 ? a0[z * 512 + h * 64 + c] : g == 2 ? k_k[h * 64 + c] : g == 3 ? k_a[h * 64 + c] : r_k[h * 64 + c]; }
        CN[i] = v; }
    for (int i = tid; i < 2 * 64 * 64; i += 512) { const int lo = i >> 12, k = (i >> 6) & 63, n = i & 63; const float* U = (lo == 0 ? w_up : a_up) + (size_t)z * 64 * 512 + h * 64;
        *(LAS unsigned short*)(lds + RW_WT + lo * 64 * RW_TA_ROW + n * RW_TA_ROW + 2 * k) = (unsigned short)f2bf(U[(size_t)k * 512 + n]); }
    for (int i = tid; i < 2 * 64 * RW_P64 / 4; i += 512) ((LAS unsigned*)(lds + RW_S0B))[i] = 0u;
    __syncthreads();
    const int NCH = SEQ / RW_CH;
    const int gcol[5] = {PC_SLAB + h * 64, PC_SLAB + 512 + h * 64, PC_SLAB + 1024 + h * 64, PC_SLAB + 1536 + z * 64, PC_SLAB + 1664 + z * 64};
    const size_t tb0 = (size_t)b * SEQ;
    v2u rawc[2][5], rawe[5];
#define RW_ROWOFF(step_) ({ const int i__ = (step_); int l__ = z ? (SEQ - 1 - i__) : i__; l__ = l__ < 0 ? 0 : (l__ > SEQ - 1 ? SEQ - 1 : l__); ((unsigned)(tb0 + l__) * (unsigned)LDP + 4u * (unsigned)cq) * 2u; })
#define RW_LOAD(cc) do { const GAS unsigned char* Pb_ = (const GAS unsigned char*)P; const int s0_ = (cc) * RW_CH + 4 * vw0; \
    const unsigned r0_ = RW_ROWOFF(s0_ + js), r1_ = RW_ROWOFF(s0_ + 4 + js), re_ = RW_ROWOFF(js == 0 ? s0_ - 1 : (js == 3 ? s0_ + 8 : s0_ + js)); \
    _Pragma("unroll") for (int g = 0; g < 5; ++g) { rawc[0][g] = *(const GAS v2u*)(Pb_ + (r0_ + 2u * (unsigned)gcol[g])); rawc[1][g] = *(const GAS v2u*)(Pb_ + (r1_ + 2u * (unsigned)gcol[g])); rawe[g] = *(const GAS v2u*)(Pb_ + (re_ + 2u * (unsigned)gcol[g])); } } while (0)
    { const int lane = lane0, js = lane >> 4, cq = lane & 15, vw0 = wave >= 4 ? 2 * (wave - 4) : 0; RW_LOAD(0); }
    f32x16 accS[2] = {f32x16{}, f32x16{}};
    LAS float* const WTOT = (LAS float*)(lds + RW_WTOT); LAS float* const RF = (LAS float*)(lds + RW_RF); LAS float* const ABF = (LAS float*)(lds + RW_ABF); LAS float* const CORR = (LAS float*)(lds + RW_CORR);
#pragma unroll 1
    for (int it = 0; it <= NCH; ++it) {
        int lane_ = lane0; asm volatile("" : "+v"(lane_));
        const int lane = lane_, r32 = lane & 31, hi = lane >> 5, js = lane >> 4, cq = lane & 15;
        const int cp = it, cc = it - 1;
        const bool prep = (wave >= 4) && (cp < NCH), chain = (wave < 4) && (cc >= 0);
        const int vw0 = 2 * (wave - 4); const int sjv[2] = {4 * vw0 + js, 4 * (vw0 + 1) + js};
        LAS unsigned char* const tsp = lds + RW_TS + (cp & 1) * RW_TSB; const LAS unsigned char* const tsc = lds + RW_TS + (cc & 1) * RW_TSB;
        const LAS unsigned char* S0cur = lds + RW_S0B + (cc & 1) * 64 * RW_P64; LAS unsigned char* S0nxt = lds + RW_S0B + ((cc + 1) & 1) * 64 * RW_P64;
        float sv[2][3][4];
        float o_kk[2][4], o_r[2][4], o_b[2][4], o_kd[2][4], o_v[2][4], lw2[2][4], Lin[2][4];
        if (prep) {
            float sw_[2][2][4];
            asm volatile("s_waitcnt vmcnt(0)" ::: "memory");
#pragma unroll
            for (int g = 0; g < 5; ++g) { const f32x4 m0 = *(const LAS f32x4*)(CN + g * 64 + 4 * cq), m1 = *(const LAS f32x4*)(CN + 320 + g * 64 + 4 * cq);
                const int am = ((lane - 16) & 63) << 2, ap = ((lane + 16) & 63) << 2;
                v2u A0, A1, B0, B1;
                A0.x = (unsigned)__builtin_amdgcn_ds_bpermute(am, (int)rawc[0][g].x); A0.y = (unsigned)__builtin_amdgcn_ds_bpermute(am, (int)rawc[0][g].y); A1.x = (unsigned)__builtin_amdgcn_ds_bpermute(am, (int)rawc[1][g].x); A1.y = (unsigned)__builtin_amdgcn_ds_bpermute(am, (int)rawc[1][g].y);
                B0.x = (unsigned)__builtin_amdgcn_ds_bpermute(ap, (int)rawc[0][g].x); B0.y = (unsigned)__builtin_amdgcn_ds_bpermute(ap, (int)rawc[0][g].y); B1.x = (unsigned)__builtin_amdgcn_ds_bpermute(ap, (int)rawc[1][g].x); B1.y = (unsigned)__builtin_amdgcn_ds_bpermute(ap, (int)rawc[1][g].y);
#pragma unroll
                for (int u = 0; u < 2; ++u) { const int i_ = cp * RW_CH + sjv[u]; const int l_ = z ? (SEQ - 1 - i_) : i_; const bool okp = (l_ - 1 >= 0), okn = (l_ + 1 < SEQ);
                    const v2u sm = u == 0 ? (js == 0 ? rawe[g] : A0) : (js == 0 ? A0 : A1), sp = u == 0 ? (js == 3 ? B1 : B0) : (js == 3 ? rawe[g] : B1);
                    const v2u lm = z ? sp : sm, lp = z ? sm : sp;
                    const v2u rp = {okp ? lm.x : 0u, okp ? lm.y : 0u}, rn_ = {okn ? lp.x : 0u, okn ? lp.y : 0u};
                    const float pr[4] = {bflo(rp.x), bfhi(rp.x), bflo(rp.y), bfhi(rp.y)}, cu[4] = {bflo(rawc[u][g].x), bfhi(rawc[u][g].x), bflo(rawc[u][g].y), bfhi(rawc[u][g].y)}, nx[4] = {bflo(rn_.x), bfhi(rn_.x), bflo(rn_.y), bfhi(rn_.y)};
#pragma unroll
                    for (int e = 0; e < 4; ++e) { const float val = cu[e] + m0[e] * (pr[e] - cu[e]) + m1[e] * (nx[e] - cu[e]); if (g < 3) sv[u][g][e] = val; else sw_[u][g - 3][e] = val; } } }
#pragma unroll
            for (int u = 0; u < 2; ++u) {
#pragma unroll
                for (int g = 0; g < 3; ++g) asm volatile("" : "+v"(sv[u][g][0]), "+v"(sv[u][g][1]), "+v"(sv[u][g][2]), "+v"(sv[u][g][3]) :: "memory");
#pragma unroll
                for (int g = 0; g < 2; ++g) asm volatile("" : "+v"(sw_[u][g][0]), "+v"(sw_[u][g][1]), "+v"(sw_[u][g][2]), "+v"(sw_[u][g][3]) :: "memory"); }
            __builtin_amdgcn_sched_barrier(0);
            LAS unsigned char* const TAw = lds + RW_PW + vw0 * RW_PWB;
            LAS float* const LRw = (LAS float*)(TAw + 2 * 8 * RW_TA_ROW);
#pragma unroll
            for (int u = 0; u < 2; ++u) { float th[4];
#pragma unroll
                for (int e = 0; e < 4; ++e) { const float ex = __builtin_amdgcn_exp2f(sw_[u][0][e] * 2.8853900817779268f); th[e] = 1.f - 2.f * __builtin_amdgcn_rcpf(1.f + ex); }
                v2u t0; t0.x = pk2(th[0], th[1]); t0.y = pk2(th[2], th[3]); *(LAS v2u*)(TAw + (4 * u + js) * RW_TA_ROW + 8 * cq) = t0;
                v2u t1; t1.x = pk2(sw_[u][1][0], sw_[u][1][1]); t1.y = pk2(sw_[u][1][2], sw_[u][1][3]); *(LAS v2u*)(TAw + 8 * RW_TA_ROW + (4 * u + js) * RW_TA_ROW + 8 * cq) = t1; }
        } else if (chain) {
            if (wave < 2) {
                const int v0 = 32 * wave; f32x16 acc = f32x16{};
#pragma unroll
                for (int s = 0; s < 4; ++s) acc = __builtin_amdgcn_mfma_f32_32x32x16_bf16(*(const LAS bf16x8*)(S0cur + (v0 + r32) * RW_P64 + 32 * s + 16 * hi), *(const LAS bf16x8*)(lds + RW_TAL + r32 * RW_P64 + 32 * s + 16 * hi), acc, 0, 0, 0);
                f32x16 ak = rw_cc(tsc + O_TKA, lds + RW_TAL, r32, hi);
#pragma unroll
                for (int r = 0; r < 16; ++r) ak[r] = (rwcrow(r, hi) < r32) ? ak[r] : 0.f;
                acc = rw_accmul(acc, tsc + O_VT + (v0 + r32) * RW_P32, ak, hi);
#pragma unroll
                for (int r = 0; r < 16; ++r) RF[(v0 + rwcrow(r, hi)) * 36 + r32] = acc[r];
            } else if (wave == 2) {
                f32x16 ab = rw_cc(tsc + O_TBE, lds + RW_TAL, r32, hi);
#pragma unroll
                for (int r = 0; r < 16; ++r) ABF[rwcrow(r, hi) * 36 + r32] = (rwcrow(r, hi) < r32) ? ab[r] : 0.f;
            }
        }
        RW_BAR();
        if (prep) {
            {   LAS unsigned char* const TAw = lds + RW_PW + vw0 * RW_PWB; LAS float* const LRw = (LAS float*)(TAw + 2 * 8 * RW_TA_ROW);
            {
                LAS float* const lrb = lane < 32 ? LRw + (4 * (lane >> 4)) * 64 + (lane & 15) : (LAS float*)(lds + RW_DUMP); const int rs = lane < 32 ? 64 : 0, ls = lane < 32 ? 512 : 0, ns = lane < 32 ? 16 : 0;
                bf16x8 Af[2][2], Wf[2][4][2]; f32x4 accL[2][4];
#pragma unroll
                for (int lo = 0; lo < 2; ++lo) { Af[lo][0] = *(const LAS bf16x8*)(TAw + lo * 8 * RW_TA_ROW + (lane & 15) * RW_TA_ROW + 16 * (lane >> 4)); Af[lo][1] = *(const LAS bf16x8*)(TAw + lo * 8 * RW_TA_ROW + (lane & 15) * RW_TA_ROW + 64 + 16 * (lane >> 4));
#pragma unroll
                    for (int nt = 0; nt < 4; ++nt) { const LAS unsigned char* wt = lds + RW_WT + lo * 64 * RW_TA_ROW + (16 * nt + (lane & 15)) * RW_TA_ROW + 16 * (lane >> 4); Wf[lo][nt][0] = *(const LAS bf16x8*)(wt); Wf[lo][nt][1] = *(const LAS bf16x8*)(wt + 64); } }
#pragma unroll
                for (int lo = 0; lo < 2; ++lo)
#pragma unroll
                    for (int nt = 0; nt < 4; ++nt) { f32x4 acc = {0.f, 0.f, 0.f, 0.f}; acc = __builtin_amdgcn_mfma_f32_16x16x32_bf16(Af[lo][0], Wf[lo][nt][0], acc, 0, 0, 0); accL[lo][nt] = __builtin_amdgcn_mfma_f32_16x16x32_bf16(Af[lo][1], Wf[lo][nt][1], acc, 0, 0, 0); }
#pragma unroll
                for (int lo = 0; lo < 2; ++lo)
#pragma unroll
                    for (int nt = 0; nt < 4; ++nt) { LAS float* lr = lrb + lo * ls + nt * ns; lr[0] = accL[lo][nt][0]; lr[rs] = accL[lo][nt][1]; lr[2 * rs] = accL[lo][nt][2]; lr[3 * rs] = accL[lo][nt][3]; } }
            }
            asm volatile("s_waitcnt lgkmcnt(0)" ::: "memory");
            LAS float* const LRw = (LAS float*)(lds + RW_PW + vw0 * RW_PWB + 2 * 8 * RW_TA_ROW); float bo_[2];
            f32x4 lw_[2], la_[2];
#pragma unroll
            for (int u = 0; u < 2; ++u) { lw_[u] = *(const LAS f32x4*)(LRw + (4 * u + js) * 64 + 4 * cq); la_[u] = *(const LAS f32x4*)(LRw + 512 + (4 * u + js) * 64 + 4 * cq); }
            const f32x4 c_w0 = *(const LAS f32x4*)(CN + 640 + 4 * cq), c_a0 = *(const LAS f32x4*)(CN + 704 + 4 * cq), c_kk = *(const LAS f32x4*)(CN + 768 + 4 * cq), c_ka = *(const LAS f32x4*)(CN + 832 + 4 * cq), c_rk = *(const LAS f32x4*)(CN + 896 + 4 * cq);
#pragma unroll
            for (int u = 0; u < 2; ++u) { const f32x4 lw = lw_[u], la = la_[u];
                float kx[4], n2 = 0.f;
#pragma unroll
                for (int e = 0; e < 4; ++e) { kx[e] = sv[u][1][e] * c_kk[e]; n2 += kx[e] * kx[e]; }
                n2 = sum16(n2); const float rn = __builtin_amdgcn_rsqf(fmaxf(n2, 1e-24f));
                float bo = 0.f;
#pragma unroll
                for (int e = 0; e < 4; ++e) { const float wraw = lw[e] + c_w0[e];
                    lw2[u][e] = -0.8750387749480469f * __builtin_amdgcn_rcpf(1.f + __expf(-wraw));
                    const float aa = __builtin_amdgcn_rcpf(1.f + __expf(-(la[e] + c_a0[e]))); o_kk[u][e] = kx[e] * rn; o_kd[u][e] = sv[u][1][e] * (1.f + (aa - 1.f) * c_ka[e]); o_b[u][e] = o_kk[u][e] * aa; o_r[u][e] = sv[u][0][e]; o_v[u][e] = sv[u][2][e];
                    bo += o_r[u][e] * o_kd[u][e] * c_rk[e]; }
                bo_[u] = sum16(bo);
#pragma unroll
                for (int e = 0; e < 4; ++e) { float x = lw2[u][e];
                    const float y1 = __builtin_bit_cast(float, __builtin_amdgcn_ds_bpermute(((lane - 16) & 63) << 2, __builtin_bit_cast(int, x))); x += (js >= 1) ? y1 : 0.f;
                    const float y2 = __builtin_bit_cast(float, __builtin_amdgcn_ds_bpermute(((lane - 32) & 63) << 2, __builtin_bit_cast(int, x))); x += (js >= 2) ? y2 : 0.f; Lin[u][e] = x; } }
#pragma unroll
            for (int u = 0; u < 2; ++u) { LAS float* wp = js == 3 ? WTOT + (vw0 + u) * 64 + 4 * cq : (LAS float*)(lds + RW_DUMP); *(LAS f32x4*)wp = (f32x4){Lin[u][0], Lin[u][1], Lin[u][2], Lin[u][3]}; }
#pragma unroll
            for (int u = 0; u < 2; ++u) { const int i_ = cp * RW_CH + sjv[u]; const int l_ = z ? (SEQ - 1 - i_) : i_; const size_t t = tb0 + l_;
                if (cq == 0) *(GAS float*)(CB + ((size_t)(z * 8 + h)) * T + t) = bo_[u];
                if (z == 0) { v2u vb; vb.x = pk2(o_v[u][0], o_v[u][1]); vb.y = pk2(o_v[u][2], o_v[u][3]); *(GAS v2u*)(VB + t * 512 + h * 64 + 4 * cq) = vb; } }
            __builtin_amdgcn_sched_barrier(0);
            { const int cn = cp + 1 < NCH ? cp + 1 : cp; RW_LOAD(cn); }
            __builtin_amdgcn_sched_barrier(0);
        } else if (chain && wave == 0) {
            LAS float* row = RF + lane * 36;
#define RW_SOLVE16(o_) do { float u[16]; \
            _Pragma("unroll") for (int q4 = 0; q4 < 4; ++q4) { f32x4 rr = *(const LAS f32x4*)(row + (o_) + 4 * q4); if ((o_) != 0) rr += *(const LAS f32x4*)(CORR + lane * 20 + 4 * q4); u[4 * q4] = rr[0]; u[4 * q4 + 1] = rr[1]; u[4 * q4 + 2] = rr[2]; u[4 * q4 + 3] = rr[3]; } \
            _Pragma("unroll") for (int tb = 0; tb < 4; ++tb) { f32x4 A_[4][4]; \
                _Pragma("unroll") for (int r_ = 0; r_ < 4; ++r_) _Pragma("unroll") for (int q4 = tb; q4 < 4; ++q4) A_[r_][q4] = *(const LAS f32x4*)(ABF + ((o_) + 4 * tb + r_) * 36 + (o_) + 4 * q4); \
                _Pragma("unroll") for (int r_ = 0; r_ < 4; ++r_) { const int tt = 4 * tb + r_; if (tt < 15) { const float nut = -u[tt]; \
                    _Pragma("unroll") for (int q4 = (tt + 1) / 4; q4 < 4; ++q4) { const f32x4 aa = A_[r_][q4]; \
                        _Pragma("unroll") for (int e_ = 0; e_ < 4; ++e_) if (4 * q4 + e_ > tt) u[4 * q4 + e_] = rw_fma(nut, aa[e_], u[4 * q4 + e_]); } } } } \
            v4u w0_, w1_; w0_.x = pk2(-u[0], -u[1]); w0_.y = pk2(-u[2], -u[3]); w0_.z = pk2(-u[4], -u[5]); w0_.w = pk2(-u[6], -u[7]); w1_.x = pk2(-u[8], -u[9]); w1_.y = pk2(-u[10], -u[11]); w1_.z = pk2(-u[12], -u[13]); w1_.w = pk2(-u[14], -u[15]); \
            *(LAS v4u*)(lds + RW_UB + lane * RW_P32 + 2 * (o_)) = w0_; *(LAS v4u*)(lds + RW_UB + lane * RW_P32 + 2 * (o_) + 16) = w1_; } while (0)
            RW_SOLVE16(0);
            asm volatile("s_waitcnt lgkmcnt(0)" ::: "memory");
            {
                v4u bw = {0u, 0u, 0u, 0u};
                if (r32 < 16) { const LAS float* ap = ABF + (8 * hi) * 36 + 16 + r32; bw.x = pk2(ap[0], ap[36]); bw.y = pk2(ap[72], ap[108]); bw.z = pk2(ap[144], ap[180]); bw.w = pk2(ap[216], ap[252]); }
#pragma unroll
                for (int vt = 0; vt < 2; ++vt) { f32x16 d = f32x16{};
                    d = __builtin_amdgcn_mfma_f32_32x32x16_bf16(*(const LAS bf16x8*)(lds + RW_UB + (32 * vt + r32) * RW_P32 + 16 * hi), __builtin_bit_cast(bf16x8, bw), d, 0, 0, 0);
                    if (r32 < 16) {
#pragma unroll
                        for (int r = 0; r < 16; ++r) CORR[(32 * vt + rwcrow(r, hi)) * 20 + r32] = d[r]; } }
            }
            asm volatile("s_waitcnt lgkmcnt(0)" ::: "memory");
            RW_SOLVE16(16);
#undef RW_SOLVE16
        }
        RW_BAR();
        if (prep) {
            f32x4 offu[2] = {{0.f, 0.f, 0.f, 0.f}, {0.f, 0.f, 0.f, 0.f}}, tot = {0.f, 0.f, 0.f, 0.f};
#pragma unroll
            for (int w = 0; w < 8; ++w) { const f32x4 tw = *(const LAS f32x4*)(WTOT + w * 64 + 4 * cq); tot += tw; if (w < vw0) offu[0] += tw; if (w < vw0 + 1) offu[1] += tw; }
#pragma unroll
            for (int u = 0; u < 2; ++u) { const int sj = sjv[u]; const f32x4 off = offu[u];
                float al[4], rh[4], be[4], ka[4], bp[4], kp[4];
#pragma unroll
                for (int e = 0; e < 4; ++e) { const float Lt = off[e] + Lin[u][e]; const float gprev = __builtin_amdgcn_exp2f(Lt - lw2[u][e]), gt = __builtin_amdgcn_exp2f(Lt), gi = __builtin_amdgcn_exp2f(-Lt), gp = __builtin_amdgcn_exp2f(tot[e] - Lt);
                    al[e] = gprev * o_kk[u][e]; rh[e] = gt * o_r[u][e]; be[e] = o_b[u][e] * gi; ka[e] = o_kd[u][e] * gi; bp[e] = o_b[u][e] * gp; kp[e] = o_kd[u][e] * gp; }
                v2u w; w.x = pk2(al[0], al[1]); w.y = pk2(al[2], al[3]); *(LAS v2u*)(lds + RW_TAL + sj * RW_P64 + 8 * cq) = w;
                w.x = pk2(rh[0], rh[1]); w.y = pk2(rh[2], rh[3]); *(LAS v2u*)(tsp + O_TRH + sj * RW_P64 + 8 * cq) = w;
                w.x = pk2(be[0], be[1]); w.y = pk2(be[2], be[3]); *(LAS v2u*)(tsp + O_TBE + sj * RW_P64 + 8 * cq) = w;
                w.x = pk2(ka[0], ka[1]); w.y = pk2(ka[2], ka[3]); *(LAS v2u*)(tsp + O_TKA + sj * RW_P64 + 8 * cq) = w;
#pragma unroll
                for (int e = 0; e < 4; ++e) { *(LAS unsigned short*)(tsp + O_TBP + (4 * cq + e) * RW_P32 + 2 * sj) = (unsigned short)f2bf(bp[e]); *(LAS unsigned short*)(tsp + O_TKP + (4 * cq + e) * RW_P32 + 2 * sj) = (unsigned short)f2bf(kp[e]);
                    *(LAS unsigned short*)(tsp + O_VT + (4 * cq + e) * RW_P32 + 2 * sj) = (unsigned short)f2bf(o_v[u][e]); }
                if (u == 1) { LAS float* gp_ = sj == 31 ? (LAS float*)(tsp + O_GC) + 4 * cq : (LAS float*)(lds + RW_DUMP); *(LAS f32x4*)gp_ = (f32x4){__builtin_amdgcn_exp2f(tot[0]), __builtin_amdgcn_exp2f(tot[1]), __builtin_amdgcn_exp2f(tot[2]), __builtin_amdgcn_exp2f(tot[3])}; } }
        } else if (chain) {
            if (wave < 2) {
                const int v0 = 32 * wave; f32x16 accY = f32x16{};
#pragma unroll
                for (int s = 0; s < 4; ++s) accY = __builtin_amdgcn_mfma_f32_32x32x16_bf16(*(const LAS bf16x8*)(S0cur + (v0 + r32) * RW_P64 + 32 * s + 16 * hi), *(const LAS bf16x8*)(tsc + O_TRH + r32 * RW_P64 + 32 * s + 16 * hi), accY, 0, 0, 0);
                { f32x16 bk = rw_cc(tsc + O_TKA, tsc + O_TRH, r32, hi);
#pragma unroll
                  for (int r = 0; r < 16; ++r) bk[r] = (rwcrow(r, hi) <= r32) ? bk[r] : 0.f;
                  accY = rw_accmul(accY, tsc + O_VT + (v0 + r32) * RW_P32, bk, hi); }
                { f32x16 bbm = rw_cc(tsc + O_TBE, tsc + O_TRH, r32, hi);
#pragma unroll
                  for (int r = 0; r < 16; ++r) bbm[r] = (rwcrow(r, hi) <= r32) ? bbm[r] : 0.f;
                  accY = rw_accmul(accY, lds + RW_UB + (v0 + r32) * RW_P32, bbm, hi); }
                {
                    const int iy = cc * RW_CH + r32; const int ly = z ? (SEQ - 1 - iy) : iy; GAS unsigned char* yb = (GAS unsigned char*)YB + (((size_t)z * T + tb0 + ly) * 512 + h * 64 + v0 + 4 * hi) * 2;
#pragma unroll
                    for (int g4 = 0; g4 < 4; ++g4) { v2u o; o.x = pk2(accY[4 * g4], accY[4 * g4 + 1]); o.y = pk2(accY[4 * g4 + 2], accY[4 * g4 + 3]); *(GAS v2u*)(yb + 16 * g4) = o; } }
            } else {
#pragma unroll
                for (int q = 0; q < 2; ++q) { const int sw = 2 * (wave - 2) + q, v0 = 32 * (sw & 1), k0 = 32 * (sw >> 1);
                    const float gcv = ((const LAS float*)(tsc + O_GC))[k0 + r32];
#pragma unroll
                    for (int r = 0; r < 16; ++r) accS[q][r] *= gcv;
#pragma unroll
                    for (int s = 0; s < 2; ++s) {
                        accS[q] = __builtin_amdgcn_mfma_f32_32x32x16_bf16(*(const LAS bf16x8*)(tsc + O_VT + (v0 + r32) * RW_P32 + 32 * s + 16 * hi), *(const LAS bf16x8*)(tsc + O_TKP + (k0 + r32) * RW_P32 + 32 * s + 16 * hi), accS[q], 0, 0, 0);
                        accS[q] = __builtin_amdgcn_mfma_f32_32x32x16_bf16(*(const LAS bf16x8*)(lds + RW_UB + (v0 + r32) * RW_P32 + 32 * s + 16 * hi), *(const LAS bf16x8*)(tsc + O_TBP + (k0 + r32) * RW_P32 + 32 * s + 16 * hi), accS[q], 0, 0, 0); } }
#pragma unroll
                for (int q = 0; q < 2; ++q) { const int sw = 2 * (wave - 2) + q, v0 = 32 * (sw & 1), k0 = 32 * (sw >> 1);
#pragma unroll
                    for (int r = 0; r < 16; ++r) *(LAS unsigned short*)(S0nxt + (v0 + rwcrow(r, hi)) * RW_P64 + 2 * (k0 + r32)) = (unsigned short)f2bf(accS[q][r]); } }
        }
        RW_BAR();
    }
#undef RW_LOAD
#undef RW_ROWOFF
    __syncthreads();
}
__device__ __forceinline__ void ph_rwkv(LAS unsigned char* lds, const bf16* P, int T, int nb, const float* mu, const float* w0, const float* w_up, const float* a0, const float* a_up, const float* k_k, const float* k_a, const float* r_k,
                                        bf16* YB, float* CB, bf16* VB, int tid, int bid, int nblk) {
    const int wv = __builtin_amdgcn_readfirstlane(tid >> 6);
#pragma unroll 1
    for (int it = bid; it < nb * 16; it += nblk) { const int z = it & 1, h = (it >> 1) & 7, b = it >> 4; rwkv_item(lds, P, T, z, b, h, mu, w0, w_up, a0, a_up, k_k, k_a, r_k, YB, CB, VB, wv); }
}
}
namespace mk {
constexpr int SS_RP = 272;
constexpr int SS_XP = 144;
constexpr int SS_BM = 0, SS_CM = SS_BM + 128 * SS_RP, SS_XN = SS_CM + 128 * SS_RP, SS_SB = SS_XN + 128 * SS_XP, SS_CUM = SS_SB + 128 * SS_XP, SS_MT = SS_CUM + 1024, SS_END = SS_MT + 10 * 2048;
__device__ __forceinline__ v2u ss_tr(unsigned addr) { v2u r; asm volatile("ds_read_b64_tr_b16 %0, %1" : "=&v"(r) : "v"(addr) : "memory"); return r; }
__device__ __forceinline__ void ss_wait4(v2u& a, v2u& b, v2u& c, v2u& d) { asm volatile("s_waitcnt lgkmcnt(0)" : "+v"(a), "+v"(b), "+v"(c), "+v"(d) :: "memory"); }
constexpr int SS_YP = 144;
static_assert(SS_END <= 147456, "ssd lds"); static_assert(SS_XP % 8 == 0 && SS_RP % 8 == 0, "transpose reads need 8-byte aligned rows");
__device__ __forceinline__ int crow(int r, int hi) { return (r & 3) + 8 * (r >> 2) + 4 * hi; }
__device__ __forceinline__ bf16x8 ldsA(const LAS unsigned char* base, int row, int colbyte) { return *(const LAS bf16x8*)(base + row * SS_RP + colbyte); }
__device__ __forceinline__ unsigned cvtpk(float lo, float hi) { typedef float f2 __attribute__((ext_vector_type(2))); typedef __bf16 b2 __attribute__((ext_vector_type(2))); f2 v = {lo, hi}; b2 b = __builtin_convertvector(v, b2); return __builtin_bit_cast(unsigned, b); }
__device__ __forceinline__ void ssd_item(LAS unsigned char* lds, const bf16* XC, const float* DT, const float* a_log, bf16* YA, int T, int z, int b, int h, const int tid) {
    const int lane = tid & 63, wave = __builtin_amdgcn_readfirstlane(tid >> 6), r32 = lane & 31, hi = lane >> 5;
    const int pt = wave & 1, qt = wave >> 1, g = h >> 2;
    const float a2 = -__expf(a_log[z * 8 + h]) * 1.4426950408889634f;
    LAS float* CUM = (LAS float*)(lds + SS_CUM);
    for (int i = tid; i < 128 * SS_XP / 4; i += 512) ((LAS unsigned*)(lds + SS_SB))[i] = 0u;
    f32x16 accS = f32x16{};
    const size_t tb0 = (size_t)b * SEQ;
    v4u pwb[4], pwc[4], pwx[2]; float pd[2], pl0, pl1;
#define SS_LOAD(cc) do { const GAS unsigned char* Xb_ = (const GAS unsigned char*)XC; const GAS unsigned char* Db_ = (const GAS unsigned char*)DT;     \
    _Pragma("unroll") for (int i = 0; i < 4; ++i) { const int idx = tid + 512 * i, q = idx >> 4, c8 = idx & 15; const int pos = 128 * (cc) + q; const unsigned t = (unsigned)tb0 + (unsigned)(z ? (SEQ - 1 - pos) : pos); \
        const unsigned o_ = (t * 1024u + 512u + (unsigned)(g * 128 + 8 * c8)) * 2u; pwb[i] = *(const GAS v4u*)(Xb_ + o_); pwc[i] = *(const GAS v4u*)(Xb_ + (o_ + 512u)); } \
    _Pragma("unroll") for (int i = 0; i < 2; ++i) { const int idx = tid + 512 * i, q = idx >> 3, c8 = idx & 7; const int pos = 128 * (cc) + q; const unsigned t = (unsigned)tb0 + (unsigned)(z ? (SEQ - 1 - pos) : pos); \
        pwx[i] = *(const GAS v4u*)(Xb_ + (t * 1024u + (unsigned)(h * 64 + 8 * c8)) * 2u); pd[i] = *(const GAS float*)(Db_ + (t * 16u + (unsigned)(z * 8 + h)) * 4u); } \
    { const int p0 = 128 * (cc) + 2 * lane; const unsigned t0 = (unsigned)tb0 + (unsigned)(z ? (SEQ - 1 - p0) : p0), t1 = (unsigned)tb0 + (unsigned)(z ? (SEQ - 2 - p0) : (p0 + 1)); pl0 = *(const GAS float*)(Db_ + (t0 * 16u + (unsigned)(z * 8 + h)) * 4u); pl1 = *(const GAS float*)(Db_ + (t1 * 16u + (unsigned)(z * 8 + h)) * 4u); } } while (0)
    SS_LOAD(0);
#pragma unroll 1
    for (int c = 0; c < SEQ / 128; ++c) {
        asm volatile("s_waitcnt vmcnt(2)" ::: "memory");
        __syncthreads();
#pragma unroll
        for (int i = 0; i < 4; ++i) { const int idx = tid + 512 * i, q = idx >> 4, c8 = idx & 15;
            *(LAS v4u*)(lds + SS_BM + q * SS_RP + 16 * c8) = pwb[i]; *(LAS v4u*)(lds + SS_CM + q * SS_RP + 16 * c8) = pwc[i]; }
#pragma unroll
        for (int i = 0; i < 2; ++i) { const int idx = tid + 512 * i, q = idx >> 3, c8 = idx & 7; const v4u wx = pwx[i]; const float d = pd[i]; v4u o;
            o.x = pk2(bflo(wx.x) * d, bfhi(wx.x) * d); o.y = pk2(bflo(wx.y) * d, bfhi(wx.y) * d); o.z = pk2(bflo(wx.z) * d, bfhi(wx.z) * d); o.w = pk2(bflo(wx.w) * d, bfhi(wx.w) * d);
            *(LAS v4u*)(lds + SS_XN + q * SS_XP + 16 * c8) = o; }
        if (wave == 0) {
            const float l0 = pl0 * a2, l1 = pl1 * a2; float x = l0 + l1;
#pragma unroll
            for (int o = 1; o < 64; o <<= 1) { const float y = __builtin_bit_cast(float, __builtin_amdgcn_ds_bpermute(((lane - o) & 63) << 2, __builtin_bit_cast(int, x))); x += (lane >= o) ? y : 0.f; }
            *(LAS f32x2v*)(CUM + 2 * lane) = (f32x2v){x - l1, x}; }
        asm volatile("" ::: "memory"); __builtin_amdgcn_sched_barrier(0);
        SS_LOAD(c + 1 < SEQ / 128 ? c + 1 : c);
        __builtin_amdgcn_sched_barrier(0);
        __syncthreads();
        const float cq = CUM[32 * qt + r32], clast = CUM[127];
        f32x16 acc = f32x16{};
        { bf16x8 cf[8];
#pragma unroll
          for (int s = 0; s < 8; ++s) cf[s] = ldsA(lds + SS_CM, 32 * qt + r32, 32 * s + 16 * hi);
          { const unsigned sa = (unsigned)(uintptr_t)(lds + SS_SB) + (unsigned)((8 * hi + ((lane & 15) >> 2)) * SS_XP + (32 * pt + 16 * ((lane >> 4) & 1) + 4 * (lane & 3)) * 2);
            v2u sl[8], sh[8];
#pragma unroll
            for (int s = 0; s < 8; ++s) { sl[s] = ss_tr(sa + 16 * s * SS_XP); sh[s] = ss_tr(sa + (16 * s + 4) * SS_XP); }
#pragma unroll
            for (int s = 0; s < 4; ++s) ss_wait4(sl[2 * s], sh[2 * s], sl[2 * s + 1], sh[2 * s + 1]);
#pragma unroll
            for (int s = 0; s < 8; ++s) { v4u av; av.x = sl[s].x; av.y = sl[s].y; av.z = sh[s].x; av.w = sh[s].y; acc = __builtin_amdgcn_mfma_f32_32x32x16_bf16(__builtin_bit_cast(bf16x8, av), cf[s], acc, 0, 0, 0); } }
          const float eq = __builtin_amdgcn_exp2f(cq);
#pragma unroll
          for (int r = 0; r < 16; ++r) acc[r] *= eq; }
#pragma unroll 1
        for (int tI = wave; tI < 10; tI += 8) { const int q2 = tI < 1 ? 0 : (tI < 3 ? 1 : (tI < 6 ? 2 : 3)), kt = tI - q2 * (q2 + 1) / 2; const float cq2 = CUM[32 * q2 + r32];
            f32x16 gT = f32x16{};
#pragma unroll
            for (int s = 0; s < 8; ++s) gT = __builtin_amdgcn_mfma_f32_32x32x16_bf16(ldsA(lds + SS_BM, 32 * kt + r32, 32 * s + 16 * hi), ldsA(lds + SS_CM, 32 * q2 + r32, 32 * s + 16 * hi), gT, 0, 0, 0);
#pragma unroll
            for (int gq = 0; gq < 4; ++gq) { const f32x4 ck = *(const LAS f32x4*)(CUM + 32 * kt + 8 * gq + 4 * hi);
#pragma unroll
                for (int e = 0; e < 4; ++e) { const int r = 4 * gq + e; const bool ok = (kt < q2) || (8 * gq + 4 * hi + e <= r32); const float m = __builtin_amdgcn_exp2f(cq2 - ck[e]); gT[r] = ok ? gT[r] * m : 0.f; } }
            v4u m0, m1; m0.x = cvtpk(gT[0], gT[1]); m0.y = cvtpk(gT[2], gT[3]); m0.z = cvtpk(gT[4], gT[5]); m0.w = cvtpk(gT[6], gT[7]); m1.x = cvtpk(gT[8], gT[9]); m1.y = cvtpk(gT[10], gT[11]); m1.z = cvtpk(gT[12], gT[13]); m1.w = cvtpk(gT[14], gT[15]);
            *(LAS v4u*)(lds + SS_MT + tI * 2048 + lane * 32) = m0; *(LAS v4u*)(lds + SS_MT + tI * 2048 + lane * 32 + 16) = m1; }
        __syncthreads();
#pragma unroll
        for (int kh = 0; kh < 2; ++kh) {
            v2u xl[2][4]; v4u mm[2][2];
#pragma unroll
            for (int k2 = 0; k2 < 2; ++k2) { const int kt = 2 * kh + k2, ktc = kt <= qt ? kt : qt;
                const unsigned xa = (unsigned)(uintptr_t)(lds + SS_XN) + (unsigned)((32 * ktc + 4 * hi + ((lane & 15) >> 2)) * SS_XP + (32 * pt + 16 * ((lane >> 4) & 1) + 4 * (lane & 3)) * 2);
                xl[k2][0] = ss_tr(xa); xl[k2][1] = ss_tr(xa + 8 * SS_XP); xl[k2][2] = ss_tr(xa + 16 * SS_XP); xl[k2][3] = ss_tr(xa + 24 * SS_XP);
                const LAS unsigned char* mp = lds + SS_MT + (qt * (qt + 1) / 2 + ktc) * 2048 + lane * 32; mm[k2][0] = *(const LAS v4u*)mp; mm[k2][1] = *(const LAS v4u*)(mp + 16); }
#pragma unroll
            for (int k2 = 0; k2 < 2; ++k2) { const int kt = 2 * kh + k2; ss_wait4(xl[k2][0], xl[k2][1], xl[k2][2], xl[k2][3]);
                if (kt <= qt) { v4u a0; a0.x = xl[k2][0].x; a0.y = xl[k2][0].y; a0.z = xl[k2][1].x; a0.w = xl[k2][1].y; v4u a1; a1.x = xl[k2][2].x; a1.y = xl[k2][2].y; a1.z = xl[k2][3].x; a1.w = xl[k2][3].y;
                    acc = __builtin_amdgcn_mfma_f32_32x32x16_bf16(__builtin_bit_cast(bf16x8, a0), __builtin_bit_cast(bf16x8, mm[k2][0]), acc, 0, 0, 0);
                    acc = __builtin_amdgcn_mfma_f32_32x32x16_bf16(__builtin_bit_cast(bf16x8, a1), __builtin_bit_cast(bf16x8, mm[k2][1]), acc, 0, 0, 0); } } }
        __syncthreads();
        { LAS unsigned short* ys = (LAS unsigned short*)(lds + SS_CM + (32 * qt + r32) * SS_YP) + 32 * pt;
#pragma unroll
          for (int g4 = 0; g4 < 4; ++g4) { v2u o; o.x = pk2(acc[4 * g4], acc[4 * g4 + 1]); o.y = pk2(acc[4 * g4 + 2], acc[4 * g4 + 3]); *(LAS v2u*)(ys + 8 * g4 + 4 * hi) = o; } }
        { const int q = tid >> 2, p0 = 16 * (tid & 3); LAS unsigned char* xr = lds + SS_XN + q * SS_XP + 2 * p0; v4u w0 = *(LAS v4u*)xr, w1 = *(LAS v4u*)(xr + 16);
          const float e = __builtin_amdgcn_exp2f(clast - CUM[q]);
          w0.x = pk2(bflo(w0.x) * e, bfhi(w0.x) * e); w0.y = pk2(bflo(w0.y) * e, bfhi(w0.y) * e); w0.z = pk2(bflo(w0.z) * e, bfhi(w0.z) * e); w0.w = pk2(bflo(w0.w) * e, bfhi(w0.w) * e);
          w1.x = pk2(bflo(w1.x) * e, bfhi(w1.x) * e); w1.y = pk2(bflo(w1.y) * e, bfhi(w1.y) * e); w1.z = pk2(bflo(w1.z) * e, bfhi(w1.z) * e); w1.w = pk2(bflo(w1.w) * e, bfhi(w1.w) * e);
          *(LAS v4u*)xr = w0; *(LAS v4u*)(xr + 16) = w1; }
        __syncthreads();
#pragma unroll
        for (int i = 0; i < 2; ++i) { const int idx = tid + 512 * i, q = idx >> 3, c8 = idx & 7; const int pos = 128 * c + q; const size_t t = tb0 + (z ? (SEQ - 1 - pos) : pos);
            *(GAS v4u*)(YA + ((size_t)z * T + t) * 512 + h * 64 + 8 * c8) = *(const LAS v4u*)(lds + SS_CM + q * SS_YP + 16 * c8); }
        { const float dl = __builtin_amdgcn_exp2f(clast);
#pragma unroll
          for (int r = 0; r < 16; ++r) accS[r] *= dl;
          { const int rq = 8 * hi + ((lane & 15) >> 2), cg = 16 * ((lane >> 4) & 1) + 4 * (lane & 3);
            const unsigned xa = (unsigned)(uintptr_t)(lds + SS_XN) + (unsigned)(rq * SS_XP + (32 * pt + cg) * 2), ba = (unsigned)(uintptr_t)(lds + SS_BM) + (unsigned)(rq * SS_RP + (32 * qt + cg) * 2);
            v2u al[8], ah[8], bl[8], bh[8];
#pragma unroll
            for (int s = 0; s < 8; ++s) { al[s] = ss_tr(xa + 16 * s * SS_XP); ah[s] = ss_tr(xa + (16 * s + 4) * SS_XP); bl[s] = ss_tr(ba + 16 * s * SS_RP); bh[s] = ss_tr(ba + (16 * s + 4) * SS_RP); }
#pragma unroll
            for (int s = 0; s < 8; ++s) ss_wait4(al[s], ah[s], bl[s], bh[s]);
#pragma unroll
            for (int s = 0; s < 8; ++s) { v4u av; av.x = al[s].x; av.y = al[s].y; av.z = ah[s].x; av.w = ah[s].y; v4u bv; bv.x = bl[s].x; bv.y = bl[s].y; bv.z = bh[s].x; bv.w = bh[s].y;
                accS = __builtin_amdgcn_mfma_f32_32x32x16_bf16(__builtin_bit_cast(bf16x8, av), __builtin_bit_cast(bf16x8, bv), accS, 0, 0, 0); } }
          LAS unsigned char* sb = lds + SS_SB + (32 * qt + r32) * SS_XP + (32 * pt + 4 * hi) * 2;
#pragma unroll
          for (int g4 = 0; g4 < 4; ++g4) { v2u o; o.x = pk2(accS[4 * g4], accS[4 * g4 + 1]); o.y = pk2(accS[4 * g4 + 2], accS[4 * g4 + 3]); *(LAS v2u*)(sb + 16 * g4) = o; } }
    }
#undef SS_LOAD
    __syncthreads();
}
__device__ __forceinline__ void ph_ssd(LAS unsigned char* lds, const bf16* XC, const float* DT, const float* a_log, bf16* YA, int T, int nb, int tid, int bid, int nblk, int blk0) {
#pragma unroll 1
    for (int it = (bid - blk0 + nblk) % nblk; it < nb * 16; it += nblk) { const int z = it & 1, h = (it >> 1) & 7, b = it >> 4; ssd_item(lds, XC, DT, a_log, YA, T, z, b, h, tid); }
}
}
namespace mk {
#define XB_TMO      128
#define XB_XCNT(j)  (256  + 64 * (j))
#define XB_XSUB(j)  (1280 + 64 * (j))
#define XB_XGEN(j)  (2304 + 64 * (j))
#define XB_TOP      3328
#define XB_TOPGEN   3392
#define XCD_BAR_WORDS 3456
#define XB_SPIN_CAP (1u << 18)

__device__ __forceinline__ unsigned xb_ld(unsigned* p)              { return __hip_atomic_load(p, __ATOMIC_RELAXED, __HIP_MEMORY_SCOPE_AGENT); }
__device__ __forceinline__ unsigned xb_add(unsigned* p, unsigned v) { return __hip_atomic_fetch_add(p, v, __ATOMIC_RELAXED, __HIP_MEMORY_SCOPE_AGENT); }
__device__ __forceinline__ unsigned xb_xcc_id() { return (unsigned)__builtin_amdgcn_s_getreg((3 << 11) | 20) & 0xFu; }
#define XB_SPIN(cond, bar) do { unsigned _sp = 0; while (cond) { __builtin_amdgcn_s_sleep(1); \
    if ((++_sp & 255u) == 0u) { if (xb_ld(&(bar)[XB_TMO])) break; if (_sp > XB_SPIN_CAP) { atomicAdd(&(bar)[XB_TMO], 1u); break; } } } } while (0)

struct XcdBarrier {
    unsigned* bar; unsigned x;
    volatile LAS unsigned* st;
};

__device__ __forceinline__ XcdBarrier xcd_barrier_post(unsigned* bar, volatile LAS unsigned* st) {
    XcdBarrier b; b.bar = bar; b.x = xb_xcc_id(); b.st = st;
    if (threadIdx.x == 0) (void)xb_add(&bar[XB_XCNT(b.x)], 1u);
    return b;
}
__device__ __forceinline__ void xcd_barrier_complete(unsigned* bar, unsigned x, unsigned& nloc, unsigned& nx) {
    const unsigned G = gridDim.x * gridDim.y * gridDim.z;
    unsigned sum, cnt, mine, sp = 0u;
    for (;;) {
        sum = 0u; cnt = 0u; mine = 0u;
#pragma unroll
        for (unsigned j = 0; j < 16; ++j) { const unsigned c = xb_ld(&bar[XB_XCNT(j)]); sum += c; cnt += (c > 0u) ? 1u : 0u; mine = (j == x) ? c : mine; }
        if (sum == G) break;
        __builtin_amdgcn_s_sleep(1);
        if ((++sp & 255u) == 0u) { if (xb_ld(&bar[XB_TMO])) break; if (sp > XB_SPIN_CAP) { atomicAdd(&bar[XB_TMO], 1u); break; } }
    }
    nloc = mine > 0u ? mine : 1u; nx = cnt > 0u ? cnt : 1u;
}

__device__ __forceinline__ void xcd_barrier(const XcdBarrier& b) {
    asm volatile("s_waitcnt vmcnt(0)" ::: "memory");
    __syncthreads();
    if (threadIdx.x == 0) {
        unsigned* bar = b.bar;
        __builtin_amdgcn_s_waitcnt(0);
        unsigned nloc = b.st[0], nx = b.st[1];
        if (nloc == 0u) { xcd_barrier_complete(bar, b.x, nloc, nx); b.st[0] = nloc; b.st[1] = nx; }
        const unsigned old = xb_add(&bar[XB_XSUB(b.x)], 1u);
        const unsigned gen = old / nloc;
        if (old + 1u == (gen + 1u) * nloc) {
            __builtin_amdgcn_fence(__ATOMIC_RELEASE, "agent");
            asm volatile("s_waitcnt vmcnt(0)" ::: "memory");
            const unsigned og = xb_add(&bar[XB_TOP], 1u);
            const unsigned tg = og / nx;
            if (og + 1u == (tg + 1u) * nx) xb_add(&bar[XB_TOPGEN], 1u);
            else XB_SPIN(xb_ld(&bar[XB_TOPGEN]) == tg, bar);
            __builtin_amdgcn_fence(__ATOMIC_ACQUIRE, "agent");
            xb_add(&bar[XB_XGEN(b.x)], 1u);
            asm volatile("s_waitcnt vmcnt(0)" ::: "memory");
        } else {
            XB_SPIN(xb_ld(&bar[XB_XGEN(b.x)]) == gen, bar);
            __builtin_amdgcn_fence(__ATOMIC_ACQUIRE, "agent");
            asm volatile("s_waitcnt vmcnt(0)" ::: "memory");
        }
    }
    __syncthreads();
}


}
#include <hip/hip_cooperative_groups.h>
namespace mk {
namespace cg = cooperative_groups;
constexpr int LDS_BYTES = 163840;
constexpr int NB_HALF = 8, TH = NB_HALF * SEQ;
constexpr size_t al256(size_t x) { return (x + 255) / 256 * 256; }
constexpr size_t WS_CTL = 0, CTL_BYTES = 65536, WS_W = CTL_BYTES, WS_ROPE = al256(WS_W + 2 * W_LAYER_ELEMS * 2), WS_H = al256(WS_ROPE + 2ull * SEQ * 32 * 4), WS_P = al256(WS_H + (size_t)TH * 1024 * 2), WS_X = al256(WS_P + (size_t)TH * LDP * 2);
constexpr size_t X_XC = 0, X_DT = al256(X_XC + (size_t)TH * 1024 * 2), X_QN = al256(X_DT + (size_t)TH * 16 * 4), X_KN = al256(X_QN + (size_t)TH * 512 * 2), X_YA = al256(X_KN + (size_t)TH * 128 * 2),
                 X_YB = al256(X_YA + 2ull * TH * 512 * 2), X_CB = al256(X_YB + 2ull * TH * 512 * 2), X_VB = al256(X_CB + 2ull * TH * 8 * 4), X_RS = al256(X_VB + (size_t)TH * 512 * 2), X_END1 = al256(X_RS + 9ull * SEQ * 512 * 4);
constexpr size_t X_MF = 0, X_MB = al256(X_MF + (size_t)TH * 1024 * 4), X_OF = al256(X_MB + (size_t)TH * 1024 * 2), X_END2 = al256(X_OF + (size_t)TH * 1024 * 4);
constexpr size_t WS_NEED = WS_X + (X_END1 > X_END2 ? X_END1 : X_END2);
static_assert(WS_NEED <= 536870912ull, "workspace map exceeds 512 MiB");
struct MegaArgs { const float* in[25]; float* out; unsigned char* ws; };
__global__ __launch_bounds__(512, 2) void k_mega(MegaArgs a) {
    extern __shared__ __attribute__((aligned(16))) unsigned char lds_[];
    LAS unsigned char* lds = (LAS unsigned char*)lds_;
    cg::grid_group grid = cg::this_grid();
    volatile LAS unsigned* xbst = (volatile LAS unsigned*)(lds + LDS_BYTES - 16);
    if (threadIdx.x < 4) xbst[threadIdx.x] = 0u;
    __syncthreads();
    XcdBarrier xbar = xcd_barrier_post((unsigned*)(a.ws + WS_CTL), xbst);
#define GSYNC() xcd_barrier(xbar)
    const int wave0 = __builtin_amdgcn_readfirstlane((int)threadIdx.x >> 6);
#define PV int bid = blockIdx.x, wv_ = wave0; unsigned mk_ = ~0u; unsigned char* ws = a.ws; asm volatile("" : "+s"(bid), "+s"(wv_), "+s"(mk_), "+s"(ws)); int tid = wv_ * 64 + (int)__builtin_amdgcn_mbcnt_hi(mk_, __builtin_amdgcn_mbcnt_lo(mk_, 0u)); asm volatile("" : "+v"(tid)); const int lane = tid & 63, wave = wv_; const int gw = bid * 8 + wave, ngw = gridDim.x * 8, gtid = bid * 512 + tid, nthr = gridDim.x * 512; (void)lane; (void)wave; (void)gw; (void)ngw; (void)gtid; (void)nthr; bf16* Wall = (bf16*)(ws + WS_W); float* rope = (float*)(ws + WS_ROPE); bf16* H = (bf16*)(ws + WS_H); bf16* P = (bf16*)(ws + WS_P); unsigned char* X = ws + WS_X; bf16* XC = (bf16*)(X + X_XC); float* DT = (float*)(X + X_DT); bf16* Qn = (bf16*)(X + X_QN); bf16* Kn = (bf16*)(X + X_KN); bf16* YA = (bf16*)(X + X_YA); bf16* YB = (bf16*)(X + X_YB); float* CB = (float*)(X + X_CB); bf16* VB = (bf16*)(X + X_VB); float* Mf = (float*)(X + X_MF); bf16* Mb = (bf16*)(X + X_MB); float* OF = (float*)(X + X_OF); const bf16* W = Wall + (size_t)l * W_LAYER_ELEMS; (void)rope; (void)H; (void)P; (void)XC; (void)DT; (void)Qn; (void)Kn; (void)YA; (void)YB; (void)CB; (void)VB; (void)Mf; (void)Mb; (void)OF; (void)W;
    { const int l = 0; PV; ph_wconv(a.in[2], a.in[22], a.in[23], Wall, lds, gw, ngw, wave, lane); }
    { const int l = 0; PV; ph_rope_table(rope, gtid, nthr); }
    { const int l = 0; PV; ph_rmsnorm(a.in[0], a.in[1], H, TH, gw, ngw, lane); }
    grid.sync();
#pragma unroll 1
    for (int hf = 0; hf < 2; ++hf) {
#pragma unroll 1
        for (int l = 0; l < 2; ++l) {
            const size_t ro = (size_t)hf * TH * 1024; const float* xin = (l == 0 ? a.in[0] : a.out) + ro; float* xout = a.out + ro;
            { PV; ph_gemm_bf16out_range(lds, H, 1024, W + WOFF_W1, TH, (int)W1T_N, 1024, P, LDP, 0, 7, tid, bid); }
            GSYNC();
            if ((int)blockIdx.x < 64) { PV; ph_gemm_bf16out_range(lds, H, 1024, W + WOFF_W1, TH, (int)W1T_N, 1024, P, LDP, 7, 1, tid, bid); }
            else { PV; ph_prep_conv(P, TH, a.in[3] + l * 5 * 1024, a.in[4] + l * 1024, a.in[5] + l * 16, XC, DT, gtid - 64 * 512, nthr - 64 * 512); }
            { PV; ph_prep_gqa(P, TH, a.in[19] + l * 64, a.in[20] + l * 64, rope, Qn, Kn, gtid, nthr); }
            GSYNC();
            { PV; ph_rwkv(lds, P, TH, NB_HALF, a.in[9] + l * 2 * 1792, a.in[10] + l * 1024, a.in[11] + (size_t)l * 2 * 64 * 512, a.in[12] + l * 1024, a.in[13] + (size_t)l * 2 * 64 * 512, a.in[14] + l * 512, a.in[15] + l * 512, a.in[16] + l * 512, YB, CB, VB, tid, bid, (int)gridDim.x); }
            { PV; ph_ssd(lds, XC, DT, a.in[6] + l * 16, YA, TH, NB_HALF, tid, bid, (int)gridDim.x, 128); }
            { PV; ph_attn((char*)lds_, P, Qn, Kn, a.in[21] + l * 8 * 465, NB_HALF, tid, (unsigned*)(ws + WS_CTL) + 8192 + 64 * (2 * l + hf), (volatile LAS unsigned*)(lds + LDS_BYTES - 8)); }
            GSYNC();
            { PV; ph_post(P, TH, XC, YA, a.in[7] + l * 8, a.in[8] + l * 512, YB, CB, VB, a.in[17] + l * 512, a.in[18] + l * 512, gw, ngw, lane); }
            { PV; ph_gemm_rsigout(lds, H, 1024, W + WOFF_W2, TH, (int)W2T_N, 1024, P, LDP, tid, bid); }
            GSYNC();
            { PV; EpiMergeF E{Mb, P, LDP}; run_gemm(lds, P + PC_Y, LDP, W + WOFF_WB, TH, 1024, 2048, E, tid, bid); }
            GSYNC();
            { PV; EpiF32 E{OF, 1024}; run_gemm(lds, Mb, 1024, W + WOFF_WO, TH, 1024, 1024, E, tid, bid); }
            GSYNC();
            { PV; ph_fin(xin, OF, a.in[24] + l * 1024, xout, l == 0 ? a.in[1] + 1024 : nullptr, H, TH, gw, ngw, lane); }
            if (l == 1 && hf == 0) { PV; ph_rmsnorm(a.in[0] + (size_t)TH * 1024, a.in[1], H, TH, gw, ngw, lane); }
            GSYNC();
        }
    }
}
}
extern "C" void kernel_launch(void* const* d_in, const int* in_sizes, int n_in, void* d_out, int out_size, void* d_ws, size_t ws_size, hipStream_t stream) {
    static int grid_blocks = 0;
    if (!grid_blocks) {
        if (ws_size < mk::WS_NEED) { fprintf(stderr, "ws too small: need %zu have %zu\n", (size_t)mk::WS_NEED, ws_size); grid_blocks = -1; return; }
        int dev = 0, cus = 0, per_cu = 0; (void)hipGetDevice(&dev); (void)hipDeviceGetAttribute(&cus, hipDeviceAttributeMultiprocessorCount, dev);
        (void)hipFuncSetAttribute((const void*)mk::k_mega, hipFuncAttributeMaxDynamicSharedMemorySize, mk::LDS_BYTES);
        (void)hipOccupancyMaxActiveBlocksPerMultiprocessor(&per_cu, (const void*)mk::k_mega, 512, mk::LDS_BYTES);
        if (per_cu < 1) { fprintf(stderr, "occupancy query says %d blocks/CU\n", per_cu); per_cu = 1; }
        grid_blocks = cus;
        fprintf(stderr, "k_mega: cus %d per_cu %d grid %d ws_need %zu ws %zu\n", cus, per_cu, grid_blocks, (size_t)mk::WS_NEED, ws_size);
    }
    if (grid_blocks < 0) return;
    mk::MegaArgs a{}; for (int i = 0; i < 25; ++i) a.in[i] = (const float*)d_in[i]; a.out = (float*)d_out; a.ws = (unsigned char*)d_ws;
    (void)hipMemsetAsync((char*)d_ws + mk::WS_CTL, 0, mk::CTL_BYTES, stream);
    void* args[] = {(void*)&a};
    hipError_t e = hipLaunchCooperativeKernel((const void*)mk::k_mega, dim3(grid_blocks), dim3(512), args, mk::LDS_BYTES, stream);
    if (e != hipSuccess) fprintf(stderr, "cooperative launch failed: %s (grid %d)\n", hipGetErrorString(e), grid_blocks);
}
```

```cpp
#include <hip/hip_runtime.h>
#include <cstdio>
#include <cstdint>
#include <cmath>
namespace pg8 {
#define PG8_LAS __attribute__((address_space(3)))
typedef unsigned short bf16_t;
typedef short bf16x8 __attribute__((ext_vector_type(8)));
typedef float f32x4 __attribute__((ext_vector_type(4)));
typedef unsigned u32x4 __attribute__((ext_vector_type(4)));
constexpr int BM = 256, BK = 64, HALF = 128, HTB = HALF * BK * 2  , STAGE_BYTES = 8 * HTB, NXCD = 8, WGM = 8;

__host__ __device__ __forceinline__ int lds_byte(int r, int c) { const int st = (r >> 4) * 2 + (c >> 5), rr = r & 15, cc = c & 31, ob = rr * 64 + cc * 2; return st * 1024 + (ob ^ (((ob >> 9) & 1) << 5)); }
__host__ __device__ __forceinline__ void stage_rc(int b, int& R, int& C) { const int st = b / 1024, sb = b % 1024, swz = sb ^ (((sb >> 9) & 1) << 5); R = (st >> 1) * 16 + swz / 64; C = (st & 1) * 32 + (swz % 64) / 2; }
__host__ __device__ __forceinline__ int perm32(int rho) { const int n = rho >> 4, i = rho & 15; return 8 * (i >> 2) + 4 * n + (i & 3); }

struct Unit { int pm, pn; };
struct Gemm { const bf16_t* A; const bf16_t* Bt; int M, N, K, lda; };

struct StaticOrder {
    int nM, nN, nwg, G, c;
    __host__ __device__ void init(int M, int N, int G_, int c_) { nM = M / BM; nN = N / BM; nwg = nM * nN; G = G_; c = c_; }
    __host__ __device__ bool next(int i, Unit& u) const {
        const long L = (long)i * G + c; if (L >= nwg) return false;
        int wgid = (int)L; { const int q = nwg / NXCD, r = nwg % NXCD, xcd = wgid % NXCD, off = wgid / NXCD; wgid = (xcd < r ? xcd * (q + 1) : r * (q + 1) + (xcd - r) * q) + off; }
        const int nig = WGM * nN, gid = wgid / nig, fm = gid * WGM, gsz = (nM - fm) < WGM ? (nM - fm) : WGM;
        u.pm = fm + ((wgid % nig) % gsz); u.pn = (wgid % nig) / gsz; return true;
    }
    __device__ __forceinline__ void a_ready(const Unit&) const {}
    __device__ __forceinline__ void done(const Unit&) const {}
};

__device__ __forceinline__ unsigned cvt_pk_bf16(float lo, float hi) { unsigned r; asm volatile("v_cvt_pk_bf16_f32 %0, %1, %2" : "=v"(r) : "v"(lo), "v"(hi)); return r; }
typedef float f32x2 __attribute__((ext_vector_type(2)));
__device__ __forceinline__ f32x2 gelu_pk(f32x2 v) {
    const f32x2 av = __builtin_elementwise_abs(v), d = av * 0.2316418882f + 1.0f;
    f32x2 t; t.x = __builtin_amdgcn_rcpf(d.x); t.y = __builtin_amdgcn_rcpf(d.y);
    f32x2 q = t * 0.5307027145f + (-0.7265760135f); q = q * t + 0.7107068705f; q = q * t + (-0.142248368f); q = q * t + 0.127414796f; q = q * t;
    const f32x2 s = (v * v) * (-0.72134752044f);
    f32x2 e; e.x = __builtin_amdgcn_exp2f(s.x); e.y = __builtin_amdgcn_exp2f(s.y);
    const f32x2 m = v * (q * e), r = v - m;
    f32x2 o; o.x = v.x < 0.f ? m.x : r.x; o.y = v.y < 0.f ? m.y : r.y; return o;
}

template <int ACT  > struct EpiBf16 {
    static constexpr bool PERM = true, AFTER_DRAIN = false, FOLD = false; static_assert(ACT >= 0 && ACT <= 2, "EpiBf16: ACT is 0 (none), 1 (gelu_pk) or 2 (1 + exp(-x), the reciprocal sigmoid)");
    bf16_t* O; int ldc; const float* bias; int split_cols; size_t split_stride; float scale0;
    __device__ __forceinline__ void operator()(const f32x4 (&acc)[2][2][4][2], const Unit& u, int wr, int wc, int fr, int fq) const {
        const int row0 = u.pm * BM + wr * 64 + fr; int colt = u.pn * BM; bf16_t* base = O;
        float sc = 1.f; if (split_cols) { const int t = colt / split_cols; base += (size_t)t * split_stride; colt -= t * split_cols; if (t == 0) sc = scale0; }
        const int col0 = colt + wc * 32 + 8 * fq, bcol0 = u.pn * BM + wc * 32 + 8 * fq;
        f32x4 bv[2][2];
#pragma unroll
        for (int bj = 0; bj < 2; ++bj)
#pragma unroll
            for (int n = 0; n < 2; ++n) bv[bj][n] = bias ? *(const f32x4*)(bias + bcol0 + bj * HALF + 4 * n) : (f32x4){0.f, 0.f, 0.f, 0.f};
#pragma unroll
        for (int ai = 0; ai < 2; ++ai)
#pragma unroll
            for (int m = 0; m < 4; ++m) { bf16_t* rowp = base + (size_t)(row0 + ai * HALF + m * 16) * ldc + col0;
#pragma unroll
                for (int bj = 0; bj < 2; ++bj) { f32x4 v0 = acc[ai][bj][m][0] + bv[bj][0], v1 = acc[ai][bj][m][1] + bv[bj][1];
                    if (ACT == 1) { f32x2 a = gelu_pk((f32x2){v0[0], v0[1]}), b = gelu_pk((f32x2){v0[2], v0[3]}), c = gelu_pk((f32x2){v1[0], v1[1]}), d = gelu_pk((f32x2){v1[2], v1[3]});
                        v0 = (f32x4){a.x, a.y, b.x, b.y}; v1 = (f32x4){c.x, c.y, d.x, d.y}; }
                    if (ACT == 2) { _Pragma("unroll") for (int e = 0; e < 4; ++e) { v0[e] = 1.f + __builtin_amdgcn_exp2f(__builtin_fminf(__builtin_fmaxf(v0[e], -60.f), 60.f) * -1.4426950408889634f); v1[e] = 1.f + __builtin_amdgcn_exp2f(__builtin_fminf(__builtin_fmaxf(v1[e], -60.f), 60.f) * -1.4426950408889634f); } }
                    v0 = v0 * sc; v1 = v1 * sc; u32x4 w; w.x = cvt_pk_bf16(v0[0], v0[1]); w.y = cvt_pk_bf16(v0[2], v0[3]); w.z = cvt_pk_bf16(v1[0], v1[1]); w.w = cvt_pk_bf16(v1[2], v1[3]);
                    *(u32x4*)(rowp + bj * HALF) = w; } }
    }
};
template <class Epi, class Sched, bool ALIGN_EPI = false, bool SP2 = false>
__device__ __forceinline__ void gemm_phase(PG8_LAS unsigned char* lds, const Gemm g, const Sched& S, const Epi& E, const int tid) {
    const int wid = __builtin_amdgcn_readfirstlane(tid >> 6), lane = tid & 63, wr = wid >> 2, wc = wid & 3, fr = lane & 15, fq = lane >> 4;
    const int K = g.K, nt = K / BK;
    unsigned voffA[2], voffB[2];
#pragma unroll
    for (int i = 0; i < 2; ++i) { int R, C; stage_rc(tid * 16 + i * 8192, R, C); const int Rb = Epi::PERM ? ((R & ~31) + perm32(R & 31)) : R;
        voffA[i] = (unsigned)(R * g.lda + C) * 2u; voffB[i] = (unsigned)(Rb * K + C) * 2u; }
    const size_t kstep = (size_t)(BK * 2);
    const size_t hstep = (size_t)HALF * K * 2;
    const size_t tstep = 2 * hstep;
    const size_t hstepA = (size_t)HALF * g.lda * 2, tstepA = 2 * hstepA;
    const unsigned ldsw = (unsigned)wid * 1024u;
    const int aoff = lds_byte(wr * 64 + fr, fq * 8), boff = lds_byte(wc * 32 + fr, fq * 8);
#define PG8_SA(b, h) (((b) * 2 + (h)) * HTB)
#define PG8_SB(b, h) ((4 + (b) * 2 + (h)) * HTB)
#define PG8_STAGE(bufoff, gbase, voff) do { _Pragma("unroll") for (int _i = 0; _i < 2; ++_i) \
        __builtin_amdgcn_global_load_lds((const unsigned*)((const char*)(gbase) + (voff)[_i]), (PG8_LAS unsigned*)(lds + (bufoff) + ldsw + _i * 8192), 16, 0, 0); } while (0)
#define PG8_LDA(dst, b, h) do { _Pragma("unroll") for (int m = 0; m < 4; ++m) _Pragma("unroll") for (int k = 0; k < 2; ++k) dst[m][k] = *(const PG8_LAS bf16x8*)(lds + PG8_SA(b, h) + aoff + m * 2048 + k * 1024); } while (0)
#define PG8_LDB(dst, b, h) do { _Pragma("unroll") for (int n = 0; n < 2; ++n) _Pragma("unroll") for (int k = 0; k < 2; ++k) dst[n][k] = *(const PG8_LAS bf16x8*)(lds + PG8_SB(b, h) + boff + n * 2048 + k * 1024); } while (0)
#define PG8_MMA(ai, bj, At, Bt) do { __builtin_amdgcn_s_setprio(1); _Pragma("unroll") for (int m = 0; m < 4; ++m) _Pragma("unroll") for (int n = 0; n < 2; ++n) _Pragma("unroll") for (int k = 0; k < 2; ++k) \
        acc[ai][bj][m][n] = __builtin_amdgcn_mfma_f32_16x16x32_bf16(Bt[n][k], At[m][k], acc[ai][bj][m][n], 0, 0, 0); __builtin_amdgcn_s_setprio(0); } while (0)
#define PG8_WAIT_V(n) asm volatile("s_waitcnt vmcnt(" #n ")" ::: "memory")
#define PG8_WAIT_L(n) asm volatile("s_waitcnt lgkmcnt(" #n ")" ::: "memory")
#define PG8_BAR __builtin_amdgcn_s_barrier()
#define PG8_SCHED __builtin_amdgcn_sched_barrier(0)
    Unit cur, nxt; int ui = 0;
    if (!S.next(0, cur)) return;
    f32x4 acc[2][2][4][2];
#pragma unroll
    for (int a = 0; a < 2; ++a)
#pragma unroll
        for (int b = 0; b < 2; ++b)
#pragma unroll
            for (int m = 0; m < 4; ++m)
#pragma unroll
                for (int n = 0; n < 2; ++n) acc[a][b][m][n] = (f32x4){0.f, 0.f, 0.f, 0.f};
    bf16x8 At[4][2], B0[2][2], B1[2][2];
    const char* cA = (const char*)g.A + (size_t)cur.pm * tstepA; const char* cB = (const char*)g.Bt + (size_t)cur.pn * tstep;
    S.a_ready(cur);
    if constexpr (SP2) {
        PG8_STAGE(PG8_SB(0, 0), cB, voffB); PG8_STAGE(PG8_SB(0, 1), cB + hstep, voffB); PG8_STAGE(PG8_SA(0, 0), cA, voffA); PG8_STAGE(PG8_SA(0, 1), cA + hstepA, voffA);
        if (wr == 1) PG8_BAR;
        PG8_WAIT_V(2); PG8_BAR;
        PG8_STAGE(PG8_SB(1, 0), cB + kstep, voffB); PG8_STAGE(PG8_SA(1, 0), cA + kstep, voffA); PG8_STAGE(PG8_SB(1, 1), cB + hstep + kstep, voffB);
        PG8_WAIT_V(6); PG8_BAR;
    } else {
        PG8_STAGE(PG8_SB(0, 0), cB, voffB); PG8_STAGE(PG8_SA(0, 0), cA, voffA); PG8_STAGE(PG8_SB(0, 1), cB + hstep, voffB); PG8_STAGE(PG8_SA(0, 1), cA + hstepA, voffA);
        if (wr == 1) PG8_BAR;
        PG8_WAIT_V(4); PG8_BAR;
        PG8_STAGE(PG8_SB(1, 0), cB + kstep, voffB); PG8_STAGE(PG8_SA(1, 0), cA + kstep, voffA); PG8_STAGE(PG8_SB(1, 1), cB + hstep + kstep, voffB);
        PG8_WAIT_V(6); PG8_BAR;
    }
    for (;;) {
        const bool has_next = S.next(ui + 1, nxt);
        const char* nA = has_next ? (const char*)g.A + (size_t)nxt.pm * tstepA : cA; const char* nB = has_next ? (const char*)g.Bt + (size_t)nxt.pn * tstep : cB;
        for (int t = 0; t < nt; t += 2) {
            const bool last = (t == nt - 2);
            const char* a1 = cA + (size_t)(t + 1) * kstep;
            const char* a2 = last ? nA : cA + (size_t)(t + 2) * kstep; const char* b2 = last ? nB : cB + (size_t)(t + 2) * kstep;
            const char* a3 = a2 + kstep; const char* b3 = b2 + kstep;
            if (last && has_next) S.a_ready(nxt);
            if constexpr (SP2) {
            PG8_LDB(B0, 0, 0); PG8_LDB(B1, 0, 1); PG8_SCHED; PG8_LDA(At, 0, 0); PG8_STAGE(PG8_SA(1, 1), a1 + hstepA, voffA);
            PG8_WAIT_V(8); PG8_WAIT_L(0); PG8_BAR; PG8_MMA(0, 0, At, B0); PG8_MMA(0, 1, At, B1); PG8_BAR; PG8_SCHED;
            PG8_LDA(At, 0, 1); PG8_STAGE(PG8_SB(0, 0), b2, voffB); PG8_STAGE(PG8_SB(0, 1), b2 + hstep, voffB); PG8_STAGE(PG8_SA(0, 0), a2, voffA);
            PG8_WAIT_V(8); PG8_WAIT_L(0); PG8_BAR; PG8_MMA(1, 0, At, B0); PG8_MMA(1, 1, At, B1); PG8_BAR; PG8_SCHED;
            PG8_LDB(B0, 1, 0); PG8_LDB(B1, 1, 1); PG8_SCHED; PG8_LDA(At, 1, 0); PG8_STAGE(PG8_SA(0, 1), a2 + hstepA, voffA);
            PG8_WAIT_V(8); PG8_WAIT_L(0); PG8_BAR; PG8_MMA(0, 0, At, B0); PG8_MMA(0, 1, At, B1); PG8_BAR; PG8_SCHED;
            PG8_LDA(At, 1, 1); PG8_STAGE(PG8_SB(1, 0), b3, voffB); PG8_STAGE(PG8_SB(1, 1), b3 + hstep, voffB); PG8_STAGE(PG8_SA(1, 0), a3, voffA);
            PG8_WAIT_V(8); PG8_WAIT_L(0); PG8_BAR; PG8_MMA(1, 0, At, B0); PG8_MMA(1, 1, At, B1); PG8_BAR; PG8_SCHED;
            } else {
            PG8_LDB(B0, 0, 0); PG8_SCHED; PG8_LDA(At, 0, 0); PG8_STAGE(PG8_SA(1, 1), a1 + hstepA, voffA);
            PG8_WAIT_L(8); PG8_BAR; PG8_WAIT_L(0); PG8_MMA(0, 0, At, B0); PG8_BAR; PG8_SCHED;
            PG8_LDB(B1, 0, 1); PG8_STAGE(PG8_SB(0, 0), b2, voffB);
            PG8_BAR; PG8_WAIT_L(0); PG8_MMA(0, 1, At, B1); PG8_BAR;
            PG8_LDA(At, 0, 1); PG8_STAGE(PG8_SA(0, 0), a2, voffA);
            PG8_BAR; PG8_WAIT_L(0); PG8_MMA(1, 0, At, B0); PG8_BAR; PG8_SCHED;
            PG8_STAGE(PG8_SB(0, 1), b2 + hstep, voffB);
            PG8_WAIT_V(6); PG8_BAR; PG8_MMA(1, 1, At, B1); PG8_BAR;
            PG8_LDB(B0, 1, 0); PG8_SCHED; PG8_LDA(At, 1, 0); PG8_STAGE(PG8_SA(0, 1), a2 + hstepA, voffA);
            PG8_WAIT_L(8); PG8_BAR; PG8_WAIT_L(0); PG8_MMA(0, 0, At, B0); PG8_BAR; PG8_SCHED;
            PG8_LDB(B1, 1, 1); PG8_STAGE(PG8_SB(1, 0), b3, voffB);
            PG8_BAR; PG8_WAIT_L(0); PG8_MMA(0, 1, At, B1); PG8_BAR;
            PG8_LDA(At, 1, 1); PG8_STAGE(PG8_SA(1, 0), a3, voffA);
            PG8_BAR; PG8_WAIT_L(0); PG8_MMA(1, 0, At, B0); PG8_BAR; PG8_SCHED;
            PG8_STAGE(PG8_SB(1, 1), b3 + hstep, voffB);
            PG8_WAIT_V(6); PG8_BAR; PG8_MMA(1, 1, At, B1); PG8_BAR;
            }
            if constexpr (Epi::FOLD) { if ((((t + 2) & 7) == 0) && !last) E.fold(acc, ((t + 2) >> 3) - 1, cur, wr, wc, fr, fq); }
        }
        if constexpr (ALIGN_EPI) { if (wr == 0) PG8_BAR; }
        if constexpr (!Epi::AFTER_DRAIN) { E(acc, cur, wr, wc, fr, fq); S.done(cur); }
        if (!has_next) break;
#pragma unroll
        for (int a = 0; a < 2; ++a)
#pragma unroll
            for (int b = 0; b < 2; ++b)
#pragma unroll
                for (int m = 0; m < 4; ++m)
#pragma unroll
                    for (int n = 0; n < 2; ++n) acc[a][b][m][n] = (f32x4){0.f, 0.f, 0.f, 0.f};
        cur = nxt; cA = nA; cB = nB; ++ui;
        if constexpr (ALIGN_EPI) { if (wr == 1) PG8_BAR; }
    }
    PG8_WAIT_V(0);
    if constexpr (!ALIGN_EPI) { if (wr == 0) PG8_BAR; }
    PG8_BAR;
    if constexpr (Epi::AFTER_DRAIN) { E.fused(acc, cur, wr, wc, fr, fq, lds, wid, lane); S.done(cur); }
#undef PG8_SA
#undef PG8_SB
#undef PG8_STAGE
#undef PG8_LDA
#undef PG8_LDB
#undef PG8_MMA
#undef PG8_WAIT_V
#undef PG8_WAIT_L
#undef PG8_BAR
#undef PG8_SCHED
}
}
namespace mk {
#define LAS __attribute__((address_space(3)))
#define GAS __attribute__((address_space(1)))
typedef unsigned short bf16;
typedef unsigned v4u __attribute__((ext_vector_type(4)));
typedef unsigned v2u __attribute__((ext_vector_type(2)));
typedef float f32x4 __attribute__((ext_vector_type(4)));
typedef float f32x16 __attribute__((ext_vector_type(16)));
typedef float f32x2v __attribute__((ext_vector_type(2)));
typedef short bf16x8 __attribute__((ext_vector_type(8)));
typedef short s16x4 __attribute__((ext_vector_type(4)));
constexpr int SEQ = 2048, DM = 1024, NIN = 11280;
constexpr int LDP = 7424;
constexpr int PC_SLAB = 0, PC_XBC = 1792, PC_DT = 2816, PC_QKVC = 3072, PC_QKVD = 3840, PC_ZA = 5376, PC_GB = 5888, PC_GC = 6400, PC_GD = 6912;
constexpr int PC_Y = PC_ZA;
constexpr size_t W1T_N = 7424, W2T_N = 4096;
constexpr size_t WOFF_W1 = 0, WOFF_W2 = WOFF_W1 + W1T_N * 1024, WOFF_WB = WOFF_W2 + W2T_N * 1024, WOFF_WO = WOFF_WB + 4ull * 1024 * 512, W_LAYER_ELEMS = WOFF_WO + 1024ull * 1024;
#define LDS_WAIT() asm volatile("s_waitcnt lgkmcnt(0)" ::: "memory")
#define VM_WAIT() asm volatile("s_waitcnt vmcnt(0)" ::: "memory")
__device__ __forceinline__ unsigned f2bf(float f) { unsigned u = __builtin_bit_cast(unsigned, f); return (u + 0x7fffu + ((u >> 16) & 1u)) >> 16; }
__device__ __forceinline__ unsigned pk2(float lo, float hi) { return f2bf(lo) | (f2bf(hi) << 16); }
__device__ __forceinline__ float bf2f(unsigned short b) { return __builtin_bit_cast(float, (unsigned)b << 16); }
__device__ __forceinline__ float bflo(unsigned w) { return __builtin_bit_cast(float, w << 16); }
__device__ __forceinline__ float bfhi(unsigned w) { return __builtin_bit_cast(float, w & 0xffff0000u); }
__device__ __forceinline__ float lane_xor(float v, int lane, int o) { return __builtin_bit_cast(float, __builtin_amdgcn_ds_bpermute((lane ^ o) << 2, __builtin_bit_cast(int, v))); }
#define MK_DPP(x, ctrl) __builtin_bit_cast(float, __builtin_amdgcn_update_dpp(0, __builtin_bit_cast(int, (x)), (ctrl), 0xf, 0xf, true))
__device__ __forceinline__ float sum_l4(float x) { x += MK_DPP(x, 0xB1); x += MK_DPP(x, 0x4E); return x; }
__device__ __forceinline__ float sum_l8(float x) { x = sum_l4(x); x += MK_DPP(x, 0x141); return x; }
__device__ __forceinline__ float sum_l16(float x) { x = sum_l8(x); x += MK_DPP(x, 0x140); return x; }
__device__ __forceinline__ float sum_l32(float x) { x = sum_l16(x); const auto rr = __builtin_amdgcn_permlane16_swap(__float_as_uint(x), __float_as_uint(x), false, false); return __uint_as_float(rr[0]) + __uint_as_float(rr[1]); }
__device__ __forceinline__ float sum_l64(float x) { x = sum_l32(x); const auto rr = __builtin_amdgcn_permlane32_swap(__float_as_uint(x), __float_as_uint(x), false, false); return __uint_as_float(rr[0]) + __uint_as_float(rr[1]); }
__device__ __forceinline__ float wave_sum(float v, int lane) { (void)lane; return sum_l64(v); }
__device__ __forceinline__ float fsilu(float x) { return x / (1.f + __expf(-x)); }
__device__ __forceinline__ float fsigmoid(float x) { return 1.f / (1.f + __expf(-x)); }

__device__ __forceinline__ void transpose_item(const float* W, int ldw, int ldt, int c0, int nvalid, int ntotal, bf16* WT, int r0, LAS float* scr, int item, int lane) {
    const int nblk = ntotal / 32, kb = item / nblk, nb = item % nblk, k0 = 64 * kb, n0 = 32 * nb;
    const bool ok = (n0 + (lane & 31)) < nvalid;
    float wv[32];
#pragma unroll
    for (int i = 0; i < 32; ++i) { const int kk = 2 * i + (lane >> 5); wv[i] = W[(size_t)(k0 + kk) * ldw + c0 + (ok ? n0 + (lane & 31) : 0)]; }
#pragma unroll
    for (int i = 0; i < 32; ++i) { const int kk = 2 * i + (lane >> 5); scr[kk * 33 + (lane & 31)] = ok ? wv[i] : 0.f; }
    LDS_WAIT(); asm volatile("" ::: "memory");
    const int c = lane & 7;
#pragma unroll
    for (int j = 0; j < 4; ++j) { const int n = (lane >> 3) + 8 * j; const LAS float* s = scr + (8 * c) * 33 + n;
        v4u o; o.x = pk2(s[0 * 33], s[1 * 33]); o.y = pk2(s[2 * 33], s[3 * 33]); o.z = pk2(s[4 * 33], s[5 * 33]); o.w = pk2(s[6 * 33], s[7 * 33]);
        *(GAS v4u*)(WT + (size_t)(r0 + n0 + n) * ldt + k0 + 8 * c) = o; }
    LDS_WAIT(); asm volatile("" ::: "memory");
}
struct WSeg { int src, soff, ldw, c0, nvalid, ntotal; unsigned doff; int ldt, r0, ni; };
constexpr int WCONV_NSEG = 15, WCONV_ITEMS = 16 * (7424 / 32) + 16 * (4096 / 32) + 4 * 8 * (1024 / 32) + 16 * (1024 / 32);
__device__ __forceinline__ void ph_wconv(const float* w_in, const float* w_branch, const float* w_out, bf16* Wall, LAS unsigned char* lds, int gw, int ngw, int wave, int lane) {
    LAS float* scr = (LAS float*)(lds + wave * 16384);
    const WSeg segs[WCONV_NSEG] = {
        {0, 0, NIN, 1552, 1792, 1792, (unsigned)WOFF_W1, 1024, 0, 16 * 56}, {0, 0, NIN, 512, 1024, 1024, (unsigned)WOFF_W1, 1024, 1792, 16 * 32}, {0, 0, NIN, 1536, 16, 256, (unsigned)WOFF_W1, 1024, PC_DT, 16 * 8},
        {0, 0, NIN, 3856, 768, 768, (unsigned)WOFF_W1, 1024, PC_QKVC, 16 * 24}, {0, 0, NIN, 5136, 1536, 1536, (unsigned)WOFF_W1, 1024, PC_QKVD, 16 * 48}, {0, 0, NIN, 0, 512, 512, (unsigned)WOFF_W1, 1024, PC_ZA, 16 * 16},
        {0, 0, NIN, 3344, 512, 512, (unsigned)WOFF_W1, 1024, PC_GB, 16 * 16}, {0, 0, NIN, 4624, 512, 512, (unsigned)WOFF_W1, 1024, PC_GC, 16 * 16}, {0, 0, NIN, 6672, 512, 512, (unsigned)WOFF_W1, 1024, PC_GD, 16 * 16},
        {0, 0, NIN, 7184, 4096, 4096, (unsigned)WOFF_W2, 1024, 0, 16 * 128},
        {1, 0 * 512 * 1024, 1024, 0, 1024, 1024, (unsigned)WOFF_WB + 0 * 512, 2048, 0, 8 * 32}, {1, 1 * 512 * 1024, 1024, 0, 1024, 1024, (unsigned)WOFF_WB + 1 * 512, 2048, 0, 8 * 32},
        {1, 2 * 512 * 1024, 1024, 0, 1024, 1024, (unsigned)WOFF_WB + 2 * 512, 2048, 0, 8 * 32}, {1, 3 * 512 * 1024, 1024, 0, 1024, 1024, (unsigned)WOFF_WB + 3 * 512, 2048, 0, 8 * 32},
        {2, 0, 1024, 0, 1024, 1024, (unsigned)WOFF_WO, 1024, 0, 16 * 32}};
#pragma unroll 1
    for (int it0 = gw; it0 < 2 * WCONV_ITEMS; it0 += ngw) { const int l2 = it0 >= WCONV_ITEMS ? 1 : 0; int it = it0 - l2 * WCONV_ITEMS, s = 0;
#pragma unroll 1
        while (it >= segs[s].ni) { it -= segs[s].ni; ++s; }
        const WSeg g = segs[s];
        const float* src = g.src == 0 ? w_in + (size_t)l2 * 1024 * NIN : (g.src == 1 ? w_branch + (size_t)l2 * 4 * 512 * 1024 + g.soff : w_out + (size_t)l2 * 1024 * 1024);
        transpose_item(src, g.ldw, g.ldt, g.c0, g.nvalid, g.ntotal, Wall + (size_t)l2 * W_LAYER_ELEMS + g.doff, g.r0, scr, it, lane); }
}
__device__ __forceinline__ void rms_row_to_bf16(const float* xrow, const float* w, bf16* orow, int lane) {
    const GAS f32x4* xr = (const GAS f32x4*)xrow + lane; const GAS f32x4* wr = (const GAS f32x4*)w + lane;
    f32x4 v[4]; float s = 0.f;
#pragma unroll
    for (int j = 0; j < 4; ++j) { v[j] = xr[64 * j]; s += (v[j].x * v[j].x + v[j].y * v[j].y) + (v[j].z * v[j].z + v[j].w * v[j].w); }
    const float rstd = 1.f / sqrtf(wave_sum(s, lane) * (1.f / 1024.f) + 1e-6f);
    GAS unsigned long long* o8 = (GAS unsigned long long*)orow + lane;
#pragma unroll
    for (int j = 0; j < 4; ++j) { const f32x4 ww = wr[64 * j]; o8[64 * j] = (unsigned long long)pk2(v[j].x * rstd * ww.x, v[j].y * rstd * ww.y) | ((unsigned long long)pk2(v[j].z * rstd * ww.z, v[j].w * rstd * ww.w) << 32); }
}
__device__ __forceinline__ void ph_rmsnorm(const float* x, const float* w, bf16* H, int nrows, int gw, int ngw, int lane) {
    f32x4 wv4[4];
#pragma unroll
    for (int j = 0; j < 4; ++j) wv4[j] = ((const GAS f32x4*)w + lane)[64 * j];
    for (int m = gw; m < nrows; m += 2 * ngw) { const int m2 = m + ngw; const bool two = m2 < nrows;
        const GAS f32x4* xa = (const GAS f32x4*)(x + (size_t)m * 1024) + lane; const GAS f32x4* xb = (const GAS f32x4*)(x + (size_t)(two ? m2 : m) * 1024) + lane;
        f32x4 va[4], vb[4]; float sa = 0.f, sb = 0.f;
#pragma unroll
        for (int j = 0; j < 4; ++j) { va[j] = xa[64 * j]; vb[j] = xb[64 * j]; }
#pragma unroll
        for (int j = 0; j < 4; ++j) { sa += (va[j].x * va[j].x + va[j].y * va[j].y) + (va[j].z * va[j].z + va[j].w * va[j].w); sb += (vb[j].x * vb[j].x + vb[j].y * vb[j].y) + (vb[j].z * vb[j].z + vb[j].w * vb[j].w); }
        const float ra = 1.f / sqrtf(sum_l64(sa) * (1.f / 1024.f) + 1e-6f), rb = 1.f / sqrtf(sum_l64(sb) * (1.f / 1024.f) + 1e-6f);
        GAS unsigned long long* oa = (GAS unsigned long long*)(H + (size_t)m * 1024) + lane; GAS unsigned long long* ob = (GAS unsigned long long*)(H + (size_t)(two ? m2 : m) * 1024) + lane;
#pragma unroll
        for (int j = 0; j < 4; ++j) { const f32x4 ww = wv4[j];
            oa[64 * j] = (unsigned long long)pk2(va[j].x * ra * ww.x, va[j].y * ra * ww.y) | ((unsigned long long)pk2(va[j].z * ra * ww.z, va[j].w * ra * ww.w) << 32);
            if (two) ob[64 * j] = (unsigned long long)pk2(vb[j].x * rb * ww.x, vb[j].y * rb * ww.y) | ((unsigned long long)pk2(vb[j].z * rb * ww.z, vb[j].w * rb * ww.w) << 32); } }
}
__device__ __forceinline__ void ph_gemm_rsigout(LAS unsigned char* lds, const bf16* A, int lda, const bf16* Bt, int M, int N, int K, bf16* O, int ldo, int tid, int bid) {
    pg8::Gemm g{A, Bt, M, N, K, lda}; pg8::StaticOrder S; S.init(M, N, (int)gridDim.x, bid);
    pg8::EpiBf16<2> E{O, ldo, nullptr, 0, 0, 1.f};
    pg8::gemm_phase<pg8::EpiBf16<2>, pg8::StaticOrder, true, true>(lds, g, S, E, tid);
}
struct RangeOrder : pg8::StaticOrder { int first, count;
    __device__ bool next(int i, pg8::Unit& u) const { return i < count && pg8::StaticOrder::next(i + first, u); } };
__device__ __forceinline__ void ph_gemm_bf16out_range(LAS unsigned char* lds, const bf16* A, int lda, const bf16* Bt, int M, int N, int K, bf16* O, int ldo, int first, int count, int tid, int bid) {
    pg8::Gemm g{A, Bt, M, N, K, lda}; RangeOrder S; S.init(M, N, (int)gridDim.x, bid); S.first = first; S.count = count;
    pg8::EpiBf16<0> E{O, ldo, nullptr, 0, 0, 1.f};
    pg8::gemm_phase<pg8::EpiBf16<0>, RangeOrder, true, true>(lds, g, S, E, tid);
}
__device__ __forceinline__ void ph_gemm_bf16out(LAS unsigned char* lds, const bf16* A, int lda, const bf16* Bt, int M, int N, int K, bf16* O, int ldo, int tid, int bid) {
    pg8::Gemm g{A, Bt, M, N, K, lda}; pg8::StaticOrder S; S.init(M, N, (int)gridDim.x, bid);
    pg8::EpiBf16<0> E{O, ldo, nullptr, 0, 0, 1.f};
    pg8::gemm_phase<pg8::EpiBf16<0>, pg8::StaticOrder, true, true>(lds, g, S, E, tid);
}
}
namespace mk {
constexpr float C2 = 0.125f * 1.4426950408889634f;
struct EpiF32 {
    static constexpr bool PERM = false, AFTER_DRAIN = false, FOLD = false;
    float* C; int ldc;
    __device__ __forceinline__ void operator()(const pg8::f32x4 (&acc)[2][2][4][2], const pg8::Unit& u, int wr, int wc, int fr, int fq) const {
        const int row0 = u.pm * 256 + wr * 64 + fr, col0 = u.pn * 256 + wc * 32 + 4 * fq;
#pragma unroll
        for (int ai = 0; ai < 2; ++ai)
#pragma unroll
            for (int m = 0; m < 4; ++m) { float* rowp = C + (size_t)(row0 + ai * 128 + m * 16) * ldc + col0;
#pragma unroll
                for (int bj = 0; bj < 2; ++bj)
#pragma unroll
                    for (int n = 0; n < 2; ++n) *(pg8::f32x4*)(rowp + bj * 128 + n * 16) = acc[ai][bj][m][n]; }
    }
};
template <int MODE> struct EpiMerge {
    static constexpr bool PERM = false, AFTER_DRAIN = false, FOLD = false;
    float* Mf; bf16* Mb; const bf16* G; int ldg;
    __device__ __forceinline__ void operator()(const pg8::f32x4 (&acc)[2][2][4][2], const pg8::Unit& u, int wr, int wc, int fr, int fq) const {
        const int row0 = u.pm * 256 + wr * 64 + fr, col0 = u.pn * 256 + wc * 32 + 4 * fq;
#pragma unroll
        for (int ai = 0; ai < 2; ++ai)
#pragma unroll
            for (int m = 0; m < 4; ++m) { const size_t r = (size_t)(row0 + ai * 128 + m * 16);
#pragma unroll
                for (int bj = 0; bj < 2; ++bj)
#pragma unroll
                    for (int n = 0; n < 2; ++n) { const int c = col0 + bj * 128 + n * 16;
                        const v2u gw = *(const v2u*)(G + r * ldg + c);
                        pg8::f32x4 v = acc[ai][bj][m][n];
                        v[0] *= fsigmoid(bflo(gw.x)); v[1] *= fsigmoid(bfhi(gw.x)); v[2] *= fsigmoid(bflo(gw.y)); v[3] *= fsigmoid(bfhi(gw.y));
                        if (MODE > 0) v += *(const pg8::f32x4*)(Mf + r * 1024 + c);
                        if (MODE < 2) *(pg8::f32x4*)(Mf + r * 1024 + c) = v;
                        else { v2u o; o.x = pk2(v[0], v[1]); o.y = pk2(v[2], v[3]); *(v2u*)(Mb + r * 1024 + c) = o; } } }
    }
};
__device__ __forceinline__ v4u gload16(const void* base, unsigned off) { v4u r; asm volatile("global_load_dwordx4 %0, %1, %2" : "=v"(r) : "v"(off), "s"(base) : "memory"); return r; }
__device__ __forceinline__ void gwait8(v4u& a, v4u& b, v4u& c, v4u& d, v4u& e, v4u& f, v4u& g, v4u& h) { asm volatile("s_waitcnt vmcnt(0)" : "+v"(a), "+v"(b), "+v"(c), "+v"(d), "+v"(e), "+v"(f), "+v"(g), "+v"(h) :: "memory"); }
struct EpiMergeF {
    static constexpr bool PERM = true, AFTER_DRAIN = false, FOLD = true;
    bf16* Mb; const bf16* S; int lds_;
    __device__ __forceinline__ void fold(pg8::f32x4 (&acc)[2][2][4][2], int seg, const pg8::Unit& u, int wr, int wc, int fr, int fq) const {
        unsigned off0 = (unsigned)((u.pm * 256 + wr * 64 + fr) * lds_ + u.pn * 256 + wc * 32 + 8 * fq + seg * 1024) * 2u; asm volatile("" : "+v"(off0));
#pragma unroll
        for (int ai = 0; ai < 2; ++ai)
#pragma unroll
            for (int mh = 0; mh < 2; ++mh) {
                v4u sa[2][2], sb[2][2];
#pragma unroll
                for (int mm = 0; mm < 2; ++mm)
#pragma unroll
                    for (int bj = 0; bj < 2; ++bj) { const unsigned ro = off0 + (unsigned)((ai * 128 + (2 * mh + mm) * 16) * lds_) * 2u + bj * 256; sa[mm][bj] = gload16(S, ro); sb[mm][bj] = gload16(S, ro + 2048); }
                gwait8(sa[0][0], sa[0][1], sa[1][0], sa[1][1], sb[0][0], sb[0][1], sb[1][0], sb[1][1]);
#pragma unroll
                for (int mm = 0; mm < 2; ++mm)
#pragma unroll
                    for (int bj = 0; bj < 2; ++bj) { const unsigned wa[4] = {sa[mm][bj].x, sa[mm][bj].y, sa[mm][bj].z, sa[mm][bj].w}, wb[4] = {sb[mm][bj].x, sb[mm][bj].y, sb[mm][bj].z, sb[mm][bj].w};
#pragma unroll
                        for (int e = 0; e < 4; ++e) { pg8::f32x4& v = acc[ai][bj][2 * mh + mm][e >> 1]; const int o = 2 * (e & 1);
                            v[o] *= bflo(wb[e]) * __builtin_amdgcn_rcpf(bflo(wa[e])); v[o + 1] *= bfhi(wb[e]) * __builtin_amdgcn_rcpf(bfhi(wa[e])); } } }
    }
    __device__ __forceinline__ void operator()(const pg8::f32x4 (&acc)[2][2][4][2], const pg8::Unit& u, int wr, int wc, int fr, int fq) const {
        const int row0 = u.pm * 256 + wr * 64 + fr, col0 = u.pn * 256 + wc * 32 + 8 * fq;
        const unsigned off0 = (unsigned)(row0 * lds_ + col0 + 3 * 1024) * 2u;
#pragma unroll
        for (int ai = 0; ai < 2; ++ai) { v4u sa[4][2];
#pragma unroll
            for (int m = 0; m < 4; ++m)
#pragma unroll
                for (int bj = 0; bj < 2; ++bj) sa[m][bj] = gload16(S, off0 + (unsigned)((ai * 128 + m * 16) * lds_) * 2u + bj * 256);
            gwait8(sa[0][0], sa[0][1], sa[1][0], sa[1][1], sa[2][0], sa[2][1], sa[3][0], sa[3][1]);
#pragma unroll
            for (int m = 0; m < 4; ++m) { const size_t r = (size_t)(row0 + ai * 128 + m * 16);
#pragma unroll
                for (int bj = 0; bj < 2; ++bj) { const int c = col0 + bj * 128; const v4u s4 = sa[m][bj]; const pg8::f32x4 v0 = acc[ai][bj][m][0], v1 = acc[ai][bj][m][1];
                    v4u o; o.x = pk2(v0[0] * __builtin_amdgcn_rcpf(bflo(s4.x)), v0[1] * __builtin_amdgcn_rcpf(bfhi(s4.x))); o.y = pk2(v0[2] * __builtin_amdgcn_rcpf(bflo(s4.y)), v0[3] * __builtin_amdgcn_rcpf(bfhi(s4.y)));
                    o.z = pk2(v1[0] * __builtin_amdgcn_rcpf(bflo(s4.z)), v1[1] * __builtin_amdgcn_rcpf(bfhi(s4.z))); o.w = pk2(v1[2] * __builtin_amdgcn_rcpf(bflo(s4.w)), v1[3] * __builtin_amdgcn_rcpf(bfhi(s4.w)));
                    *(GAS v4u*)(Mb + r * 1024 + c) = o; } } }
    }
};
template <class Epi> __device__ __forceinline__ void run_gemm(LAS unsigned char* lds, const bf16* A, int lda, const bf16* Bt, int M, int N, int K, const Epi& E, int tid, int bid) {
    pg8::Gemm g{A, Bt, M, N, K, lda}; pg8::StaticOrder S; S.init(M, N, (int)gridDim.x, bid);
    pg8::gemm_phase<Epi, pg8::StaticOrder, true, true>(lds, g, S, E, tid);
}
__device__ __forceinline__ void ph_rope_table(float* rope, int gtid, int nthr) {
    for (int i = gtid; i < SEQ * 32; i += nthr) { const int l = i >> 5, j = i & 31; const float inv = __builtin_amdgcn_exp2f(-(float)(j & 15) * 0.83048202372184f);
        const float ang = (float)(j < 16 ? (l >> 6) : (l & 63)) * inv; rope[i] = __cosf(ang); rope[SEQ * 32 + i] = __sinf(ang); }
}
__device__ __forceinline__ void ph_prep_conv(const bf16* P, int T, const float* cw, const float* cb, const float* dtb, bf16* XC, float* DT, int gtid, int nthr) {
    { const int c = (gtid & 127) * 8;
        float wj[5][8], bb[8];
#pragma unroll
        for (int j = 0; j < 5; ++j) { const f32x4 w0 = *(const GAS f32x4*)(cw + j * 1024 + c), w1 = *(const GAS f32x4*)(cw + j * 1024 + c + 4); wj[j][0] = w0.x; wj[j][1] = w0.y; wj[j][2] = w0.z; wj[j][3] = w0.w; wj[j][4] = w1.x; wj[j][5] = w1.y; wj[j][6] = w1.z; wj[j][7] = w1.w; }
        { const f32x4 b0 = *(const GAS f32x4*)(cb + c), b1 = *(const GAS f32x4*)(cb + c + 4); bb[0] = b0.x; bb[1] = b0.y; bb[2] = b0.z; bb[3] = b0.w; bb[4] = b1.x; bb[5] = b1.y; bb[6] = b1.z; bb[7] = b1.w; }
    for (int it = gtid; it < (T >> 3) * 128; it += nthr) { const int t0 = (it >> 7) * 8, l0 = t0 & (SEQ - 1);
        v4u row[12];
#pragma unroll
        for (int r = 0; r < 12; ++r) { const int ll = l0 + r - 2; const bool ok = (ll >= 0) && (ll < SEQ); const v4u z4 = {0u, 0u, 0u, 0u};
            row[r] = ok ? *(const GAS v4u*)(P + (size_t)(t0 + r - 2) * LDP + PC_XBC + c) : z4; }
#pragma unroll
        for (int q = 0; q < 8; ++q) { float a[8];
#pragma unroll
            for (int e = 0; e < 8; ++e) a[e] = bb[e];
#pragma unroll
            for (int j = 0; j < 5; ++j) { const v4u w = row[q + j];
                a[0] += wj[j][0] * bflo(w.x); a[1] += wj[j][1] * bfhi(w.x); a[2] += wj[j][2] * bflo(w.y); a[3] += wj[j][3] * bfhi(w.y); a[4] += wj[j][4] * bflo(w.z); a[5] += wj[j][5] * bfhi(w.z); a[6] += wj[j][6] * bflo(w.w); a[7] += wj[j][7] * bfhi(w.w); }
            v4u o; o.x = pk2(fsilu(a[0]), fsilu(a[1])); o.y = pk2(fsilu(a[2]), fsilu(a[3])); o.z = pk2(fsilu(a[4]), fsilu(a[5])); o.w = pk2(fsilu(a[6]), fsilu(a[7]));
            *(GAS v4u*)(XC + (size_t)(t0 + q) * 1024 + c) = o; } } }
    for (int it = gtid; it < T * 16; it += nthr) { const int t = it >> 4, j = it & 15; const float x = bf2f(P[(size_t)t * LDP + PC_DT + j]) + dtb[j]; DT[it] = x > 20.f ? x : __logf(1.f + __expf(x)); }
}
__device__ __forceinline__ void ph_prep_gqa(const bf16* P, int T, const float* qw, const float* kw, const float* rope, bf16* Qn, bf16* Kn, int gtid, int nthr) {
    { const int j8 = gtid & 7, g8 = gtid >> 3, ng8 = nthr >> 3;
      const f32x4 qw1 = *(const GAS f32x4*)(qw + 4 * j8), qw2 = *(const GAS f32x4*)(qw + 32 + 4 * j8), kw1 = *(const GAS f32x4*)(kw + 4 * j8), kw2 = *(const GAS f32x4*)(kw + 32 + 4 * j8);
      constexpr int GR = 2;
      for (int it0 = g8; it0 < T * 10; it0 += GR * ng8) {
        int tq[GR], hq[GR]; bool okq[GR]; v2u r1[GR], r2[GR]; f32x4 cs[GR], sn[GR];
#pragma unroll
        for (int q = 0; q < GR; ++q) { const int it = it0 + q * ng8; okq[q] = it < T * 10; const int itc = okq[q] ? it : it0; tq[q] = itc / 10; hq[q] = itc - tq[q] * 10; const int l = tq[q] & (SEQ - 1);
            const bf16* src = P + (size_t)tq[q] * LDP + PC_QKVC + hq[q] * 64 + 4 * j8; r1[q] = *(const GAS v2u*)src; r2[q] = *(const GAS v2u*)(src + 32);
            cs[q] = *(const GAS f32x4*)(rope + l * 32 + 4 * j8); sn[q] = *(const GAS f32x4*)(rope + SEQ * 32 + l * 32 + 4 * j8); }
#pragma unroll
        for (int q = 0; q < GR; ++q) { const int t = tq[q], hh = hq[q]; const f32x4 w1 = hh < 8 ? qw1 : kw1, w2 = hh < 8 ? qw2 : kw2;
            const float x1[4] = {bflo(r1[q].x), bfhi(r1[q].x), bflo(r1[q].y), bfhi(r1[q].y)}, x2[4] = {bflo(r2[q].x), bfhi(r2[q].x), bflo(r2[q].y), bfhi(r2[q].y)};
            float ss = 0.f;
#pragma unroll
            for (int e = 0; e < 4; ++e) ss += x1[e] * x1[e] + x2[e] * x2[e];
            const float rs = 1.f / sqrtf(sum_l8(ss) * (1.f / 64.f) + 1e-6f), sc = hh < 8 ? C2 : 1.f; float o1[4], o2[4];
#pragma unroll
            for (int e = 0; e < 4; ++e) { const float y1 = x1[e] * rs * w1[e], y2 = x2[e] * rs * w2[e]; o1[e] = (y1 * cs[q][e] - y2 * sn[q][e]) * sc; o2[e] = (y2 * cs[q][e] + y1 * sn[q][e]) * sc; }
            bf16* dst = (hh < 8 ? Qn + (size_t)t * 512 + hh * 64 : Kn + (size_t)t * 128 + (hh - 8) * 64) + 4 * j8;
            v2u a1, a2; a1.x = pk2(o1[0], o1[1]); a1.y = pk2(o1[2], o1[3]); a2.x = pk2(o2[0], o2[1]); a2.y = pk2(o2[2], o2[3]);
            if (okq[q]) { *(GAS v2u*)dst = a1; *(GAS v2u*)(dst + 32) = a2; } } } }
}
__device__ __forceinline__ void ph_post(bf16* P, int T, const bf16* XC, const bf16* YA  , const float* d_skip, const float* norm_w,
                                        const bf16* YB  , const float* CB  , const bf16* VB  , const float* lnx_w, const float* lnx_b, int gw, int ngw, int lane) {
    const int c = lane * 8, h = lane >> 3;
    const float D = d_skip[c >> 6]; const f32x4 n0 = *(const GAS f32x4*)(norm_w + c), n1 = *(const GAS f32x4*)(norm_w + c + 4);
    const f32x4 lw0 = *(const GAS f32x4*)(lnx_w + c), lw1 = *(const GAS f32x4*)(lnx_w + c + 4), lb0 = *(const GAS f32x4*)(lnx_b + c), lb1 = *(const GAS f32x4*)(lnx_b + c + 4);
    for (int t = gw; t < T; t += ngw) {
        const v4u y0 = *(const GAS v4u*)(YA + (size_t)t * 512 + c), y1 = *(const GAS v4u*)(YA + ((size_t)T + t) * 512 + c), xs = *(const GAS v4u*)(XC + (size_t)t * 1024 + c), zz = *(const GAS v4u*)(P + (size_t)t * LDP + PC_ZA + c);
        const v4u a0 = *(const GAS v4u*)(YB + (size_t)t * 512 + c), a1 = *(const GAS v4u*)(YB + ((size_t)T + t) * 512 + c), vv = *(const GAS v4u*)(VB + (size_t)t * 512 + c), gg = *(const GAS v4u*)(P + (size_t)t * LDP + PC_GB + c);
        const float coef = CB[(size_t)h * T + t] + CB[(size_t)(8 + h) * T + t];
        {
            const unsigned yw0[4] = {y0.x, y0.y, y0.z, y0.w}, yw1[4] = {y1.x, y1.y, y1.z, y1.w}, xw[4] = {xs.x, xs.y, xs.z, xs.w}, zw[4] = {zz.x, zz.y, zz.z, zz.w}; float y[8], ss = 0.f;
#pragma unroll
            for (int e = 0; e < 4; ++e) { y[2 * e] = (bflo(yw0[e]) + bflo(yw1[e]) + bflo(xw[e]) * D) * fsilu(bflo(zw[e])); y[2 * e + 1] = (bfhi(yw0[e]) + bfhi(yw1[e]) + bfhi(xw[e]) * D) * fsilu(bfhi(zw[e])); ss += y[2 * e] * y[2 * e] + y[2 * e + 1] * y[2 * e + 1]; }
            const float r = 1.f / sqrtf(sum_l32(ss) * (1.f / 256.f) + 1e-6f);
            v4u o; o.x = pk2(y[0] * r * n0.x, y[1] * r * n0.y); o.y = pk2(y[2] * r * n0.z, y[3] * r * n0.w); o.z = pk2(y[4] * r * n1.x, y[5] * r * n1.y); o.w = pk2(y[6] * r * n1.z, y[7] * r * n1.w);
            *(GAS v4u*)(P + (size_t)t * LDP + PC_ZA + c) = o; }
        {
            float y[8] = {bflo(a0.x) + bflo(a1.x), bfhi(a0.x) + bfhi(a1.x), bflo(a0.y) + bflo(a1.y), bfhi(a0.y) + bfhi(a1.y), bflo(a0.z) + bflo(a1.z), bfhi(a0.z) + bfhi(a1.z), bflo(a0.w) + bflo(a1.w), bfhi(a0.w) + bfhi(a1.w)};
            const float v[8] = {bflo(vv.x), bfhi(vv.x), bflo(vv.y), bfhi(vv.y), bflo(vv.z), bfhi(vv.z), bflo(vv.w), bfhi(vv.w)};
            const float g[8] = {bflo(gg.x), bfhi(gg.x), bflo(gg.y), bfhi(gg.y), bflo(gg.z), bfhi(gg.z), bflo(gg.w), bfhi(gg.w)};
            float s = 0.f;
#pragma unroll
            for (int e = 0; e < 8; ++e) s += y[e];
            const float mu = sum_l8(s) * (1.f / 64.f); float q = 0.f;
#pragma unroll
            for (int e = 0; e < 8; ++e) { y[e] -= mu; q += y[e] * y[e]; }
            const float rs = 1.f / sqrtf(sum_l8(q) * (1.f / 64.f) + 64e-5f);
            const float lw[8] = {lw0.x, lw0.y, lw0.z, lw0.w, lw1.x, lw1.y, lw1.z, lw1.w}, lb[8] = {lb0.x, lb0.y, lb0.z, lb0.w, lb1.x, lb1.y, lb1.z, lb1.w}; float o[8];
#pragma unroll
            for (int e = 0; e < 8; ++e) o[e] = (y[e] * rs * lw[e] + lb[e] + coef * v[e]) * fsilu(g[e]);
            v4u ov; ov.x = pk2(o[0], o[1]); ov.y = pk2(o[2], o[3]); ov.z = pk2(o[4], o[5]); ov.w = pk2(o[6], o[7]);
            *(GAS v4u*)(P + (size_t)t * LDP + PC_GB + c) = ov; }
    }
}
__device__ __forceinline__ void ph_fin(const float* xin, const float* outf, const float* w, float* xout, const float* wn, bf16* Hn, int nrows, int gw, int ngw, int lane) {
    f32x4 wpost[4], wpre[4];
#pragma unroll
    for (int j = 0; j < 4; ++j) { wpost[j] = ((const GAS f32x4*)w + lane)[64 * j]; wpre[j] = wn ? ((const GAS f32x4*)wn + lane)[64 * j] : (f32x4){0.f, 0.f, 0.f, 0.f}; }
    for (int m = gw; m < nrows; m += 2 * ngw) { const int m2 = (m + ngw < nrows) ? m + ngw : m; const bool two = m2 != m;
        const GAS f32x4* oa = (const GAS f32x4*)(outf + (size_t)m * 1024) + lane; const GAS f32x4* ob = (const GAS f32x4*)(outf + (size_t)m2 * 1024) + lane;
        const GAS f32x4* xa = (const GAS f32x4*)(xin + (size_t)m * 1024) + lane; const GAS f32x4* xb = (const GAS f32x4*)(xin + (size_t)m2 * 1024) + lane;
        f32x4 va[4], vb[4], ya[4], yb[4]; float sa = 0.f, sb = 0.f;
#pragma unroll
        for (int j = 0; j < 4; ++j) { va[j] = oa[64 * j]; vb[j] = ob[64 * j]; ya[j] = xa[64 * j]; yb[j] = xb[64 * j]; }
#pragma unroll
        for (int j = 0; j < 4; ++j) { sa += (va[j].x * va[j].x + va[j].y * va[j].y) + (va[j].z * va[j].z + va[j].w * va[j].w); sb += (vb[j].x * vb[j].x + vb[j].y * vb[j].y) + (vb[j].z * vb[j].z + vb[j].w * vb[j].w); }
        const float ra = 1.f / sqrtf(sum_l64(sa) * (1.f / 1024.f) + 1e-6f), rb = 1.f / sqrtf(sum_l64(sb) * (1.f / 1024.f) + 1e-6f);
        GAS f32x4* pa = (GAS f32x4*)(xout + (size_t)m * 1024) + lane; GAS f32x4* pb = (GAS f32x4*)(xout + (size_t)m2 * 1024) + lane;
        float qa = 0.f, qb = 0.f;
#pragma unroll
        for (int j = 0; j < 4; ++j) { const f32x4 ww = wpost[j]; ya[j] = ya[j] + va[j] * ra * ww; yb[j] = yb[j] + vb[j] * rb * ww; pa[64 * j] = ya[j]; if (two) pb[64 * j] = yb[j];
            qa += (ya[j].x * ya[j].x + ya[j].y * ya[j].y) + (ya[j].z * ya[j].z + ya[j].w * ya[j].w); qb += (yb[j].x * yb[j].x + yb[j].y * yb[j].y) + (yb[j].z * yb[j].z + yb[j].w * yb[j].w); }
        if (wn) { const float na = 1.f / sqrtf(sum_l64(qa) * (1.f / 1024.f) + 1e-6f), nb = 1.f / sqrtf(sum_l64(qb) * (1.f / 1024.f) + 1e-6f);
            GAS unsigned long long* ha = (GAS unsigned long long*)(Hn + (size_t)m * 1024) + lane; GAS unsigned long long* hb = (GAS unsigned long long*)(Hn + (size_t)m2 * 1024) + lane;
#pragma unroll
            for (int j = 0; j < 4; ++j) { const f32x4 ww = wpre[j];
                ha[64 * j] = (unsigned long long)pk2(ya[j].x * na * ww.x, ya[j].y * na * ww.y) | ((unsigned long long)pk2(ya[j].z * na * ww.z, ya[j].w * na * ww.w) << 32);
                if (two) hb[64 * j] = (unsigned long long)pk2(yb[j].x * nb * ww.x, yb[j].y * nb * ww.y) | ((unsigned long long)pk2(yb[j].z * nb * ww.z, yb[j].w * nb * ww.w) << 32); } } }
}
}
namespace mk {
__device__ __forceinline__ void unpack8(const v4u w, float* f) { f[0] = bflo(w.x); f[1] = bfhi(w.x); f[2] = bflo(w.y); f[3] = bfhi(w.y); f[4] = bflo(w.z); f[5] = bfhi(w.z); f[6] = bflo(w.w); f[7] = bfhi(w.w); }
__device__ __forceinline__ void ph_ssd_simple(const bf16* XC, const float* DT, const float* a_log, bf16* YA, int nb, int T, int tid, int bid) {
    if (tid >= 64) return;
    const int i = bid * 64 + tid; if (i >= 2 * nb * 512) return;
    const int p = i % 64, h = (i / 64) % 8, b = (i / 512) % nb, z = i / (512 * nb);
    float s[128];
#pragma unroll
    for (int n = 0; n < 128; ++n) s[n] = 0.f;
    const float an = -expf(a_log[z * 8 + h]); const int g = h >> 2;
    for (int st = 0; st < SEQ; ++st) { const int l = z ? (SEQ - 1 - st) : st; const size_t t = (size_t)b * SEQ + l;
        const float d = DT[t * 16 + z * 8 + h]; const float dec = expf(d * an); const float xd = bf2f(XC[t * 1024 + h * 64 + p]) * d;
        const GAS v4u* Bv = (const GAS v4u*)(XC + t * 1024 + 512 + g * 128); const GAS v4u* Cv = (const GAS v4u*)(XC + t * 1024 + 768 + g * 128);
        float y = 0.f;
#pragma unroll
        for (int n8 = 0; n8 < 16; ++n8) { float bb[8], cc[8]; unpack8(Bv[n8], bb); unpack8(Cv[n8], cc);
#pragma unroll
            for (int e = 0; e < 8; ++e) { s[n8 * 8 + e] = s[n8 * 8 + e] * dec + xd * bb[e]; y += cc[e] * s[n8 * 8 + e]; } }
        YA[((size_t)z * T + t) * 512 + h * 64 + p] = (bf16)f2bf(y); }
}
__device__ __forceinline__ float shiftP(const bf16* P, int t, int ch, const float* mu) {
    const int l = t & (SEQ - 1); const float cur = bf2f(P[(size_t)t * LDP + PC_SLAB + ch]);
    const float prev = l > 0 ? bf2f(P[(size_t)(t - 1) * LDP + PC_SLAB + ch]) : 0.f; const float nxt = l < SEQ - 1 ? bf2f(P[(size_t)(t + 1) * LDP + PC_SLAB + ch]) : 0.f;
    return cur + mu[ch] * (prev - cur) + mu[1792 + ch] * (nxt - cur);
}
struct RwkvS { float *R, *V, *KK, *DEC, *BB, *KD; };
__device__ __forceinline__ void ph_rwkv_prep_simple(const bf16* P, int T, int t0, int Ts, const float* mu, const float* w0, const float* w_up, const float* a0, const float* a_up, const float* k_k, const float* k_a, const float* r_k,
                                                    RwkvS A, bf16* VB, float* CB, int gtid, int nthr) {
    for (int it = gtid; it < Ts * 512; it += nthr) { const int tl = it >> 9, c = it & 511, t = t0 + tl;
        const float r = shiftP(P, t, c, mu), k = shiftP(P, t, 512 + c, mu), v = shiftP(P, t, 1024 + c, mu);
        A.R[it] = r; A.V[it] = v; VB[(size_t)t * 512 + c] = (bf16)f2bf(v);
        const float kx = k * k_k[c]; const float ss = wave_sum(kx * kx, gtid & 63);
        const float kk = kx / sqrtf(fmaxf(ss, 1e-24f)); A.KK[it] = kk;
#pragma unroll 1
        for (int z = 0; z < 2; ++z) { float wr = w0[z * 512 + c], ar = a0[z * 512 + c];
            for (int q = 0; q < 64; ++q) { wr += tanhf(shiftP(P, t, 1536 + z * 64 + q, mu)) * w_up[((size_t)z * 64 + q) * 512 + c]; ar += shiftP(P, t, 1664 + z * 64 + q, mu) * a_up[((size_t)z * 64 + q) * 512 + c]; }
            const float sp = (-wr) > 20.f ? (-wr) : log1pf(expf(-wr)); const float dec = expf(-expf(-sp - 0.5f)); const float a = 1.f / (1.f + expf(-ar));
            const float kd = k * (1.f + (a - 1.f) * k_a[c]);
            A.DEC[(size_t)z * Ts * 512 + it] = dec; A.BB[(size_t)z * Ts * 512 + it] = kk * a; A.KD[(size_t)z * Ts * 512 + it] = kd;
            const float cb = wave_sum(r * kd * r_k[c], gtid & 63); if ((c & 63) == 0) CB[((size_t)(z * 8 + (c >> 6))) * T + t] = cb; } }
}
__device__ __forceinline__ void ph_rwkv_scan_simple(int T, int t0, int nbs, RwkvS A, bf16* YB, int tid, int bid) {
    if (tid >= 64) return;
    const int i = bid * 64 + tid; if (i >= 2 * nbs * 512) return;
    const int v = i % 64, h = (i / 64) % 8, b = (i / 512) % nbs, z = i / (512 * nbs); const int Ts = nbs * SEQ;
    float S[64];
#pragma unroll
    for (int k = 0; k < 64; ++k) S[k] = 0.f;
    for (int st = 0; st < SEQ; ++st) { const int l = z ? (SEQ - 1 - st) : st; const size_t tl = (size_t)b * SEQ + l; const size_t o = tl * 512 + h * 64, oz = ((size_t)z * Ts + tl) * 512 + h * 64;
        float sa = 0.f;
#pragma unroll
        for (int k = 0; k < 64; ++k) sa += S[k] * A.KK[o + k];
        const float vv = A.V[o + v]; float y = 0.f;
#pragma unroll
        for (int k = 0; k < 64; ++k) { S[k] = S[k] * A.DEC[oz + k] - sa * A.BB[oz + k] + vv * A.KD[oz + k]; y += S[k] * A.R[o + k]; }
        YB[((size_t)z * T + t0 + tl) * 512 + h * 64 + v] = (bf16)f2bf(y); }
}
__device__ __forceinline__ void ph_gqa_simple(bf16* P, const bf16* Qn, const bf16* Kn, int nb, int gtid, int nthr) {
    for (int it = gtid; it < nb * 8 * SEQ; it += nthr) { const int ql = it % SEQ, h = (it / SEQ) % 8, b = it / (8 * SEQ), g = h >> 2; const size_t t = (size_t)b * SEQ + ql;
        float q[64], o[64];
#pragma unroll
        for (int d8 = 0; d8 < 8; ++d8) { unpack8(*(const GAS v4u*)(Qn + t * 512 + h * 64 + d8 * 8), q + d8 * 8); }
#pragma unroll
        for (int d = 0; d < 64; ++d) o[d] = 0.f;
        float m = -1e30f, lsum = 0.f;
        for (int k = 0; k < SEQ; ++k) { const size_t tk = (size_t)b * SEQ + k; float s = 0.f;
#pragma unroll
            for (int d8 = 0; d8 < 8; ++d8) { float kf[8]; unpack8(*(const GAS v4u*)(Kn + tk * 128 + g * 64 + d8 * 8), kf);
#pragma unroll
                for (int e = 0; e < 8; ++e) s += q[d8 * 8 + e] * kf[e]; }
            const float mn = fmaxf(m, s); const float al = exp2f(m - mn), p = exp2f(s - mn); m = mn; lsum = lsum * al + p;
#pragma unroll
            for (int d8 = 0; d8 < 8; ++d8) { float vf[8]; unpack8(*(const GAS v4u*)(P + tk * LDP + PC_QKVC + 640 + g * 64 + d8 * 8), vf);
#pragma unroll
                for (int e = 0; e < 8; ++e) o[d8 * 8 + e] = o[d8 * 8 + e] * al + p * vf[e]; } }
        const float il = 1.f / lsum;
#pragma unroll
        for (int d8 = 0; d8 < 8; ++d8) { GAS v4u* dst = (GAS v4u*)(P + t * LDP + PC_GC + h * 64 + d8 * 8); float gf[8]; unpack8(*dst, gf); v4u ov;
            ov.x = pk2(o[d8 * 8 + 0] * il * fsilu(gf[0]), o[d8 * 8 + 1] * il * fsilu(gf[1])); ov.y = pk2(o[d8 * 8 + 2] * il * fsilu(gf[2]), o[d8 * 8 + 3] * il * fsilu(gf[3]));
            ov.z = pk2(o[d8 * 8 + 4] * il * fsilu(gf[4]), o[d8 * 8 + 5] * il * fsilu(gf[5])); ov.w = pk2(o[d8 * 8 + 6] * il * fsilu(gf[6]), o[d8 * 8 + 7] * il * fsilu(gf[7])); *dst = ov; } }
}
__device__ __forceinline__ void ph_na_simple(bf16* P, const float* rpb, int nb, int gtid, int nthr) {
    for (int it = gtid; it < nb * 8 * SEQ; it += nthr) { const int ql = it % SEQ, h = (it / SEQ) % 8, b = it / (8 * SEQ); const size_t t = (size_t)b * SEQ + ql; const int qr = ql >> 6, qc = ql & 63;
        int rs = qr - 4; rs = rs < 0 ? 0 : (rs > 24 ? 24 : rs); int cs = qc - 8; cs = cs < 0 ? 0 : (cs > 48 ? 48 : cs);
        float q[64], o[64];
#pragma unroll
        for (int d8 = 0; d8 < 8; ++d8) { unpack8(*(const GAS v4u*)(P + t * LDP + PC_QKVD + h * 64 + d8 * 8), q + d8 * 8); }
#pragma unroll
        for (int d = 0; d < 64; ++d) { q[d] *= 0.125f; o[d] = 0.f; }
        float m = -1e30f, lsum = 0.f;
        for (int i = 0; i < 128; ++i) { const int kr = rs + (i >> 4), kc = cs + (i & 15); const size_t tk = (size_t)b * SEQ + kr * 64 + kc; float s = 0.f;
#pragma unroll
            for (int d8 = 0; d8 < 8; ++d8) { float kf[8]; unpack8(*(const GAS v4u*)(P + tk * LDP + PC_QKVD + 512 + h * 64 + d8 * 8), kf);
#pragma unroll
                for (int e = 0; e < 8; ++e) s += q[d8 * 8 + e] * kf[e]; }
            s += rpb[h * 465 + (kr - qr + 7) * 31 + (kc - qc + 15)];
            const float mn = fmaxf(m, s); const float al = __expf(m - mn), p = __expf(s - mn); m = mn; lsum = lsum * al + p;
#pragma unroll
            for (int d8 = 0; d8 < 8; ++d8) { float vf[8]; unpack8(*(const GAS v4u*)(P + tk * LDP + PC_QKVD + 1024 + h * 64 + d8 * 8), vf);
#pragma unroll
                for (int e = 0; e < 8; ++e) o[d8 * 8 + e] = o[d8 * 8 + e] * al + p * vf[e]; } }
        const float il = 1.f / lsum;
#pragma unroll
        for (int d8 = 0; d8 < 8; ++d8) { GAS v4u* dst = (GAS v4u*)(P + t * LDP + PC_GD + h * 64 + d8 * 8); float gf[8]; unpack8(*dst, gf); v4u ov;
            ov.x = pk2(o[d8 * 8 + 0] * il * fsilu(gf[0]), o[d8 * 8 + 1] * il * fsilu(gf[1])); ov.y = pk2(o[d8 * 8 + 2] * il * fsilu(gf[2]), o[d8 * 8 + 3] * il * fsilu(gf[3]));
            ov.z = pk2(o[d8 * 8 + 4] * il * fsilu(gf[4]), o[d8 * 8 + 5] * il * fsilu(gf[5])); ov.w = pk2(o[d8 * 8 + 6] * il * fsilu(gf[6]), o[d8 * 8 + 7] * il * fsilu(gf[7])); *dst = ov; } }
}
}
#include <hip/hip_bf16.h>
namespace attn_body {
using bf16=__hip_bfloat16;
using bf16x8=__attribute__((ext_vector_type(8)))short;
using s16x4=__attribute__((ext_vector_type(4)))short;
using f32x16=__attribute__((ext_vector_type(16)))float;
using u32x4=__attribute__((ext_vector_type(4)))unsigned;
constexpr int SEQ=2048,D=64;
constexpr int NW=8,QBLK=32,QB=QBLK*NW,KVBLK=64,NQB=SEQ/QB;
__device__ __forceinline__ int crow(int r,int hi){return (r&3)+8*(r>>2)+4*hi;}
#define SBAR() __builtin_amdgcn_sched_barrier(0)
constexpr int NSLOT=3, SLOTB=8192;
constexpr int LDS_K=0, LDS_V=NSLOT*SLOTB, LDS_WS=2*NSLOT*SLOTB, LDS_OST=LDS_WS+NW*64*4, LDS_RPB=LDS_OST+NW*4096,LDS_BYTES=LDS_RPB+2048;
constexpr float C2=0.125f*1.4426950408889634f;
__device__ __forceinline__ void glds16(const void*gsrc,unsigned lds_dst){unsigned keep;
  asm volatile("s_mov_b32 %0, m0\n\ts_mov_b32 m0, %2\n\ts_nop 0\n\tglobal_load_lds_dwordx4 %1, off\n\ts_mov_b32 m0, %0":"=&s"(keep):"v"(gsrc),"s"(lds_dst):"memory");}
__device__ __forceinline__ float max3f(float a,float b,float c){float r;asm("v_max3_f32 %0, %1, %2, %3":"=v"(r):"v"(a),"v"(b),"v"(c));return r;}
__device__ __forceinline__ float max2f(float a,float b){float r;asm("v_max_f32_e32 %0, %1, %2":"=v"(r):"v"(a),"v"(b));return r;}
__device__ __forceinline__ float fadd_s(float a,float b){float r;asm("v_add_f32_e32 %0, %1, %2":"=v"(r):"v"(a),"v"(b));return r;}
__device__ __forceinline__ float fsub_s(float a,float b){float r;asm("v_sub_f32_e32 %0, %1, %2":"=v"(r):"v"(a),"v"(b));return r;}
typedef float f32x2_t __attribute__((ext_vector_type(2))); typedef __bf16 bf16x2_t __attribute__((ext_vector_type(2)));
__device__ __forceinline__ unsigned cvtpk_s(float lo,float hi){f32x2_t v={lo,hi};bf16x2_t b=__builtin_convertvector(v,bf16x2_t);return __builtin_bit_cast(unsigned,b);}
#define WAIT_BAR(N) asm volatile("s_waitcnt vmcnt(" #N ") lgkmcnt(0)\n\ts_barrier":::"memory")

__device__ __forceinline__ void qkt(f32x16&p0,f32x16&p1,const char*Kslot,const bf16x8*qr,int r32,int hi){ const f32x16 negm=f32x16{};
  const char*kb=Kslot+hi*1024+r32*16;
  #pragma unroll
  for(int d0=0;d0<4;++d0){
    const bf16x8 b0=*reinterpret_cast<const bf16x8*>(kb+d0*2048);
    const bf16x8 b1=*reinterpret_cast<const bf16x8*>(kb+d0*2048+512);
    if(d0==0){p0=__builtin_amdgcn_mfma_f32_32x32x16_bf16(b0,qr[0],negm,0,0,0);p1=__builtin_amdgcn_mfma_f32_32x32x16_bf16(b1,qr[0],negm,0,0,0);}
    else{p0=__builtin_amdgcn_mfma_f32_32x32x16_bf16(b0,qr[d0],p0,0,0,0);p1=__builtin_amdgcn_mfma_f32_32x32x16_bf16(b1,qr[d0],p1,0,0,0);}}
}
typedef __attribute__((address_space(3))) const char* lds_cptr;
typedef short v4i16_t __attribute__((ext_vector_type(4)));
__device__ __forceinline__ void kload8(bf16x8*kf,lds_cptr kp){
  kf[0]=*(const __attribute__((address_space(3))) bf16x8*)(kp);      kf[1]=*(const __attribute__((address_space(3))) bf16x8*)(kp+512);
  kf[2]=*(const __attribute__((address_space(3))) bf16x8*)(kp+2048); kf[3]=*(const __attribute__((address_space(3))) bf16x8*)(kp+2560);
  kf[4]=*(const __attribute__((address_space(3))) bf16x8*)(kp+4096); kf[5]=*(const __attribute__((address_space(3))) bf16x8*)(kp+4608);
  kf[6]=*(const __attribute__((address_space(3))) bf16x8*)(kp+6144); kf[7]=*(const __attribute__((address_space(3))) bf16x8*)(kp+6656);
}
__device__ __forceinline__ void kload2(bf16x8*kf,lds_cptr kp,int j){ kf[2*j]=*(const __attribute__((address_space(3))) bf16x8*)(kp+j*2048); kf[2*j+1]=*(const __attribute__((address_space(3))) bf16x8*)(kp+j*2048+512); }
__device__ __forceinline__ s16x4 vtr(lds_cptr p){ return __builtin_bit_cast(s16x4,__builtin_amdgcn_ds_read_tr16_b64_v4i16((__attribute__((address_space(3))) v4i16_t*)p)); }
__device__ __forceinline__ float rowmax(const f32x16&p0,const f32x16&p1){
  float a=max3f(p0[0],p0[1],p1[0]),b=max3f(p0[2],p0[3],p1[1]);a=max3f(a,p1[2],p1[3]);
  #pragma unroll
  for(int r=4;r<16;r+=4){a=max3f(a,p0[r],p0[r+1]);b=max3f(b,p0[r+2],p0[r+3]);a=max3f(a,p1[r],p1[r+1]);b=max3f(b,p1[r+2],p1[r+3]);}
  const float m=max2f(a,b);
  auto rr=__builtin_amdgcn_permlane32_swap(__float_as_uint(m),__float_as_uint(m),false,false);
  return max2f(__uint_as_float(rr[0]),__uint_as_float(rr[1]));
}
__device__ __forceinline__ void pv(f32x16*o,int vb,bf16x8 pa0,bf16x8 pa1,bf16x8 pa2,bf16x8 pa3){
  #pragma unroll
  for(int d0=0;d0<2;++d0){s16x4 lo[4],hi[4];
    #pragma unroll
    for(int ks=0;ks<4;++ks){
      asm volatile("ds_read_b64_tr_b16 %0,%1 offset:%c2":"=&v"(lo[ks]):"v"(vb),"i"(d0*4096+ks*1024):"memory");
      asm volatile("ds_read_b64_tr_b16 %0,%1 offset:%c2":"=&v"(hi[ks]):"v"(vb),"i"(d0*4096+ks*1024+512):"memory");}
    asm volatile("s_waitcnt lgkmcnt(0)":::"memory");SBAR();
    #define PK(k) (bf16x8){lo[k][0],lo[k][1],lo[k][2],lo[k][3],hi[k][0],hi[k][1],hi[k][2],hi[k][3]}
    o[d0]=__builtin_amdgcn_mfma_f32_32x32x16_bf16(pa0,PK(0),o[d0],0,0,0);
    o[d0]=__builtin_amdgcn_mfma_f32_32x32x16_bf16(pa1,PK(1),o[d0],0,0,0);
    o[d0]=__builtin_amdgcn_mfma_f32_32x32x16_bf16(pa2,PK(2),o[d0],0,0,0);
    o[d0]=__builtin_amdgcn_mfma_f32_32x32x16_bf16(pa3,PK(3),o[d0],0,0,0);
    #undef PK
  }
}

struct AttnP { const bf16* Qw0; const bf16* Kh; const bf16* Vh; bf16* Ow0; int NT; int tbase; int toff; int qr0; float qscale; };
template<int THRL,int MODE,int QP,int KP,int VP,int OP> __device__ __forceinline__ void attn_unit(const AttnP&A,char*shm,const int tid){
  const int lane=tid&63,r32=lane&31,hi=lane>>5; const int wid=__builtin_amdgcn_readfirstlane(tid>>6);
  const bf16*Qw=A.Qw0+(long)(wid*QBLK)*QP;
  const bf16*Kh=A.Kh,*Vh=A.Vh;
  const int NT=A.NT;
  #define TROW(t) ((MODE==1)?(A.tbase+(((t)+A.toff)%NT)):(t))
  const unsigned lds0=(unsigned)(uintptr_t)shm;
  float*wsf=(float*)(shm+LDS_WS)+wid*64;
  const bf16*ksrc=Kh+(long)lane*KP+wid*8;
  const bf16*vsrc=Vh+(long)(16*(wid&3)+(lane>>2))*VP+(wid>>2)*32+(lane&3)*8;
  const unsigned kdst=lds0+LDS_K+wid*1024, vdst=lds0+LDS_V+wid*1024;
  #define DMA_K(t,slot) glds16(ksrc+(long)TROW(t)*KVBLK*KP,(unsigned)__builtin_amdgcn_readfirstlane(kdst+(slot)))
  #define DMA_V(t,slot) glds16(vsrc+(long)TROW(t)*KVBLK*VP,(unsigned)__builtin_amdgcn_readfirstlane(vdst+(slot)))
  const int vb0=(int)(lds0+LDS_V)+((lane>>4)&1)*32+(lane&3)*8+(4*hi+((lane&15)>>2))*64;
  const char*Kbase=shm+LDS_K; bf16x8 kf[8];
  const lds_cptr shm3=(lds_cptr)shm; const lds_cptr kp0=shm3+LDS_K+hi*1024+r32*16; const lds_cptr vp0=shm3+LDS_V+((lane>>4)&1)*32+(lane&3)*8+(4*hi+((lane&15)>>2))*64;
  DMA_K(0,0);DMA_V(0,0);DMA_K(1,SLOTB);
  bf16x8 qr[4];
  #pragma unroll
  for(int d0=0;d0<4;++d0)qr[d0]=*reinterpret_cast<const bf16x8*>(&Qw[(long)r32*QP+d0*16+hi*8]);
  if(MODE==1){
    #pragma unroll
    for(int d0=0;d0<4;++d0){ u32x4 w=__builtin_bit_cast(u32x4,qr[d0]);
      #pragma unroll
      for(int j=0;j<4;++j){ const float lo=__uint_as_float(w[j]<<16)*A.qscale, hv=__uint_as_float(w[j]&0xffff0000u)*A.qscale; w[j]=cvtpk_s(lo,hv);} qr[d0]=__builtin_bit_cast(bf16x8,w);} }
  const int na_qr=A.qr0+(wid>>1), na_qc=32*(wid&1)+r32; int na_rs=na_qr-4; na_rs=na_rs<0?0:(na_rs>24?24:na_rs); int na_cs=na_qc-8; na_cs=na_cs<0?0:(na_cs>48?48:na_cs);
  const float*rpbl=(const float*)(shm+LDS_RPB);
  #define NAMASK(P0,P1,t) do{ if(MODE==1){ const int kr_=TROW(t); const bool wv_=(kr_>=na_rs)&&(kr_<=na_rs+7); const float*tb_=rpbl+(kr_-na_qr+7)*31+(15-na_qc); const float NEG_=-INFINITY; \
      _Pragma("unroll") for(int r=0;r<16;++r){ const int kc_=crow(r,hi); const bool o0_=wv_&&(kc_>=na_cs)&&(kc_<na_cs+16); const bool o1_=wv_&&(kc_+32>=na_cs)&&(kc_+32<na_cs+16); \
        const float b0_=o0_?tb_[kc_]:0.f; const float b1_=o1_?tb_[kc_+32]:0.f; P0[r]=o0_?(P0[r]+b0_):NEG_; P1[r]=o1_?(P1[r]+b1_):NEG_; } } }while(0)
  float mhat=0.f,l_reg=0.f;f32x16 o[2];o[0]=f32x16{};o[1]=f32x16{};
  #define CMASK(P0,P1,t) NAMASK(P0,P1,t)
  bool resc=false;
  #define START(P0,P1) do{ const float rm=rowmax(P0,P1); resc=false; \
    { const float dl=rm; mhat=fadd_s(mhat,dl); \
      _Pragma("unroll") for(int r=0;r<16;++r){P0[r]=fsub_s(P0[r],dl);P1[r]=fsub_s(P1[r],dl);} \
      } \
    _Pragma("unroll") for(int r=0;r<16;++r)P0[r]=__builtin_amdgcn_exp2f(P0[r]); }while(0)
  #define RESC() do{ if(resc){ asm volatile("s_waitcnt lgkmcnt(0)":::"memory"); \
      _Pragma("unroll") for(int d_=0;d_<2;++d_) _Pragma("unroll") for(int r=0;r<16;++r)o[d_][r]*=wsf[crow(r,hi)]; } }while(0)
  f32x16 pA0,pA1,pB0,pB1;
  int sl_prev=0,sl_cur=0,sl_next=SLOTB;
  #define ROT() do{sl_prev=sl_cur;sl_cur=sl_next;sl_next=(sl_next==(NSLOT-1)*SLOTB)?0:sl_next+SLOTB;}while(0)
  DMA_K(2,2*SLOTB);
  WAIT_BAR(3);
  qkt(pA0,pA1,Kbase,qr,r32,hi);asm volatile("s_nop 15\n\ts_nop 7":"+v"(pA0),"+v"(pA1));CMASK(pA0,pA1,0);
  START(pA0,pA1);
  _Pragma("unroll") for(int r=0;r<16;++r)pA1[r]=__builtin_amdgcn_exp2f(pA1[r]);
  WAIT_BAR(0);
  DMA_K(3,0);DMA_V(1,SLOTB);
  ROT();
  kload8(kf,kp0+sl_cur);
  WAIT_BAR(2);
  s16x4 vlo[8],vhi[8]; u32x4 pw0,pw1,pw2,pw3;
  #define PKW(P,B) cvtpk_s(P[B],P[B+1])
  #define PAF(k) __builtin_bit_cast(bf16x8,pw##k)
  #define VFR(i) (bf16x8){vlo[i][0],vlo[i][1],vlo[i][2],vlo[i][3],vhi[i][0],vhi[i][1],vhi[i][2],vhi[i][3]}
  #define PIN(x) asm volatile("":"+v"(x))
  #define MX3(a,b,c) __builtin_fmaxf(__builtin_fmaxf((a),(b)),(c))
  #define GAPA(MF,A0,A1,A2,A3,W0,W1,PW) do{ MF; sacc+=A0; sacc+=A1; sacc+=A2; sacc+=A3; PIN(sacc); W0; W1; PIN(PW); SBAR(); }while(0)
  #define EX(v) __builtin_amdgcn_exp2f(v)
  #define GAPB(MF,X,B) do{ MF; X[B]=EX(X[B]); X[B+1]=EX(X[B+1]); X[B+2]=EX(X[B+2]); X[B+3]=EX(X[B+3]); PIN(X); SBAR(); }while(0)
  #define VRD(i) do{ vlo[i]=vtr(vp_+(((i)>>2)*4096+((i)&3)*1024)); vhi[i]=vtr(vp_+(((i)>>2)*4096+((i)&3)*1024+512)); }while(0)
  #define KRD(G,j) do{ if(G){ kload2(kf,kp0+sl_next,j); SBAR(); } }while(0)
  #define STEP(C0,C1,P0,P1,t,GK,GV,GL) do{ SBAR(); const f32x16 ZC_=f32x16{}; \
    const lds_cptr vp_=vp0+sl_prev; \
    VRD(0); SBAR(); float sacc=(P0[0]+P0[1]); \
    GAPA(C0=__builtin_amdgcn_mfma_f32_32x32x16_bf16(kf[0],qr[0],ZC_,0,0,0), P0[2],P0[3],P0[4],P0[5],     pw0[0]=PKW(P0,0), pw0[1]=PKW(P0,2), pw0); \
    VRD(4); SBAR(); GAPA(C1=__builtin_amdgcn_mfma_f32_32x32x16_bf16(kf[1],qr[0],ZC_,0,0,0), P0[6],P0[7],P0[8],P0[9],     pw0[2]=PKW(P0,4), pw0[3]=PKW(P0,6), pw0); \
    VRD(1); SBAR(); GAPA(C0=__builtin_amdgcn_mfma_f32_32x32x16_bf16(kf[2],qr[1],C0,0,0,0),   P0[10],P0[11],P0[12],P0[13], pw1[0]=PKW(P0,8), pw1[1]=PKW(P0,10), pw1); \
    VRD(5); SBAR(); GAPA(C1=__builtin_amdgcn_mfma_f32_32x32x16_bf16(kf[3],qr[1],C1,0,0,0),   P0[14],P0[15],P1[0],P1[1],   pw1[2]=PKW(P0,12),pw1[3]=PKW(P0,14), pw1); \
    VRD(2); SBAR(); GAPA(C0=__builtin_amdgcn_mfma_f32_32x32x16_bf16(kf[4],qr[2],C0,0,0,0),   P1[2],P1[3],P1[4],P1[5],     pw2[0]=PKW(P1,0), pw2[1]=PKW(P1,2), pw2); \
    VRD(6); SBAR(); GAPA(C1=__builtin_amdgcn_mfma_f32_32x32x16_bf16(kf[5],qr[2],C1,0,0,0),   P1[6],P1[7],P1[8],P1[9],     pw2[2]=PKW(P1,4), pw2[3]=PKW(P1,6), pw2); \
    VRD(3); SBAR(); GAPA(C0=__builtin_amdgcn_mfma_f32_32x32x16_bf16(kf[6],qr[3],C0,0,0,0),   P1[10],P1[11],P1[12],P1[13], pw3[0]=PKW(P1,8), pw3[1]=PKW(P1,10), pw3); \
    VRD(7); SBAR(); GAPA(C1=__builtin_amdgcn_mfma_f32_32x32x16_bf16(kf[7],qr[3],C1,0,0,0),   P1[14],P1[15],0.f,0.f,       pw3[2]=PKW(P1,12),pw3[3]=PKW(P1,14), pw3); \
    l_reg+=sacc; \
    if(GK){DMA_K((t)+3,sl_cur);} if(GV){DMA_V((t)+1,sl_next);} \
    _Pragma("unroll") for(int r=0;r<16;++r){C0[r]-=mhat;C1[r]-=mhat;} \
    CMASK(C0,C1,t); \
    { float a=MX3(C0[0],C0[1],C1[0]),b=MX3(C0[2],C0[3],C1[1]); a=MX3(a,C1[2],C1[3]); \
      _Pragma("unroll") for(int r=4;r<16;r+=4){a=MX3(a,C0[r],C0[r+1]);b=MX3(b,C0[r+2],C0[r+3]);a=MX3(a,C1[r],C1[r+1]);b=MX3(b,C1[r+2],C1[r+3]);} \
      float rm=__builtin_fmaxf(a,b); { auto rr=__builtin_amdgcn_permlane32_swap(__float_as_uint(rm),__float_as_uint(rm),false,false); rm=__builtin_fmaxf(__uint_as_float(rr[0]),__uint_as_float(rr[1])); } \
      resc=false; \
      if(__builtin_expect(__any(rm>(float)THRL),0)){ const float dl=__builtin_fmaxf(rm,0.f); mhat+=dl; \
        _Pragma("unroll") for(int r=0;r<16;++r){C0[r]-=dl;C1[r]-=dl;} \
        const float f=__builtin_amdgcn_exp2f(-dl); l_reg*=f; if(hi==0)wsf[r32]=f; resc=true; } } \
    SBAR(); \
    GAPB(o[0]=__builtin_amdgcn_mfma_f32_32x32x16_bf16(PAF(0),VFR(0),o[0],0,0,0), C0,0); \
    GAPB(o[1]=__builtin_amdgcn_mfma_f32_32x32x16_bf16(PAF(0),VFR(4),o[1],0,0,0), C0,4); \
    KRD(GL,0); GAPB(o[0]=__builtin_amdgcn_mfma_f32_32x32x16_bf16(PAF(1),VFR(1),o[0],0,0,0), C0,8); \
    KRD(GL,1); GAPB(o[1]=__builtin_amdgcn_mfma_f32_32x32x16_bf16(PAF(1),VFR(5),o[1],0,0,0), C0,12); \
    KRD(GL,2); GAPB(o[0]=__builtin_amdgcn_mfma_f32_32x32x16_bf16(PAF(2),VFR(2),o[0],0,0,0), C1,0); \
    KRD(GL,3); GAPB(o[1]=__builtin_amdgcn_mfma_f32_32x32x16_bf16(PAF(2),VFR(6),o[1],0,0,0), C1,4); \
    GAPB(o[0]=__builtin_amdgcn_mfma_f32_32x32x16_bf16(PAF(3),VFR(3),o[0],0,0,0), C1,8); \
    GAPB(o[1]=__builtin_amdgcn_mfma_f32_32x32x16_bf16(PAF(3),VFR(7),o[1],0,0,0), C1,12); \
    }while(0)
  int t=1;
  for(;t+5<NT;t+=2){
    STEP(pB0,pB1,pA0,pA1,t,true,true,true);     WAIT_BAR(2); RESC(); ROT();
    STEP(pA0,pA1,pB0,pB1,t+1,true,true,true);   WAIT_BAR(2); RESC(); ROT();
  }
  #define ENDW(tt) do{ if((tt)+3<NT){WAIT_BAR(2);} else if((tt)+2<NT){WAIT_BAR(1);} else {WAIT_BAR(0);} }while(0)
  for(;t+1<NT;t+=2){
    STEP(pB0,pB1,pA0,pA1,t,(t+3<NT),(t+1<NT),(t+1<NT));       ENDW(t);   RESC(); ROT();
    STEP(pA0,pA1,pB0,pB1,t+1,(t+4<NT),(t+2<NT),(t+2<NT));     ENDW(t+1); RESC(); ROT();
  }
  STEP(pB0,pB1,pA0,pA1,NT-1,false,false,false); RESC();
  { float sacc=pB0[0]+pB0[1]; _Pragma("unroll") for(int r=2;r<16;++r)sacc+=pB0[r]; _Pragma("unroll") for(int r=0;r<16;++r)sacc+=pB1[r]; l_reg+=sacc;
    pw0=(u32x4){PKW(pB0,0),PKW(pB0,2),PKW(pB0,4),PKW(pB0,6)};pw1=(u32x4){PKW(pB0,8),PKW(pB0,10),PKW(pB0,12),PKW(pB0,14)};pw2=(u32x4){PKW(pB1,0),PKW(pB1,2),PKW(pB1,4),PKW(pB1,6)};pw3=(u32x4){PKW(pB1,8),PKW(pB1,10),PKW(pB1,12),PKW(pB1,14)};
    SBAR(); pv(o,vb0+sl_cur,PAF(0),PAF(1),PAF(2),PAF(3)); }
  #undef PKW
  #undef PAF
  #undef VFR
  #undef PIN
  #undef MX3
  #undef GAPA
  #undef GAPB
  #undef EX
  #undef VRD
  #undef KRD
  #undef STEP
  #undef ENDW
  {auto rr=__builtin_amdgcn_permlane32_swap(__float_as_uint(l_reg),__float_as_uint(l_reg),false,false);l_reg=__uint_as_float(rr[0])+__uint_as_float(rr[1]);}
  if(hi==0)wsf[32+r32]=l_reg;asm volatile("s_waitcnt lgkmcnt(0)":::"memory");
  float rli[16];
  #pragma unroll
  for(int r=0;r<16;++r)rli[r]=__builtin_amdgcn_rcpf(wsf[32+crow(r,hi)]);
  bf16*Ow=A.Ow0+(long)(wid*QBLK)*OP;
  { bf16*stg=(bf16*)(shm+LDS_OST)+wid*2048;
    #pragma unroll
    for(int r=0;r<16;++r){const int orow=crow(r,hi);
      #pragma unroll
      for(int d0=0;d0<2;++d0)stg[orow*64+d0*32+r32]=__float2bfloat16(o[d0][r]*rli[r]);}
    asm volatile("s_waitcnt lgkmcnt(0)":::"memory");
    #pragma unroll
    for(int i=0;i<4;++i){const int row=i*8+(lane>>3),ch=lane&7; const u32x4 v=*(const u32x4*)(stg+row*64+ch*8); u32x4*dst=(u32x4*)(Ow+(long)row*OP+ch*8); const u32x4 g=*dst; u32x4 w;
      #pragma unroll
      for(int j=0;j<4;++j){ const float g0=__uint_as_float(g[j]<<16),g1=__uint_as_float(g[j]&0xffff0000u); const float o0=__uint_as_float(v[j]<<16),o1=__uint_as_float(v[j]&0xffff0000u);
        w[j]=cvtpk_s(o0*g0/(1.f+__expf(-g0)),o1*g1/(1.f+__expf(-g1))); }
      *dst=w; } }
  asm volatile("s_waitcnt lgkmcnt(0)\n\ts_barrier":::"memory");
  #undef DMA_K
  #undef DMA_V
  #undef CMASK
  #undef NAMASK
  #undef TROW
  #undef START
  #undef RESC
  #undef ROT
}
constexpr int ATTN_LDS_BYTES=LDS_BYTES;

#undef SBAR
#undef WAIT_BAR
}
namespace mk {
__device__ __forceinline__ void ph_attn(char* shm, bf16* P, const bf16* Qn, const bf16* Kn, const float* rpb, int nb, int tid, unsigned* ticket, volatile LAS unsigned* slot) {
    using attn_body::AttnP; typedef attn_body::bf16 abf;
    const int nunits = nb * 64;
#pragma unroll 1
    for (;;) {
        if (tid == 0) *slot = __hip_atomic_fetch_add(ticket, 1u, __ATOMIC_RELAXED, __HIP_MEMORY_SCOPE_AGENT);
        __syncthreads();
        const int uu = (int)__builtin_amdgcn_readfirstlane((int)*slot);
        __syncthreads();
        if (uu >= 2 * nunits) break;
        if (uu < nunits) { const int u = uu; const int b = u >> 6, h = (u >> 3) & 7, qb = u & 7, g = h >> 2; const size_t rb = (size_t)b * SEQ;
            AttnP A; A.Qw0 = (const abf*)(Qn + (rb + qb * 256) * 512 + h * 64); A.Kh = (const abf*)(Kn + rb * 128 + g * 64);
            A.Vh = (const abf*)(P + rb * LDP + PC_QKVC + 640 + g * 64); A.Ow0 = (abf*)(P + (rb + qb * 256) * LDP + PC_GC + h * 64);
            A.NT = 32; A.tbase = 0; A.toff = 0; A.qr0 = 0; A.qscale = 1.f;
            int tid2 = tid; asm volatile("" : "+v"(tid2)); attn_body::attn_unit<8, 0, 512, 128, LDP, LDP>(A, shm, tid2);
        } else { const int u = uu - nunits; const int b = u >> 6, h = (u >> 3) & 7, qb = u & 7; const size_t rb = (size_t)b * SEQ; const int qr0 = qb * 4;
            { float* tb = (float*)(shm + attn_body::LDS_RPB); for (int i = tid; i < 465; i += 512) tb[i] = rpb[h * 465 + i] * 1.4426950408889634f; }
            int rs0 = qr0 - 4; rs0 = rs0 < 0 ? 0 : (rs0 > 24 ? 24 : rs0); int rs3 = qr0 - 1; rs3 = rs3 < 0 ? 0 : (rs3 > 24 ? 24 : rs3); int NT = rs3 - rs0 + 8; NT += (NT & 1);
            AttnP A; A.Qw0 = (const abf*)(P + (rb + qb * 256) * LDP + PC_QKVD + h * 64); A.Kh = (const abf*)(P + rb * LDP + PC_QKVD + 512 + h * 64);
            A.Vh = (const abf*)(P + rb * LDP + PC_QKVD + 1024 + h * 64); A.Ow0 = (abf*)(P + (rb + qb * 256) * LDP + PC_GD + h * 64);
            A.NT = NT; A.tbase = rs0; A.toff = rs3 - rs0; A.qr0 = qr0; A.qscale = C2;
            int tid2 = tid; asm volatile("" : "+v"(tid2)); attn_body::attn_unit<8, 1, LDP, LDP, LDP, LDP>(A, shm, tid2); }
    }
}
}
namespace mk {
constexpr int RW_CH = 32;
constexpr int RW_P64 = 144, RW_P32 = 80, RW_TA_ROW = 144;
constexpr int RW_CONST = 0;
constexpr int RW_TA_LO = 4 * RW_TA_ROW;
constexpr int RW_PW = RW_CONST + 960 * 4, RW_PWB = 2 * RW_TA_LO + 2 * 4 * 64 * 4;
constexpr int RW_WT = RW_PW + 8 * RW_PWB;
constexpr int RW_WTOT = RW_WT + 2 * 64 * RW_TA_ROW;
constexpr int RW_TAL = RW_WTOT + 8 * 64 * 4;
constexpr int RW_TS = RW_TAL + 32 * RW_P64;
constexpr int O_TRH = 0, O_TBE = O_TRH + 32 * RW_P64, O_TKA = O_TBE + 32 * RW_P64, O_TBP = O_TKA + 32 * RW_P64, O_TKP = O_TBP + 64 * RW_P32, O_VT = O_TKP + 64 * RW_P32, O_GC = O_VT + 64 * RW_P32, RW_TSB = O_GC + 256;
constexpr int RW_S0B = RW_TS + 2 * RW_TSB;
constexpr int RW_UB = RW_S0B + 2 * 64 * RW_P64;
constexpr int RW_RF = RW_UB + 64 * RW_P32;
constexpr int RW_ABF = RW_RF + 64 * 36 * 4;
constexpr int RW_CORR = RW_ABF + 32 * 36 * 4;
constexpr int RW_DUMP = RW_CORR + 64 * 20 * 4;
constexpr int RW_LDS_END = RW_DUMP + 256;
static_assert(RW_LDS_END <= 163840 - 16, "rwkv lds");
#define RW_BAR() do { asm volatile("s_waitcnt lgkmcnt(0)" ::: "memory"); __builtin_amdgcn_s_barrier(); asm volatile("" ::: "memory"); } while (0)
__device__ __forceinline__ float dppf(float x, const int ctrl_sel) {
    const int xi = __builtin_bit_cast(int, x); int r;
    if (ctrl_sel == 0) r = __builtin_amdgcn_update_dpp(0, xi, 0xB1, 0xf, 0xf, true);
    else if (ctrl_sel == 1) r = __builtin_amdgcn_update_dpp(0, xi, 0x4E, 0xf, 0xf, true);
    else if (ctrl_sel == 2) r = __builtin_amdgcn_update_dpp(0, xi, 0x141, 0xf, 0xf, true);
    else r = __builtin_amdgcn_update_dpp(0, xi, 0x140, 0xf, 0xf, true);
    return __builtin_bit_cast(float, r);
}
__device__ __forceinline__ float sum16(float x) { x += dppf(x, 0); x += dppf(x, 1); x += dppf(x, 2); x += dppf(x, 3); return x; }
__device__ __forceinline__ float rw_fma(float a, float b, float c) { float r; asm("v_fma_f32 %0, %1, %2, %3" : "=v"(r) : "v"(a), "v"(b), "v"(c)); return r; }
__device__ __forceinline__ int rwcrow(int r, int hi) { return (r & 3) + 8 * (r >> 2) + 4 * hi; }
__device__ __forceinline__ unsigned rwpk(float lo, float hi) { typedef float f2 __attribute__((ext_vector_type(2))); typedef __bf16 b2 __attribute__((ext_vector_type(2))); f2 v = {lo, hi}; b2 b = __builtin_convertvector(v, b2); return __builtin_bit_cast(unsigned, b); }
__device__ __forceinline__ f32x16 rw_cc(const LAS unsigned char* X, const LAS unsigned char* Y, int r32, int hi) {
    f32x16 d = f32x16{};
#pragma unroll
    for (int s = 0; s < 4; ++s) d = __builtin_amdgcn_mfma_f32_32x32x16_bf16(*(const LAS bf16x8*)(X + r32 * RW_P64 + 32 * s + 16 * hi), *(const LAS bf16x8*)(Y + r32 * RW_P64 + 32 * s + 16 * hi), d, 0, 0, 0);
    return d;
}
__device__ __forceinline__ f32x16 rw_accmul(f32x16 acc, const LAS unsigned char* Lt_row, const f32x16& M, int hi) {
    v4u m0, m1; m0.x = rwpk(M[0], M[1]); m0.y = rwpk(M[2], M[3]); m0.z = rwpk(M[4], M[5]); m0.w = rwpk(M[6], M[7]); m1.x = rwpk(M[8], M[9]); m1.y = rwpk(M[10], M[11]); m1.z = rwpk(M[12], M[13]); m1.w = rwpk(M[14], M[15]);
#pragma unroll
    for (int s = 0; s < 2; ++s) { const LAS unsigned char* p = Lt_row + 2 * (16 * s + 4 * hi); const v2u lo = *(const LAS v2u*)p, hv = *(const LAS v2u*)(p + 16); v4u av; av.x = lo.x; av.y = lo.y; av.z = hv.x; av.w = hv.y;
        acc = __builtin_amdgcn_mfma_f32_32x32x16_bf16(__builtin_bit_cast(bf16x8, av), __builtin_bit_cast(bf16x8, s == 0 ? m0 : m1), acc, 0, 0, 0); }
    return acc;
}
__device__ __forceinline__ void rwkv_item(LAS unsigned char* lds, const bf16* P, int T, int z, int b, int h, const float* mu, const float* w0, const float* w_up, const float* a0, const float* a_up,
                                          const float* k_k, const float* k_a, const float* r_k, bf16* YB, float* CB, bf16* VB, const int tid_in) {
    unsigned mk_ = ~0u; int wv_ = tid_in; asm volatile("" : "+s"(mk_), "+s"(wv_));
    const int tid = wv_ * 64 + (int)__builtin_amdgcn_mbcnt_hi(mk_, __builtin_amdgcn_mbcnt_lo(mk_, 0u));
    const int lane0 = tid & 63, wave = __builtin_amdgcn_readfirstlane(tid >> 6);
    LAS float* CN = (LAS float*)(lds + RW_CONST);
    for (int i = tid; i < 960; i += 512) { float v;
        if (i < 640) { const int m = i / 320, j = i % 320, g = j >> 6, c = j & 63; const int ch = (g < 3 ? g * 512 + h * 64 : (g == 3 ? 1536 + z * 64 : 1664 + z * 64)) + c; v = mu[m * 1792 + ch]; }
        else { const int j = i - 640, g = j >> 6, c = j & 63; v = g == 0 ? w0[z * 512 + h * 64 + c] : g == 1 ? a0[z * 512 + h * 64 + c] : g == 2 ? k_k[h * 64 + c] : g == 3 ? k_a[h * 64 + c] : r_k[h * 64 + c]; }
        CN[i] = v; }
    for (int i = tid; i < 2 * 64 * 64; i += 512) { const int lo = i >> 12, k = (i >> 6) & 63, n = i & 63; const float* U = (lo == 0 ? w_up : a_up) + (size_t)z * 64 * 512 + h * 64;
        *(LAS unsigned short*)(lds + RW_WT + lo * 64 * RW_TA_ROW + n * RW_TA_ROW + 2 * k) = (unsigned short)f2bf(U[(size_t)k * 512 + n]); }
    for (int i = tid; i < 2 * 64 * RW_P64 / 4; i += 512) ((LAS unsigned*)(lds + RW_S0B))[i] = 0u;
    __syncthreads();
    const int NCH = SEQ / RW_CH;
    const int gcol[5] = {PC_SLAB + h * 64, PC_SLAB + 512 + h * 64, PC_SLAB + 1024 + h * 64, PC_SLAB + 1536 + z * 64, PC_SLAB + 1664 + z * 64};
    const size_t tb0 = (size_t)b * SEQ;
    v2u rawc[2][5], rawe[5];
#define RW_ROWOFF(step_) ({ const int i__ = (step_); int l__ = z ? (SEQ - 1 - i__) : i__; l__ = l__ < 0 ? 0 : (l__ > SEQ - 1 ? SEQ - 1 : l__); ((unsigned)(tb0 + l__) * (unsigned)LDP + 4u * (unsigned)cq) * 2u; })
#define RW_LOAD(cc) do { const GAS unsigned char* Pb_ = (const GAS unsigned char*)P; const int s0_ = (cc) * RW_CH + 4 * vw0; \
    const unsigned r0_ = RW_ROWOFF(s0_ + js), r1_ = RW_ROWOFF(s0_ + 4 + js), re_ = RW_ROWOFF(js == 0 ? s0_ - 1 : (js == 3 ? s0_ + 8 : s0_ + js)); \
    _Pragma("unroll") for (int g = 0; g < 5; ++g) { rawc[0][g] = *(const GAS v2u*)(Pb_ + (r0_ + 2u * (unsigned)gcol[g])); rawc[1][g] = *(const GAS v2u*)(Pb_ + (r1_ + 2u * (unsigned)gcol[g])); rawe[g] = *(const GAS v2u*)(Pb_ + (re_ + 2u * (unsigned)gcol[g])); } } while (0)
    { const int lane = lane0, js = lane >> 4, cq = lane & 15, vw0 = wave >= 4 ? 2 * (wave - 4) : 0; RW_LOAD(0); }
    f32x16 accS[2] = {f32x16{}, f32x16{}};
    LAS float* const WTOT = (LAS float*)(lds + RW_WTOT); LAS float* const RF = (LAS float*)(lds + RW_RF); LAS float* const ABF = (LAS float*)(lds + RW_ABF); LAS float* const CORR = (LAS float*)(lds + RW_CORR);
#pragma unroll 1
    for (int it = 0; it <= NCH; ++it) {
        int lane_ = lane0; asm volatile("" : "+v"(lane_));
        const int lane = lane_, r32 = lane & 31, hi = lane >> 5, js = lane >> 4, cq = lane & 15;
        const int cp = it, cc = it - 1;
        const bool prep = (wave >= 4) && (cp < NCH), chain = (wave < 4) && (cc >= 0);
        const int vw0 = 2 * (wave - 4); const int sjv[2] = {4 * vw0 + js, 4 * (vw0 + 1) + js};
        LAS unsigned char* const tsp = lds + RW_TS + (cp & 1) * RW_TSB; const LAS unsigned char* const tsc = lds + RW_TS + (cc & 1) * RW_TSB;
        const LAS unsigned char* S0cur = lds + RW_S0B + (cc & 1) * 64 * RW_P64; LAS unsigned char* S0nxt = lds + RW_S0B + ((cc + 1) & 1) * 64 * RW_P64;
        float sv[2][3][4];
        float o_kk[2][4], o_r[2][4], o_b[2][4], o_kd[2][4], o_v[2][4], lw2[2][4], Lin[2][4];
        if (prep) {
            float sw_[2][2][4];
            asm volatile("s_waitcnt vmcnt(0)" ::: "memory");
#pragma unroll
            for (int g = 0; g < 5; ++g) { const f32x4 m0 = *(const LAS f32x4*)(CN + g * 64 + 4 * cq), m1 = *(const LAS f32x4*)(CN + 320 + g * 64 + 4 * cq);
                const int am = ((lane - 16) & 63) << 2, ap = ((lane + 16) & 63) << 2;
                v2u A0, A1, B0, B1;
                A0.x = (unsigned)__builtin_amdgcn_ds_bpermute(am, (int)rawc[0][g].x); A0.y = (unsigned)__builtin_amdgcn_ds_bpermute(am, (int)rawc[0][g].y); A1.x = (unsigned)__builtin_amdgcn_ds_bpermute(am, (int)rawc[1][g].x); A1.y = (unsigned)__builtin_amdgcn_ds_bpermute(am, (int)rawc[1][g].y);
                B0.x = (unsigned)__builtin_amdgcn_ds_bpermute(ap, (int)rawc[0][g].x); B0.y = (unsigned)__builtin_amdgcn_ds_bpermute(ap, (int)rawc[0][g].y); B1.x = (unsigned)__builtin_amdgcn_ds_bpermute(ap, (int)rawc[1][g].x); B1.y = (unsigned)__builtin_amdgcn_ds_bpermute(ap, (int)rawc[1][g].y);
#pragma unroll
                for (int u = 0; u < 2; ++u) { const int i_ = cp * RW_CH + sjv[u]; const int l_ = z ? (SEQ - 1 - i_) : i_; const bool okp = (l_ - 1 >= 0), okn = (l_ + 1 < SEQ);
                    const v2u sm = u == 0 ? (js == 0 ? rawe[g] : A0) : (js == 0 ? A0 : A1), sp = u == 0 ? (js == 3 ? B1 : B0) : (js == 3 ? rawe[g] : B1);
                    const v2u lm = z ? sp : sm, lp = z ? sm : sp;
                    const v2u rp = {okp ? lm.x : 0u, okp ? lm.y : 0u}, rn_ = {okn ? lp.x : 0u, okn ? lp.y : 0u};
                    const float pr[4] = {bflo(rp.x), bfhi(rp.x), bflo(rp.y), bfhi(rp.y)}, cu[4] = {bflo(rawc[u][g].x), bfhi(rawc[u][g].x), bflo(rawc[u][g].y), bfhi(rawc[u][g].y)}, nx[4] = {bflo(rn_.x), bfhi(rn_.x), bflo(rn_.y), bfhi(rn_.y)};
#pragma unroll
                    for (int e = 0; e < 4; ++e) { const float val = cu[e] + m0[e] * (pr[e] - cu[e]) + m1[e] * (nx[e] - cu[e]); if (g < 3) sv[u][g][e] = val; else sw_[u][g - 3][e] = val; } } }
#pragma unroll
            for (int u = 0; u < 2; ++u) {
#pragma unroll
                for (int g = 0; g < 3; ++g) asm volatile("" : "+v"(sv[u][g][0]), "+v"(sv[u][g][1]), "+v"(sv[u][g][2]), "+v"(sv[u][g][3]) :: "memory");
#pragma unroll
                for (int g = 0; g < 2; ++g) asm volatile("" : "+v"(sw_[u][g][0]), "+v"(sw_[u][g][1]), "+v"(sw_[u][g][2]), "+v"(sw_[u][g][3]) :: "memory"); }
            __builtin_amdgcn_sched_barrier(0);
            LAS unsigned char* const TAw = lds + RW_PW + vw0 * RW_PWB;
            LAS float* const LRw = (LAS float*)(TAw + 2 * 8 * RW_TA_ROW);
#pragma unroll
            for (int u = 0; u < 2; ++u) { float th[4];
#pragma unroll
                for (int e = 0; e < 4; ++e) { const float ex = __builtin_amdgcn_exp2f(sw_[u][0][e] * 2.8853900817779268f); th[e] = 1.f - 2.f * __builtin_amdgcn_rcpf(1.f + ex); }
                v2u t0; t0.x = pk2(th[0], th[1]); t0.y = pk2(th[2], th[3]); *(LAS v2u*)(TAw + (4 * u + js) * RW_TA_ROW + 8 * cq) = t0;
                v2u t1; t1.x = pk2(sw_[u][1][0], sw_[u][1][1]); t1.y = pk2(sw_[u][1][2], sw_[u][1][3]); *(LAS v2u*)(TAw + 8 * RW_TA_ROW + (4 * u + js) * RW_TA_ROW + 8 * cq) = t1; }
        } else if (chain) {
            if (wave < 2) {
                const int v0 = 32 * wave; f32x16 acc = f32x16{};
#pragma unroll
                for (int s = 0; s < 4; ++s) acc = __builtin_amdgcn_mfma_f32_32x32x16_bf16(*(const LAS bf16x8*)(S0cur + (v0 + r32) * RW_P64 + 32 * s + 16 * hi), *(const LAS bf16x8*)(lds + RW_TAL + r32 * RW_P64 + 32 * s + 16 * hi), acc, 0, 0, 0);
                f32x16 ak = rw_cc(tsc + O_TKA, lds + RW_TAL, r32, hi);
#pragma unroll
                for (int r = 0; r < 16; ++r) ak[r] = (rwcrow(r, hi) < r32) ? ak[r] : 0.f;
                acc = rw_accmul(acc, tsc + O_VT + (v0 + r32) * RW_P32, ak, hi);
#pragma unroll
                for (int r = 0; r < 16; ++r) RF[(v0 + rwcrow(r, hi)) * 36 + r32] = acc[r];
            } else if (wave == 2) {
                f32x16 ab = rw_cc(tsc + O_TBE, lds + RW_TAL, r32, hi);
#pragma unroll
                for (int r = 0; r < 16; ++r) ABF[rwcrow(r, hi) * 36 + r32] = (rwcrow(r, hi) < r32) ? ab[r] : 0.f;
            }
        }
        RW_BAR();
        if (prep) {
            {   LAS unsigned char* const TAw = lds + RW_PW + vw0 * RW_PWB; LAS float* const LRw = (LAS float*)(TAw + 2 * 8 * RW_TA_ROW);
            {
                LAS float* const lrb = lane < 32 ? LRw + (4 * (lane >> 4)) * 64 + (lane & 15) : (LAS float*)(lds + RW_DUMP); const int rs = lane < 32 ? 64 : 0, ls = lane < 32 ? 512 : 0, ns = lane < 32 ? 16 : 0;
                bf16x8 Af[2][2], Wf[2][4][2]; f32x4 accL[2][4];
#pragma unroll
                for (int lo = 0; lo < 2; ++lo) { Af[lo][0] = *(const LAS bf16x8*)(TAw + lo * 8 * RW_TA_ROW + (lane & 15) * RW_TA_ROW + 16 * (lane >> 4)); Af[lo][1] = *(const LAS bf16x8*)(TAw + lo * 8 * RW_TA_ROW + (lane & 15) * RW_TA_ROW + 64 + 16 * (lane >> 4));
#pragma unroll
                    for (int nt = 0; nt < 4; ++nt) { const LAS unsigned char* wt = lds + RW_WT + lo * 64 * RW_TA_ROW + (16 * nt + (lane & 15)) * RW_TA_ROW + 16 * (lane >> 4); Wf[lo][nt][0] = *(const LAS bf16x8*)(wt); Wf[lo][nt][1] = *(const LAS bf16x8*)(wt + 64); } }
#pragma unroll
                for (int lo = 0; lo < 2; ++lo)
#pragma unroll
                    for (int nt = 0; nt < 4; ++nt) { f32x4 acc = {0.f, 0.f, 0.f, 0.f}; acc = __builtin_amdgcn_mfma_f32_16x16x32_bf16(Af[lo][0], Wf[lo][nt][0], acc, 0, 0, 0); accL[lo][nt] = __builtin_amdgcn_mfma_f32_16x16x32_bf16(Af[lo][1], Wf[lo][nt][1], acc, 0, 0, 0); }
#pragma unroll
                for (int lo = 0; lo < 2; ++lo)
#pragma unroll
                    for (int nt = 0; nt < 4; ++nt) { LAS float* lr = lrb + lo * ls + nt * ns; lr[0] = accL[lo][nt][0]; lr[rs] = accL[lo][nt][1]; lr[2 * rs] = accL[lo][nt][2]; lr[3 * rs] = accL[lo][nt][3]; } }
            }
            asm volatile("s_waitcnt lgkmcnt(0)" ::: "memory");
            LAS float* const LRw = (LAS float*)(lds + RW_PW + vw0 * RW_PWB + 2 * 8 * RW_TA_ROW); float bo_[2];
            f32x4 lw_[2], la_[2];
#pragma unroll
            for (int u = 0; u < 2; ++u) { lw_[u] = *(const LAS f32x4*)(LRw + (4 * u + js) * 64 + 4 * cq); la_[u] = *(const LAS f32x4*)(LRw + 512 + (4 * u + js) * 64 + 4 * cq); }
            const f32x4 c_w0 = *(const LAS f32x4*)(CN + 640 + 4 * cq), c_a0 = *(const LAS f32x4*)(CN + 704 + 4 * cq), c_kk = *(const LAS f32x4*)(CN + 768 + 4 * cq), c_ka = *(const LAS f32x4*)(CN + 832 + 4 * cq), c_rk = *(const LAS f32x4*)(CN + 896 + 4 * cq);
#pragma unroll
            for (int u = 0; u < 2; ++u) { const f32x4 lw = lw_[u], la = la_[u];
                float kx[4], n2 = 0.f;
#pragma unroll
                for (int e = 0; e < 4; ++e) { kx[e] = sv[u][1][e] * c_kk[e]; n2 += kx[e] * kx[e]; }
                n2 = sum16(n2); const float rn = __builtin_amdgcn_rsqf(fmaxf(n2, 1e-24f));
                float bo = 0.f;
#pragma unroll
                for (int e = 0; e < 4; ++e) { const float wraw = lw[e] + c_w0[e];
                    lw2[u][e] = -0.8750387749480469f * __builtin_amdgcn_rcpf(1.f + __expf(-wraw));
                    const float aa = __builtin_amdgcn_rcpf(1.f + __expf(-(la[e] + c_a0[e]))); o_kk[u][e] = kx[e] * rn; o_kd[u][e] = sv[u][1][e] * (1.f + (aa - 1.f) * c_ka[e]); o_b[u][e] = o_kk[u][e] * aa; o_r[u][e] = sv[u][0][e]; o_v[u][e] = sv[u][2][e];
                    bo += o_r[u][e] * o_kd[u][e] * c_rk[e]; }
                bo_[u] = sum16(bo);
#pragma unroll
                for (int e = 0; e < 4; ++e) { float x = lw2[u][e];
                    const float y1 = __builtin_bit_cast(float, __builtin_amdgcn_ds_bpermute(((lane - 16) & 63) << 2, __builtin_bit_cast(int, x))); x += (js >= 1) ? y1 : 0.f;
                    const float y2 = __builtin_bit_cast(float, __builtin_amdgcn_ds_bpermute(((lane - 32) & 63) << 2, __builtin_bit_cast(int, x))); x += (js >= 2) ? y2 : 0.f; Lin[u][e] = x; } }
#pragma unroll
            for (int u = 0; u < 2; ++u) { LAS float* wp = js == 3 ? WTOT + (vw0 + u) * 64 + 4 * cq : (LAS float*)(lds + RW_DUMP); *(LAS f32x4*)wp = (f32x4){Lin[u][0], Lin[u][1], Lin[u][2], Lin[u][3]}; }
#pragma unroll
            for (int u = 0; u < 2; ++u) { const int i_ = cp * RW_CH + sjv[u]; const int l_ = z ? (SEQ - 1 - i_) : i_; const size_t t = tb0 + l_;
                if (cq == 0) *(GAS float*)(CB + ((size_t)(z * 8 + h)) * T + t) = bo_[u];
                if (z == 0) { v2u vb; vb.x = pk2(o_v[u][0], o_v[u][1]); vb.y = pk2(o_v[u][2], o_v[u][3]); *(GAS v2u*)(VB + t * 512 + h * 64 + 4 * cq) = vb; } }
            __builtin_amdgcn_sched_barrier(0);
            { const int cn = cp + 1 < NCH ? cp + 1 : cp; RW_LOAD(cn); }
            __builtin_amdgcn_sched_barrier(0);
        } else if (chain && wave == 0) {
            LAS float* row = RF + lane * 36;
#define RW_SOLVE16(o_) do { float u[16]; \
            _Pragma("unroll") for (int q4 = 0; q4 < 4; ++q4) { f32x4 rr = *(const LAS f32x4*)(row + (o_) + 4 * q4); if ((o_) != 0) rr += *(const LAS f32x4*)(CORR + lane * 20 + 4 * q4); u[4 * q4] = rr[0]; u[4 * q4 + 1] = rr[1]; u[4 * q4 + 2] = rr[2]; u[4 * q4 + 3] = rr[3]; } \
            _Pragma("unroll") for (int tb = 0; tb < 4; ++tb) { f32x4 A_[4][4]; \
                _Pragma("unroll") for (int r_ = 0; r_ < 4; ++r_) _Pragma("unroll") for (int q4 = tb; q4 < 4; ++q4) A_[r_][q4] = *(const LAS f32x4*)(ABF + ((o_) + 4 * tb + r_) * 36 + (o_) + 4 * q4); \
                _Pragma("unroll") for (int r_ = 0; r_ < 4; ++r_) { const int tt = 4 * tb + r_; if (tt < 15) { const float nut = -u[tt]; \
                    _Pragma("unroll") for (int q4 = (tt + 1) / 4; q4 < 4; ++q4) { const f32x4 aa = A_[r_][q4]; \
                        _Pragma("unroll") for (int e_ = 0; e_ < 4; ++e_) if (4 * q4 + e_ > tt) u[4 * q4 + e_] = rw_fma(nut, aa[e_], u[4 * q4 + e_]); } } } } \
            v4u w0_, w1_; w0_.x = pk2(-u[0], -u[1]); w0_.y = pk2(-u[2], -u[3]); w0_.z = pk2(-u[4], -u[5]); w0_.w = pk2(-u[6], -u[7]); w1_.x = pk2(-u[8], -u[9]); w1_.y = pk2(-u[10], -u[11]); w1_.z = pk2(-u[12], -u[13]); w1_.w = pk2(-u[14], -u[15]); \
            *(LAS v4u*)(lds + RW_UB + lane * RW_P32 + 2 * (o_)) = w0_; *(LAS v4u*)(lds + RW_UB + lane * RW_P32 + 2 * (o_) + 16) = w1_; } while (0)
            RW_SOLVE16(0);
            asm volatile("s_waitcnt lgkmcnt(0)" ::: "memory");
            {
                v4u bw = {0u, 0u, 0u, 0u};
                if (r32 < 16) { const LAS float* ap = ABF + (8 * hi) * 36 + 16 + r32; bw.x = pk2(ap[0], ap[36]); bw.y = pk2(ap[72], ap[108]); bw.z = pk2(ap[144], ap[180]); bw.w = pk2(ap[216], ap[252]); }
#pragma unroll
                for (int vt = 0; vt < 2; ++vt) { f32x16 d = f32x16{};
                    d = __builtin_amdgcn_mfma_f32_32x32x16_bf16(*(const LAS bf16x8*)(lds + RW_UB + (32 * vt + r32) * RW_P32 + 16 * hi), __builtin_bit_cast(bf16x8, bw), d, 0, 0, 0);
                    if (r32 < 16) {
#pragma unroll
                        for (int r = 0; r < 16; ++r) CORR[(32 * vt + rwcrow(r, hi)) * 20 + r32] = d[r]; } }
            }
            asm volatile("s_waitcnt lgkmcnt(0)" ::: "memory");
            RW_SOLVE16(16);
#undef RW_SOLVE16
        }
        RW_BAR();
        if (prep) {
            f32x4 offu[2] = {{0.f, 0.f, 0.f, 0.f}, {0.f, 0.f, 0.f, 0.f}}, tot = {0.f, 0.f, 0.f, 0.f};
#pragma unroll
            for (int w = 0; w < 8; ++w) { const f32x4 tw = *(const LAS f32x4*)(WTOT + w * 64 + 4 * cq); tot += tw; if (w < vw0) offu[0] += tw; if (w < vw0 + 1) offu[1] += tw; }
#pragma unroll
            for (int u = 0; u < 2; ++u) { const int sj = sjv[u]; const f32x4 off = offu[u];
                float al[4], rh[4], be[4], ka[4], bp[4], kp[4];
#pragma unroll
                for (int e = 0; e < 4; ++e) { const float Lt = off[e] + Lin[u][e]; const float gprev = __builtin_amdgcn_exp2f(Lt - lw2[u][e]), gt = __builtin_amdgcn_exp2f(Lt), gi = __builtin_amdgcn_exp2f(-Lt), gp = __builtin_amdgcn_exp2f(tot[e] - Lt);
                    al[e] = gprev * o_kk[u][e]; rh[e] = gt * o_r[u][e]; be[e] = o_b[u][e] * gi; ka[e] = o_kd[u][e] * gi; bp[e] = o_b[u][e] * gp; kp[e] = o_kd[u][e] * gp; }
                v2u w; w.x = pk2(al[0], al[1]); w.y = pk2(al[2], al[3]); *(LAS v2u*)(lds + RW_TAL + sj * RW_P64 + 8 * cq) = w;
                w.x = pk2(rh[0], rh[1]); w.y = pk2(rh[2], rh[3]); *(LAS v2u*)(tsp + O_TRH + sj * RW_P64 + 8 * cq) = w;
                w.x = pk2(be[0], be[1]); w.y = pk2(be[2], be[3]); *(LAS v2u*)(tsp + O_TBE + sj * RW_P64 + 8 * cq) = w;
                w.x = pk2(ka[0], ka[1]); w.y = pk2(ka[2], ka[3]); *(LAS v2u*)(tsp + O_TKA + sj * RW_P64 + 8 * cq) = w;
#pragma unroll
                for (int e = 0; e < 4; ++e) { *(LAS unsigned short*)(tsp + O_TBP + (4 * cq + e) * RW_P32 + 2 * sj) = (unsigned short)f2bf(bp[e]); *(LAS unsigned short*)(tsp + O_TKP + (4 * cq + e) * RW_P32 + 2 * sj) = (unsigned short)f2bf(kp[e]);
                    *(LAS unsigned short*)(tsp + O_VT + (4 * cq + e) * RW_P32 + 2 * sj) = (unsigned short)f2bf(o_v[u][e]); }
                if (u == 1) { LAS float* gp_ = sj == 31 ? (LAS float*)(tsp + O_GC) + 4 * cq : (LAS float*)(lds + RW_DUMP); *(LAS f32x4*)gp_ = (f32x4){__builtin_amdgcn_exp2f(tot[0]), __builtin_amdgcn_exp2f(tot[1]), __builtin_amdgcn_exp2f(tot[2]), __builtin_amdgcn_exp2f(tot[3])}; } }
        } else if (chain) {
            if (wave < 2) {
                const int v0 = 32 * wave; f32x16 accY = f32x16{};
#pragma unroll
                for (int s = 0; s < 4; ++s) accY = __builtin_amdgcn_mfma_f32_32x32x16_bf16(*(const LAS bf16x8*)(S0cur + (v0 + r32) * RW_P64 + 32 * s + 16 * hi), *(const LAS bf16x8*)(tsc + O_TRH + r32 * RW_P64 + 32 * s + 16 * hi), accY, 0, 0, 0);
                { f32x16 bk = rw_cc(tsc + O_TKA, tsc + O_TRH, r32, hi);
#pragma unroll
                  for (int r = 0; r < 16; ++r) bk[r] = (rwcrow(r, hi) <= r32) ? bk[r] : 0.f;
                  accY = rw_accmul(accY, tsc + O_VT + (v0 + r32) * RW_P32, bk, hi); }
                { f32x16 bbm = rw_cc(tsc + O_TBE, tsc + O_TRH, r32, hi);
#pragma unroll
                  for (int r = 0; r < 16; ++r) bbm[r] = (rwcrow(r, hi) <= r32) ? bbm[r] : 0.f;
                  accY = rw_accmul(accY, lds + RW_UB + (v0 + r32) * RW_P32, bbm, hi); }
                {
                    const int iy = cc * RW_CH + r32; const int ly = z ? (SEQ - 1 - iy) : iy; GAS unsigned char* yb = (GAS unsigned char*)YB + (((size_t)z * T + tb0 + ly) * 512 + h * 64 + v0 + 4 * hi) * 2;
#pragma unroll
                    for (int g4 = 0; g4 < 4; ++g4) { v2u o; o.x = pk2(accY[4 * g4], accY[4 * g4 + 1]); o.y = pk2(accY[4 * g4 + 2], accY[4 * g4 + 3]); *(GAS v2u*)(yb + 16 * g4) = o; } }
            } else {
#pragma unroll
                for (int q = 0; q < 2; ++q) { const int sw = 2 * (wave - 2) + q, v0 = 32 * (sw & 1), k0 = 32 * (sw >> 1);
                    const float gcv = ((const LAS float*)(tsc + O_GC))[k0 + r32];
#pragma unroll
                    for (int r = 0; r < 16; ++r) accS[q][r] *= gcv;
#pragma unroll
                    for (int s = 0; s < 2; ++s) {
                        accS[q] = __builtin_amdgcn_mfma_f32_32x32x16_bf16(*(const LAS bf16x8*)(tsc + O_VT + (v0 + r32) * RW_P32 + 32 * s + 16 * hi), *(const LAS bf16x8*)(tsc + O_TKP + (k0 + r32) * RW_P32 + 32 * s + 16 * hi), accS[q], 0, 0, 0);
                        accS[q] = __builtin_amdgcn_mfma_f32_32x32x16_bf16(*(const LAS bf16x8*)(lds + RW_UB + (v0 + r32) * RW_P32 + 32 * s + 16 * hi), *(const LAS bf16x8*)(tsc + O_TBP + (k0 + r32) * RW_P32 + 32 * s + 16 * hi), accS[q], 0, 0, 0); } }
#pragma unroll
                for (int q = 0; q < 2; ++q) { const int sw = 2 * (wave - 2) + q, v0 = 32 * (sw & 1), k0 = 32 * (sw >> 1);
#pragma unroll
                    for (int r = 0; r < 16; ++r) *(LAS unsigned short*)(S0nxt + (v0 + rwcrow(r, hi)) * RW_P64 + 2 * (k0 + r32)) = (unsigned short)f2bf(accS[q][r]); } }
        }
        RW_BAR();
    }
#undef RW_LOAD
#undef RW_ROWOFF
    __syncthreads();
}
__device__ __forceinline__ void ph_rwkv(LAS unsigned char* lds, const bf16* P, int T, int nb, const float* mu, const float* w0, const float* w_up, const float* a0, const float* a_up, const float* k_k, const float* k_a, const float* r_k,
                                        bf16* YB, float* CB, bf16* VB, int tid, int bid, int nblk) {
    const int wv = __builtin_amdgcn_readfirstlane(tid >> 6);
#pragma unroll 1
    for (int it = bid; it < nb * 16; it += nblk) { const int z = it & 1, h = (it >> 1) & 7, b = it >> 4; rwkv_item(lds, P, T, z, b, h, mu, w0, w_up, a0, a_up, k_k, k_a, r_k, YB, CB, VB, wv); }
}
}
namespace mk {
constexpr int SS_RP = 272;
constexpr int SS_XP = 144;
constexpr int SS_BM = 0, SS_CM = SS_BM + 128 * SS_RP, SS_XN = SS_CM + 128 * SS_RP, SS_SB = SS_XN + 128 * SS_XP, SS_CUM = SS_SB + 128 * SS_XP, SS_MT = SS_CUM + 1024, SS_END = SS_MT + 10 * 2048;
__device__ __forceinline__ v2u ss_tr(unsigned addr) { v2u r; asm volatile("ds_read_b64_tr_b16 %0, %1" : "=&v"(r) : "v"(addr) : "memory"); return r; }
__device__ __forceinline__ void ss_wait4(v2u& a, v2u& b, v2u& c, v2u& d) { asm volatile("s_waitcnt lgkmcnt(0)" : "+v"(a), "+v"(b), "+v"(c), "+v"(d) :: "memory"); }
constexpr int SS_YP = 144;
static_assert(SS_END <= 147456, "ssd lds"); static_assert(SS_XP % 8 == 0 && SS_RP % 8 == 0, "transpose reads need 8-byte aligned rows");
__device__ __forceinline__ int crow(int r, int hi) { return (r & 3) + 8 * (r >> 2) + 4 * hi; }
__device__ __forceinline__ bf16x8 ldsA(const LAS unsigned char* base, int row, int colbyte) { return *(const LAS bf16x8*)(base + row * SS_RP + colbyte); }
__device__ __forceinline__ unsigned cvtpk(float lo, float hi) { typedef float f2 __attribute__((ext_vector_type(2))); typedef __bf16 b2 __attribute__((ext_vector_type(2))); f2 v = {lo, hi}; b2 b = __builtin_convertvector(v, b2); return __builtin_bit_cast(unsigned, b); }
__device__ __forceinline__ void ssd_item(LAS unsigned char* lds, const bf16* XC, const float* DT, const float* a_log, bf16* YA, int T, int z, int b, int h, const int tid) {
    const int lane = tid & 63, wave = __builtin_amdgcn_readfirstlane(tid >> 6), r32 = lane & 31, hi = lane >> 5;
    const int pt = wave & 1, qt = wave >> 1, g = h >> 2;
    const float a2 = -__expf(a_log[z * 8 + h]) * 1.4426950408889634f;
    LAS float* CUM = (LAS float*)(lds + SS_CUM);
    for (int i = tid; i < 128 * SS_XP / 4; i += 512) ((LAS unsigned*)(lds + SS_SB))[i] = 0u;
    f32x16 accS = f32x16{};
    const size_t tb0 = (size_t)b * SEQ;
    v4u pwb[4], pwc[4], pwx[2]; float pd[2], pl0, pl1;
#define SS_LOAD(cc) do { const GAS unsigned char* Xb_ = (const GAS unsigned char*)XC; const GAS unsigned char* Db_ = (const GAS unsigned char*)DT;     \
    _Pragma("unroll") for (int i = 0; i < 4; ++i) { const int idx = tid + 512 * i, q = idx >> 4, c8 = idx & 15; const int pos = 128 * (cc) + q; const unsigned t = (unsigned)tb0 + (unsigned)(z ? (SEQ - 1 - pos) : pos); \
        const unsigned o_ = (t * 1024u + 512u + (unsigned)(g * 128 + 8 * c8)) * 2u; pwb[i] = *(const GAS v4u*)(Xb_ + o_); pwc[i] = *(const GAS v4u*)(Xb_ + (o_ + 512u)); } \
    _Pragma("unroll") for (int i = 0; i < 2; ++i) { const int idx = tid + 512 * i, q = idx >> 3, c8 = idx & 7; const int pos = 128 * (cc) + q; const unsigned t = (unsigned)tb0 + (unsigned)(z ? (SEQ - 1 - pos) : pos); \
        pwx[i] = *(const GAS v4u*)(Xb_ + (t * 1024u + (unsigned)(h * 64 + 8 * c8)) * 2u); pd[i] = *(const GAS float*)(Db_ + (t * 16u + (unsigned)(z * 8 + h)) * 4u); } \
    { const int p0 = 128 * (cc) + 2 * lane; const unsigned t0 = (unsigned)tb0 + (unsigned)(z ? (SEQ - 1 - p0) : p0), t1 = (unsigned)tb0 + (unsigned)(z ? (SEQ - 2 - p0) : (p0 + 1)); pl0 = *(const GAS float*)(Db_ + (t0 * 16u + (unsigned)(z * 8 + h)) * 4u); pl1 = *(const GAS float*)(Db_ + (t1 * 16u + (unsigned)(z * 8 + h)) * 4u); } } while (0)
    SS_LOAD(0);
#pragma unroll 1
    for (int c = 0; c < SEQ / 128; ++c) {
        asm volatile("s_waitcnt vmcnt(2)" ::: "memory");
        __syncthreads();
#pragma unroll
        for (int i = 0; i < 4; ++i) { const int idx = tid + 512 * i, q = idx >> 4, c8 = idx & 15;
            *(LAS v4u*)(lds + SS_BM + q * SS_RP + 16 * c8) = pwb[i]; *(LAS v4u*)(lds + SS_CM + q * SS_RP + 16 * c8) = pwc[i]; }
#pragma unroll
        for (int i = 0; i < 2; ++i) { const int idx = tid + 512 * i, q = idx >> 3, c8 = idx & 7; const v4u wx = pwx[i]; const float d = pd[i]; v4u o;
            o.x = pk2(bflo(wx.x) * d, bfhi(wx.x) * d); o.y = pk2(bflo(wx.y) * d, bfhi(wx.y) * d); o.z = pk2(bflo(wx.z) * d, bfhi(wx.z) * d); o.w = pk2(bflo(wx.w) * d, bfhi(wx.w) * d);
            *(LAS v4u*)(lds + SS_XN + q * SS_XP + 16 * c8) = o; }
        if (wave == 0) {
            const float l0 = pl0 * a2, l1 = pl1 * a2; float x = l0 + l1;
#pragma unroll
            for (int o = 1; o < 64; o <<= 1) { const float y = __builtin_bit_cast(float, __builtin_amdgcn_ds_bpermute(((lane - o) & 63) << 2, __builtin_bit_cast(int, x))); x += (lane >= o) ? y : 0.f; }
            *(LAS f32x2v*)(CUM + 2 * lane) = (f32x2v){x - l1, x}; }
        asm volatile("" ::: "memory"); __builtin_amdgcn_sched_barrier(0);
        SS_LOAD(c + 1 < SEQ / 128 ? c + 1 : c);
        __builtin_amdgcn_sched_barrier(0);
        __syncthreads();
        const float cq = CUM[32 * qt + r32], clast = CUM[127];
        f32x16 acc = f32x16{};
        { bf16x8 cf[8];
#pragma unroll
          for (int s = 0; s < 8; ++s) cf[s] = ldsA(lds + SS_CM, 32 * qt + r32, 32 * s + 16 * hi);
          { const unsigned sa = (unsigned)(uintptr_t)(lds + SS_SB) + (unsigned)((8 * hi + ((lane & 15) >> 2)) * SS_XP + (32 * pt + 16 * ((lane >> 4) & 1) + 4 * (lane & 3)) * 2);
            v2u sl[8], sh[8];
#pragma unroll
            for (int s = 0; s < 8; ++s) { sl[s] = ss_tr(sa + 16 * s * SS_XP); sh[s] = ss_tr(sa + (16 * s + 4) * SS_XP); }
#pragma unroll
            for (int s = 0; s < 4; ++s) ss_wait4(sl[2 * s], sh[2 * s], sl[2 * s + 1], sh[2 * s + 1]);
#pragma unroll
            for (int s = 0; s < 8; ++s) { v4u av; av.x = sl[s].x; av.y = sl[s].y; av.z = sh[s].x; av.w = sh[s].y; acc = __builtin_amdgcn_mfma_f32_32x32x16_bf16(__builtin_bit_cast(bf16x8, av), cf[s], acc, 0, 0, 0); } }
          const float eq = __builtin_amdgcn_exp2f(cq);
#pragma unroll
          for (int r = 0; r < 16; ++r) acc[r] *= eq; }
#pragma unroll 1
        for (int tI = wave; tI < 10; tI += 8) { const int q2 = tI < 1 ? 0 : (tI < 3 ? 1 : (tI < 6 ? 2 : 3)), kt = tI - q2 * (q2 + 1) / 2; const float cq2 = CUM[32 * q2 + r32];
            f32x16 gT = f32x16{};
#pragma unroll
            for (int s = 0; s < 8; ++s) gT = __builtin_amdgcn_mfma_f32_32x32x16_bf16(ldsA(lds + SS_BM, 32 * kt + r32, 32 * s + 16 * hi), ldsA(lds + SS_CM, 32 * q2 + r32, 32 * s + 16 * hi), gT, 0, 0, 0);
#pragma unroll
            for (int gq = 0; gq < 4; ++gq) { const f32x4 ck = *(const LAS f32x4*)(CUM + 32 * kt + 8 * gq + 4 * hi);
#pragma unroll
                for (int e = 0; e < 4; ++e) { const int r = 4 * gq + e; const bool ok = (kt < q2) || (8 * gq + 4 * hi + e <= r32); const float m = __builtin_amdgcn_exp2f(cq2 - ck[e]); gT[r] = ok ? gT[r] * m : 0.f; } }
            v4u m0, m1; m0.x = cvtpk(gT[0], gT[1]); m0.y = cvtpk(gT[2], gT[3]); m0.z = cvtpk(gT[4], gT[5]); m0.w = cvtpk(gT[6], gT[7]); m1.x = cvtpk(gT[8], gT[9]); m1.y = cvtpk(gT[10], gT[11]); m1.z = cvtpk(gT[12], gT[13]); m1.w = cvtpk(gT[14], gT[15]);
            *(LAS v4u*)(lds + SS_MT + tI * 2048 + lane * 32) = m0; *(LAS v4u*)(lds + SS_MT + tI * 2048 + lane * 32 + 16) = m1; }
        __syncthreads();
#pragma unroll
        for (int kh = 0; kh < 2; ++kh) {
            v2u xl[2][4]; v4u mm[2][2];
#pragma unroll
            for (int k2 = 0; k2 < 2; ++k2) { const int kt = 2 * kh + k2, ktc = kt <= qt ? kt : qt;
                const unsigned xa = (unsigned)(uintptr_t)(lds + SS_XN) + (unsigned)((32 * ktc + 4 * hi + ((lane & 15) >> 2)) * SS_XP + (32 * pt + 16 * ((lane >> 4) & 1) + 4 * (lane & 3)) * 2);
                xl[k2][0] = ss_tr(xa); xl[k2][1] = ss_tr(xa + 8 * SS_XP); xl[k2][2] = ss_tr(xa + 16 * SS_XP); xl[k2][3] = ss_tr(xa + 24 * SS_XP);
                const LAS unsigned char* mp = lds + SS_MT + (qt * (qt + 1) / 2 + ktc) * 2048 + lane * 32; mm[k2][0] = *(const LAS v4u*)mp; mm[k2][1] = *(const LAS v4u*)(mp + 16); }
#pragma unroll
            for (int k2 = 0; k2 < 2; ++k2) { const int kt = 2 * kh + k2; ss_wait4(xl[k2][0], xl[k2][1], xl[k2][2], xl[k2][3]);
                if (kt <= qt) { v4u a0; a0.x = xl[k2][0].x; a0.y = xl[k2][0].y; a0.z = xl[k2][1].x; a0.w = xl[k2][1].y; v4u a1; a1.x = xl[k2][2].x; a1.y = xl[k2][2].y; a1.z = xl[k2][3].x; a1.w = xl[k2][3].y;
                    acc = __builtin_amdgcn_mfma_f32_32x32x16_bf16(__builtin_bit_cast(bf16x8, a0), __builtin_bit_cast(bf16x8, mm[k2][0]), acc, 0, 0, 0);
                    acc = __builtin_amdgcn_mfma_f32_32x32x16_bf16(__builtin_bit_cast(bf16x8, a1), __builtin_bit_cast(bf16x8, mm[k2][1]), acc, 0, 0, 0); } } }
        __syncthreads();
        { LAS unsigned short* ys = (LAS unsigned short*)(lds + SS_CM + (32 * qt + r32) * SS_YP) + 32 * pt;
#pragma unroll
          for (int g4 = 0; g4 < 4; ++g4) { v2u o; o.x = pk2(acc[4 * g4], acc[4 * g4 + 1]); o.y = pk2(acc[4 * g4 + 2], acc[4 * g4 + 3]); *(LAS v2u*)(ys + 8 * g4 + 4 * hi) = o; } }
        { const int q = tid >> 2, p0 = 16 * (tid & 3); LAS unsigned char* xr = lds + SS_XN + q * SS_XP + 2 * p0; v4u w0 = *(LAS v4u*)xr, w1 = *(LAS v4u*)(xr + 16);
          const float e = __builtin_amdgcn_exp2f(clast - CUM[q]);
          w0.x = pk2(bflo(w0.x) * e, bfhi(w0.x) * e); w0.y = pk2(bflo(w0.y) * e, bfhi(w0.y) * e); w0.z = pk2(bflo(w0.z) * e, bfhi(w0.z) * e); w0.w = pk2(bflo(w0.w) * e, bfhi(w0.w) * e);
          w1.x = pk2(bflo(w1.x) * e, bfhi(w1.x) * e); w1.y = pk2(bflo(w1.y) * e, bfhi(w1.y) * e); w1.z = pk2(bflo(w1.z) * e, bfhi(w1.z) * e); w1.w = pk2(bflo(w1.w) * e, bfhi(w1.w) * e);
          *(LAS v4u*)xr = w0; *(LAS v4u*)(xr + 16) = w1; }
        __syncthreads();
#pragma unroll
        for (int i = 0; i < 2; ++i) { const int idx = tid + 512 * i, q = idx >> 3, c8 = idx & 7; const int pos = 128 * c + q; const size_t t = tb0 + (z ? (SEQ - 1 - pos) : pos);
            *(GAS v4u*)(YA + ((size_t)z * T + t) * 512 + h * 64 + 8 * c8) = *(const LAS v4u*)(lds + SS_CM + q * SS_YP + 16 * c8); }
        { const float dl = __builtin_amdgcn_exp2f(clast);
#pragma unroll
          for (int r = 0; r < 16; ++r) accS[r] *= dl;
          { const int rq = 8 * hi + ((lane & 15) >> 2), cg = 16 * ((lane >> 4) & 1) + 4 * (lane & 3);
            const unsigned xa = (unsigned)(uintptr_t)(lds + SS_XN) + (unsigned)(rq * SS_XP + (32 * pt + cg) * 2), ba = (unsigned)(uintptr_t)(lds + SS_BM) + (unsigned)(rq * SS_RP + (32 * qt + cg) * 2);
            v2u al[8], ah[8], bl[8], bh[8];
#pragma unroll
            for (int s = 0; s < 8; ++s) { al[s] = ss_tr(xa + 16 * s * SS_XP); ah[s] = ss_tr(xa + (16 * s + 4) * SS_XP); bl[s] = ss_tr(ba + 16 * s * SS_RP); bh[s] = ss_tr(ba + (16 * s + 4) * SS_RP); }
#pragma unroll
            for (int s = 0; s < 8; ++s) ss_wait4(al[s], ah[s], bl[s], bh[s]);
#pragma unroll
            for (int s = 0; s < 8; ++s) { v4u av; av.x = al[s].x; av.y = al[s].y; av.z = ah[s].x; av.w = ah[s].y; v4u bv; bv.x = bl[s].x; bv.y = bl[s].y; bv.z = bh[s].x; bv.w = bh[s].y;
                accS = __builtin_amdgcn_mfma_f32_32x32x16_bf16(__builtin_bit_cast(bf16x8, av), __builtin_bit_cast(bf16x8, bv), accS, 0, 0, 0); } }
          LAS unsigned char* sb = lds + SS_SB + (32 * qt + r32) * SS_XP + (32 * pt + 4 * hi) * 2;
#pragma unroll
          for (int g4 = 0; g4 < 4; ++g4) { v2u o; o.x = pk2(accS[4 * g4], accS[4 * g4 + 1]); o.y = pk2(accS[4 * g4 + 2], accS[4 * g4 + 3]); *(LAS v2u*)(sb + 16 * g4) = o; } }
    }
#undef SS_LOAD
    __syncthreads();
}
__device__ __forceinline__ void ph_ssd(LAS unsigned char* lds, const bf16* XC, const float* DT, const float* a_log, bf16* YA, int T, int nb, int tid, int bid, int nblk, int blk0) {
#pragma unroll 1
    for (int it = (bid - blk0 + nblk) % nblk; it < nb * 16; it += nblk) { const int z = it & 1, h = (it >> 1) & 7, b = it >> 4; ssd_item(lds, XC, DT, a_log, YA, T, z, b, h, tid); }
}
}
namespace mk {
#define XB_TMO      128
#define XB_XCNT(j)  (256  + 64 * (j))
#define XB_XSUB(j)  (1280 + 64 * (j))
#define XB_XGEN(j)  (2304 + 64 * (j))
#define XB_TOP      3328
#define XB_TOPGEN   3392
#define XCD_BAR_WORDS 3456
#define XB_SPIN_CAP (1u << 18)

__device__ __forceinline__ unsigned xb_ld(unsigned* p)              { return __hip_atomic_load(p, __ATOMIC_RELAXED, __HIP_MEMORY_SCOPE_AGENT); }
__device__ __forceinline__ unsigned xb_add(unsigned* p, unsigned v) { return __hip_atomic_fetch_add(p, v, __ATOMIC_RELAXED, __HIP_MEMORY_SCOPE_AGENT); }
__device__ __forceinline__ unsigned xb_xcc_id() { return (unsigned)__builtin_amdgcn_s_getreg((3 << 11) | 20) & 0xFu; }
#define XB_SPIN(cond, bar) do { unsigned _sp = 0; while (cond) { __builtin_amdgcn_s_sleep(1); \
    if ((++_sp & 255u) == 0u) { if (xb_ld(&(bar)[XB_TMO])) break; if (_sp > XB_SPIN_CAP) { atomicAdd(&(bar)[XB_TMO], 1u); break; } } } } while (0)

struct XcdBarrier {
    unsigned* bar; unsigned x;
    volatile LAS unsigned* st;
};

__device__ __forceinline__ XcdBarrier xcd_barrier_post(unsigned* bar, volatile LAS unsigned* st) {
    XcdBarrier b; b.bar = bar; b.x = xb_xcc_id(); b.st = st;
    if (threadIdx.x == 0) (void)xb_add(&bar[XB_XCNT(b.x)], 1u);
    return b;
}
__device__ __forceinline__ void xcd_barrier_complete(unsigned* bar, unsigned x, unsigned& nloc, unsigned& nx) {
    const unsigned G = gridDim.x * gridDim.y * gridDim.z;
    unsigned sum, cnt, mine, sp = 0u;
    for (;;) {
        sum = 0u; cnt = 0u; mine = 0u;
#pragma unroll
        for (unsigned j = 0; j < 16; ++j) { const unsigned c = xb_ld(&bar[XB_XCNT(j)]); sum += c; cnt += (c > 0u) ? 1u : 0u; mine = (j == x) ? c : mine; }
        if (sum == G) break;
        __builtin_amdgcn_s_sleep(1);
        if ((++sp & 255u) == 0u) { if (xb_ld(&bar[XB_TMO])) break; if (sp > XB_SPIN_CAP) { atomicAdd(&bar[XB_TMO], 1u); break; } }
    }
    nloc = mine > 0u ? mine : 1u; nx = cnt > 0u ? cnt : 1u;
}

__device__ __forceinline__ void xcd_barrier(const XcdBarrier& b) {
    asm volatile("s_waitcnt vmcnt(0)" ::: "memory");
    __syncthreads();
    if (threadIdx.x == 0) {
        unsigned* bar = b.bar;
        __builtin_amdgcn_s_waitcnt(0);
        unsigned nloc = b.st[0], nx = b.st[1];
        if (nloc == 0u) { xcd_barrier_complete(bar, b.x, nloc, nx); b.st[0] = nloc; b.st[1] = nx; }
        const unsigned old = xb_add(&bar[XB_XSUB(b.x)], 1u);
        const unsigned gen = old / nloc;
        if (old + 1u == (gen + 1u) * nloc) {
            __builtin_amdgcn_fence(__ATOMIC_RELEASE, "agent");
            asm volatile("s_waitcnt vmcnt(0)" ::: "memory");
            const unsigned og = xb_add(&bar[XB_TOP], 1u);
            const unsigned tg = og / nx;
            if (og + 1u == (tg + 1u) * nx) xb_add(&bar[XB_TOPGEN], 1u);
            else XB_SPIN(xb_ld(&bar[XB_TOPGEN]) == tg, bar);
            __builtin_amdgcn_fence(__ATOMIC_ACQUIRE, "agent");
            xb_add(&bar[XB_XGEN(b.x)], 1u);
            asm volatile("s_waitcnt vmcnt(0)" ::: "memory");
        } else {
            XB_SPIN(xb_ld(&bar[XB_XGEN(b.x)]) == gen, bar);
            __builtin_amdgcn_fence(__ATOMIC_ACQUIRE, "agent");
            asm volatile("s_waitcnt vmcnt(0)" ::: "memory");
        }
    }
    __syncthreads();
}


}
#include <hip/hip_cooperative_groups.h>
namespace mk {
namespace cg = cooperative_groups;
constexpr int LDS_BYTES = 163840;
constexpr int NB_HALF = 8, TH = NB_HALF * SEQ;
constexpr size_t al256(size_t x) { return (x + 255) / 256 * 256; }
constexpr size_t WS_CTL = 0, CTL_BYTES = 65536, WS_W = CTL_BYTES, WS_ROPE = al256(WS_W + 2 * W_LAYER_ELEMS * 2), WS_H = al256(WS_ROPE + 2ull * SEQ * 32 * 4), WS_P = al256(WS_H + (size_t)TH * 1024 * 2), WS_X = al256(WS_P + (size_t)TH * LDP * 2);
constexpr size_t X_XC = 0, X_DT = al256(X_XC + (size_t)TH * 1024 * 2), X_QN = al256(X_DT + (size_t)TH * 16 * 4), X_KN = al256(X_QN + (size_t)TH * 512 * 2), X_YA = al256(X_KN + (size_t)TH * 128 * 2),
                 X_YB = al256(X_YA + 2ull * TH * 512 * 2), X_CB = al256(X_YB + 2ull * TH * 512 * 2), X_VB = al256(X_CB + 2ull * TH * 8 * 4), X_RS = al256(X_VB + (size_t)TH * 512 * 2), X_END1 = al256(X_RS + 9ull * SEQ * 512 * 4);
constexpr size_t X_MF = 0, X_MB = al256(X_MF + (size_t)TH * 1024 * 4), X_OF = al256(X_MB + (size_t)TH * 1024 * 2), X_END2 = al256(X_OF + (size_t)TH * 1024 * 4);
constexpr size_t WS_NEED = WS_X + (X_END1 > X_END2 ? X_END1 : X_END2);
static_assert(WS_NEED <= 536870912ull, "workspace map exceeds 512 MiB");
struct MegaArgs { const float* in[25]; float* out; unsigned char* ws; };
__global__ __launch_bounds__(512, 2) void k_mega(MegaArgs a) {
    extern __shared__ __attribute__((aligned(16))) unsigned char lds_[];
    LAS unsigned char* lds = (LAS unsigned char*)lds_;
    cg::grid_group grid = cg::this_grid();
    volatile LAS unsigned* xbst = (volatile LAS unsigned*)(lds + LDS_BYTES - 16);
    if (threadIdx.x < 4) xbst[threadIdx.x] = 0u;
    __syncthreads();
    XcdBarrier xbar = xcd_barrier_post((unsigned*)(a.ws + WS_CTL), xbst);
#define GSYNC() xcd_barrier(xbar)
    const int wave0 = __builtin_amdgcn_readfirstlane((int)threadIdx.x >> 6);
#define PV int bid = blockIdx.x, wv_ = wave0; unsigned mk_ = ~0u; unsigned char* ws = a.ws; asm volatile("" : "+s"(bid), "+s"(wv_), "+s"(mk_), "+s"(ws)); int tid = wv_ * 64 + (int)__builtin_amdgcn_mbcnt_hi(mk_, __builtin_amdgcn_mbcnt_lo(mk_, 0u)); asm volatile("" : "+v"(tid)); const int lane = tid & 63, wave = wv_; const int gw = bid * 8 + wave, ngw = gridDim.x * 8, gtid = bid * 512 + tid, nthr = gridDim.x * 512; (void)lane; (void)wave; (void)gw; (void)ngw; (void)gtid; (void)nthr; bf16* Wall = (bf16*)(ws + WS_W); float* rope = (float*)(ws + WS_ROPE); bf16* H = (bf16*)(ws + WS_H); bf16* P = (bf16*)(ws + WS_P); unsigned char* X = ws + WS_X; bf16* XC = (bf16*)(X + X_XC); float* DT = (float*)(X + X_DT); bf16* Qn = (bf16*)(X + X_QN); bf16* Kn = (bf16*)(X + X_KN); bf16* YA = (bf16*)(X + X_YA); bf16* YB = (bf16*)(X + X_YB); float* CB = (float*)(X + X_CB); bf16* VB = (bf16*)(X + X_VB); float* Mf = (float*)(X + X_MF); bf16* Mb = (bf16*)(X + X_MB); float* OF = (float*)(X + X_OF); const bf16* W = Wall + (size_t)l * W_LAYER_ELEMS; (void)rope; (void)H; (void)P; (void)XC; (void)DT; (void)Qn; (void)Kn; (void)YA; (void)YB; (void)CB; (void)VB; (void)Mf; (void)Mb; (void)OF; (void)W;
    { const int l = 0; PV; ph_wconv(a.in[2], a.in[22], a.in[23], Wall, lds, gw, ngw, wave, lane); }
    { const int l = 0; PV; ph_rope_table(rope, gtid, nthr); }
    { const int l = 0; PV; ph_rmsnorm(a.in[0], a.in[1], H, TH, gw, ngw, lane); }
    grid.sync();
#pragma unroll 1
    for (int hf = 0; hf < 2; ++hf) {
#pragma unroll 1
        for (int l = 0; l < 2; ++l) {
            const size_t ro = (size_t)hf * TH * 1024; const float* xin = (l == 0 ? a.in[0] : a.out) + ro; float* xout = a.out + ro;
            { PV; ph_gemm_bf16out_range(lds, H, 1024, W + WOFF_W1, TH, (int)W1T_N, 1024, P, LDP, 0, 7, tid, bid); }
            GSYNC();
            { const int G_ = (int)gridDim.x, nwg_ = (TH / 256) * ((int)W1T_N / 256); int nb8 = nwg_ - 7 * G_; nb8 = nb8 < 0 ? 0 : (nb8 > G_ ? G_ : nb8);
              const bool ov = (7 * G_ >= 960) && (nb8 < G_);
              if (!ov || (int)blockIdx.x < nb8) { PV; ph_gemm_bf16out_range(lds, H, 1024, W + WOFF_W1, TH, (int)W1T_N, 1024, P, LDP, 7, 1 << 20, tid, bid); }
              if (!ov) GSYNC();
              if (!ov || (int)blockIdx.x >= nb8) { PV; const int off = ov ? nb8 * 512 : 0; ph_prep_conv(P, TH, a.in[3] + l * 5 * 1024, a.in[4] + l * 1024, a.in[5] + l * 16, XC, DT, gtid - off, nthr - off); } }
            { PV; ph_prep_gqa(P, TH, a.in[19] + l * 64, a.in[20] + l * 64, rope, Qn, Kn, gtid, nthr); }
            GSYNC();
            { PV; ph_rwkv(lds, P, TH, NB_HALF, a.in[9] + l * 2 * 1792, a.in[10] + l * 1024, a.in[11] + (size_t)l * 2 * 64 * 512, a.in[12] + l * 1024, a.in[13] + (size_t)l * 2 * 64 * 512, a.in[14] + l * 512, a.in[15] + l * 512, a.in[16] + l * 512, YB, CB, VB, tid, bid, (int)gridDim.x); }
            { PV; ph_ssd(lds, XC, DT, a.in[6] + l * 16, YA, TH, NB_HALF, tid, bid, (int)gridDim.x, 128); }
            { PV; ph_attn((char*)lds_, P, Qn, Kn, a.in[21] + l * 8 * 465, NB_HALF, tid, (unsigned*)(ws + WS_CTL) + 8192 + 64 * (2 * l + hf), (volatile LAS unsigned*)(lds + LDS_BYTES - 8)); }
            GSYNC();
            { PV; ph_post(P, TH, XC, YA, a.in[7] + l * 8, a.in[8] + l * 512, YB, CB, VB, a.in[17] + l * 512, a.in[18] + l * 512, gw, ngw, lane); }
            { PV; ph_gemm_rsigout(lds, H, 1024, W + WOFF_W2, TH, (int)W2T_N, 1024, P, LDP, tid, bid); }
            GSYNC();
            { PV; EpiMergeF E{Mb, P, LDP}; run_gemm(lds, P + PC_Y, LDP, W + WOFF_WB, TH, 1024, 2048, E, tid, bid); }
            GSYNC();
            { PV; EpiF32 E{OF, 1024}; run_gemm(lds, Mb, 1024, W + WOFF_WO, TH, 1024, 1024, E, tid, bid); }
            GSYNC();
            { PV; ph_fin(xin, OF, a.in[24] + l * 1024, xout, l == 0 ? a.in[1] + 1024 : nullptr, H, TH, gw, ngw, lane); }
            if (l == 1 && hf == 0) { PV; ph_rmsnorm(a.in[0] + (size_t)TH * 1024, a.in[1], H, TH, gw, ngw, lane); }
            GSYNC();
        }
    }
}
}
extern "C" void kernel_launch(void* const* d_in, const int* in_sizes, int n_in, void* d_out, int out_size, void* d_ws, size_t ws_size, hipStream_t stream) {
    static int grid_blocks = 0;
    if (!grid_blocks) {
        if (ws_size < mk::WS_NEED) { fprintf(stderr, "ws too small: need %zu have %zu\n", (size_t)mk::WS_NEED, ws_size); grid_blocks = -1; return; }
        int dev = 0, cus = 0, per_cu = 0; (void)hipGetDevice(&dev); (void)hipDeviceGetAttribute(&cus, hipDeviceAttributeMultiprocessorCount, dev);
        (void)hipFuncSetAttribute((const void*)mk::k_mega, hipFuncAttributeMaxDynamicSharedMemorySize, mk::LDS_BYTES);
        (void)hipOccupancyMaxActiveBlocksPerMultiprocessor(&per_cu, (const void*)mk::k_mega, 512, mk::LDS_BYTES);
        if (per_cu < 1) { fprintf(stderr, "occupancy query says %d blocks/CU\n", per_cu); per_cu = 1; }
        grid_blocks = cus;
        fprintf(stderr, "k_mega: cus %d per_cu %d grid %d ws_need %zu ws %zu\n", cus, per_cu, grid_blocks, (size_t)mk::WS_NEED, ws_size);
    }
    if (grid_blocks < 0) return;
    mk::MegaArgs a{}; for (int i = 0; i < 25; ++i) a.in[i] = (const float*)d_in[i]; a.out = (float*)d_out; a.ws = (unsigned char*)d_ws;
    (void)hipMemsetAsync((char*)d_ws + mk::WS_CTL, 0, mk::CTL_BYTES, stream);
    void* args[] = {(void*)&a};
    hipError_t e = hipLaunchCooperativeKernel((const void*)mk::k_mega, dim3(grid_blocks), dim3(512), args, mk::LDS_BYTES, stream);
    if (e != hipSuccess) fprintf(stderr, "cooperative launch failed: %s (grid %d)\n", hipGetErrorString(e), grid_blocks);
}
```

```cpp
#include <hip/hip_runtime.h>
#include <cstdio>
#include <cstdint>
#include <cmath>
namespace pg8 {
#define PG8_LAS __attribute__((address_space(3)))
typedef unsigned short bf16_t;
typedef short bf16x8 __attribute__((ext_vector_type(8)));
typedef float f32x4 __attribute__((ext_vector_type(4)));
typedef unsigned u32x4 __attribute__((ext_vector_type(4)));
constexpr int BM = 256, BK = 64, HALF = 128, HTB = HALF * BK * 2  , STAGE_BYTES = 8 * HTB, NXCD = 8, WGM = 8;

__host__ __device__ __forceinline__ int lds_byte(int r, int c) { const int st = (r >> 4) * 2 + (c >> 5), rr = r & 15, cc = c & 31, ob = rr * 64 + cc * 2; return st * 1024 + (ob ^ (((ob >> 9) & 1) << 5)); }
__host__ __device__ __forceinline__ void stage_rc(int b, int& R, int& C) { const int st = b / 1024, sb = b % 1024, swz = sb ^ (((sb >> 9) & 1) << 5); R = (st >> 1) * 16 + swz / 64; C = (st & 1) * 32 + (swz % 64) / 2; }
__host__ __device__ __forceinline__ int perm32(int rho) { const int n = rho >> 4, i = rho & 15; return 8 * (i >> 2) + 4 * n + (i & 3); }

struct Unit { int pm, pn; };
struct Gemm { const bf16_t* A; const bf16_t* Bt; int M, N, K, lda; };

struct StaticOrder {
    int nM, nN, nwg, G, c;
    __host__ __device__ void init(int M, int N, int G_, int c_) { nM = M / BM; nN = N / BM; nwg = nM * nN; G = G_; c = c_; }
    __host__ __device__ bool next(int i, Unit& u) const {
        const long L = (long)i * G + c; if (L >= nwg) return false;
        int wgid = (int)L; { const int q = nwg / NXCD, r = nwg % NXCD, xcd = wgid % NXCD, off = wgid / NXCD; wgid = (xcd < r ? xcd * (q + 1) : r * (q + 1) + (xcd - r) * q) + off; }
        const int nig = WGM * nN, gid = wgid / nig, fm = gid * WGM, gsz = (nM - fm) < WGM ? (nM - fm) : WGM;
        u.pm = fm + ((wgid % nig) % gsz); u.pn = (wgid % nig) / gsz; return true;
    }
    __device__ __forceinline__ void a_ready(const Unit&) const {}
    __device__ __forceinline__ void done(const Unit&) const {}
};

__device__ __forceinline__ unsigned cvt_pk_bf16(float lo, float hi) { unsigned r; asm volatile("v_cvt_pk_bf16_f32 %0, %1, %2" : "=v"(r) : "v"(lo), "v"(hi)); return r; }
typedef float f32x2 __attribute__((ext_vector_type(2)));
__device__ __forceinline__ f32x2 gelu_pk(f32x2 v) {
    const f32x2 av = __builtin_elementwise_abs(v), d = av * 0.2316418882f + 1.0f;
    f32x2 t; t.x = __builtin_amdgcn_rcpf(d.x); t.y = __builtin_amdgcn_rcpf(d.y);
    f32x2 q = t * 0.5307027145f + (-0.7265760135f); q = q * t + 0.7107068705f; q = q * t + (-0.142248368f); q = q * t + 0.127414796f; q = q * t;
    const f32x2 s = (v * v) * (-0.72134752044f);
    f32x2 e; e.x = __builtin_amdgcn_exp2f(s.x); e.y = __builtin_amdgcn_exp2f(s.y);
    const f32x2 m = v * (q * e), r = v - m;
    f32x2 o; o.x = v.x < 0.f ? m.x : r.x; o.y = v.y < 0.f ? m.y : r.y; return o;
}

template <int ACT  > struct EpiBf16 {
    static constexpr bool PERM = true, AFTER_DRAIN = false, FOLD = false; static_assert(ACT >= 0 && ACT <= 2, "EpiBf16: ACT is 0 (none), 1 (gelu_pk) or 2 (1 + exp(-x), the reciprocal sigmoid)");
    bf16_t* O; int ldc; const float* bias; int split_cols; size_t split_stride; float scale0;
    __device__ __forceinline__ void operator()(const f32x4 (&acc)[2][2][4][2], const Unit& u, int wr, int wc, int fr, int fq) const {
        const int row0 = u.pm * BM + wr * 64 + fr; int colt = u.pn * BM; bf16_t* base = O;
        float sc = 1.f; if (split_cols) { const int t = colt / split_cols; base += (size_t)t * split_stride; colt -= t * split_cols; if (t == 0) sc = scale0; }
        const int col0 = colt + wc * 32 + 8 * fq, bcol0 = u.pn * BM + wc * 32 + 8 * fq;
        f32x4 bv[2][2];
#pragma unroll
        for (int bj = 0; bj < 2; ++bj)
#pragma unroll
            for (int n = 0; n < 2; ++n) bv[bj][n] = bias ? *(const f32x4*)(bias + bcol0 + bj * HALF + 4 * n) : (f32x4){0.f, 0.f, 0.f, 0.f};
#pragma unroll
        for (int ai = 0; ai < 2; ++ai)
#pragma unroll
            for (int m = 0; m < 4; ++m) { bf16_t* rowp = base + (size_t)(row0 + ai * HALF + m * 16) * ldc + col0;
#pragma unroll
                for (int bj = 0; bj < 2; ++bj) { f32x4 v0 = acc[ai][bj][m][0] + bv[bj][0], v1 = acc[ai][bj][m][1] + bv[bj][1];
                    if (ACT == 1) { f32x2 a = gelu_pk((f32x2){v0[0], v0[1]}), b = gelu_pk((f32x2){v0[2], v0[3]}), c = gelu_pk((f32x2){v1[0], v1[1]}), d = gelu_pk((f32x2){v1[2], v1[3]});
                        v0 = (f32x4){a.x, a.y, b.x, b.y}; v1 = (f32x4){c.x, c.y, d.x, d.y}; }
                    if (ACT == 2) { _Pragma("unroll") for (int e = 0; e < 4; ++e) { v0[e] = 1.f + __builtin_amdgcn_exp2f(__builtin_fminf(__builtin_fmaxf(v0[e], -60.f), 60.f) * -1.4426950408889634f); v1[e] = 1.f + __builtin_amdgcn_exp2f(__builtin_fminf(__builtin_fmaxf(v1[e], -60.f), 60.f) * -1.4426950408889634f); } }
                    v0 = v0 * sc; v1 = v1 * sc; u32x4 w; w.x = cvt_pk_bf16(v0[0], v0[1]); w.y = cvt_pk_bf16(v0[2], v0[3]); w.z = cvt_pk_bf16(v1[0], v1[1]); w.w = cvt_pk_bf16(v1[2], v1[3]);
                    *(u32x4*)(rowp + bj * HALF) = w; } }
    }
};
template <class Epi, class Sched, bool ALIGN_EPI = false, bool SP2 = false>
__device__ __forceinline__ void gemm_phase(PG8_LAS unsigned char* lds, const Gemm g, const Sched& S, const Epi& E, const int tid) {
    const int wid = __builtin_amdgcn_readfirstlane(tid >> 6), lane = tid & 63, wr = wid >> 2, wc = wid & 3, fr = lane & 15, fq = lane >> 4;
    const int K = g.K, nt = K / BK;
    unsigned voffA[2], voffB[2];
#pragma unroll
    for (int i = 0; i < 2; ++i) { int R, C; stage_rc(tid * 16 + i * 8192, R, C); const int Rb = Epi::PERM ? ((R & ~31) + perm32(R & 31)) : R;
        voffA[i] = (unsigned)(R * g.lda + C) * 2u; voffB[i] = (unsigned)(Rb * K + C) * 2u; }
    const size_t kstep = (size_t)(BK * 2);
    const size_t hstep = (size_t)HALF * K * 2;
    const size_t tstep = 2 * hstep;
    const size_t hstepA = (size_t)HALF * g.lda * 2, tstepA = 2 * hstepA;
    const unsigned ldsw = (unsigned)wid * 1024u;
    const int aoff = lds_byte(wr * 64 + fr, fq * 8), boff = lds_byte(wc * 32 + fr, fq * 8);
#define PG8_SA(b, h) (((b) * 2 + (h)) * HTB)
#define PG8_SB(b, h) ((4 + (b) * 2 + (h)) * HTB)
#define PG8_STAGE(bufoff, gbase, voff) do { _Pragma("unroll") for (int _i = 0; _i < 2; ++_i) \
        __builtin_amdgcn_global_load_lds((const unsigned*)((const char*)(gbase) + (voff)[_i]), (PG8_LAS unsigned*)(lds + (bufoff) + ldsw + _i * 8192), 16, 0, 0); } while (0)
#define PG8_LDA(dst, b, h) do { _Pragma("unroll") for (int m = 0; m < 4; ++m) _Pragma("unroll") for (int k = 0; k < 2; ++k) dst[m][k] = *(const PG8_LAS bf16x8*)(lds + PG8_SA(b, h) + aoff + m * 2048 + k * 1024); } while (0)
#define PG8_LDB(dst, b, h) do { _Pragma("unroll") for (int n = 0; n < 2; ++n) _Pragma("unroll") for (int k = 0; k < 2; ++k) dst[n][k] = *(const PG8_LAS bf16x8*)(lds + PG8_SB(b, h) + boff + n * 2048 + k * 1024); } while (0)
#define PG8_MMA(ai, bj, At, Bt) do { __builtin_amdgcn_s_setprio(1); _Pragma("unroll") for (int m = 0; m < 4; ++m) _Pragma("unroll") for (int n = 0; n < 2; ++n) _Pragma("unroll") for (int k = 0; k < 2; ++k) \
        acc[ai][bj][m][n] = __builtin_amdgcn_mfma_f32_16x16x32_bf16(Bt[n][k], At[m][k], acc[ai][bj][m][n], 0, 0, 0); __builtin_amdgcn_s_setprio(0); } while (0)
#define PG8_WAIT_V(n) asm volatile("s_waitcnt vmcnt(" #n ")" ::: "memory")
#define PG8_WAIT_L(n) asm volatile("s_waitcnt lgkmcnt(" #n ")" ::: "memory")
#define PG8_BAR __builtin_amdgcn_s_barrier()
#define PG8_SCHED __builtin_amdgcn_sched_barrier(0)
    Unit cur, nxt; int ui = 0;
    if (!S.next(0, cur)) return;
    f32x4 acc[2][2][4][2];
#pragma unroll
    for (int a = 0; a < 2; ++a)
#pragma unroll
        for (int b = 0; b < 2; ++b)
#pragma unroll
            for (int m = 0; m < 4; ++m)
#pragma unroll
                for (int n = 0; n < 2; ++n) acc[a][b][m][n] = (f32x4){0.f, 0.f, 0.f, 0.f};
    bf16x8 At[4][2], B0[2][2], B1[2][2];
    const char* cA = (const char*)g.A + (size_t)cur.pm * tstepA; const char* cB = (const char*)g.Bt + (size_t)cur.pn * tstep;
    S.a_ready(cur);
    if constexpr (SP2) {
        PG8_STAGE(PG8_SB(0, 0), cB, voffB); PG8_STAGE(PG8_SB(0, 1), cB + hstep, voffB); PG8_STAGE(PG8_SA(0, 0), cA, voffA); PG8_STAGE(PG8_SA(0, 1), cA + hstepA, voffA);
        if (wr == 1) PG8_BAR;
        PG8_WAIT_V(2); PG8_BAR;
        PG8_STAGE(PG8_SB(1, 0), cB + kstep, voffB); PG8_STAGE(PG8_SA(1, 0), cA + kstep, voffA); PG8_STAGE(PG8_SB(1, 1), cB + hstep + kstep, voffB);
        PG8_WAIT_V(6); PG8_BAR;
    } else {
        PG8_STAGE(PG8_SB(0, 0), cB, voffB); PG8_STAGE(PG8_SA(0, 0), cA, voffA); PG8_STAGE(PG8_SB(0, 1), cB + hstep, voffB); PG8_STAGE(PG8_SA(0, 1), cA + hstepA, voffA);
        if (wr == 1) PG8_BAR;
        PG8_WAIT_V(4); PG8_BAR;
        PG8_STAGE(PG8_SB(1, 0), cB + kstep, voffB); PG8_STAGE(PG8_SA(1, 0), cA + kstep, voffA); PG8_STAGE(PG8_SB(1, 1), cB + hstep + kstep, voffB);
        PG8_WAIT_V(6); PG8_BAR;
    }
    for (;;) {
        const bool has_next = S.next(ui + 1, nxt);
        const char* nA = has_next ? (const char*)g.A + (size_t)nxt.pm * tstepA : cA; const char* nB = has_next ? (const char*)g.Bt + (size_t)nxt.pn * tstep : cB;
        for (int t = 0; t < nt; t += 2) {
            const bool last = (t == nt - 2);
            const char* a1 = cA + (size_t)(t + 1) * kstep;
            const char* a2 = last ? nA : cA + (size_t)(t + 2) * kstep; const char* b2 = last ? nB : cB + (size_t)(t + 2) * kstep;
            const char* a3 = a2 + kstep; const char* b3 = b2 + kstep;
            if (last && has_next) S.a_ready(nxt);
            if constexpr (SP2) {
            PG8_LDB(B0, 0, 0); PG8_LDB(B1, 0, 1); PG8_SCHED; PG8_LDA(At, 0, 0); PG8_STAGE(PG8_SA(1, 1), a1 + hstepA, voffA);
            PG8_WAIT_V(8); PG8_WAIT_L(0); PG8_BAR; PG8_MMA(0, 0, At, B0); PG8_MMA(0, 1, At, B1); PG8_BAR; PG8_SCHED;
            PG8_LDA(At, 0, 1); PG8_STAGE(PG8_SB(0, 0), b2, voffB); PG8_STAGE(PG8_SB(0, 1), b2 + hstep, voffB); PG8_STAGE(PG8_SA(0, 0), a2, voffA);
            PG8_WAIT_V(8); PG8_WAIT_L(0); PG8_BAR; PG8_MMA(1, 0, At, B0); PG8_MMA(1, 1, At, B1); PG8_BAR; PG8_SCHED;
            PG8_LDB(B0, 1, 0); PG8_LDB(B1, 1, 1); PG8_SCHED; PG8_LDA(At, 1, 0); PG8_STAGE(PG8_SA(0, 1), a2 + hstepA, voffA);
            PG8_WAIT_V(8); PG8_WAIT_L(0); PG8_BAR; PG8_MMA(0, 0, At, B0); PG8_MMA(0, 1, At, B1); PG8_BAR; PG8_SCHED;
            PG8_LDA(At, 1, 1); PG8_STAGE(PG8_SB(1, 0), b3, voffB); PG8_STAGE(PG8_SB(1, 1), b3 + hstep, voffB); PG8_STAGE(PG8_SA(1, 0), a3, voffA);
            PG8_WAIT_V(8); PG8_WAIT_L(0); PG8_BAR; PG8_MMA(1, 0, At, B0); PG8_MMA(1, 1, At, B1); PG8_BAR; PG8_SCHED;
            } else {
            PG8_LDB(B0, 0, 0); PG8_SCHED; PG8_LDA(At, 0, 0); PG8_STAGE(PG8_SA(1, 1), a1 + hstepA, voffA);
            PG8_WAIT_L(8); PG8_BAR; PG8_WAIT_L(0); PG8_MMA(0, 0, At, B0); PG8_BAR; PG8_SCHED;
            PG8_LDB(B1, 0, 1); PG8_STAGE(PG8_SB(0, 0), b2, voffB);
            PG8_BAR; PG8_WAIT_L(0); PG8_MMA(0, 1, At, B1); PG8_BAR;
            PG8_LDA(At, 0, 1); PG8_STAGE(PG8_SA(0, 0), a2, voffA);
            PG8_BAR; PG8_WAIT_L(0); PG8_MMA(1, 0, At, B0); PG8_BAR; PG8_SCHED;
            PG8_STAGE(PG8_SB(0, 1), b2 + hstep, voffB);
            PG8_WAIT_V(6); PG8_BAR; PG8_MMA(1, 1, At, B1); PG8_BAR;
            PG8_LDB(B0, 1, 0); PG8_SCHED; PG8_LDA(At, 1, 0); PG8_STAGE(PG8_SA(0, 1), a2 + hstepA, voffA);
            PG8_WAIT_L(8); PG8_BAR; PG8_WAIT_L(0); PG8_MMA(0, 0, At, B0); PG8_BAR; PG8_SCHED;
            PG8_LDB(B1, 1, 1); PG8_STAGE(PG8_SB(1, 0), b3, voffB);
            PG8_BAR; PG8_WAIT_L(0); PG8_MMA(0, 1, At, B1); PG8_BAR;
            PG8_LDA(At, 1, 1); PG8_STAGE(PG8_SA(1, 0), a3, voffA);
            PG8_BAR; PG8_WAIT_L(0); PG8_MMA(1, 0, At, B0); PG8_BAR; PG8_SCHED;
            PG8_STAGE(PG8_SB(1, 1), b3 + hstep, voffB);
            PG8_WAIT_V(6); PG8_BAR; PG8_MMA(1, 1, At, B1); PG8_BAR;
            }
            if constexpr (Epi::FOLD) { if ((((t + 2) & 7) == 0) && !last) E.fold(acc, ((t + 2) >> 3) - 1, cur, wr, wc, fr, fq); }
        }
        if constexpr (ALIGN_EPI) { if (wr == 0) PG8_BAR; }
        if constexpr (!Epi::AFTER_DRAIN) { E(acc, cur, wr, wc, fr, fq); S.done(cur); }
        if (!has_next) break;
#pragma unroll
        for (int a = 0; a < 2; ++a)
#pragma unroll
            for (int b = 0; b < 2; ++b)
#pragma unroll
                for (int m = 0; m < 4; ++m)
#pragma unroll
                    for (int n = 0; n < 2; ++n) acc[a][b][m][n] = (f32x4){0.f, 0.f, 0.f, 0.f};
        cur = nxt; cA = nA; cB = nB; ++ui;
        if constexpr (ALIGN_EPI) { if (wr == 1) PG8_BAR; }
    }
    PG8_WAIT_V(0);
    if constexpr (!ALIGN_EPI) { if (wr == 0) PG8_BAR; }
    PG8_BAR;
    if constexpr (Epi::AFTER_DRAIN) { E.fused(acc, cur, wr, wc, fr, fq, lds, wid, lane); S.done(cur); }
#undef PG8_SA
#undef PG8_SB
#undef PG8_STAGE
#undef PG8_LDA
#undef PG8_LDB
#undef PG8_MMA
#undef PG8_WAIT_V
#undef PG8_WAIT_L
#undef PG8_BAR
#undef PG8_SCHED
}
}
namespace mk {
#define LAS __attribute__((address_space(3)))
#define GAS __attribute__((address_space(1)))
typedef unsigned short bf16;
typedef unsigned v4u __attribute__((ext_vector_type(4)));
typedef unsigned v2u __attribute__((ext_vector_type(2)));
typedef float f32x4 __attribute__((ext_vector_type(4)));
typedef float f32x16 __attribute__((ext_vector_type(16)));
typedef float f32x2v __attribute__((ext_vector_type(2)));
typedef short bf16x8 __attribute__((ext_vector_type(8)));
typedef short s16x4 __attribute__((ext_vector_type(4)));
constexpr int SEQ = 2048, DM = 1024, NIN = 11280;
constexpr int LDP = 7424;
constexpr int PC_SLAB = 0, PC_XBC = 1792, PC_DT = 2816, PC_QKVC = 3072, PC_QKVD = 3840, PC_ZA = 5376, PC_GB = 5888, PC_GC = 6400, PC_GD = 6912;
constexpr int PC_Y = PC_ZA;
constexpr size_t W1T_N = 7424, W2T_N = 4096;
constexpr size_t WOFF_W1 = 0, WOFF_W2 = WOFF_W1 + W1T_N * 1024, WOFF_WB = WOFF_W2 + W2T_N * 1024, WOFF_WO = WOFF_WB + 4ull * 1024 * 512, W_LAYER_ELEMS = WOFF_WO + 1024ull * 1024;
#define LDS_WAIT() asm volatile("s_waitcnt lgkmcnt(0)" ::: "memory")
#define VM_WAIT() asm volatile("s_waitcnt vmcnt(0)" ::: "memory")
__device__ __forceinline__ unsigned f2bf(float f) { unsigned u = __builtin_bit_cast(unsigned, f); return (u + 0x7fffu + ((u >> 16) & 1u)) >> 16; }
__device__ __forceinline__ unsigned pk2(float lo, float hi) { return f2bf(lo) | (f2bf(hi) << 16); }
__device__ __forceinline__ float bf2f(unsigned short b) { return __builtin_bit_cast(float, (unsigned)b << 16); }
__device__ __forceinline__ float bflo(unsigned w) { return __builtin_bit_cast(float, w << 16); }
__device__ __forceinline__ float bfhi(unsigned w) { return __builtin_bit_cast(float, w & 0xffff0000u); }
__device__ __forceinline__ float lane_xor(float v, int lane, int o) { return __builtin_bit_cast(float, __builtin_amdgcn_ds_bpermute((lane ^ o) << 2, __builtin_bit_cast(int, v))); }
#define MK_DPP(x, ctrl) __builtin_bit_cast(float, __builtin_amdgcn_update_dpp(0, __builtin_bit_cast(int, (x)), (ctrl), 0xf, 0xf, true))
__device__ __forceinline__ float sum_l4(float x) { x += MK_DPP(x, 0xB1); x += MK_DPP(x, 0x4E); return x; }
__device__ __forceinline__ float sum_l8(float x) { x = sum_l4(x); x += MK_DPP(x, 0x141); return x; }
__device__ __forceinline__ float sum_l16(float x) { x = sum_l8(x); x += MK_DPP(x, 0x140); return x; }
__device__ __forceinline__ float sum_l32(float x) { x = sum_l16(x); const auto rr = __builtin_amdgcn_permlane16_swap(__float_as_uint(x), __float_as_uint(x), false, false); return __uint_as_float(rr[0]) + __uint_as_float(rr[1]); }
__device__ __forceinline__ float sum_l64(float x) { x = sum_l32(x); const auto rr = __builtin_amdgcn_permlane32_swap(__float_as_uint(x), __float_as_uint(x), false, false); return __uint_as_float(rr[0]) + __uint_as_float(rr[1]); }
__device__ __forceinline__ float wave_sum(float v, int lane) { (void)lane; return sum_l64(v); }
__device__ __forceinline__ float fsilu(float x) { return x / (1.f + __expf(-x)); }
__device__ __forceinline__ float fsigmoid(float x) { return 1.f / (1.f + __expf(-x)); }

__device__ __forceinline__ void transpose_item(const float* W, int ldw, int ldt, int c0, int nvalid, int ntotal, bf16* WT, int r0, LAS float* scr, int item, int lane) {
    const int nblk = ntotal / 32, kb = item / nblk, nb = item % nblk, k0 = 64 * kb, n0 = 32 * nb;
    const bool ok = (n0 + (lane & 31)) < nvalid;
    float wv[32];
#pragma unroll
    for (int i = 0; i < 32; ++i) { const int kk = 2 * i + (lane >> 5); wv[i] = W[(size_t)(k0 + kk) * ldw + c0 + (ok ? n0 + (lane & 31) : 0)]; }
#pragma unroll
    for (int i = 0; i < 32; ++i) { const int kk = 2 * i + (lane >> 5); scr[kk * 33 + (lane & 31)] = ok ? wv[i] : 0.f; }
    LDS_WAIT(); asm volatile("" ::: "memory");
    const int c = lane & 7;
#pragma unroll
    for (int j = 0; j < 4; ++j) { const int n = (lane >> 3) + 8 * j; const LAS float* s = scr + (8 * c) * 33 + n;
        v4u o; o.x = pk2(s[0 * 33], s[1 * 33]); o.y = pk2(s[2 * 33], s[3 * 33]); o.z = pk2(s[4 * 33], s[5 * 33]); o.w = pk2(s[6 * 33], s[7 * 33]);
        *(GAS v4u*)(WT + (size_t)(r0 + n0 + n) * ldt + k0 + 8 * c) = o; }
    LDS_WAIT(); asm volatile("" ::: "memory");
}
struct WSeg { int src, soff, ldw, c0, nvalid, ntotal; unsigned doff; int ldt, r0, ni; };
constexpr int WCONV_NSEG = 15, WCONV_ITEMS = 16 * (7424 / 32) + 16 * (4096 / 32) + 4 * 8 * (1024 / 32) + 16 * (1024 / 32);
__device__ __forceinline__ void ph_wconv(const float* w_in, const float* w_branch, const float* w_out, bf16* Wall, LAS unsigned char* lds, int gw, int ngw, int wave, int lane) {
    LAS float* scr = (LAS float*)(lds + wave * 16384);
    const WSeg segs[WCONV_NSEG] = {
        {0, 0, NIN, 1552, 1792, 1792, (unsigned)WOFF_W1, 1024, 0, 16 * 56}, {0, 0, NIN, 512, 1024, 1024, (unsigned)WOFF_W1, 1024, 1792, 16 * 32}, {0, 0, NIN, 1536, 16, 256, (unsigned)WOFF_W1, 1024, PC_DT, 16 * 8},
        {0, 0, NIN, 3856, 768, 768, (unsigned)WOFF_W1, 1024, PC_QKVC, 16 * 24}, {0, 0, NIN, 5136, 1536, 1536, (unsigned)WOFF_W1, 1024, PC_QKVD, 16 * 48}, {0, 0, NIN, 0, 512, 512, (unsigned)WOFF_W1, 1024, PC_ZA, 16 * 16},
        {0, 0, NIN, 3344, 512, 512, (unsigned)WOFF_W1, 1024, PC_GB, 16 * 16}, {0, 0, NIN, 4624, 512, 512, (unsigned)WOFF_W1, 1024, PC_GC, 16 * 16}, {0, 0, NIN, 6672, 512, 512, (unsigned)WOFF_W1, 1024, PC_GD, 16 * 16},
        {0, 0, NIN, 7184, 4096, 4096, (unsigned)WOFF_W2, 1024, 0, 16 * 128},
        {1, 0 * 512 * 1024, 1024, 0, 1024, 1024, (unsigned)WOFF_WB + 0 * 512, 2048, 0, 8 * 32}, {1, 1 * 512 * 1024, 1024, 0, 1024, 1024, (unsigned)WOFF_WB + 1 * 512, 2048, 0, 8 * 32},
        {1, 2 * 512 * 1024, 1024, 0, 1024, 1024, (unsigned)WOFF_WB + 2 * 512, 2048, 0, 8 * 32}, {1, 3 * 512 * 1024, 1024, 0, 1024, 1024, (unsigned)WOFF_WB + 3 * 512, 2048, 0, 8 * 32},
        {2, 0, 1024, 0, 1024, 1024, (unsigned)WOFF_WO, 1024, 0, 16 * 32}};
#pragma unroll 1
    for (int it0 = gw; it0 < 2 * WCONV_ITEMS; it0 += ngw) { const int l2 = it0 >= WCONV_ITEMS ? 1 : 0; int it = it0 - l2 * WCONV_ITEMS, s = 0;
#pragma unroll 1
        while (it >= segs[s].ni) { it -= segs[s].ni; ++s; }
        const WSeg g = segs[s];
        const float* src = g.src == 0 ? w_in + (size_t)l2 * 1024 * NIN : (g.src == 1 ? w_branch + (size_t)l2 * 4 * 512 * 1024 + g.soff : w_out + (size_t)l2 * 1024 * 1024);
        transpose_item(src, g.ldw, g.ldt, g.c0, g.nvalid, g.ntotal, Wall + (size_t)l2 * W_LAYER_ELEMS + g.doff, g.r0, scr, it, lane); }
}
__device__ __forceinline__ void rms_row_to_bf16(const float* xrow, const float* w, bf16* orow, int lane) {
    const GAS f32x4* xr = (const GAS f32x4*)xrow + lane; const GAS f32x4* wr = (const GAS f32x4*)w + lane;
    f32x4 v[4]; float s = 0.f;
#pragma unroll
    for (int j = 0; j < 4; ++j) { v[j] = xr[64 * j]; s += (v[j].x * v[j].x + v[j].y * v[j].y) + (v[j].z * v[j].z + v[j].w * v[j].w); }
    const float rstd = 1.f / sqrtf(wave_sum(s, lane) * (1.f / 1024.f) + 1e-6f);
    GAS unsigned long long* o8 = (GAS unsigned long long*)orow + lane;
#pragma unroll
    for (int j = 0; j < 4; ++j) { const f32x4 ww = wr[64 * j]; o8[64 * j] = (unsigned long long)pk2(v[j].x * rstd * ww.x, v[j].y * rstd * ww.y) | ((unsigned long long)pk2(v[j].z * rstd * ww.z, v[j].w * rstd * ww.w) << 32); }
}
__device__ __forceinline__ void ph_rmsnorm(const float* x, const float* w, bf16* H, int nrows, int gw, int ngw, int lane) {
    f32x4 wv4[4];
#pragma unroll
    for (int j = 0; j < 4; ++j) wv4[j] = ((const GAS f32x4*)w + lane)[64 * j];
    for (int m = gw; m < nrows; m += 2 * ngw) { const int m2 = m + ngw; const bool two = m2 < nrows;
        const GAS f32x4* xa = (const GAS f32x4*)(x + (size_t)m * 1024) + lane; const GAS f32x4* xb = (const GAS f32x4*)(x + (size_t)(two ? m2 : m) * 1024) + lane;
        f32x4 va[4], vb[4]; float sa = 0.f, sb = 0.f;
#pragma unroll
        for (int j = 0; j < 4; ++j) { va[j] = xa[64 * j]; vb[j] = xb[64 * j]; }
#pragma unroll
        for (int j = 0; j < 4; ++j) { sa += (va[j].x * va[j].x + va[j].y * va[j].y) + (va[j].z * va[j].z + va[j].w * va[j].w); sb += (vb[j].x * vb[j].x + vb[j].y * vb[j].y) + (vb[j].z * vb[j].z + vb[j].w * vb[j].w); }
        const float ra = 1.f / sqrtf(sum_l64(sa) * (1.f / 1024.f) + 1e-6f), rb = 1.f / sqrtf(sum_l64(sb) * (1.f / 1024.f) + 1e-6f);
        GAS unsigned long long* oa = (GAS unsigned long long*)(H + (size_t)m * 1024) + lane; GAS unsigned long long* ob = (GAS unsigned long long*)(H + (size_t)(two ? m2 : m) * 1024) + lane;
#pragma unroll
        for (int j = 0; j < 4; ++j) { const f32x4 ww = wv4[j];
            oa[64 * j] = (unsigned long long)pk2(va[j].x * ra * ww.x, va[j].y * ra * ww.y) | ((unsigned long long)pk2(va[j].z * ra * ww.z, va[j].w * ra * ww.w) << 32);
            if (two) ob[64 * j] = (unsigned long long)pk2(vb[j].x * rb * ww.x, vb[j].y * rb * ww.y) | ((unsigned long long)pk2(vb[j].z * rb * ww.z, vb[j].w * rb * ww.w) << 32); } }
}
__device__ __forceinline__ void ph_gemm_rsigout(LAS unsigned char* lds, const bf16* A, int lda, const bf16* Bt, int M, int N, int K, bf16* O, int ldo, int tid, int bid) {
    pg8::Gemm g{A, Bt, M, N, K, lda}; pg8::StaticOrder S; S.init(M, N, (int)gridDim.x, bid);
    pg8::EpiBf16<2> E{O, ldo, nullptr, 0, 0, 1.f};
    pg8::gemm_phase<pg8::EpiBf16<2>, pg8::StaticOrder, true, true>(lds, g, S, E, tid);
}
struct RangeOrder : pg8::StaticOrder { int first, count;
    __device__ bool next(int i, pg8::Unit& u) const { return i < count && pg8::StaticOrder::next(i + first, u); } };
__device__ __forceinline__ void ph_gemm_bf16out_range(LAS unsigned char* lds, const bf16* A, int lda, const bf16* Bt, int M, int N, int K, bf16* O, int ldo, int first, int count, int tid, int bid) {
    pg8::Gemm g{A, Bt, M, N, K, lda}; RangeOrder S; S.init(M, N, (int)gridDim.x, bid); S.first = first; S.count = count;
    pg8::EpiBf16<0> E{O, ldo, nullptr, 0, 0, 1.f};
    pg8::gemm_phase<pg8::EpiBf16<0>, RangeOrder, true, true>(lds, g, S, E, tid);
}
__device__ __forceinline__ void ph_gemm_bf16out(LAS unsigned char* lds, const bf16* A, int lda, const bf16* Bt, int M, int N, int K, bf16* O, int ldo, int tid, int bid) {
    pg8::Gemm g{A, Bt, M, N, K, lda}; pg8::StaticOrder S; S.init(M, N, (int)gridDim.x, bid);
    pg8::EpiBf16<0> E{O, ldo, nullptr, 0, 0, 1.f};
    pg8::gemm_phase<pg8::EpiBf16<0>, pg8::StaticOrder, true, true>(lds, g, S, E, tid);
}
}
namespace mk {
constexpr float C2 = 0.125f * 1.4426950408889634f;
struct EpiF32 {
    static constexpr bool PERM = false, AFTER_DRAIN = false, FOLD = false;
    float* C; int ldc;
    __device__ __forceinline__ void operator()(const pg8::f32x4 (&acc)[2][2][4][2], const pg8::Unit& u, int wr, int wc, int fr, int fq) const {
        const int row0 = u.pm * 256 + wr * 64 + fr, col0 = u.pn * 256 + wc * 32 + 4 * fq;
#pragma unroll
        for (int ai = 0; ai < 2; ++ai)
#pragma unroll
            for (int m = 0; m < 4; ++m) { float* rowp = C + (size_t)(row0 + ai * 128 + m * 16) * ldc + col0;
#pragma unroll
                for (int bj = 0; bj < 2; ++bj)
#pragma unroll
                    for (int n = 0; n < 2; ++n) *(pg8::f32x4*)(rowp + bj * 128 + n * 16) = acc[ai][bj][m][n]; }
    }
};
template <int MODE> struct EpiMerge {
    static constexpr bool PERM = false, AFTER_DRAIN = false, FOLD = false;
    float* Mf; bf16* Mb; const bf16* G; int ldg;
    __device__ __forceinline__ void operator()(const pg8::f32x4 (&acc)[2][2][4][2], const pg8::Unit& u, int wr, int wc, int fr, int fq) const {
        const int row0 = u.pm * 256 + wr * 64 + fr, col0 = u.pn * 256 + wc * 32 + 4 * fq;
#pragma unroll
        for (int ai = 0; ai < 2; ++ai)
#pragma unroll
            for (int m = 0; m < 4; ++m) { const size_t r = (size_t)(row0 + ai * 128 + m * 16);
#pragma unroll
                for (int bj = 0; bj < 2; ++bj)
#pragma unroll
                    for (int n = 0; n < 2; ++n) { const int c = col0 + bj * 128 + n * 16;
                        const v2u gw = *(const v2u*)(G + r * ldg + c);
                        pg8::f32x4 v = acc[ai][bj][m][n];
                        v[0] *= fsigmoid(bflo(gw.x)); v[1] *= fsigmoid(bfhi(gw.x)); v[2] *= fsigmoid(bflo(gw.y)); v[3] *= fsigmoid(bfhi(gw.y));
                        if (MODE > 0) v += *(const pg8::f32x4*)(Mf + r * 1024 + c);
                        if (MODE < 2) *(pg8::f32x4*)(Mf + r * 1024 + c) = v;
                        else { v2u o; o.x = pk2(v[0], v[1]); o.y = pk2(v[2], v[3]); *(v2u*)(Mb + r * 1024 + c) = o; } } }
    }
};
__device__ __forceinline__ v4u gload16(const void* base, unsigned off) { v4u r; asm volatile("global_load_dwordx4 %0, %1, %2" : "=v"(r) : "v"(off), "s"(base) : "memory"); return r; }
__device__ __forceinline__ void gwait8(v4u& a, v4u& b, v4u& c, v4u& d, v4u& e, v4u& f, v4u& g, v4u& h) { asm volatile("s_waitcnt vmcnt(0)" : "+v"(a), "+v"(b), "+v"(c), "+v"(d), "+v"(e), "+v"(f), "+v"(g), "+v"(h) :: "memory"); }
struct EpiMergeF {
    static constexpr bool PERM = true, AFTER_DRAIN = false, FOLD = true;
    bf16* Mb; const bf16* S; int lds_;
    __device__ __forceinline__ void fold(pg8::f32x4 (&acc)[2][2][4][2], int seg, const pg8::Unit& u, int wr, int wc, int fr, int fq) const {
        unsigned off0 = (unsigned)((u.pm * 256 + wr * 64 + fr) * lds_ + u.pn * 256 + wc * 32 + 8 * fq + seg * 1024) * 2u; asm volatile("" : "+v"(off0));
#pragma unroll
        for (int ai = 0; ai < 2; ++ai)
#pragma unroll
            for (int mh = 0; mh < 2; ++mh) {
                v4u sa[2][2], sb[2][2];
#pragma unroll
                for (int mm = 0; mm < 2; ++mm)
#pragma unroll
                    for (int bj = 0; bj < 2; ++bj) { const unsigned ro = off0 + (unsigned)((ai * 128 + (2 * mh + mm) * 16) * lds_) * 2u + bj * 256; sa[mm][bj] = gload16(S, ro); sb[mm][bj] = gload16(S, ro + 2048); }
                gwait8(sa[0][0], sa[0][1], sa[1][0], sa[1][1], sb[0][0], sb[0][1], sb[1][0], sb[1][1]);
#pragma unroll
                for (int mm = 0; mm < 2; ++mm)
#pragma unroll
                    for (int bj = 0; bj < 2; ++bj) { const unsigned wa[4] = {sa[mm][bj].x, sa[mm][bj].y, sa[mm][bj].z, sa[mm][bj].w}, wb[4] = {sb[mm][bj].x, sb[mm][bj].y, sb[mm][bj].z, sb[mm][bj].w};
#pragma unroll
                        for (int e = 0; e < 4; ++e) { pg8::f32x4& v = acc[ai][bj][2 * mh + mm][e >> 1]; const int o = 2 * (e & 1);
                            v[o] *= bflo(wb[e]) * __builtin_amdgcn_rcpf(bflo(wa[e])); v[o + 1] *= bfhi(wb[e]) * __builtin_amdgcn_rcpf(bfhi(wa[e])); } } }
    }
    __device__ __forceinline__ void operator()(const pg8::f32x4 (&acc)[2][2][4][2], const pg8::Unit& u, int wr, int wc, int fr, int fq) const {
        const int row0 = u.pm * 256 + wr * 64 + fr, col0 = u.pn * 256 + wc * 32 + 8 * fq;
        const unsigned off0 = (unsigned)(row0 * lds_ + col0 + 3 * 1024) * 2u;
#pragma unroll
        for (int ai = 0; ai < 2; ++ai) { v4u sa[4][2];
#pragma unroll
            for (int m = 0; m < 4; ++m)
#pragma unroll
                for (int bj = 0; bj < 2; ++bj) sa[m][bj] = gload16(S, off0 + (unsigned)((ai * 128 + m * 16) * lds_) * 2u + bj * 256);
            gwait8(sa[0][0], sa[0][1], sa[1][0], sa[1][1], sa[2][0], sa[2][1], sa[3][0], sa[3][1]);
#pragma unroll
            for (int m = 0; m < 4; ++m) { const size_t r = (size_t)(row0 + ai * 128 + m * 16);
#pragma unroll
                for (int bj = 0; bj < 2; ++bj) { const int c = col0 + bj * 128; const v4u s4 = sa[m][bj]; const pg8::f32x4 v0 = acc[ai][bj][m][0], v1 = acc[ai][bj][m][1];
                    v4u o; o.x = pk2(v0[0] * __builtin_amdgcn_rcpf(bflo(s4.x)), v0[1] * __builtin_amdgcn_rcpf(bfhi(s4.x))); o.y = pk2(v0[2] * __builtin_amdgcn_rcpf(bflo(s4.y)), v0[3] * __builtin_amdgcn_rcpf(bfhi(s4.y)));
                    o.z = pk2(v1[0] * __builtin_amdgcn_rcpf(bflo(s4.z)), v1[1] * __builtin_amdgcn_rcpf(bfhi(s4.z))); o.w = pk2(v1[2] * __builtin_amdgcn_rcpf(bflo(s4.w)), v1[3] * __builtin_amdgcn_rcpf(bfhi(s4.w)));
                    *(GAS v4u*)(Mb + r * 1024 + c) = o; } } }
    }
};
template <class Epi> __device__ __forceinline__ void run_gemm(LAS unsigned char* lds, const bf16* A, int lda, const bf16* Bt, int M, int N, int K, const Epi& E, int tid, int bid) {
    pg8::Gemm g{A, Bt, M, N, K, lda}; pg8::StaticOrder S; S.init(M, N, (int)gridDim.x, bid);
    pg8::gemm_phase<Epi, pg8::StaticOrder, true, true>(lds, g, S, E, tid);
}
__device__ __forceinline__ void ph_rope_table(float* rope, int gtid, int nthr) {
    for (int i = gtid; i < SEQ * 32; i += nthr) { const int l = i >> 5, j = i & 31; const float inv = __builtin_amdgcn_exp2f(-(float)(j & 15) * 0.83048202372184f);
        const float ang = (float)(j < 16 ? (l >> 6) : (l & 63)) * inv; rope[i] = __cosf(ang); rope[SEQ * 32 + i] = __sinf(ang); }
}
__device__ __forceinline__ void ph_prep_conv(const bf16* P, int T, const float* cw, const float* cb, const float* dtb, bf16* XC, float* DT, int gtid, int nthr) {
    { const int c = (gtid & 127) * 8;
        float wj[5][8], bb[8];
#pragma unroll
        for (int j = 0; j < 5; ++j) { const f32x4 w0 = *(const GAS f32x4*)(cw + j * 1024 + c), w1 = *(const GAS f32x4*)(cw + j * 1024 + c + 4); wj[j][0] = w0.x; wj[j][1] = w0.y; wj[j][2] = w0.z; wj[j][3] = w0.w; wj[j][4] = w1.x; wj[j][5] = w1.y; wj[j][6] = w1.z; wj[j][7] = w1.w; }
        { const f32x4 b0 = *(const GAS f32x4*)(cb + c), b1 = *(const GAS f32x4*)(cb + c + 4); bb[0] = b0.x; bb[1] = b0.y; bb[2] = b0.z; bb[3] = b0.w; bb[4] = b1.x; bb[5] = b1.y; bb[6] = b1.z; bb[7] = b1.w; }
    for (int it = gtid; it < (T >> 3) * 128; it += nthr) { const int t0 = (it >> 7) * 8, l0 = t0 & (SEQ - 1);
        v4u row[12];
#pragma unroll
        for (int r = 0; r < 12; ++r) { const int ll = l0 + r - 2; const bool ok = (ll >= 0) && (ll < SEQ); const v4u z4 = {0u, 0u, 0u, 0u};
            row[r] = ok ? *(const GAS v4u*)(P + (size_t)(t0 + r - 2) * LDP + PC_XBC + c) : z4; }
#pragma unroll
        for (int q = 0; q < 8; ++q) { float a[8];
#pragma unroll
            for (int e = 0; e < 8; ++e) a[e] = bb[e];
#pragma unroll
            for (int j = 0; j < 5; ++j) { const v4u w = row[q + j];
                a[0] += wj[j][0] * bflo(w.x); a[1] += wj[j][1] * bfhi(w.x); a[2] += wj[j][2] * bflo(w.y); a[3] += wj[j][3] * bfhi(w.y); a[4] += wj[j][4] * bflo(w.z); a[5] += wj[j][5] * bfhi(w.z); a[6] += wj[j][6] * bflo(w.w); a[7] += wj[j][7] * bfhi(w.w); }
            v4u o; o.x = pk2(fsilu(a[0]), fsilu(a[1])); o.y = pk2(fsilu(a[2]), fsilu(a[3])); o.z = pk2(fsilu(a[4]), fsilu(a[5])); o.w = pk2(fsilu(a[6]), fsilu(a[7]));
            *(GAS v4u*)(XC + (size_t)(t0 + q) * 1024 + c) = o; } } }
    for (int it = gtid; it < T * 16; it += nthr) { const int t = it >> 4, j = it & 15; const float x = bf2f(P[(size_t)t * LDP + PC_DT + j]) + dtb[j]; DT[it] = x > 20.f ? x : __logf(1.f + __expf(x)); }
}
__device__ __forceinline__ void ph_prep_gqa(const bf16* P, int T, const float* qw, const float* kw, const float* rope, bf16* Qn, bf16* Kn, int gtid, int nthr) {
    { const int j8 = gtid & 7, g8 = gtid >> 3, ng8 = nthr >> 3;
      const f32x4 qw1 = *(const GAS f32x4*)(qw + 4 * j8), qw2 = *(const GAS f32x4*)(qw + 32 + 4 * j8), kw1 = *(const GAS f32x4*)(kw + 4 * j8), kw2 = *(const GAS f32x4*)(kw + 32 + 4 * j8);
      constexpr int GR = 2;
      for (int it0 = g8; it0 < T * 10; it0 += GR * ng8) {
        int tq[GR], hq[GR]; bool okq[GR]; v2u r1[GR], r2[GR]; f32x4 cs[GR], sn[GR];
#pragma unroll
        for (int q = 0; q < GR; ++q) { const int it = it0 + q * ng8; okq[q] = it < T * 10; const int itc = okq[q] ? it : it0; tq[q] = itc / 10; hq[q] = itc - tq[q] * 10; const int l = tq[q] & (SEQ - 1);
            const bf16* src = P + (size_t)tq[q] * LDP + PC_QKVC + hq[q] * 64 + 4 * j8; r1[q] = *(const GAS v2u*)src; r2[q] = *(const GAS v2u*)(src + 32);
            cs[q] = *(const GAS f32x4*)(rope + l * 32 + 4 * j8); sn[q] = *(const GAS f32x4*)(rope + SEQ * 32 + l * 32 + 4 * j8); }
#pragma unroll
        for (int q = 0; q < GR; ++q) { const int t = tq[q], hh = hq[q]; const f32x4 w1 = hh < 8 ? qw1 : kw1, w2 = hh < 8 ? qw2 : kw2;
            const float x1[4] = {bflo(r1[q].x), bfhi(r1[q].x), bflo(r1[q].y), bfhi(r1[q].y)}, x2[4] = {bflo(r2[q].x), bfhi(r2[q].x), bflo(r2[q].y), bfhi(r2[q].y)};
            float ss = 0.f;
#pragma unroll
            for (int e = 0; e < 4; ++e) ss += x1[e] * x1[e] + x2[e] * x2[e];
            const float rs = 1.f / sqrtf(sum_l8(ss) * (1.f / 64.f) + 1e-6f), sc = hh < 8 ? C2 : 1.f; float o1[4], o2[4];
#pragma unroll
            for (int e = 0; e < 4; ++e) { const float y1 = x1[e] * rs * w1[e], y2 = x2[e] * rs * w2[e]; o1[e] = (y1 * cs[q][e] - y2 * sn[q][e]) * sc; o2[e] = (y2 * cs[q][e] + y1 * sn[q][e]) * sc; }
            bf16* dst = (hh < 8 ? Qn + (size_t)t * 512 + hh * 64 : Kn + (size_t)t * 128 + (hh - 8) * 64) + 4 * j8;
            v2u a1, a2; a1.x = pk2(o1[0], o1[1]); a1.y = pk2(o1[2], o1[3]); a2.x = pk2(o2[0], o2[1]); a2.y = pk2(o2[2], o2[3]);
            if (okq[q]) { *(GAS v2u*)dst = a1; *(GAS v2u*)(dst + 32) = a2; } } } }
}
__device__ __forceinline__ void ph_post(bf16* P, int T, const bf16* XC, const bf16* YA  , const float* d_skip, const float* norm_w,
                                        const bf16* YB  , const float* CB  , const bf16* VB  , const float* lnx_w, const float* lnx_b, int gw, int ngw, int lane) {
    const int c = lane * 8, h = lane >> 3;
    const float D = d_skip[c >> 6]; const f32x4 n0 = *(const GAS f32x4*)(norm_w + c), n1 = *(const GAS f32x4*)(norm_w + c + 4);
    const f32x4 lw0 = *(const GAS f32x4*)(lnx_w + c), lw1 = *(const GAS f32x4*)(lnx_w + c + 4), lb0 = *(const GAS f32x4*)(lnx_b + c), lb1 = *(const GAS f32x4*)(lnx_b + c + 4);
    for (int t = gw; t < T; t += ngw) {
        const v4u y0 = *(const GAS v4u*)(YA + (size_t)t * 512 + c), y1 = *(const GAS v4u*)(YA + ((size_t)T + t) * 512 + c), xs = *(const GAS v4u*)(XC + (size_t)t * 1024 + c), zz = *(const GAS v4u*)(P + (size_t)t * LDP + PC_ZA + c);
        const v4u a0 = *(const GAS v4u*)(YB + (size_t)t * 512 + c), a1 = *(const GAS v4u*)(YB + ((size_t)T + t) * 512 + c), vv = *(const GAS v4u*)(VB + (size_t)t * 512 + c), gg = *(const GAS v4u*)(P + (size_t)t * LDP + PC_GB + c);
        const float coef = CB[(size_t)h * T + t] + CB[(size_t)(8 + h) * T + t];
        {
            const unsigned yw0[4] = {y0.x, y0.y, y0.z, y0.w}, yw1[4] = {y1.x, y1.y, y1.z, y1.w}, xw[4] = {xs.x, xs.y, xs.z, xs.w}, zw[4] = {zz.x, zz.y, zz.z, zz.w}; float y[8], ss = 0.f;
#pragma unroll
            for (int e = 0; e < 4; ++e) { y[2 * e] = (bflo(yw0[e]) + bflo(yw1[e]) + bflo(xw[e]) * D) * fsilu(bflo(zw[e])); y[2 * e + 1] = (bfhi(yw0[e]) + bfhi(yw1[e]) + bfhi(xw[e]) * D) * fsilu(bfhi(zw[e])); ss += y[2 * e] * y[2 * e] + y[2 * e + 1] * y[2 * e + 1]; }
            const float r = 1.f / sqrtf(sum_l32(ss) * (1.f / 256.f) + 1e-6f);
            v4u o; o.x = pk2(y[0] * r * n0.x, y[1] * r * n0.y); o.y = pk2(y[2] * r * n0.z, y[3] * r * n0.w); o.z = pk2(y[4] * r * n1.x, y[5] * r * n1.y); o.w = pk2(y[6] * r * n1.z, y[7] * r * n1.w);
            *(GAS v4u*)(P + (size_t)t * LDP + PC_ZA + c) = o; }
        {
            float y[8] = {bflo(a0.x) + bflo(a1.x), bfhi(a0.x) + bfhi(a1.x), bflo(a0.y) + bflo(a1.y), bfhi(a0.y) + bfhi(a1.y), bflo(a0.z) + bflo(a1.z), bfhi(a0.z) + bfhi(a1.z), bflo(a0.w) + bflo(a1.w), bfhi(a0.w) + bfhi(a1.w)};
            const float v[8] = {bflo(vv.x), bfhi(vv.x), bflo(vv.y), bfhi(vv.y), bflo(vv.z), bfhi(vv.z), bflo(vv.w), bfhi(vv.w)};
            const float g[8] = {bflo(gg.x), bfhi(gg.x), bflo(gg.y), bfhi(gg.y), bflo(gg.z), bfhi(gg.z), bflo(gg.w), bfhi(gg.w)};
            float s = 0.f;
#pragma unroll
            for (int e = 0; e < 8; ++e) s += y[e];
            const float mu = sum_l8(s) * (1.f / 64.f); float q = 0.f;
#pragma unroll
            for (int e = 0; e < 8; ++e) { y[e] -= mu; q += y[e] * y[e]; }
            const float rs = 1.f / sqrtf(sum_l8(q) * (1.f / 64.f) + 64e-5f);
            const float lw[8] = {lw0.x, lw0.y, lw0.z, lw0.w, lw1.x, lw1.y, lw1.z, lw1.w}, lb[8] = {lb0.x, lb0.y, lb0.z, lb0.w, lb1.x, lb1.y, lb1.z, lb1.w}; float o[8];
#pragma unroll
            for (int e = 0; e < 8; ++e) o[e] = (y[e] * rs * lw[e] + lb[e] + coef * v[e]) * fsilu(g[e]);
            v4u ov; ov.x = pk2(o[0], o[1]); ov.y = pk2(o[2], o[3]); ov.z = pk2(o[4], o[5]); ov.w = pk2(o[6], o[7]);
            *(GAS v4u*)(P + (size_t)t * LDP + PC_GB + c) = ov; }
    }
}
__device__ __forceinline__ void ph_fin(const float* xin, const float* outf, const float* w, float* xout, const float* wn, bf16* Hn, int nrows, int gw, int ngw, int lane) {
    f32x4 wpost[4], wpre[4];
#pragma unroll
    for (int j = 0; j < 4; ++j) { wpost[j] = ((const GAS f32x4*)w + lane)[64 * j]; wpre[j] = wn ? ((const GAS f32x4*)wn + lane)[64 * j] : (f32x4){0.f, 0.f, 0.f, 0.f}; }
    for (int m = gw; m < nrows; m += 2 * ngw) { const int m2 = (m + ngw < nrows) ? m + ngw : m; const bool two = m2 != m;
        const GAS f32x4* oa = (const GAS f32x4*)(outf + (size_t)m * 1024) + lane; const GAS f32x4* ob = (const GAS f32x4*)(outf + (size_t)m2 * 1024) + lane;
        const GAS f32x4* xa = (const GAS f32x4*)(xin + (size_t)m * 1024) + lane; const GAS f32x4* xb = (const GAS f32x4*)(xin + (size_t)m2 * 1024) + lane;
        f32x4 va[4], vb[4], ya[4], yb[4]; float sa = 0.f, sb = 0.f;
#pragma unroll
        for (int j = 0; j < 4; ++j) { va[j] = oa[64 * j]; vb[j] = ob[64 * j]; ya[j] = xa[64 * j]; yb[j] = xb[64 * j]; }
#pragma unroll
        for (int j = 0; j < 4; ++j) { sa += (va[j].x * va[j].x + va[j].y * va[j].y) + (va[j].z * va[j].z + va[j].w * va[j].w); sb += (vb[j].x * vb[j].x + vb[j].y * vb[j].y) + (vb[j].z * vb[j].z + vb[j].w * vb[j].w); }
        const float ra = 1.f / sqrtf(sum_l64(sa) * (1.f / 1024.f) + 1e-6f), rb = 1.f / sqrtf(sum_l64(sb) * (1.f / 1024.f) + 1e-6f);
        GAS f32x4* pa = (GAS f32x4*)(xout + (size_t)m * 1024) + lane; GAS f32x4* pb = (GAS f32x4*)(xout + (size_t)m2 * 1024) + lane;
        float qa = 0.f, qb = 0.f;
#pragma unroll
        for (int j = 0; j < 4; ++j) { const f32x4 ww = wpost[j]; ya[j] = ya[j] + va[j] * ra * ww; yb[j] = yb[j] + vb[j] * rb * ww; pa[64 * j] = ya[j]; if (two) pb[64 * j] = yb[j];
            qa += (ya[j].x * ya[j].x + ya[j].y * ya[j].y) + (ya[j].z * ya[j].z + ya[j].w * ya[j].w); qb += (yb[j].x * yb[j].x + yb[j].y * yb[j].y) + (yb[j].z * yb[j].z + yb[j].w * yb[j].w); }
        if (wn) { const float na = 1.f / sqrtf(sum_l64(qa) * (1.f / 1024.f) + 1e-6f), nb = 1.f / sqrtf(sum_l64(qb) * (1.f / 1024.f) + 1e-6f);
            GAS unsigned long long* ha = (GAS unsigned long long*)(Hn + (size_t)m * 1024) + lane; GAS unsigned long long* hb = (GAS unsigned long long*)(Hn + (size_t)m2 * 1024) + lane;
#pragma unroll
            for (int j = 0; j < 4; ++j) { const f32x4 ww = wpre[j];
                ha[64 * j] = (unsigned long long)pk2(ya[j].x * na * ww.x, ya[j].y * na * ww.y) | ((unsigned long long)pk2(ya[j].z * na * ww.z, ya[j].w * na * ww.w) << 32);
                if (two) hb[64 * j] = (unsigned long long)pk2(yb[j].x * nb * ww.x, yb[j].y * nb * ww.y) | ((unsigned long long)pk2(yb[j].z * nb * ww.z, yb[j].w * nb * ww.w) << 32); } } }
}
}
namespace mk {
__device__ __forceinline__ void unpack8(const v4u w, float* f) { f[0] = bflo(w.x); f[1] = bfhi(w.x); f[2] = bflo(w.y); f[3] = bfhi(w.y); f[4] = bflo(w.z); f[5] = bfhi(w.z); f[6] = bflo(w.w); f[7] = bfhi(w.w); }
__device__ __forceinline__ void ph_ssd_simple(const bf16* XC, const float* DT, const float* a_log, bf16* YA, int nb, int T, int tid, int bid) {
    if (tid >= 64) return;
    const int i = bid * 64 + tid; if (i >= 2 * nb * 512) return;
    const int p = i % 64, h = (i / 64) % 8, b = (i / 512) % nb, z = i / (512 * nb);
    float s[128];
#pragma unroll
    for (int n = 0; n < 128; ++n) s[n] = 0.f;
    const float an = -expf(a_log[z * 8 + h]); const int g = h >> 2;
    for (int st = 0; st < SEQ; ++st) { const int l = z ? (SEQ - 1 - st) : st; const size_t t = (size_t)b * SEQ + l;
        const float d = DT[t * 16 + z * 8 + h]; const float dec = expf(d * an); const float xd = bf2f(XC[t * 1024 + h * 64 + p]) * d;
        const GAS v4u* Bv = (const GAS v4u*)(XC + t * 1024 + 512 + g * 128); const GAS v4u* Cv = (const GAS v4u*)(XC + t * 1024 + 768 + g * 128);
        float y = 0.f;
#pragma unroll
        for (int n8 = 0; n8 < 16; ++n8) { float bb[8], cc[8]; unpack8(Bv[n8], bb); unpack8(Cv[n8], cc);
#pragma unroll
            for (int e = 0; e < 8; ++e) { s[n8 * 8 + e] = s[n8 * 8 + e] * dec + xd * bb[e]; y += cc[e] * s[n8 * 8 + e]; } }
        YA[((size_t)z * T + t) * 512 + h * 64 + p] = (bf16)f2bf(y); }
}
__device__ __forceinline__ float shiftP(const bf16* P, int t, int ch, const float* mu) {
    const int l = t & (SEQ - 1); const float cur = bf2f(P[(size_t)t * LDP + PC_SLAB + ch]);
    const float prev = l > 0 ? bf2f(P[(size_t)(t - 1) * LDP + PC_SLAB + ch]) : 0.f; const float nxt = l < SEQ - 1 ? bf2f(P[(size_t)(t + 1) * LDP + PC_SLAB + ch]) : 0.f;
    return cur + mu[ch] * (prev - cur) + mu[1792 + ch] * (nxt - cur);
}
struct RwkvS { float *R, *V, *KK, *DEC, *BB, *KD; };
__device__ __forceinline__ void ph_rwkv_prep_simple(const bf16* P, int T, int t0, int Ts, const float* mu, const float* w0, const float* w_up, const float* a0, const float* a_up, const float* k_k, const float* k_a, const float* r_k,
                                                    RwkvS A, bf16* VB, float* CB, int gtid, int nthr) {
    for (int it = gtid; it < Ts * 512; it += nthr) { const int tl = it >> 9, c = it & 511, t = t0 + tl;
        const float r = shiftP(P, t, c, mu), k = shiftP(P, t, 512 + c, mu), v = shiftP(P, t, 1024 + c, mu);
        A.R[it] = r; A.V[it] = v; VB[(size_t)t * 512 + c] = (bf16)f2bf(v);
        const float kx = k * k_k[c]; const float ss = wave_sum(kx * kx, gtid & 63);
        const float kk = kx / sqrtf(fmaxf(ss, 1e-24f)); A.KK[it] = kk;
#pragma unroll 1
        for (int z = 0; z < 2; ++z) { float wr = w0[z * 512 + c], ar = a0[z * 512 + c];
            for (int q = 0; q < 64; ++q) { wr += tanhf(shiftP(P, t, 1536 + z * 64 + q, mu)) * w_up[((size_t)z * 64 + q) * 512 + c]; ar += shiftP(P, t, 1664 + z * 64 + q, mu) * a_up[((size_t)z * 64 + q) * 512 + c]; }
            const float sp = (-wr) > 20.f ? (-wr) : log1pf(expf(-wr)); const float dec = expf(-expf(-sp - 0.5f)); const float a = 1.f / (1.f + expf(-ar));
            const float kd = k * (1.f + (a - 1.f) * k_a[c]);
            A.DEC[(size_t)z * Ts * 512 + it] = dec; A.BB[(size_t)z * Ts * 512 + it] = kk * a; A.KD[(size_t)z * Ts * 512 + it] = kd;
            const float cb = wave_sum(r * kd * r_k[c], gtid & 63); if ((c & 63) == 0) CB[((size_t)(z * 8 + (c >> 6))) * T + t] = cb; } }
}
__device__ __forceinline__ void ph_rwkv_scan_simple(int T, int t0, int nbs, RwkvS A, bf16* YB, int tid, int bid) {
    if (tid >= 64) return;
    const int i = bid * 64 + tid; if (i >= 2 * nbs * 512) return;
    const int v = i % 64, h = (i / 64) % 8, b = (i / 512) % nbs, z = i / (512 * nbs); const int Ts = nbs * SEQ;
    float S[64];
#pragma unroll
    for (int k = 0; k < 64; ++k) S[k] = 0.f;
    for (int st = 0; st < SEQ; ++st) { const int l = z ? (SEQ - 1 - st) : st; const size_t tl = (size_t)b * SEQ + l; const size_t o = tl * 512 + h * 64, oz = ((size_t)z * Ts + tl) * 512 + h * 64;
        float sa = 0.f;
#pragma unroll
        for (int k = 0; k < 64; ++k) sa += S[k] * A.KK[o + k];
        const float vv = A.V[o + v]; float y = 0.f;
#pragma unroll
        for (int k = 0; k < 64; ++k) { S[k] = S[k] * A.DEC[oz + k] - sa * A.BB[oz + k] + vv * A.KD[oz + k]; y += S[k] * A.R[o + k]; }
        YB[((size_t)z * T + t0 + tl) * 512 + h * 64 + v] = (bf16)f2bf(y); }
}
__device__ __forceinline__ void ph_gqa_simple(bf16* P, const bf16* Qn, const bf16* Kn, int nb, int gtid, int nthr) {
    for (int it = gtid; it < nb * 8 * SEQ; it += nthr) { const int ql = it % SEQ, h = (it / SEQ) % 8, b = it / (8 * SEQ), g = h >> 2; const size_t t = (size_t)b * SEQ + ql;
        float q[64], o[64];
#pragma unroll
        for (int d8 = 0; d8 < 8; ++d8) { unpack8(*(const GAS v4u*)(Qn + t * 512 + h * 64 + d8 * 8), q + d8 * 8); }
#pragma unroll
        for (int d = 0; d < 64; ++d) o[d] = 0.f;
        float m = -1e30f, lsum = 0.f;
        for (int k = 0; k < SEQ; ++k) { const size_t tk = (size_t)b * SEQ + k; float s = 0.f;
#pragma unroll
            for (int d8 = 0; d8 < 8; ++d8) { float kf[8]; unpack8(*(const GAS v4u*)(Kn + tk * 128 + g * 64 + d8 * 8), kf);
#pragma unroll
                for (int e = 0; e < 8; ++e) s += q[d8 * 8 + e] * kf[e]; }
            const float mn = fmaxf(m, s); const float al = exp2f(m - mn), p = exp2f(s - mn); m = mn; lsum = lsum * al + p;
#pragma unroll
            for (int d8 = 0; d8 < 8; ++d8) { float vf[8]; unpack8(*(const GAS v4u*)(P + tk * LDP + PC_QKVC + 640 + g * 64 + d8 * 8), vf);
#pragma unroll
                for (int e = 0; e < 8; ++e) o[d8 * 8 + e] = o[d8 * 8 + e] * al + p * vf[e]; } }
        const float il = 1.f / lsum;
#pragma unroll
        for (int d8 = 0; d8 < 8; ++d8) { GAS v4u* dst = (GAS v4u*)(P + t * LDP + PC_GC + h * 64 + d8 * 8); float gf[8]; unpack8(*dst, gf); v4u ov;
            ov.x = pk2(o[d8 * 8 + 0] * il * fsilu(gf[0]), o[d8 * 8 + 1] * il * fsilu(gf[1])); ov.y = pk2(o[d8 * 8 + 2] * il * fsilu(gf[2]), o[d8 * 8 + 3] * il * fsilu(gf[3]));
            ov.z = pk2(o[d8 * 8 + 4] * il * fsilu(gf[4]), o[d8 * 8 + 5] * il * fsilu(gf[5])); ov.w = pk2(o[d8 * 8 + 6] * il * fsilu(gf[6]), o[d8 * 8 + 7] * il * fsilu(gf[7])); *dst = ov; } }
}
__device__ __forceinline__ void ph_na_simple(bf16* P, const float* rpb, int nb, int gtid, int nthr) {
    for (int it = gtid; it < nb * 8 * SEQ; it += nthr) { const int ql = it % SEQ, h = (it / SEQ) % 8, b = it / (8 * SEQ); const size_t t = (size_t)b * SEQ + ql; const int qr = ql >> 6, qc = ql & 63;
        int rs = qr - 4; rs = rs < 0 ? 0 : (rs > 24 ? 24 : rs); int cs = qc - 8; cs = cs < 0 ? 0 : (cs > 48 ? 48 : cs);
        float q[64], o[64];
#pragma unroll
        for (int d8 = 0; d8 < 8; ++d8) { unpack8(*(const GAS v4u*)(P + t * LDP + PC_QKVD + h * 64 + d8 * 8), q + d8 * 8); }
#pragma unroll
        for (int d = 0; d < 64; ++d) { q[d] *= 0.125f; o[d] = 0.f; }
        float m = -1e30f, lsum = 0.f;
        for (int i = 0; i < 128; ++i) { const int kr = rs + (i >> 4), kc = cs + (i & 15); const size_t tk = (size_t)b * SEQ + kr * 64 + kc; float s = 0.f;
#pragma unroll
            for (int d8 = 0; d8 < 8; ++d8) { float kf[8]; unpack8(*(const GAS v4u*)(P + tk * LDP + PC_QKVD + 512 + h * 64 + d8 * 8), kf);
#pragma unroll
                for (int e = 0; e < 8; ++e) s += q[d8 * 8 + e] * kf[e]; }
            s += rpb[h * 465 + (kr - qr + 7) * 31 + (kc - qc + 15)];
            const float mn = fmaxf(m, s); const float al = __expf(m - mn), p = __expf(s - mn); m = mn; lsum = lsum * al + p;
#pragma unroll
            for (int d8 = 0; d8 < 8; ++d8) { float vf[8]; unpack8(*(const GAS v4u*)(P + tk * LDP + PC_QKVD + 1024 + h * 64 + d8 * 8), vf);
#pragma unroll
                for (int e = 0; e < 8; ++e) o[d8 * 8 + e] = o[d8 * 8 + e] * al + p * vf[e]; } }
        const float il = 1.f / lsum;
#pragma unroll
        for (int d8 = 0; d8 < 8; ++d8) { GAS v4u* dst = (GAS v4u*)(P + t * LDP + PC_GD + h * 64 + d8 * 8); float gf[8]; unpack8(*dst, gf); v4u ov;
            ov.x = pk2(o[d8 * 8 + 0] * il * fsilu(gf[0]), o[d8 * 8 + 1] * il * fsilu(gf[1])); ov.y = pk2(o[d8 * 8 + 2] * il * fsilu(gf[2]), o[d8 * 8 + 3] * il * fsilu(gf[3]));
            ov.z = pk2(o[d8 * 8 + 4] * il * fsilu(gf[4]), o[d8 * 8 + 5] * il * fsilu(gf[5])); ov.w = pk2(o[d8 * 8 + 6] * il * fsilu(gf[6]), o[d8 * 8 + 7] * il * fsilu(gf[7])); *dst = ov; } }
}
}
#include <hip/hip_bf16.h>
namespace attn_body {
using bf16=__hip_bfloat16;
using bf16x8=__attribute__((ext_vector_type(8)))short;
using s16x4=__attribute__((ext_vector_type(4)))short;
using f32x16=__attribute__((ext_vector_type(16)))float;
using u32x4=__attribute__((ext_vector_type(4)))unsigned;
constexpr int SEQ=2048,D=64;
constexpr int NW=8,QBLK=32,QB=QBLK*NW,KVBLK=64,NQB=SEQ/QB;
__device__ __forceinline__ int crow(int r,int hi){return (r&3)+8*(r>>2)+4*hi;}
#define SBAR() __builtin_amdgcn_sched_barrier(0)
constexpr int NSLOT=3, SLOTB=8192;
constexpr int LDS_K=0, LDS_V=NSLOT*SLOTB, LDS_WS=2*NSLOT*SLOTB, LDS_OST=LDS_WS+NW*64*4, LDS_RPB=LDS_OST+NW*4096,LDS_BYTES=LDS_RPB+2048;
constexpr float C2=0.125f*1.4426950408889634f;
__device__ __forceinline__ void glds16(const void*gsrc,unsigned lds_dst){unsigned keep;
  asm volatile("s_mov_b32 %0, m0\n\ts_mov_b32 m0, %2\n\ts_nop 0\n\tglobal_load_lds_dwordx4 %1, off\n\ts_mov_b32 m0, %0":"=&s"(keep):"v"(gsrc),"s"(lds_dst):"memory");}
__device__ __forceinline__ float max3f(float a,float b,float c){float r;asm("v_max3_f32 %0, %1, %2, %3":"=v"(r):"v"(a),"v"(b),"v"(c));return r;}
__device__ __forceinline__ float max2f(float a,float b){float r;asm("v_max_f32_e32 %0, %1, %2":"=v"(r):"v"(a),"v"(b));return r;}
__device__ __forceinline__ float fadd_s(float a,float b){float r;asm("v_add_f32_e32 %0, %1, %2":"=v"(r):"v"(a),"v"(b));return r;}
__device__ __forceinline__ float fsub_s(float a,float b){float r;asm("v_sub_f32_e32 %0, %1, %2":"=v"(r):"v"(a),"v"(b));return r;}
typedef float f32x2_t __attribute__((ext_vector_type(2))); typedef __bf16 bf16x2_t __attribute__((ext_vector_type(2)));
__device__ __forceinline__ unsigned cvtpk_s(float lo,float hi){f32x2_t v={lo,hi};bf16x2_t b=__builtin_convertvector(v,bf16x2_t);return __builtin_bit_cast(unsigned,b);}
#define WAIT_BAR(N) asm volatile("s_waitcnt vmcnt(" #N ") lgkmcnt(0)\n\ts_barrier":::"memory")

__device__ __forceinline__ void qkt(f32x16&p0,f32x16&p1,const char*Kslot,const bf16x8*qr,int r32,int hi){ const f32x16 negm=f32x16{};
  const char*kb=Kslot+hi*1024+r32*16;
  #pragma unroll
  for(int d0=0;d0<4;++d0){
    const bf16x8 b0=*reinterpret_cast<const bf16x8*>(kb+d0*2048);
    const bf16x8 b1=*reinterpret_cast<const bf16x8*>(kb+d0*2048+512);
    if(d0==0){p0=__builtin_amdgcn_mfma_f32_32x32x16_bf16(b0,qr[0],negm,0,0,0);p1=__builtin_amdgcn_mfma_f32_32x32x16_bf16(b1,qr[0],negm,0,0,0);}
    else{p0=__builtin_amdgcn_mfma_f32_32x32x16_bf16(b0,qr[d0],p0,0,0,0);p1=__builtin_amdgcn_mfma_f32_32x32x16_bf16(b1,qr[d0],p1,0,0,0);}}
}
typedef __attribute__((address_space(3))) const char* lds_cptr;
typedef short v4i16_t __attribute__((ext_vector_type(4)));
__device__ __forceinline__ void kload8(bf16x8*kf,lds_cptr kp){
  kf[0]=*(const __attribute__((address_space(3))) bf16x8*)(kp);      kf[1]=*(const __attribute__((address_space(3))) bf16x8*)(kp+512);
  kf[2]=*(const __attribute__((address_space(3))) bf16x8*)(kp+2048); kf[3]=*(const __attribute__((address_space(3))) bf16x8*)(kp+2560);
  kf[4]=*(const __attribute__((address_space(3))) bf16x8*)(kp+4096); kf[5]=*(const __attribute__((address_space(3))) bf16x8*)(kp+4608);
  kf[6]=*(const __attribute__((address_space(3))) bf16x8*)(kp+6144); kf[7]=*(const __attribute__((address_space(3))) bf16x8*)(kp+6656);
}
__device__ __forceinline__ void kload2(bf16x8*kf,lds_cptr kp,int j){ kf[2*j]=*(const __attribute__((address_space(3))) bf16x8*)(kp+j*2048); kf[2*j+1]=*(const __attribute__((address_space(3))) bf16x8*)(kp+j*2048+512); }
__device__ __forceinline__ s16x4 vtr(lds_cptr p){ return __builtin_bit_cast(s16x4,__builtin_amdgcn_ds_read_tr16_b64_v4i16((__attribute__((address_space(3))) v4i16_t*)p)); }
__device__ __forceinline__ float rowmax(const f32x16&p0,const f32x16&p1){
  float a=max3f(p0[0],p0[1],p1[0]),b=max3f(p0[2],p0[3],p1[1]);a=max3f(a,p1[2],p1[3]);
  #pragma unroll
  for(int r=4;r<16;r+=4){a=max3f(a,p0[r],p0[r+1]);b=max3f(b,p0[r+2],p0[r+3]);a=max3f(a,p1[r],p1[r+1]);b=max3f(b,p1[r+2],p1[r+3]);}
  const float m=max2f(a,b);
  auto rr=__builtin_amdgcn_permlane32_swap(__float_as_uint(m),__float_as_uint(m),false,false);
  return max2f(__uint_as_float(rr[0]),__uint_as_float(rr[1]));
}
__device__ __forceinline__ void pv(f32x16*o,int vb,bf16x8 pa0,bf16x8 pa1,bf16x8 pa2,bf16x8 pa3){
  #pragma unroll
  for(int d0=0;d0<2;++d0){s16x4 lo[4],hi[4];
    #pragma unroll
    for(int ks=0;ks<4;++ks){
      asm volatile("ds_read_b64_tr_b16 %0,%1 offset:%c2":"=&v"(lo[ks]):"v"(vb),"i"(d0*4096+ks*1024):"memory");
      asm volatile("ds_read_b64_tr_b16 %0,%1 offset:%c2":"=&v"(hi[ks]):"v"(vb),"i"(d0*4096+ks*1024+512):"memory");}
    asm volatile("s_waitcnt lgkmcnt(0)":::"memory");SBAR();
    #define PK(k) (bf16x8){lo[k][0],lo[k][1],lo[k][2],lo[k][3],hi[k][0],hi[k][1],hi[k][2],hi[k][3]}
    o[d0]=__builtin_amdgcn_mfma_f32_32x32x16_bf16(pa0,PK(0),o[d0],0,0,0);
    o[d0]=__builtin_amdgcn_mfma_f32_32x32x16_bf16(pa1,PK(1),o[d0],0,0,0);
    o[d0]=__builtin_amdgcn_mfma_f32_32x32x16_bf16(pa2,PK(2),o[d0],0,0,0);
    o[d0]=__builtin_amdgcn_mfma_f32_32x32x16_bf16(pa3,PK(3),o[d0],0,0,0);
    #undef PK
  }
}

struct AttnP { const bf16* Qw0; const bf16* Kh; const bf16* Vh; bf16* Ow0; int NT; int tbase; int toff; int qr0; float qscale; };
template<int THRL,int MODE,int QP,int KP,int VP,int OP> __device__ __forceinline__ void attn_unit(const AttnP&A,char*shm,const int tid){
  const int lane=tid&63,r32=lane&31,hi=lane>>5; const int wid=__builtin_amdgcn_readfirstlane(tid>>6);
  const bf16*Qw=A.Qw0+(long)(wid*QBLK)*QP;
  const bf16*Kh=A.Kh,*Vh=A.Vh;
  const int NT=A.NT;
  #define TROW(t) ((MODE==1)?(A.tbase+(((t)+A.toff)%NT)):(t))
  const unsigned lds0=(unsigned)(uintptr_t)shm;
  float*wsf=(float*)(shm+LDS_WS)+wid*64;
  const bf16*ksrc=Kh+(long)lane*KP+wid*8;
  const bf16*vsrc=Vh+(long)(16*(wid&3)+(lane>>2))*VP+(wid>>2)*32+(lane&3)*8;
  const unsigned kdst=lds0+LDS_K+wid*1024, vdst=lds0+LDS_V+wid*1024;
  #define DMA_K(t,slot) glds16(ksrc+(long)TROW(t)*KVBLK*KP,(unsigned)__builtin_amdgcn_readfirstlane(kdst+(slot)))
  #define DMA_V(t,slot) glds16(vsrc+(long)TROW(t)*KVBLK*VP,(unsigned)__builtin_amdgcn_readfirstlane(vdst+(slot)))
  const int vb0=(int)(lds0+LDS_V)+((lane>>4)&1)*32+(lane&3)*8+(4*hi+((lane&15)>>2))*64;
  const char*Kbase=shm+LDS_K; bf16x8 kf[8];
  const lds_cptr shm3=(lds_cptr)shm; const lds_cptr kp0=shm3+LDS_K+hi*1024+r32*16; const lds_cptr vp0=shm3+LDS_V+((lane>>4)&1)*32+(lane&3)*8+(4*hi+((lane&15)>>2))*64;
  DMA_K(0,0);DMA_V(0,0);DMA_K(1,SLOTB);
  bf16x8 qr[4];
  #pragma unroll
  for(int d0=0;d0<4;++d0)qr[d0]=*reinterpret_cast<const bf16x8*>(&Qw[(long)r32*QP+d0*16+hi*8]);
  if(MODE==1){
    #pragma unroll
    for(int d0=0;d0<4;++d0){ u32x4 w=__builtin_bit_cast(u32x4,qr[d0]);
      #pragma unroll
      for(int j=0;j<4;++j){ const float lo=__uint_as_float(w[j]<<16)*A.qscale, hv=__uint_as_float(w[j]&0xffff0000u)*A.qscale; w[j]=cvtpk_s(lo,hv);} qr[d0]=__builtin_bit_cast(bf16x8,w);} }
  const int na_qr=A.qr0+(wid>>1), na_qc=32*(wid&1)+r32; int na_rs=na_qr-4; na_rs=na_rs<0?0:(na_rs>24?24:na_rs); int na_cs=na_qc-8; na_cs=na_cs<0?0:(na_cs>48?48:na_cs);
  const float*rpbl=(const float*)(shm+LDS_RPB);
  #define NAMASK(P0,P1,t) do{ if(MODE==1){ const int kr_=TROW(t); const bool wv_=(kr_>=na_rs)&&(kr_<=na_rs+7); const float*tb_=rpbl+(kr_-na_qr+7)*31+(15-na_qc); const float NEG_=-INFINITY; \
      _Pragma("unroll") for(int r=0;r<16;++r){ const int kc_=crow(r,hi); const bool o0_=wv_&&(kc_>=na_cs)&&(kc_<na_cs+16); const bool o1_=wv_&&(kc_+32>=na_cs)&&(kc_+32<na_cs+16); \
        const float b0_=o0_?tb_[kc_]:0.f; const float b1_=o1_?tb_[kc_+32]:0.f; P0[r]=o0_?(P0[r]+b0_):NEG_; P1[r]=o1_?(P1[r]+b1_):NEG_; } } }while(0)
  float mhat=0.f,l_reg=0.f;f32x16 o[2];o[0]=f32x16{};o[1]=f32x16{};
  #define CMASK(P0,P1,t) NAMASK(P0,P1,t)
  bool resc=false;
  #define START(P0,P1) do{ const float rm=rowmax(P0,P1); resc=false; \
    { const float dl=rm; mhat=fadd_s(mhat,dl); \
      _Pragma("unroll") for(int r=0;r<16;++r){P0[r]=fsub_s(P0[r],dl);P1[r]=fsub_s(P1[r],dl);} \
      } \
    _Pragma("unroll") for(int r=0;r<16;++r)P0[r]=__builtin_amdgcn_exp2f(P0[r]); }while(0)
  #define RESC() do{ if(resc){ asm volatile("s_waitcnt lgkmcnt(0)":::"memory"); \
      _Pragma("unroll") for(int d_=0;d_<2;++d_) _Pragma("unroll") for(int r=0;r<16;++r)o[d_][r]*=wsf[crow(r,hi)]; } }while(0)
  f32x16 pA0,pA1,pB0,pB1;
  int sl_prev=0,sl_cur=0,sl_next=SLOTB;
  #define ROT() do{sl_prev=sl_cur;sl_cur=sl_next;sl_next=(sl_next==(NSLOT-1)*SLOTB)?0:sl_next+SLOTB;}while(0)
  DMA_K(2,2*SLOTB);
  WAIT_BAR(3);
  qkt(pA0,pA1,Kbase,qr,r32,hi);asm volatile("s_nop 15\n\ts_nop 7":"+v"(pA0),"+v"(pA1));CMASK(pA0,pA1,0);
  START(pA0,pA1);
  _Pragma("unroll") for(int r=0;r<16;++r)pA1[r]=__builtin_amdgcn_exp2f(pA1[r]);
  WAIT_BAR(0);
  DMA_K(3,0);DMA_V(1,SLOTB);
  ROT();
  kload8(kf,kp0+sl_cur);
  WAIT_BAR(2);
  s16x4 vlo[8],vhi[8]; u32x4 pw0,pw1,pw2,pw3;
  #define PKW(P,B) cvtpk_s(P[B],P[B+1])
  #define PAF(k) __builtin_bit_cast(bf16x8,pw##k)
  #define VFR(i) (bf16x8){vlo[i][0],vlo[i][1],vlo[i][2],vlo[i][3],vhi[i][0],vhi[i][1],vhi[i][2],vhi[i][3]}
  #define PIN(x) asm volatile("":"+v"(x))
  #define MX3(a,b,c) __builtin_fmaxf(__builtin_fmaxf((a),(b)),(c))
  #define GAPA(MF,A0,A1,A2,A3,W0,W1,PW) do{ MF; sacc+=A0; sacc+=A1; sacc+=A2; sacc+=A3; PIN(sacc); W0; W1; PIN(PW); SBAR(); }while(0)
  #define EX(v) __builtin_amdgcn_exp2f(v)
  #define GAPB(MF,X,B) do{ MF; X[B]=EX(X[B]); X[B+1]=EX(X[B+1]); X[B+2]=EX(X[B+2]); X[B+3]=EX(X[B+3]); PIN(X); SBAR(); }while(0)
  #define VRD(i) do{ vlo[i]=vtr(vp_+(((i)>>2)*4096+((i)&3)*1024)); vhi[i]=vtr(vp_+(((i)>>2)*4096+((i)&3)*1024+512)); }while(0)
  #define KRD(G,j) do{ if(G){ kload2(kf,kp0+sl_next,j); SBAR(); } }while(0)
  #define STEP(C0,C1,P0,P1,t,GK,GV,GL) do{ SBAR(); const f32x16 ZC_=f32x16{}; \
    const lds_cptr vp_=vp0+sl_prev; \
    VRD(0); SBAR(); float sacc=(P0[0]+P0[1]); \
    GAPA(C0=__builtin_amdgcn_mfma_f32_32x32x16_bf16(kf[0],qr[0],ZC_,0,0,0), P0[2],P0[3],P0[4],P0[5],     pw0[0]=PKW(P0,0), pw0[1]=PKW(P0,2), pw0); \
    VRD(4); SBAR(); GAPA(C1=__builtin_amdgcn_mfma_f32_32x32x16_bf16(kf[1],qr[0],ZC_,0,0,0), P0[6],P0[7],P0[8],P0[9],     pw0[2]=PKW(P0,4), pw0[3]=PKW(P0,6), pw0); \
    VRD(1); SBAR(); GAPA(C0=__builtin_amdgcn_mfma_f32_32x32x16_bf16(kf[2],qr[1],C0,0,0,0),   P0[10],P0[11],P0[12],P0[13], pw1[0]=PKW(P0,8), pw1[1]=PKW(P0,10), pw1); \
    VRD(5); SBAR(); GAPA(C1=__builtin_amdgcn_mfma_f32_32x32x16_bf16(kf[3],qr[1],C1,0,0,0),   P0[14],P0[15],P1[0],P1[1],   pw1[2]=PKW(P0,12),pw1[3]=PKW(P0,14), pw1); \
    VRD(2); SBAR(); GAPA(C0=__builtin_amdgcn_mfma_f32_32x32x16_bf16(kf[4],qr[2],C0,0,0,0),   P1[2],P1[3],P1[4],P1[5],     pw2[0]=PKW(P1,0), pw2[1]=PKW(P1,2), pw2); \
    VRD(6); SBAR(); GAPA(C1=__builtin_amdgcn_mfma_f32_32x32x16_bf16(kf[5],qr[2],C1,0,0,0),   P1[6],P1[7],P1[8],P1[9],     pw2[2]=PKW(P1,4), pw2[3]=PKW(P1,6), pw2); \
    VRD(3); SBAR(); GAPA(C0=__builtin_amdgcn_mfma_f32_32x32x16_bf16(kf[6],qr[3],C0,0,0,0),   P1[10],P1[11],P1[12],P1[13], pw3[0]=PKW(P1,8), pw3[1]=PKW(P1,10), pw3); \
    VRD(7); SBAR(); GAPA(C1=__builtin_amdgcn_mfma_f32_32x32x16_bf16(kf[7],qr[3],C1,0,0,0),   P1[14],P1[15],0.f,0.f,       pw3[2]=PKW(P1,12),pw3[3]=PKW(P1,14), pw3); \
    l_reg+=sacc; \
    if(GK){DMA_K((t)+3,sl_cur);} if(GV){DMA_V((t)+1,sl_next);} \
    _Pragma("unroll") for(int r=0;r<16;++r){C0[r]-=mhat;C1[r]-=mhat;} \
    CMASK(C0,C1,t); \
    { float a=MX3(C0[0],C0[1],C1[0]),b=MX3(C0[2],C0[3],C1[1]); a=MX3(a,C1[2],C1[3]); \
      _Pragma("unroll") for(int r=4;r<16;r+=4){a=MX3(a,C0[r],C0[r+1]);b=MX3(b,C0[r+2],C0[r+3]);a=MX3(a,C1[r],C1[r+1]);b=MX3(b,C1[r+2],C1[r+3]);} \
      float rm=__builtin_fmaxf(a,b); { auto rr=__builtin_amdgcn_permlane32_swap(__float_as_uint(rm),__float_as_uint(rm),false,false); rm=__builtin_fmaxf(__uint_as_float(rr[0]),__uint_as_float(rr[1])); } \
      resc=false; \
      if(__builtin_expect(__any(rm>(float)THRL),0)){ const float dl=__builtin_fmaxf(rm,0.f); mhat+=dl; \
        _Pragma("unroll") for(int r=0;r<16;++r){C0[r]-=dl;C1[r]-=dl;} \
        const float f=__builtin_amdgcn_exp2f(-dl); l_reg*=f; if(hi==0)wsf[r32]=f; resc=true; } } \
    SBAR(); \
    GAPB(o[0]=__builtin_amdgcn_mfma_f32_32x32x16_bf16(PAF(0),VFR(0),o[0],0,0,0), C0,0); \
    GAPB(o[1]=__builtin_amdgcn_mfma_f32_32x32x16_bf16(PAF(0),VFR(4),o[1],0,0,0), C0,4); \
    KRD(GL,0); GAPB(o[0]=__builtin_amdgcn_mfma_f32_32x32x16_bf16(PAF(1),VFR(1),o[0],0,0,0), C0,8); \
    KRD(GL,1); GAPB(o[1]=__builtin_amdgcn_mfma_f32_32x32x16_bf16(PAF(1),VFR(5),o[1],0,0,0), C0,12); \
    KRD(GL,2); GAPB(o[0]=__builtin_amdgcn_mfma_f32_32x32x16_bf16(PAF(2),VFR(2),o[0],0,0,0), C1,0); \
    KRD(GL,3); GAPB(o[1]=__builtin_amdgcn_mfma_f32_32x32x16_bf16(PAF(2),VFR(6),o[1],0,0,0), C1,4); \
    GAPB(o[0]=__builtin_amdgcn_mfma_f32_32x32x16_bf16(PAF(3),VFR(3),o[0],0,0,0), C1,8); \
    GAPB(o[1]=__builtin_amdgcn_mfma_f32_32x32x16_bf16(PAF(3),VFR(7),o[1],0,0,0), C1,12); \
    }while(0)
  int t=1;
  for(;t+5<NT;t+=2){
    STEP(pB0,pB1,pA0,pA1,t,true,true,true);     WAIT_BAR(2); RESC(); ROT();
    STEP(pA0,pA1,pB0,pB1,t+1,true,true,true);   WAIT_BAR(2); RESC(); ROT();
  }
  #define ENDW(tt) do{ if((tt)+3<NT){WAIT_BAR(2);} else if((tt)+2<NT){WAIT_BAR(1);} else {WAIT_BAR(0);} }while(0)
  for(;t+1<NT;t+=2){
    STEP(pB0,pB1,pA0,pA1,t,(t+3<NT),(t+1<NT),(t+1<NT));       ENDW(t);   RESC(); ROT();
    STEP(pA0,pA1,pB0,pB1,t+1,(t+4<NT),(t+2<NT),(t+2<NT));     ENDW(t+1); RESC(); ROT();
  }
  STEP(pB0,pB1,pA0,pA1,NT-1,false,false,false); RESC();
  { float sacc=pB0[0]+pB0[1]; _Pragma("unroll") for(int r=2;r<16;++r)sacc+=pB0[r]; _Pragma("unroll") for(int r=0;r<16;++r)sacc+=pB1[r]; l_reg+=sacc;
    pw0=(u32x4){PKW(pB0,0),PKW(pB0,2),PKW(pB0,4),PKW(pB0,6)};pw1=(u32x4){PKW(pB0,8),PKW(pB0,10),PKW(pB0,12),PKW(pB0,14)};pw2=(u32x4){PKW(pB1,0),PKW(pB1,2),PKW(pB1,4),PKW(pB1,6)};pw3=(u32x4){PKW(pB1,8),PKW(pB1,10),PKW(pB1,12),PKW(pB1,14)};
    SBAR(); pv(o,vb0+sl_cur,PAF(0),PAF(1),PAF(2),PAF(3)); }
  #undef PKW
  #undef PAF
  #undef VFR
  #undef PIN
  #undef MX3
  #undef GAPA
  #undef GAPB
  #undef EX
  #undef VRD
  #undef KRD
  #undef STEP
  #undef ENDW
  {auto rr=__builtin_amdgcn_permlane32_swap(__float_as_uint(l_reg),__float_as_uint(l_reg),false,false);l_reg=__uint_as_float(rr[0])+__uint_as_float(rr[1]);}
  if(hi==0)wsf[32+r32]=l_reg;asm volatile("s_waitcnt lgkmcnt(0)":::"memory");
  float rli[16];
  #pragma unroll
  for(int r=0;r<16;++r)rli[r]=__builtin_amdgcn_rcpf(wsf[32+crow(r,hi)]);
  bf16*Ow=A.Ow0+(long)(wid*QBLK)*OP;
  { bf16*stg=(bf16*)(shm+LDS_OST)+wid*2048;
    #pragma unroll
    for(int r=0;r<16;++r){const int orow=crow(r,hi);
      #pragma unroll
      for(int d0=0;d0<2;++d0)stg[orow*64+d0*32+r32]=__float2bfloat16(o[d0][r]*rli[r]);}
    asm volatile("s_waitcnt lgkmcnt(0)":::"memory");
    #pragma unroll
    for(int i=0;i<4;++i){const int row=i*8+(lane>>3),ch=lane&7; const u32x4 v=*(const u32x4*)(stg+row*64+ch*8); u32x4*dst=(u32x4*)(Ow+(long)row*OP+ch*8); const u32x4 g=*dst; u32x4 w;
      #pragma unroll
      for(int j=0;j<4;++j){ const float g0=__uint_as_float(g[j]<<16),g1=__uint_as_float(g[j]&0xffff0000u); const float o0=__uint_as_float(v[j]<<16),o1=__uint_as_float(v[j]&0xffff0000u);
        w[j]=cvtpk_s(o0*g0/(1.f+__expf(-g0)),o1*g1/(1.f+__expf(-g1))); }
      *dst=w; } }
  asm volatile("s_waitcnt lgkmcnt(0)\n\ts_barrier":::"memory");
  #undef DMA_K
  #undef DMA_V
  #undef CMASK
  #undef NAMASK
  #undef TROW
  #undef START
  #undef RESC
  #undef ROT
}
constexpr int ATTN_LDS_BYTES=LDS_BYTES;

#undef SBAR
#undef WAIT_BAR
}
namespace mk {
__device__ __forceinline__ void ph_attn(char* shm, bf16* P, const bf16* Qn, const bf16* Kn, const float* rpb, int nb, int tid, unsigned* ticket, volatile LAS unsigned* slot) {
    using attn_body::AttnP; typedef attn_body::bf16 abf;
    const int nunits = nb * 64;
#pragma unroll 1
    for (;;) {
        if (tid == 0) *slot = __hip_atomic_fetch_add(ticket, 1u, __ATOMIC_RELAXED, __HIP_MEMORY_SCOPE_AGENT);
        __syncthreads();
        const int uu = (int)__builtin_amdgcn_readfirstlane((int)*slot);
        __syncthreads();
        if (uu >= 2 * nunits) break;
        if (uu < nunits) { const int u = uu; const int b = u >> 6, h = (u >> 3) & 7, qb = u & 7, g = h >> 2; const size_t rb = (size_t)b * SEQ;
            AttnP A; A.Qw0 = (const abf*)(Qn + (rb + qb * 256) * 512 + h * 64); A.Kh = (const abf*)(Kn + rb * 128 + g * 64);
            A.Vh = (const abf*)(P + rb * LDP + PC_QKVC + 640 + g * 64); A.Ow0 = (abf*)(P + (rb + qb * 256) * LDP + PC_GC + h * 64);
            A.NT = 32; A.tbase = 0; A.toff = 0; A.qr0 = 0; A.qscale = 1.f;
            int tid2 = tid; asm volatile("" : "+v"(tid2)); attn_body::attn_unit<8, 0, 512, 128, LDP, LDP>(A, shm, tid2);
        } else { const int u = uu - nunits; const int b = u >> 6, h = (u >> 3) & 7, qb = u & 7; const size_t rb = (size_t)b * SEQ; const int qr0 = qb * 4;
            { float* tb = (float*)(shm + attn_body::LDS_RPB); for (int i = tid; i < 465; i += 512) tb[i] = rpb[h * 465 + i] * 1.4426950408889634f; }
            int rs0 = qr0 - 4; rs0 = rs0 < 0 ? 0 : (rs0 > 24 ? 24 : rs0); int rs3 = qr0 - 1; rs3 = rs3 < 0 ? 0 : (rs3 > 24 ? 24 : rs3); int NT = rs3 - rs0 + 8; NT += (NT & 1);
            AttnP A; A.Qw0 = (const abf*)(P + (rb + qb * 256) * LDP + PC_QKVD + h * 64); A.Kh = (const abf*)(P + rb * LDP + PC_QKVD + 512 + h * 64);
            A.Vh = (const abf*)(P + rb * LDP + PC_QKVD + 1024 + h * 64); A.Ow0 = (abf*)(P + (rb + qb * 256) * LDP + PC_GD + h * 64);
            A.NT = NT; A.tbase = rs0; A.toff = rs3 - rs0; A.qr0 = qr0; A.qscale = C2;
            int tid2 = tid; asm volatile("" : "+v"(tid2)); attn_body::attn_unit<8, 1, LDP, LDP, LDP, LDP>(A, shm, tid2); }
    }
}
}
namespace mk {
constexpr int RW_CH = 32;
constexpr int RW_P64 = 144, RW_P32 = 80, RW_TA_ROW = 144;
constexpr int RW_CONST = 0;
constexpr int RW_TA_LO = 4 * RW_TA_ROW;
constexpr int RW_PW = RW_CONST + 960 * 4, RW_PWB = 2 * RW_TA_LO + 2 * 4 * 64 * 4;
constexpr int RW_WT = RW_PW + 8 * RW_PWB;
constexpr int RW_WTOT = RW_WT + 2 * 64 * RW_TA_ROW;
constexpr int RW_TAL = RW_WTOT + 8 * 64 * 4;
constexpr int RW_TS = RW_TAL + 32 * RW_P64;
constexpr int O_TRH = 0, O_TBE = O_TRH + 32 * RW_P64, O_TKA = O_TBE + 32 * RW_P64, O_TBP = O_TKA + 32 * RW_P64, O_TKP = O_TBP + 64 * RW_P32, O_VT = O_TKP + 64 * RW_P32, O_GC = O_VT + 64 * RW_P32, RW_TSB = O_GC + 256;
constexpr int RW_S0B = RW_TS + 2 * RW_TSB;
constexpr int RW_UB = RW_S0B + 2 * 64 * RW_P64;
constexpr int RW_RF = RW_UB + 64 * RW_P32;
constexpr int RW_ABF = RW_RF + 64 * 36 * 4;
constexpr int RW_CORR = RW_ABF + 32 * 36 * 4;
constexpr int RW_DUMP = RW_CORR + 64 * 20 * 4;
constexpr int RW_LDS_END = RW_DUMP + 256;
static_assert(RW_LDS_END <= 163840 - 16, "rwkv lds");
#define RW_BAR() do { asm volatile("s_waitcnt lgkmcnt(0)" ::: "memory"); __builtin_amdgcn_s_barrier(); asm volatile("" ::: "memory"); } while (0)
__device__ __forceinline__ float dppf(float x, const int ctrl_sel) {
    const int xi = __builtin_bit_cast(int, x); int r;
    if (ctrl_sel == 0) r = __builtin_amdgcn_update_dpp(0, xi, 0xB1, 0xf, 0xf, true);
    else if (ctrl_sel == 1) r = __builtin_amdgcn_update_dpp(0, xi, 0x4E, 0xf, 0xf, true);
    else if (ctrl_sel == 2) r = __builtin_amdgcn_update_dpp(0, xi, 0x141, 0xf, 0xf, true);
    else r = __builtin_amdgcn_update_dpp(0, xi, 0x140, 0xf, 0xf, true);
    return __builtin_bit_cast(float, r);
}
__device__ __forceinline__ float sum16(float x) { x += dppf(x, 0); x += dppf(x, 1); x += dppf(x, 2); x += dppf(x, 3); return x; }
__device__ __forceinline__ float rw_fma(float a, float b, float c) { float r; asm("v_fma_f32 %0, %1, %2, %3" : "=v"(r) : "v"(a), "v"(b), "v"(c)); return r; }
__device__ __forceinline__ int rwcrow(int r, int hi) { return (r & 3) + 8 * (r >> 2) + 4 * hi; }
__device__ __forceinline__ unsigned rwpk(float lo, float hi) { typedef float f2 __attribute__((ext_vector_type(2))); typedef __bf16 b2 __attribute__((ext_vector_type(2))); f2 v = {lo, hi}; b2 b = __builtin_convertvector(v, b2); return __builtin_bit_cast(unsigned, b); }
__device__ __forceinline__ f32x16 rw_cc(const LAS unsigned char* X, const LAS unsigned char* Y, int r32, int hi) {
    f32x16 d = f32x16{};
#pragma unroll
    for (int s = 0; s < 4; ++s) d = __builtin_amdgcn_mfma_f32_32x32x16_bf16(*(const LAS bf16x8*)(X + r32 * RW_P64 + 32 * s + 16 * hi), *(const LAS bf16x8*)(Y + r32 * RW_P64 + 32 * s + 16 * hi), d, 0, 0, 0);
    return d;
}
__device__ __forceinline__ f32x16 rw_accmul(f32x16 acc, const LAS unsigned char* Lt_row, const f32x16& M, int hi) {
    v4u m0, m1; m0.x = rwpk(M[0], M[1]); m0.y = rwpk(M[2], M[3]); m0.z = rwpk(M[4], M[5]); m0.w = rwpk(M[6], M[7]); m1.x = rwpk(M[8], M[9]); m1.y = rwpk(M[10], M[11]); m1.z = rwpk(M[12], M[13]); m1.w = rwpk(M[14], M[15]);
#pragma unroll
    for (int s = 0; s < 2; ++s) { const LAS unsigned char* p = Lt_row + 2 * (16 * s + 4 * hi); const v2u lo = *(const LAS v2u*)p, hv = *(const LAS v2u*)(p + 16); v4u av; av.x = lo.x; av.y = lo.y; av.z = hv.x; av.w = hv.y;
        acc = __builtin_amdgcn_mfma_f32_32x32x16_bf16(__builtin_bit_cast(bf16x8, av), __builtin_bit_cast(bf16x8, s == 0 ? m0 : m1), acc, 0, 0, 0); }
    return acc;
}
__device__ __forceinline__ void rwkv_item(LAS unsigned char* lds_dyn, const bf16* P, int T, int z, int b, int h, const float* mu, const float* w0, const float* w_up, const float* a0, const float* a_up,
                                          const float* k_k, const float* k_a, const float* r_k, bf16* YB, float* CB, bf16* VB, const int tid_in) {
    (void)lds_dyn; LAS unsigned char* const lds = (LAS unsigned char*)(unsigned)0;
    unsigned mk_ = ~0u; int wv_ = tid_in; asm volatile("" : "+s"(mk_), "+s"(wv_));
    const int tid = wv_ * 64 + (int)__builtin_amdgcn_mbcnt_hi(mk_, __builtin_amdgcn_mbcnt_lo(mk_, 0u));
    const int lane0 = tid & 63, wave = __builtin_amdgcn_readfirstlane(tid >> 6);
    LAS float* CN = (LAS float*)(lds + RW_CONST);
    for (int i = tid; i < 960; i += 512) { float v;
        if (i < 640) { const int m = i / 320, j = i % 320, g = j >> 6, c = j & 63; const int ch = (g < 3 ? g * 512 + h * 64 : (g == 3 ? 1536 + z * 64 : 1664 + z * 64)) + c; v = mu[m * 1792 + ch]; }
        else { const int j = i - 640, g = j >> 6, c = j & 63; v = g == 0 ? w0[z * 512 + h * 64 + c] : g == 1 ? a0[z * 512 + h * 64 + c] : g == 2 ? k_k[h * 64 + c] : g == 3 ? k_a[h * 64 + c] : r_k[h * 64 + c]; }
        CN[i] = v; }
    for (int i = tid; i < 2 * 64 * 64; i += 512) { const int lo = i >> 12, k = (i >> 6) & 63, n = i & 63; const float* U = (lo == 0 ? w_up : a_up) + (size_t)z * 64 * 512 + h * 64;
        *(LAS unsigned short*)(lds + RW_WT + lo * 64 * RW_TA_ROW + n * RW_TA_ROW + 2 * k) = (unsigned short)f2bf(U[(size_t)k * 512 + n]); }
    for (int i = tid; i < 2 * 64 * RW_P64 / 4; i += 512) ((LAS unsigned*)(lds + RW_S0B))[i] = 0u;
    __syncthreads();
    const int NCH = SEQ / RW_CH;
    const int gcol[5] = {PC_SLAB + h * 64, PC_SLAB + 512 + h * 64, PC_SLAB + 1024 + h * 64, PC_SLAB + 1536 + z * 64, PC_SLAB + 1664 + z * 64};
    const size_t tb0 = (size_t)b * SEQ;
    v2u rawc[2][5], rawe[5];
#define RW_ROWOFF(step_) ({ const int i__ = (step_); int l__ = z ? (SEQ - 1 - i__) : i__; l__ = l__ < 0 ? 0 : (l__ > SEQ - 1 ? SEQ - 1 : l__); ((unsigned)(tb0 + l__) * (unsigned)LDP + 4u * (unsigned)cq) * 2u; })
#define RW_LOAD(cc) do { const GAS unsigned char* Pb_ = (const GAS unsigned char*)P; const int s0_ = (cc) * RW_CH + 4 * vw0; \
    const unsigned r0_ = RW_ROWOFF(s0_ + js), r1_ = RW_ROWOFF(s0_ + 4 + js), re_ = RW_ROWOFF(js == 0 ? s0_ - 1 : (js == 3 ? s0_ + 8 : s0_ + js)); \
    _Pragma("unroll") for (int g = 0; g < 5; ++g) { rawc[0][g] = *(const GAS v2u*)(Pb_ + (r0_ + 2u * (unsigned)gcol[g])); rawc[1][g] = *(const GAS v2u*)(Pb_ + (r1_ + 2u * (unsigned)gcol[g])); rawe[g] = *(const GAS v2u*)(Pb_ + (re_ + 2u * (unsigned)gcol[g])); } } while (0)
    { const int lane = lane0, js = lane >> 4, cq = lane & 15, vw0 = wave >= 4 ? 2 * (wave - 4) : 0; RW_LOAD(0); }
    f32x16 accS[2] = {f32x16{}, f32x16{}};
    LAS float* const WTOT = (LAS float*)(lds + RW_WTOT); LAS float* const RF = (LAS float*)(lds + RW_RF); LAS float* const ABF = (LAS float*)(lds + RW_ABF); LAS float* const CORR = (LAS float*)(lds + RW_CORR);
#pragma unroll 1
    for (int it = 0; it <= NCH; ++it) {
        int lane_ = lane0; asm volatile("" : "+v"(lane_));
        const int lane = lane_, r32 = lane & 31, hi = lane >> 5, js = lane >> 4, cq = lane & 15;
        const int cp = it, cc = it - 1;
        const bool prep = (wave >= 4) && (cp < NCH), chain = (wave < 4) && (cc >= 0);
        const int vw0 = 2 * (wave - 4); const int sjv[2] = {4 * vw0 + js, 4 * (vw0 + 1) + js};
        LAS unsigned char* const tsp = lds + RW_TS + (cp & 1) * RW_TSB; const LAS unsigned char* const tsc = lds + RW_TS + (cc & 1) * RW_TSB;
        const LAS unsigned char* S0cur = lds + RW_S0B + (cc & 1) * 64 * RW_P64; LAS unsigned char* S0nxt = lds + RW_S0B + ((cc + 1) & 1) * 64 * RW_P64;
        float sv[2][3][4];
        float o_kk[2][4], o_r[2][4], o_b[2][4], o_kd[2][4], o_v[2][4], lw2[2][4], Lin[2][4];
        if (prep) {
            float sw_[2][2][4];
            asm volatile("s_waitcnt vmcnt(0)" ::: "memory");
#pragma unroll
            for (int g = 0; g < 5; ++g) { const f32x4 m0 = *(const LAS f32x4*)(CN + g * 64 + 4 * cq), m1 = *(const LAS f32x4*)(CN + 320 + g * 64 + 4 * cq);
                const int am = ((lane - 16) & 63) << 2, ap = ((lane + 16) & 63) << 2;
                v2u A0, A1, B0, B1;
                A0.x = (unsigned)__builtin_amdgcn_ds_bpermute(am, (int)rawc[0][g].x); A0.y = (unsigned)__builtin_amdgcn_ds_bpermute(am, (int)rawc[0][g].y); A1.x = (unsigned)__builtin_amdgcn_ds_bpermute(am, (int)rawc[1][g].x); A1.y = (unsigned)__builtin_amdgcn_ds_bpermute(am, (int)rawc[1][g].y);
                B0.x = (unsigned)__builtin_amdgcn_ds_bpermute(ap, (int)rawc[0][g].x); B0.y = (unsigned)__builtin_amdgcn_ds_bpermute(ap, (int)rawc[0][g].y); B1.x = (unsigned)__builtin_amdgcn_ds_bpermute(ap, (int)rawc[1][g].x); B1.y = (unsigned)__builtin_amdgcn_ds_bpermute(ap, (int)rawc[1][g].y);
#pragma unroll
                for (int u = 0; u < 2; ++u) { const int i_ = cp * RW_CH + sjv[u]; const int l_ = z ? (SEQ - 1 - i_) : i_; const bool okp = (l_ - 1 >= 0), okn = (l_ + 1 < SEQ);
                    const v2u sm = u == 0 ? (js == 0 ? rawe[g] : A0) : (js == 0 ? A0 : A1), sp = u == 0 ? (js == 3 ? B1 : B0) : (js == 3 ? rawe[g] : B1);
                    const v2u lm = z ? sp : sm, lp = z ? sm : sp;
                    const v2u rp = {okp ? lm.x : 0u, okp ? lm.y : 0u}, rn_ = {okn ? lp.x : 0u, okn ? lp.y : 0u};
                    const float pr[4] = {bflo(rp.x), bfhi(rp.x), bflo(rp.y), bfhi(rp.y)}, cu[4] = {bflo(rawc[u][g].x), bfhi(rawc[u][g].x), bflo(rawc[u][g].y), bfhi(rawc[u][g].y)}, nx[4] = {bflo(rn_.x), bfhi(rn_.x), bflo(rn_.y), bfhi(rn_.y)};
#pragma unroll
                    for (int e = 0; e < 4; ++e) { const float val = cu[e] + m0[e] * (pr[e] - cu[e]) + m1[e] * (nx[e] - cu[e]); if (g < 3) sv[u][g][e] = val; else sw_[u][g - 3][e] = val; } } }
#pragma unroll
            for (int u = 0; u < 2; ++u) {
#pragma unroll
                for (int g = 0; g < 3; ++g) asm volatile("" : "+v"(sv[u][g][0]), "+v"(sv[u][g][1]), "+v"(sv[u][g][2]), "+v"(sv[u][g][3]) :: "memory");
#pragma unroll
                for (int g = 0; g < 2; ++g) asm volatile("" : "+v"(sw_[u][g][0]), "+v"(sw_[u][g][1]), "+v"(sw_[u][g][2]), "+v"(sw_[u][g][3]) :: "memory"); }
            __builtin_amdgcn_sched_barrier(0);
            LAS unsigned char* const TAw = lds + RW_PW + vw0 * RW_PWB;
            LAS float* const LRw = (LAS float*)(TAw + 2 * 8 * RW_TA_ROW);
#pragma unroll
            for (int u = 0; u < 2; ++u) { float th[4];
#pragma unroll
                for (int e = 0; e < 4; ++e) { const float ex = __builtin_amdgcn_exp2f(sw_[u][0][e] * 2.8853900817779268f); th[e] = 1.f - 2.f * __builtin_amdgcn_rcpf(1.f + ex); }
                v2u t0; t0.x = pk2(th[0], th[1]); t0.y = pk2(th[2], th[3]); *(LAS v2u*)(TAw + (4 * u + js) * RW_TA_ROW + 8 * cq) = t0;
                v2u t1; t1.x = pk2(sw_[u][1][0], sw_[u][1][1]); t1.y = pk2(sw_[u][1][2], sw_[u][1][3]); *(LAS v2u*)(TAw + 8 * RW_TA_ROW + (4 * u + js) * RW_TA_ROW + 8 * cq) = t1; }
        } else if (chain) {
            if (wave < 2) {
                const int v0 = 32 * wave; f32x16 acc = f32x16{};
#pragma unroll
                for (int s = 0; s < 4; ++s) acc = __builtin_amdgcn_mfma_f32_32x32x16_bf16(*(const LAS bf16x8*)(S0cur + (v0 + r32) * RW_P64 + 32 * s + 16 * hi), *(const LAS bf16x8*)(lds + RW_TAL + r32 * RW_P64 + 32 * s + 16 * hi), acc, 0, 0, 0);
                f32x16 ak = rw_cc(tsc + O_TKA, lds + RW_TAL, r32, hi);
#pragma unroll
                for (int r = 0; r < 16; ++r) ak[r] = (rwcrow(r, hi) < r32) ? ak[r] : 0.f;
                acc = rw_accmul(acc, tsc + O_VT + (v0 + r32) * RW_P32, ak, hi);
#pragma unroll
                for (int r = 0; r < 16; ++r) RF[(v0 + rwcrow(r, hi)) * 36 + r32] = acc[r];
            } else if (wave == 2) {
                f32x16 ab = rw_cc(tsc + O_TBE, lds + RW_TAL, r32, hi);
#pragma unroll
                for (int r = 0; r < 16; ++r) ABF[rwcrow(r, hi) * 36 + r32] = (rwcrow(r, hi) < r32) ? ab[r] : 0.f;
            }
        }
        RW_BAR();
        if (prep) {
            {   LAS unsigned char* const TAw = lds + RW_PW + vw0 * RW_PWB; LAS float* const LRw = (LAS float*)(TAw + 2 * 8 * RW_TA_ROW);
            {
                LAS float* const lrb = lane < 32 ? LRw + (4 * (lane >> 4)) * 64 + (lane & 15) : (LAS float*)(lds + RW_DUMP); const int rs = lane < 32 ? 64 : 0, ls = lane < 32 ? 512 : 0, ns = lane < 32 ? 16 : 0;
                bf16x8 Af[2][2], Wf[2][4][2]; f32x4 accL[2][4];
#pragma unroll
                for (int lo = 0; lo < 2; ++lo) { Af[lo][0] = *(const LAS bf16x8*)(TAw + lo * 8 * RW_TA_ROW + (lane & 15) * RW_TA_ROW + 16 * (lane >> 4)); Af[lo][1] = *(const LAS bf16x8*)(TAw + lo * 8 * RW_TA_ROW + (lane & 15) * RW_TA_ROW + 64 + 16 * (lane >> 4));
#pragma unroll
                    for (int nt = 0; nt < 4; ++nt) { const LAS unsigned char* wt = lds + RW_WT + lo * 64 * RW_TA_ROW + (16 * nt + (lane & 15)) * RW_TA_ROW + 16 * (lane >> 4); Wf[lo][nt][0] = *(const LAS bf16x8*)(wt); Wf[lo][nt][1] = *(const LAS bf16x8*)(wt + 64); } }
#pragma unroll
                for (int lo = 0; lo < 2; ++lo)
#pragma unroll
                    for (int nt = 0; nt < 4; ++nt) { f32x4 acc = {0.f, 0.f, 0.f, 0.f}; acc = __builtin_amdgcn_mfma_f32_16x16x32_bf16(Af[lo][0], Wf[lo][nt][0], acc, 0, 0, 0); accL[lo][nt] = __builtin_amdgcn_mfma_f32_16x16x32_bf16(Af[lo][1], Wf[lo][nt][1], acc, 0, 0, 0); }
#pragma unroll
                for (int lo = 0; lo < 2; ++lo)
#pragma unroll
                    for (int nt = 0; nt < 4; ++nt) { LAS float* lr = lrb + lo * ls + nt * ns; lr[0] = accL[lo][nt][0]; lr[rs] = accL[lo][nt][1]; lr[2 * rs] = accL[lo][nt][2]; lr[3 * rs] = accL[lo][nt][3]; } }
            }
            asm volatile("s_waitcnt lgkmcnt(0)" ::: "memory");
            LAS float* const LRw = (LAS float*)(lds + RW_PW + vw0 * RW_PWB + 2 * 8 * RW_TA_ROW); float bo_[2];
            f32x4 lw_[2], la_[2];
#pragma unroll
            for (int u = 0; u < 2; ++u) { lw_[u] = *(const LAS f32x4*)(LRw + (4 * u + js) * 64 + 4 * cq); la_[u] = *(const LAS f32x4*)(LRw + 512 + (4 * u + js) * 64 + 4 * cq); }
            const f32x4 c_w0 = *(const LAS f32x4*)(CN + 640 + 4 * cq), c_a0 = *(const LAS f32x4*)(CN + 704 + 4 * cq), c_kk = *(const LAS f32x4*)(CN + 768 + 4 * cq), c_ka = *(const LAS f32x4*)(CN + 832 + 4 * cq), c_rk = *(const LAS f32x4*)(CN + 896 + 4 * cq);
#pragma unroll
            for (int u = 0; u < 2; ++u) { const f32x4 lw = lw_[u], la = la_[u];
                float kx[4], n2 = 0.f;
#pragma unroll
                for (int e = 0; e < 4; ++e) { kx[e] = sv[u][1][e] * c_kk[e]; n2 += kx[e] * kx[e]; }
                n2 = sum16(n2); const float rn = __builtin_amdgcn_rsqf(fmaxf(n2, 1e-24f));
                float bo = 0.f;
#pragma unroll
                for (int e = 0; e < 4; ++e) { const float wraw = lw[e] + c_w0[e];
                    lw2[u][e] = -0.8750387749480469f * __builtin_amdgcn_rcpf(1.f + __expf(-wraw));
                    const float aa = __builtin_amdgcn_rcpf(1.f + __expf(-(la[e] + c_a0[e]))); o_kk[u][e] = kx[e] * rn; o_kd[u][e] = sv[u][1][e] * (1.f + (aa - 1.f) * c_ka[e]); o_b[u][e] = o_kk[u][e] * aa; o_r[u][e] = sv[u][0][e]; o_v[u][e] = sv[u][2][e];
                    bo += o_r[u][e] * o_kd[u][e] * c_rk[e]; }
                bo_[u] = sum16(bo);
#pragma unroll
                for (int e = 0; e < 4; ++e) { float x = lw2[u][e];
                    const float y1 = __builtin_bit_cast(float, __builtin_amdgcn_ds_bpermute(((lane - 16) & 63) << 2, __builtin_bit_cast(int, x))); x += (js >= 1) ? y1 : 0.f;
                    const float y2 = __builtin_bit_cast(float, __builtin_amdgcn_ds_bpermute(((lane - 32) & 63) << 2, __builtin_bit_cast(int, x))); x += (js >= 2) ? y2 : 0.f; Lin[u][e] = x; } }
#pragma unroll
            for (int u = 0; u < 2; ++u) { LAS float* wp = js == 3 ? WTOT + (vw0 + u) * 64 + 4 * cq : (LAS float*)(lds + RW_DUMP); *(LAS f32x4*)wp = (f32x4){Lin[u][0], Lin[u][1], Lin[u][2], Lin[u][3]}; }
#pragma unroll
            for (int u = 0; u < 2; ++u) { const int i_ = cp * RW_CH + sjv[u]; const int l_ = z ? (SEQ - 1 - i_) : i_; const size_t t = tb0 + l_;
                if (cq == 0) *(GAS float*)(CB + ((size_t)(z * 8 + h)) * T + t) = bo_[u];
                if (z == 0) { v2u vb; vb.x = pk2(o_v[u][0], o_v[u][1]); vb.y = pk2(o_v[u][2], o_v[u][3]); *(GAS v2u*)(VB + t * 512 + h * 64 + 4 * cq) = vb; } }
            __builtin_amdgcn_sched_barrier(0);
            { const int cn = cp + 1 < NCH ? cp + 1 : cp; RW_LOAD(cn); }
            __builtin_amdgcn_sched_barrier(0);
        } else if (chain && wave == 0) {
            LAS float* row = RF + lane * 36;
#define RW_SOLVE16(o_) do { float u[16]; \
            _Pragma("unroll") for (int q4 = 0; q4 < 4; ++q4) { f32x4 rr = *(const LAS f32x4*)(row + (o_) + 4 * q4); if ((o_) != 0) rr += *(const LAS f32x4*)(CORR + lane * 20 + 4 * q4); u[4 * q4] = rr[0]; u[4 * q4 + 1] = rr[1]; u[4 * q4 + 2] = rr[2]; u[4 * q4 + 3] = rr[3]; } \
            _Pragma("unroll") for (int tb = 0; tb < 4; ++tb) { f32x4 A_[4][4]; \
                _Pragma("unroll") for (int r_ = 0; r_ < 4; ++r_) _Pragma("unroll") for (int q4 = tb; q4 < 4; ++q4) A_[r_][q4] = *(const LAS f32x4*)(ABF + ((o_) + 4 * tb + r_) * 36 + (o_) + 4 * q4); \
                _Pragma("unroll") for (int r_ = 0; r_ < 4; ++r_) { const int tt = 4 * tb + r_; if (tt < 15) { const float nut = -u[tt]; \
                    _Pragma("unroll") for (int q4 = (tt + 1) / 4; q4 < 4; ++q4) { const f32x4 aa = A_[r_][q4]; \
                        _Pragma("unroll") for (int e_ = 0; e_ < 4; ++e_) if (4 * q4 + e_ > tt) u[4 * q4 + e_] = rw_fma(nut, aa[e_], u[4 * q4 + e_]); } } } } \
            v4u w0_, w1_; w0_.x = pk2(-u[0], -u[1]); w0_.y = pk2(-u[2], -u[3]); w0_.z = pk2(-u[4], -u[5]); w0_.w = pk2(-u[6], -u[7]); w1_.x = pk2(-u[8], -u[9]); w1_.y = pk2(-u[10], -u[11]); w1_.z = pk2(-u[12], -u[13]); w1_.w = pk2(-u[14], -u[15]); \
            *(LAS v4u*)(lds + RW_UB + lane * RW_P32 + 2 * (o_)) = w0_; *(LAS v4u*)(lds + RW_UB + lane * RW_P32 + 2 * (o_) + 16) = w1_; } while (0)
            RW_SOLVE16(0);
            asm volatile("s_waitcnt lgkmcnt(0)" ::: "memory");
            {
                v4u bw = {0u, 0u, 0u, 0u};
                if (r32 < 16) { const LAS float* ap = ABF + (8 * hi) * 36 + 16 + r32; bw.x = pk2(ap[0], ap[36]); bw.y = pk2(ap[72], ap[108]); bw.z = pk2(ap[144], ap[180]); bw.w = pk2(ap[216], ap[252]); }
#pragma unroll
                for (int vt = 0; vt < 2; ++vt) { f32x16 d = f32x16{};
                    d = __builtin_amdgcn_mfma_f32_32x32x16_bf16(*(const LAS bf16x8*)(lds + RW_UB + (32 * vt + r32) * RW_P32 + 16 * hi), __builtin_bit_cast(bf16x8, bw), d, 0, 0, 0);
                    if (r32 < 16) {
#pragma unroll
                        for (int r = 0; r < 16; ++r) CORR[(32 * vt + rwcrow(r, hi)) * 20 + r32] = d[r]; } }
            }
            asm volatile("s_waitcnt lgkmcnt(0)" ::: "memory");
            RW_SOLVE16(16);
#undef RW_SOLVE16
        }
        RW_BAR();
        if (prep) {
            f32x4 offu[2] = {{0.f, 0.f, 0.f, 0.f}, {0.f, 0.f, 0.f, 0.f}}, tot = {0.f, 0.f, 0.f, 0.f};
#pragma unroll
            for (int w = 0; w < 8; ++w) { const f32x4 tw = *(const LAS f32x4*)(WTOT + w * 64 + 4 * cq); tot += tw; if (w < vw0) offu[0] += tw; if (w < vw0 + 1) offu[1] += tw; }
#pragma unroll
            for (int u = 0; u < 2; ++u) { const int sj = sjv[u]; const f32x4 off = offu[u];
                float al[4], rh[4], be[4], ka[4], bp[4], kp[4];
#pragma unroll
                for (int e = 0; e < 4; ++e) { const float Lt = off[e] + Lin[u][e]; const float gprev = __builtin_amdgcn_exp2f(Lt - lw2[u][e]), gt = __builtin_amdgcn_exp2f(Lt), gi = __builtin_amdgcn_exp2f(-Lt), gp = __builtin_amdgcn_exp2f(tot[e] - Lt);
                    al[e] = gprev * o_kk[u][e]; rh[e] = gt * o_r[u][e]; be[e] = o_b[u][e] * gi; ka[e] = o_kd[u][e] * gi; bp[e] = o_b[u][e] * gp; kp[e] = o_kd[u][e] * gp; }
                v2u w; w.x = pk2(al[0], al[1]); w.y = pk2(al[2], al[3]); *(LAS v2u*)(lds + RW_TAL + sj * RW_P64 + 8 * cq) = w;
                w.x = pk2(rh[0], rh[1]); w.y = pk2(rh[2], rh[3]); *(LAS v2u*)(tsp + O_TRH + sj * RW_P64 + 8 * cq) = w;
                w.x = pk2(be[0], be[1]); w.y = pk2(be[2], be[3]); *(LAS v2u*)(tsp + O_TBE + sj * RW_P64 + 8 * cq) = w;
                w.x = pk2(ka[0], ka[1]); w.y = pk2(ka[2], ka[3]); *(LAS v2u*)(tsp + O_TKA + sj * RW_P64 + 8 * cq) = w;
#pragma unroll
                for (int e = 0; e < 4; ++e) { *(LAS unsigned short*)(tsp + O_TBP + (4 * cq + e) * RW_P32 + 2 * sj) = (unsigned short)f2bf(bp[e]); *(LAS unsigned short*)(tsp + O_TKP + (4 * cq + e) * RW_P32 + 2 * sj) = (unsigned short)f2bf(kp[e]);
                    *(LAS unsigned short*)(tsp + O_VT + (4 * cq + e) * RW_P32 + 2 * sj) = (unsigned short)f2bf(o_v[u][e]); }
                if (u == 1) { LAS float* gp_ = sj == 31 ? (LAS float*)(tsp + O_GC) + 4 * cq : (LAS float*)(lds + RW_DUMP); *(LAS f32x4*)gp_ = (f32x4){__builtin_amdgcn_exp2f(tot[0]), __builtin_amdgcn_exp2f(tot[1]), __builtin_amdgcn_exp2f(tot[2]), __builtin_amdgcn_exp2f(tot[3])}; } }
        } else if (chain) {
            if (wave < 2) {
                const int v0 = 32 * wave; f32x16 accY = f32x16{};
#pragma unroll
                for (int s = 0; s < 4; ++s) accY = __builtin_amdgcn_mfma_f32_32x32x16_bf16(*(const LAS bf16x8*)(S0cur + (v0 + r32) * RW_P64 + 32 * s + 16 * hi), *(const LAS bf16x8*)(tsc + O_TRH + r32 * RW_P64 + 32 * s + 16 * hi), accY, 0, 0, 0);
                { f32x16 bk = rw_cc(tsc + O_TKA, tsc + O_TRH, r32, hi);
#pragma unroll
                  for (int r = 0; r < 16; ++r) bk[r] = (rwcrow(r, hi) <= r32) ? bk[r] : 0.f;
                  accY = rw_accmul(accY, tsc + O_VT + (v0 + r32) * RW_P32, bk, hi); }
                { f32x16 bbm = rw_cc(tsc + O_TBE, tsc + O_TRH, r32, hi);
#pragma unroll
                  for (int r = 0; r < 16; ++r) bbm[r] = (rwcrow(r, hi) <= r32) ? bbm[r] : 0.f;
                  accY = rw_accmul(accY, lds + RW_UB + (v0 + r32) * RW_P32, bbm, hi); }
                {
                    const int iy = cc * RW_CH + r32; const int ly = z ? (SEQ - 1 - iy) : iy; GAS unsigned char* yb = (GAS unsigned char*)YB + (((size_t)z * T + tb0 + ly) * 512 + h * 64 + v0 + 4 * hi) * 2;
#pragma unroll
                    for (int g4 = 0; g4 < 4; ++g4) { v2u o; o.x = pk2(accY[4 * g4], accY[4 * g4 + 1]); o.y = pk2(accY[4 * g4 + 2], accY[4 * g4 + 3]); *(GAS v2u*)(yb + 16 * g4) = o; } }
            } else {
#pragma unroll
                for (int q = 0; q < 2; ++q) { const int sw = 2 * (wave - 2) + q, v0 = 32 * (sw & 1), k0 = 32 * (sw >> 1);
                    const float gcv = ((const LAS float*)(tsc + O_GC))[k0 + r32];
#pragma unroll
                    for (int r = 0; r < 16; ++r) accS[q][r] *= gcv;
#pragma unroll
                    for (int s = 0; s < 2; ++s) {
                        accS[q] = __builtin_amdgcn_mfma_f32_32x32x16_bf16(*(const LAS bf16x8*)(tsc + O_VT + (v0 + r32) * RW_P32 + 32 * s + 16 * hi), *(const LAS bf16x8*)(tsc + O_TKP + (k0 + r32) * RW_P32 + 32 * s + 16 * hi), accS[q], 0, 0, 0);
                        accS[q] = __builtin_amdgcn_mfma_f32_32x32x16_bf16(*(const LAS bf16x8*)(lds + RW_UB + (v0 + r32) * RW_P32 + 32 * s + 16 * hi), *(const LAS bf16x8*)(tsc + O_TBP + (k0 + r32) * RW_P32 + 32 * s + 16 * hi), accS[q], 0, 0, 0); } }
#pragma unroll
                for (int q = 0; q < 2; ++q) { const int sw = 2 * (wave - 2) + q, v0 = 32 * (sw & 1), k0 = 32 * (sw >> 1);
#pragma unroll
                    for (int r = 0; r < 16; ++r) *(LAS unsigned short*)(S0nxt + (v0 + rwcrow(r, hi)) * RW_P64 + 2 * (k0 + r32)) = (unsigned short)f2bf(accS[q][r]); } }
        }
        RW_BAR();
    }
#undef RW_LOAD
#undef RW_ROWOFF
    __syncthreads();
}
__device__ __forceinline__ void ph_rwkv(LAS unsigned char* lds, const bf16* P, int T, int nb, const float* mu, const float* w0, const float* w_up, const float* a0, const float* a_up, const float* k_k, const float* k_a, const float* r_k,
                                        bf16* YB, float* CB, bf16* VB, int tid, int bid, int nblk) {
    const int wv = __builtin_amdgcn_readfirstlane(tid >> 6);
#pragma unroll 1
    for (int it = bid; it < nb * 16; it += nblk) { const int z = it & 1, h = (it >> 1) & 7, b = it >> 4; rwkv_item(lds, P, T, z, b, h, mu, w0, w_up, a0, a_up, k_k, k_a, r_k, YB, CB, VB, wv); }
}
}
namespace mk {
constexpr int SS_RP = 272;
constexpr int SS_XP = 144;
constexpr int SS_BM = 0, SS_CM = SS_BM + 128 * SS_RP, SS_XN = SS_CM + 128 * SS_RP, SS_SB = SS_XN + 128 * SS_XP, SS_CUM = SS_SB + 128 * SS_XP, SS_MT = SS_CUM + 1024, SS_END = SS_MT + 10 * 2048;
__device__ __forceinline__ v2u ss_tr(unsigned addr) { v2u r; asm volatile("ds_read_b64_tr_b16 %0, %1" : "=&v"(r) : "v"(addr) : "memory"); return r; }
__device__ __forceinline__ void ss_wait4(v2u& a, v2u& b, v2u& c, v2u& d) { asm volatile("s_waitcnt lgkmcnt(0)" : "+v"(a), "+v"(b), "+v"(c), "+v"(d) :: "memory"); }
constexpr int SS_YP = 144;
static_assert(SS_END <= 147456, "ssd lds"); static_assert(SS_XP % 8 == 0 && SS_RP % 8 == 0, "transpose reads need 8-byte aligned rows");
__device__ __forceinline__ int crow(int r, int hi) { return (r & 3) + 8 * (r >> 2) + 4 * hi; }
__device__ __forceinline__ bf16x8 ldsA(const LAS unsigned char* base, int row, int colbyte) { return *(const LAS bf16x8*)(base + row * SS_RP + colbyte); }
__device__ __forceinline__ unsigned cvtpk(float lo, float hi) { typedef float f2 __attribute__((ext_vector_type(2))); typedef __bf16 b2 __attribute__((ext_vector_type(2))); f2 v = {lo, hi}; b2 b = __builtin_convertvector(v, b2); return __builtin_bit_cast(unsigned, b); }
__device__ __forceinline__ void ssd_item(LAS unsigned char* lds, const bf16* XC, const float* DT, const float* a_log, bf16* YA, int T, int z, int b, int h, const int tid) {
    const int lane = tid & 63, wave = __builtin_amdgcn_readfirstlane(tid >> 6), r32 = lane & 31, hi = lane >> 5;
    const int pt = wave & 1, qt = wave >> 1, g = h >> 2;
    const float a2 = -__expf(a_log[z * 8 + h]) * 1.4426950408889634f;
    LAS float* CUM = (LAS float*)(lds + SS_CUM);
    for (int i = tid; i < 128 * SS_XP / 4; i += 512) ((LAS unsigned*)(lds + SS_SB))[i] = 0u;
    f32x16 accS = f32x16{};
    const size_t tb0 = (size_t)b * SEQ;
    v4u pwb[4], pwc[4], pwx[2]; float pd[2], pl0, pl1;
#define SS_LOAD(cc) do { const GAS unsigned char* Xb_ = (const GAS unsigned char*)XC; const GAS unsigned char* Db_ = (const GAS unsigned char*)DT;     \
    _Pragma("unroll") for (int i = 0; i < 4; ++i) { const int idx = tid + 512 * i, q = idx >> 4, c8 = idx & 15; const int pos = 128 * (cc) + q; const unsigned t = (unsigned)tb0 + (unsigned)(z ? (SEQ - 1 - pos) : pos); \
        const unsigned o_ = (t * 1024u + 512u + (unsigned)(g * 128 + 8 * c8)) * 2u; pwb[i] = *(const GAS v4u*)(Xb_ + o_); pwc[i] = *(const GAS v4u*)(Xb_ + (o_ + 512u)); } \
    _Pragma("unroll") for (int i = 0; i < 2; ++i) { const int idx = tid + 512 * i, q = idx >> 3, c8 = idx & 7; const int pos = 128 * (cc) + q; const unsigned t = (unsigned)tb0 + (unsigned)(z ? (SEQ - 1 - pos) : pos); \
        pwx[i] = *(const GAS v4u*)(Xb_ + (t * 1024u + (unsigned)(h * 64 + 8 * c8)) * 2u); pd[i] = *(const GAS float*)(Db_ + (t * 16u + (unsigned)(z * 8 + h)) * 4u); } \
    { const int p0 = 128 * (cc) + 2 * lane; const unsigned t0 = (unsigned)tb0 + (unsigned)(z ? (SEQ - 1 - p0) : p0), t1 = (unsigned)tb0 + (unsigned)(z ? (SEQ - 2 - p0) : (p0 + 1)); pl0 = *(const GAS float*)(Db_ + (t0 * 16u + (unsigned)(z * 8 + h)) * 4u); pl1 = *(const GAS float*)(Db_ + (t1 * 16u + (unsigned)(z * 8 + h)) * 4u); } } while (0)
    SS_LOAD(0);
#pragma unroll 1
    for (int c = 0; c < SEQ / 128; ++c) {
        asm volatile("s_waitcnt vmcnt(2)" ::: "memory");
        __syncthreads();
#pragma unroll
        for (int i = 0; i < 4; ++i) { const int idx = tid + 512 * i, q = idx >> 4, c8 = idx & 15;
            *(LAS v4u*)(lds + SS_BM + q * SS_RP + 16 * c8) = pwb[i]; *(LAS v4u*)(lds + SS_CM + q * SS_RP + 16 * c8) = pwc[i]; }
#pragma unroll
        for (int i = 0; i < 2; ++i) { const int idx = tid + 512 * i, q = idx >> 3, c8 = idx & 7; const v4u wx = pwx[i]; const float d = pd[i]; v4u o;
            o.x = pk2(bflo(wx.x) * d, bfhi(wx.x) * d); o.y = pk2(bflo(wx.y) * d, bfhi(wx.y) * d); o.z = pk2(bflo(wx.z) * d, bfhi(wx.z) * d); o.w = pk2(bflo(wx.w) * d, bfhi(wx.w) * d);
            *(LAS v4u*)(lds + SS_XN + q * SS_XP + 16 * c8) = o; }
        if (wave == 0) {
            const float l0 = pl0 * a2, l1 = pl1 * a2; float x = l0 + l1;
#pragma unroll
            for (int o = 1; o < 64; o <<= 1) { const float y = __builtin_bit_cast(float, __builtin_amdgcn_ds_bpermute(((lane - o) & 63) << 2, __builtin_bit_cast(int, x))); x += (lane >= o) ? y : 0.f; }
            *(LAS f32x2v*)(CUM + 2 * lane) = (f32x2v){x - l1, x}; }
        asm volatile("" ::: "memory"); __builtin_amdgcn_sched_barrier(0);
        SS_LOAD(c + 1 < SEQ / 128 ? c + 1 : c);
        __builtin_amdgcn_sched_barrier(0);
        __syncthreads();
        const float cq = CUM[32 * qt + r32], clast = CUM[127];
        f32x16 acc = f32x16{};
        { bf16x8 cf[8];
#pragma unroll
          for (int s = 0; s < 8; ++s) cf[s] = ldsA(lds + SS_CM, 32 * qt + r32, 32 * s + 16 * hi);
          { const unsigned sa = (unsigned)(uintptr_t)(lds + SS_SB) + (unsigned)((8 * hi + ((lane & 15) >> 2)) * SS_XP + (32 * pt + 16 * ((lane >> 4) & 1) + 4 * (lane & 3)) * 2);
            v2u sl[8], sh[8];
#pragma unroll
            for (int s = 0; s < 8; ++s) { sl[s] = ss_tr(sa + 16 * s * SS_XP); sh[s] = ss_tr(sa + (16 * s + 4) * SS_XP); }
#pragma unroll
            for (int s = 0; s < 4; ++s) ss_wait4(sl[2 * s], sh[2 * s], sl[2 * s + 1], sh[2 * s + 1]);
#pragma unroll
            for (int s = 0; s < 8; ++s) { v4u av; av.x = sl[s].x; av.y = sl[s].y; av.z = sh[s].x; av.w = sh[s].y; acc = __builtin_amdgcn_mfma_f32_32x32x16_bf16(__builtin_bit_cast(bf16x8, av), cf[s], acc, 0, 0, 0); } }
          const float eq = __builtin_amdgcn_exp2f(cq);
#pragma unroll
          for (int r = 0; r < 16; ++r) acc[r] *= eq; }
#pragma unroll 1
        for (int tI = wave; tI < 10; tI += 8) { const int q2 = tI < 1 ? 0 : (tI < 3 ? 1 : (tI < 6 ? 2 : 3)), kt = tI - q2 * (q2 + 1) / 2; const float cq2 = CUM[32 * q2 + r32];
            f32x16 gT = f32x16{};
#pragma unroll
            for (int s = 0; s < 8; ++s) gT = __builtin_amdgcn_mfma_f32_32x32x16_bf16(ldsA(lds + SS_BM, 32 * kt + r32, 32 * s + 16 * hi), ldsA(lds + SS_CM, 32 * q2 + r32, 32 * s + 16 * hi), gT, 0, 0, 0);
#pragma unroll
            for (int gq = 0; gq < 4; ++gq) { const f32x4 ck = *(const LAS f32x4*)(CUM + 32 * kt + 8 * gq + 4 * hi);
#pragma unroll
                for (int e = 0; e < 4; ++e) { const int r = 4 * gq + e; const bool ok = (kt < q2) || (8 * gq + 4 * hi + e <= r32); const float m = __builtin_amdgcn_exp2f(cq2 - ck[e]); gT[r] = ok ? gT[r] * m : 0.f; } }
            v4u m0, m1; m0.x = cvtpk(gT[0], gT[1]); m0.y = cvtpk(gT[2], gT[3]); m0.z = cvtpk(gT[4], gT[5]); m0.w = cvtpk(gT[6], gT[7]); m1.x = cvtpk(gT[8], gT[9]); m1.y = cvtpk(gT[10], gT[11]); m1.z = cvtpk(gT[12], gT[13]); m1.w = cvtpk(gT[14], gT[15]);
            *(LAS v4u*)(lds + SS_MT + tI * 2048 + lane * 32) = m0; *(LAS v4u*)(lds + SS_MT + tI * 2048 + lane * 32 + 16) = m1; }
        __syncthreads();
#pragma unroll
        for (int kh = 0; kh < 2; ++kh) {
            v2u xl[2][4]; v4u mm[2][2];
#pragma unroll
            for (int k2 = 0; k2 < 2; ++k2) { const int kt = 2 * kh + k2, ktc = kt <= qt ? kt : qt;
                const unsigned xa = (unsigned)(uintptr_t)(lds + SS_XN) + (unsigned)((32 * ktc + 4 * hi + ((lane & 15) >> 2)) * SS_XP + (32 * pt + 16 * ((lane >> 4) & 1) + 4 * (lane & 3)) * 2);
                xl[k2][0] = ss_tr(xa); xl[k2][1] = ss_tr(xa + 8 * SS_XP); xl[k2][2] = ss_tr(xa + 16 * SS_XP); xl[k2][3] = ss_tr(xa + 24 * SS_XP);
                const LAS unsigned char* mp = lds + SS_MT + (qt * (qt + 1) / 2 + ktc) * 2048 + lane * 32; mm[k2][0] = *(const LAS v4u*)mp; mm[k2][1] = *(const LAS v4u*)(mp + 16); }
#pragma unroll
            for (int k2 = 0; k2 < 2; ++k2) { const int kt = 2 * kh + k2; ss_wait4(xl[k2][0], xl[k2][1], xl[k2][2], xl[k2][3]);
                if (kt <= qt) { v4u a0; a0.x = xl[k2][0].x; a0.y = xl[k2][0].y; a0.z = xl[k2][1].x; a0.w = xl[k2][1].y; v4u a1; a1.x = xl[k2][2].x; a1.y = xl[k2][2].y; a1.z = xl[k2][3].x; a1.w = xl[k2][3].y;
                    acc = __builtin_amdgcn_mfma_f32_32x32x16_bf16(__builtin_bit_cast(bf16x8, a0), __builtin_bit_cast(bf16x8, mm[k2][0]), acc, 0, 0, 0);
                    acc = __builtin_amdgcn_mfma_f32_32x32x16_bf16(__builtin_bit_cast(bf16x8, a1), __builtin_bit_cast(bf16x8, mm[k2][1]), acc, 0, 0, 0); } } }
        __syncthreads();
        { LAS unsigned short* ys = (LAS unsigned short*)(lds + SS_CM + (32 * qt + r32) * SS_YP) + 32 * pt;
#pragma unroll
          for (int g4 = 0; g4 < 4; ++g4) { v2u o; o.x = pk2(acc[4 * g4], acc[4 * g4 + 1]); o.y = pk2(acc[4 * g4 + 2], acc[4 * g4 + 3]); *(LAS v2u*)(ys + 8 * g4 + 4 * hi) = o; } }
        { const int q = tid >> 2, p0 = 16 * (tid & 3); LAS unsigned char* xr = lds + SS_XN + q * SS_XP + 2 * p0; v4u w0 = *(LAS v4u*)xr, w1 = *(LAS v4u*)(xr + 16);
          const float e = __builtin_amdgcn_exp2f(clast - CUM[q]);
          w0.x = pk2(bflo(w0.x) * e, bfhi(w0.x) * e); w0.y = pk2(bflo(w0.y) * e, bfhi(w0.y) * e); w0.z = pk2(bflo(w0.z) * e, bfhi(w0.z) * e); w0.w = pk2(bflo(w0.w) * e, bfhi(w0.w) * e);
          w1.x = pk2(bflo(w1.x) * e, bfhi(w1.x) * e); w1.y = pk2(bflo(w1.y) * e, bfhi(w1.y) * e); w1.z = pk2(bflo(w1.z) * e, bfhi(w1.z) * e); w1.w = pk2(bflo(w1.w) * e, bfhi(w1.w) * e);
          *(LAS v4u*)xr = w0; *(LAS v4u*)(xr + 16) = w1; }
        __syncthreads();
#pragma unroll
        for (int i = 0; i < 2; ++i) { const int idx = tid + 512 * i, q = idx >> 3, c8 = idx & 7; const int pos = 128 * c + q; const size_t t = tb0 + (z ? (SEQ - 1 - pos) : pos);
            *(GAS v4u*)(YA + ((size_t)z * T + t) * 512 + h * 64 + 8 * c8) = *(const LAS v4u*)(lds + SS_CM + q * SS_YP + 16 * c8); }
        { const float dl = __builtin_amdgcn_exp2f(clast);
#pragma unroll
          for (int r = 0; r < 16; ++r) accS[r] *= dl;
          { const int rq = 8 * hi + ((lane & 15) >> 2), cg = 16 * ((lane >> 4) & 1) + 4 * (lane & 3);
            const unsigned xa = (unsigned)(uintptr_t)(lds + SS_XN) + (unsigned)(rq * SS_XP + (32 * pt + cg) * 2), ba = (unsigned)(uintptr_t)(lds + SS_BM) + (unsigned)(rq * SS_RP + (32 * qt + cg) * 2);
            v2u al[8], ah[8], bl[8], bh[8];
#pragma unroll
            for (int s = 0; s < 8; ++s) { al[s] = ss_tr(xa + 16 * s * SS_XP); ah[s] = ss_tr(xa + (16 * s + 4) * SS_XP); bl[s] = ss_tr(ba + 16 * s * SS_RP); bh[s] = ss_tr(ba + (16 * s + 4) * SS_RP); }
#pragma unroll
            for (int s = 0; s < 8; ++s) ss_wait4(al[s], ah[s], bl[s], bh[s]);
#pragma unroll
            for (int s = 0; s < 8; ++s) { v4u av; av.x = al[s].x; av.y = al[s].y; av.z = ah[s].x; av.w = ah[s].y; v4u bv; bv.x = bl[s].x; bv.y = bl[s].y; bv.z = bh[s].x; bv.w = bh[s].y;
                accS = __builtin_amdgcn_mfma_f32_32x32x16_bf16(__builtin_bit_cast(bf16x8, av), __builtin_bit_cast(bf16x8, bv), accS, 0, 0, 0); } }
          LAS unsigned char* sb = lds + SS_SB + (32 * qt + r32) * SS_XP + (32 * pt + 4 * hi) * 2;
#pragma unroll
          for (int g4 = 0; g4 < 4; ++g4) { v2u o; o.x = pk2(accS[4 * g4], accS[4 * g4 + 1]); o.y = pk2(accS[4 * g4 + 2], accS[4 * g4 + 3]); *(LAS v2u*)(sb + 16 * g4) = o; } }
    }
#undef SS_LOAD
    __syncthreads();
}
__device__ __forceinline__ void ph_ssd(LAS unsigned char* lds, const bf16* XC, const float* DT, const float* a_log, bf16* YA, int T, int nb, int tid, int bid, int nblk, int blk0) {
#pragma unroll 1
    for (int it = (bid - blk0 + nblk) % nblk; it < nb * 16; it += nblk) { const int z = it & 1, h = (it >> 1) & 7, b = it >> 4; ssd_item(lds, XC, DT, a_log, YA, T, z, b, h, tid); }
}
}
namespace mk {
#define XB_TMO      128
#define XB_XCNT(j)  (256  + 64 * (j))
#define XB_XSUB(j)  (1280 + 64 * (j))
#define XB_XGEN(j)  (2304 + 64 * (j))
#define XB_TOP      3328
#define XB_TOPGEN   3392
#define XCD_BAR_WORDS 3456
#define XB_SPIN_CAP (1u << 18)

__device__ __forceinline__ unsigned xb_ld(unsigned* p)              { return __hip_atomic_load(p, __ATOMIC_RELAXED, __HIP_MEMORY_SCOPE_AGENT); }
__device__ __forceinline__ unsigned xb_add(unsigned* p, unsigned v) { return __hip_atomic_fetch_add(p, v, __ATOMIC_RELAXED, __HIP_MEMORY_SCOPE_AGENT); }
__device__ __forceinline__ unsigned xb_xcc_id() { return (unsigned)__builtin_amdgcn_s_getreg((3 << 11) | 20) & 0xFu; }
#define XB_SPIN(cond, bar) do { unsigned _sp = 0; while (cond) { __builtin_amdgcn_s_sleep(1); \
    if ((++_sp & 255u) == 0u) { if (xb_ld(&(bar)[XB_TMO])) break; if (_sp > XB_SPIN_CAP) { atomicAdd(&(bar)[XB_TMO], 1u); break; } } } } while (0)

struct XcdBarrier {
    unsigned* bar; unsigned x;
    volatile LAS unsigned* st;
};

__device__ __forceinline__ XcdBarrier xcd_barrier_post(unsigned* bar, volatile LAS unsigned* st) {
    XcdBarrier b; b.bar = bar; b.x = xb_xcc_id(); b.st = st;
    if (threadIdx.x == 0) (void)xb_add(&bar[XB_XCNT(b.x)], 1u);
    return b;
}
__device__ __forceinline__ void xcd_barrier_complete(unsigned* bar, unsigned x, unsigned& nloc, unsigned& nx) {
    const unsigned G = gridDim.x * gridDim.y * gridDim.z;
    unsigned sum, cnt, mine, sp = 0u;
    for (;;) {
        sum = 0u; cnt = 0u; mine = 0u;
#pragma unroll
        for (unsigned j = 0; j < 16; ++j) { const unsigned c = xb_ld(&bar[XB_XCNT(j)]); sum += c; cnt += (c > 0u) ? 1u : 0u; mine = (j == x) ? c : mine; }
        if (sum == G) break;
        __builtin_amdgcn_s_sleep(1);
        if ((++sp & 255u) == 0u) { if (xb_ld(&bar[XB_TMO])) break; if (sp > XB_SPIN_CAP) { atomicAdd(&bar[XB_TMO], 1u); break; } }
    }
    nloc = mine > 0u ? mine : 1u; nx = cnt > 0u ? cnt : 1u;
}

__device__ __forceinline__ void xcd_barrier(const XcdBarrier& b) {
    asm volatile("s_waitcnt vmcnt(0)" ::: "memory");
    __syncthreads();
    if (threadIdx.x == 0) {
        unsigned* bar = b.bar;
        __builtin_amdgcn_s_waitcnt(0);
        unsigned nloc = b.st[0], nx = b.st[1];
        if (nloc == 0u) { xcd_barrier_complete(bar, b.x, nloc, nx); b.st[0] = nloc; b.st[1] = nx; }
        const unsigned old = xb_add(&bar[XB_XSUB(b.x)], 1u);
        const unsigned gen = old / nloc;
        if (old + 1u == (gen + 1u) * nloc) {
            __builtin_amdgcn_fence(__ATOMIC_RELEASE, "agent");
            asm volatile("s_waitcnt vmcnt(0)" ::: "memory");
            const unsigned og = xb_add(&bar[XB_TOP], 1u);
            const unsigned tg = og / nx;
            if (og + 1u == (tg + 1u) * nx) xb_add(&bar[XB_TOPGEN], 1u);
            else XB_SPIN(xb_ld(&bar[XB_TOPGEN]) == tg, bar);
            __builtin_amdgcn_fence(__ATOMIC_ACQUIRE, "agent");
            xb_add(&bar[XB_XGEN(b.x)], 1u);
            asm volatile("s_waitcnt vmcnt(0)" ::: "memory");
        } else {
            XB_SPIN(xb_ld(&bar[XB_XGEN(b.x)]) == gen, bar);
            __builtin_amdgcn_fence(__ATOMIC_ACQUIRE, "agent");
            asm volatile("s_waitcnt vmcnt(0)" ::: "memory");
        }
    }
    __syncthreads();
}


}
#include <hip/hip_cooperative_groups.h>
namespace mk {
namespace cg = cooperative_groups;
constexpr int LDS_BYTES = 163840;
constexpr int NB_HALF = 8, TH = NB_HALF * SEQ;
constexpr size_t al256(size_t x) { return (x + 255) / 256 * 256; }
constexpr size_t WS_CTL = 0, CTL_BYTES = 65536, WS_W = CTL_BYTES, WS_ROPE = al256(WS_W + 2 * W_LAYER_ELEMS * 2), WS_H = al256(WS_ROPE + 2ull * SEQ * 32 * 4), WS_P = al256(WS_H + (size_t)TH * 1024 * 2), WS_X = al256(WS_P + (size_t)TH * LDP * 2);
constexpr size_t X_XC = 0, X_DT = al256(X_XC + (size_t)TH * 1024 * 2), X_QN = al256(X_DT + (size_t)TH * 16 * 4), X_KN = al256(X_QN + (size_t)TH * 512 * 2), X_YA = al256(X_KN + (size_t)TH * 128 * 2),
                 X_YB = al256(X_YA + 2ull * TH * 512 * 2), X_CB = al256(X_YB + 2ull * TH * 512 * 2), X_VB = al256(X_CB + 2ull * TH * 8 * 4), X_RS = al256(X_VB + (size_t)TH * 512 * 2), X_END1 = al256(X_RS + 9ull * SEQ * 512 * 4);
constexpr size_t X_MF = 0, X_MB = al256(X_MF + (size_t)TH * 1024 * 4), X_OF = al256(X_MB + (size_t)TH * 1024 * 2), X_END2 = al256(X_OF + (size_t)TH * 1024 * 4);
constexpr size_t WS_NEED = WS_X + (X_END1 > X_END2 ? X_END1 : X_END2);
static_assert(WS_NEED <= 536870912ull, "workspace map exceeds 512 MiB");
struct MegaArgs { const float* in[25]; float* out; unsigned char* ws; };
__global__ __launch_bounds__(512, 2) void k_mega(MegaArgs a) {
    extern __shared__ __attribute__((aligned(16))) unsigned char lds_[];
    LAS unsigned char* const lds = (LAS unsigned char*)(unsigned)0;
    cg::grid_group grid = cg::this_grid();
    volatile LAS unsigned* xbst = (volatile LAS unsigned*)(lds + LDS_BYTES - 16);
    if (threadIdx.x < 4) xbst[threadIdx.x] = 0u;
    __syncthreads();
    XcdBarrier xbar = xcd_barrier_post((unsigned*)(a.ws + WS_CTL), xbst);
#define GSYNC() xcd_barrier(xbar)
    const int wave0 = __builtin_amdgcn_readfirstlane((int)threadIdx.x >> 6);
#define PV int bid = blockIdx.x, wv_ = wave0; unsigned mk_ = ~0u; unsigned char* ws = a.ws; asm volatile("" : "+s"(bid), "+s"(wv_), "+s"(mk_), "+s"(ws)); int tid = wv_ * 64 + (int)__builtin_amdgcn_mbcnt_hi(mk_, __builtin_amdgcn_mbcnt_lo(mk_, 0u)); asm volatile("" : "+v"(tid)); const int lane = tid & 63, wave = wv_; const int gw = bid * 8 + wave, ngw = gridDim.x * 8, gtid = bid * 512 + tid, nthr = gridDim.x * 512; (void)lane; (void)wave; (void)gw; (void)ngw; (void)gtid; (void)nthr; bf16* Wall = (bf16*)(ws + WS_W); float* rope = (float*)(ws + WS_ROPE); bf16* H = (bf16*)(ws + WS_H); bf16* P = (bf16*)(ws + WS_P); unsigned char* X = ws + WS_X; bf16* XC = (bf16*)(X + X_XC); float* DT = (float*)(X + X_DT); bf16* Qn = (bf16*)(X + X_QN); bf16* Kn = (bf16*)(X + X_KN); bf16* YA = (bf16*)(X + X_YA); bf16* YB = (bf16*)(X + X_YB); float* CB = (float*)(X + X_CB); bf16* VB = (bf16*)(X + X_VB); float* Mf = (float*)(X + X_MF); bf16* Mb = (bf16*)(X + X_MB); float* OF = (float*)(X + X_OF); const bf16* W = Wall + (size_t)l * W_LAYER_ELEMS; (void)rope; (void)H; (void)P; (void)XC; (void)DT; (void)Qn; (void)Kn; (void)YA; (void)YB; (void)CB; (void)VB; (void)Mf; (void)Mb; (void)OF; (void)W;
    { const int l = 0; PV; ph_wconv(a.in[2], a.in[22], a.in[23], Wall, lds, gw, ngw, wave, lane); }
    { const int l = 0; PV; ph_rope_table(rope, gtid, nthr); }
    { const int l = 0; PV; ph_rmsnorm(a.in[0], a.in[1], H, TH, gw, ngw, lane); }
    grid.sync();
#pragma unroll 1
    for (int hf = 0; hf < 2; ++hf) {
#pragma unroll 1
        for (int l = 0; l < 2; ++l) {
            const size_t ro = (size_t)hf * TH * 1024; const float* xin = (l == 0 ? a.in[0] : a.out) + ro; float* xout = a.out + ro;
            { PV; ph_gemm_bf16out_range(lds, H, 1024, W + WOFF_W1, TH, (int)W1T_N, 1024, P, LDP, 0, 7, tid, bid); }
            GSYNC();
            { const int G_ = (int)gridDim.x, nwg_ = (TH / 256) * ((int)W1T_N / 256); int nb8 = nwg_ - 7 * G_; nb8 = nb8 < 0 ? 0 : (nb8 > G_ ? G_ : nb8);
              const bool ov = (7 * G_ >= 960) && (nb8 < G_);
              if (!ov || (int)blockIdx.x < nb8) { PV; ph_gemm_bf16out_range(lds, H, 1024, W + WOFF_W1, TH, (int)W1T_N, 1024, P, LDP, 7, 1 << 20, tid, bid); }
              if (!ov) GSYNC();
              if (!ov || (int)blockIdx.x >= nb8) { PV; const int off = ov ? nb8 * 512 : 0; ph_prep_conv(P, TH, a.in[3] + l * 5 * 1024, a.in[4] + l * 1024, a.in[5] + l * 16, XC, DT, gtid - off, nthr - off); } }
            { PV; ph_prep_gqa(P, TH, a.in[19] + l * 64, a.in[20] + l * 64, rope, Qn, Kn, gtid, nthr); }
            GSYNC();
            { PV; ph_rwkv(lds, P, TH, NB_HALF, a.in[9] + l * 2 * 1792, a.in[10] + l * 1024, a.in[11] + (size_t)l * 2 * 64 * 512, a.in[12] + l * 1024, a.in[13] + (size_t)l * 2 * 64 * 512, a.in[14] + l * 512, a.in[15] + l * 512, a.in[16] + l * 512, YB, CB, VB, tid, bid, (int)gridDim.x); }
            { PV; ph_ssd(lds, XC, DT, a.in[6] + l * 16, YA, TH, NB_HALF, tid, bid, (int)gridDim.x, 128); }
            { PV; ph_attn((char*)lds_, P, Qn, Kn, a.in[21] + l * 8 * 465, NB_HALF, tid, (unsigned*)(ws + WS_CTL) + 8192 + 64 * (2 * l + hf), (volatile LAS unsigned*)(lds + LDS_BYTES - 8)); }
            GSYNC();
            { PV; ph_post(P, TH, XC, YA, a.in[7] + l * 8, a.in[8] + l * 512, YB, CB, VB, a.in[17] + l * 512, a.in[18] + l * 512, gw, ngw, lane); }
            { PV; ph_gemm_rsigout(lds, H, 1024, W + WOFF_W2, TH, (int)W2T_N, 1024, P, LDP, tid, bid); }
            GSYNC();
            { PV; EpiMergeF E{Mb, P, LDP}; run_gemm(lds, P + PC_Y, LDP, W + WOFF_WB, TH, 1024, 2048, E, tid, bid); }
            GSYNC();
            { PV; EpiF32 E{OF, 1024}; run_gemm(lds, Mb, 1024, W + WOFF_WO, TH, 1024, 1024, E, tid, bid); }
            GSYNC();
            { PV; ph_fin(xin, OF, a.in[24] + l * 1024, xout, l == 0 ? a.in[1] + 1024 : nullptr, H, TH, gw, ngw, lane); }
            if (l == 1 && hf == 0) { PV; ph_rmsnorm(a.in[0] + (size_t)TH * 1024, a.in[1], H, TH, gw, ngw, lane); }
            GSYNC();
        }
    }
}
}
extern "C" void kernel_launch(void* const* d_in, const int* in_sizes, int n_in, void* d_out, int out_size, void* d_ws, size_t ws_size, hipStream_t stream) {
    static int grid_blocks = 0;
    if (!grid_blocks) {
        if (ws_size < mk::WS_NEED) { fprintf(stderr, "ws too small: need %zu have %zu\n", (size_t)mk::WS_NEED, ws_size); grid_blocks = -1; return; }
        int dev = 0, cus = 0, per_cu = 0; (void)hipGetDevice(&dev); (void)hipDeviceGetAttribute(&cus, hipDeviceAttributeMultiprocessorCount, dev);
        (void)hipFuncSetAttribute((const void*)mk::k_mega, hipFuncAttributeMaxDynamicSharedMemorySize, mk::LDS_BYTES);
        (void)hipOccupancyMaxActiveBlocksPerMultiprocessor(&per_cu, (const void*)mk::k_mega, 512, mk::LDS_BYTES);
        if (per_cu < 1) { fprintf(stderr, "occupancy query says %d blocks/CU\n", per_cu); per_cu = 1; }
        grid_blocks = cus;
        fprintf(stderr, "k_mega: cus %d per_cu %d grid %d ws_need %zu ws %zu\n", cus, per_cu, grid_blocks, (size_t)mk::WS_NEED, ws_size);
    }
    if (grid_blocks < 0) return;
    mk::MegaArgs a{}; for (int i = 0; i < 25; ++i) a.in[i] = (const float*)d_in[i]; a.out = (float*)d_out; a.ws = (unsigned char*)d_ws;
    (void)hipMemsetAsync((char*)d_ws + mk::WS_CTL, 0, mk::CTL_BYTES, stream);
    void* args[] = {(void*)&a};
    hipError_t e = hipLaunchCooperativeKernel((const void*)mk::k_mega, dim3(grid_blocks), dim3(512), args, mk::LDS_BYTES, stream);
    if (e != hipSuccess) fprintf(stderr, "cooperative launch failed: %s (grid %d)\n", hipGetErrorString(e), grid_blocks);
}
```

```cpp
#include <hip/hip_runtime.h>
#include <cstdio>
#include <cstdint>
#include <cmath>
namespace pg8 {
#define PG8_LAS __attribute__((address_space(3)))
typedef unsigned short bf16_t;
typedef short bf16x8 __attribute__((ext_vector_type(8)));
typedef float f32x4 __attribute__((ext_vector_type(4)));
typedef unsigned u32x4 __attribute__((ext_vector_type(4)));
constexpr int BM = 256, BK = 64, HALF = 128, HTB = HALF * BK * 2  , STAGE_BYTES = 8 * HTB, NXCD = 8, WGM = 8;

__host__ __device__ __forceinline__ int lds_byte(int r, int c) { const int st = (r >> 4) * 2 + (c >> 5), rr = r & 15, cc = c & 31, ob = rr * 64 + cc * 2; return st * 1024 + (ob ^ (((ob >> 9) & 1) << 5)); }
__host__ __device__ __forceinline__ void stage_rc(int b, int& R, int& C) { const int st = b / 1024, sb = b % 1024, swz = sb ^ (((sb >> 9) & 1) << 5); R = (st >> 1) * 16 + swz / 64; C = (st & 1) * 32 + (swz % 64) / 2; }
__host__ __device__ __forceinline__ int perm32(int rho) { const int n = rho >> 4, i = rho & 15; return 8 * (i >> 2) + 4 * n + (i & 3); }

struct Unit { int pm, pn; };
struct Gemm { const bf16_t* A; const bf16_t* Bt; int M, N, K, lda; };

struct StaticOrder {
    int nM, nN, nwg, G, c;
    __host__ __device__ void init(int M, int N, int G_, int c_) { nM = M / BM; nN = N / BM; nwg = nM * nN; G = G_; c = c_; }
    __host__ __device__ bool next(int i, Unit& u) const {
        const long L = (long)i * G + c; if (L >= nwg) return false;
        int wgid = (int)L; { const int q = nwg / NXCD, r = nwg % NXCD, xcd = wgid % NXCD, off = wgid / NXCD; wgid = (xcd < r ? xcd * (q + 1) : r * (q + 1) + (xcd - r) * q) + off; }
        const int nig = WGM * nN, gid = wgid / nig, fm = gid * WGM, gsz = (nM - fm) < WGM ? (nM - fm) : WGM;
        u.pm = fm + ((wgid % nig) % gsz); u.pn = (wgid % nig) / gsz; return true;
    }
    __device__ __forceinline__ void a_ready(const Unit&) const {}
    __device__ __forceinline__ void done(const Unit&) const {}
};

__device__ __forceinline__ unsigned cvt_pk_bf16(float lo, float hi) { unsigned r; asm volatile("v_cvt_pk_bf16_f32 %0, %1, %2" : "=v"(r) : "v"(lo), "v"(hi)); return r; }
typedef float f32x2 __attribute__((ext_vector_type(2)));
__device__ __forceinline__ f32x2 gelu_pk(f32x2 v) {
    const f32x2 av = __builtin_elementwise_abs(v), d = av * 0.2316418882f + 1.0f;
    f32x2 t; t.x = __builtin_amdgcn_rcpf(d.x); t.y = __builtin_amdgcn_rcpf(d.y);
    f32x2 q = t * 0.5307027145f + (-0.7265760135f); q = q * t + 0.7107068705f; q = q * t + (-0.142248368f); q = q * t + 0.127414796f; q = q * t;
    const f32x2 s = (v * v) * (-0.72134752044f);
    f32x2 e; e.x = __builtin_amdgcn_exp2f(s.x); e.y = __builtin_amdgcn_exp2f(s.y);
    const f32x2 m = v * (q * e), r = v - m;
    f32x2 o; o.x = v.x < 0.f ? m.x : r.x; o.y = v.y < 0.f ? m.y : r.y; return o;
}

template <int ACT  > struct EpiBf16 {
    static constexpr bool PERM = true, AFTER_DRAIN = false, FOLD = false; static_assert(ACT >= 0 && ACT <= 2, "EpiBf16: ACT is 0 (none), 1 (gelu_pk) or 2 (1 + exp(-x), the reciprocal sigmoid)");
    bf16_t* O; int ldc; const float* bias; int split_cols; size_t split_stride; float scale0;
    __device__ __forceinline__ void operator()(const f32x4 (&acc)[2][2][4][2], const Unit& u, int wr, int wc, int fr, int fq) const {
        const int row0 = u.pm * BM + wr * 64 + fr; int colt = u.pn * BM; bf16_t* base = O;
        float sc = 1.f; if (split_cols) { const int t = colt / split_cols; base += (size_t)t * split_stride; colt -= t * split_cols; if (t == 0) sc = scale0; }
        const int col0 = colt + wc * 32 + 8 * fq, bcol0 = u.pn * BM + wc * 32 + 8 * fq;
        f32x4 bv[2][2];
#pragma unroll
        for (int bj = 0; bj < 2; ++bj)
#pragma unroll
            for (int n = 0; n < 2; ++n) bv[bj][n] = bias ? *(const f32x4*)(bias + bcol0 + bj * HALF + 4 * n) : (f32x4){0.f, 0.f, 0.f, 0.f};
#pragma unroll
        for (int ai = 0; ai < 2; ++ai)
#pragma unroll
            for (int m = 0; m < 4; ++m) { bf16_t* rowp = base + (size_t)(row0 + ai * HALF + m * 16) * ldc + col0;
#pragma unroll
                for (int bj = 0; bj < 2; ++bj) { f32x4 v0 = acc[ai][bj][m][0] + bv[bj][0], v1 = acc[ai][bj][m][1] + bv[bj][1];
                    if (ACT == 1) { f32x2 a = gelu_pk((f32x2){v0[0], v0[1]}), b = gelu_pk((f32x2){v0[2], v0[3]}), c = gelu_pk((f32x2){v1[0], v1[1]}), d = gelu_pk((f32x2){v1[2], v1[3]});
                        v0 = (f32x4){a.x, a.y, b.x, b.y}; v1 = (f32x4){c.x, c.y, d.x, d.y}; }
                    if (ACT == 2) { _Pragma("unroll") for (int e = 0; e < 4; ++e) { v0[e] = 1.f + __builtin_amdgcn_exp2f(__builtin_fminf(__builtin_fmaxf(v0[e], -60.f), 60.f) * -1.4426950408889634f); v1[e] = 1.f + __builtin_amdgcn_exp2f(__builtin_fminf(__builtin_fmaxf(v1[e], -60.f), 60.f) * -1.4426950408889634f); } }
                    v0 = v0 * sc; v1 = v1 * sc; u32x4 w; w.x = cvt_pk_bf16(v0[0], v0[1]); w.y = cvt_pk_bf16(v0[2], v0[3]); w.z = cvt_pk_bf16(v1[0], v1[1]); w.w = cvt_pk_bf16(v1[2], v1[3]);
                    *(u32x4*)(rowp + bj * HALF) = w; } }
    }
};
template <class Epi, class Sched, bool ALIGN_EPI = false, bool SP2 = false>
__device__ __forceinline__ void gemm_phase(PG8_LAS unsigned char* lds, const Gemm g, const Sched& S, const Epi& E, const int tid) {
    const int wid = __builtin_amdgcn_readfirstlane(tid >> 6), lane = tid & 63, wr = wid >> 2, wc = wid & 3, fr = lane & 15, fq = lane >> 4;
    const int K = g.K, nt = K / BK;
    unsigned voffA[2], voffB[2];
#pragma unroll
    for (int i = 0; i < 2; ++i) { int R, C; stage_rc(tid * 16 + i * 8192, R, C); const int Rb = Epi::PERM ? ((R & ~31) + perm32(R & 31)) : R;
        voffA[i] = (unsigned)(R * g.lda + C) * 2u; voffB[i] = (unsigned)(Rb * K + C) * 2u; }
    const size_t kstep = (size_t)(BK * 2);
    const size_t hstep = (size_t)HALF * K * 2;
    const size_t tstep = 2 * hstep;
    const size_t hstepA = (size_t)HALF * g.lda * 2, tstepA = 2 * hstepA;
    const unsigned ldsw = (unsigned)wid * 1024u;
    const int aoff = lds_byte(wr * 64 + fr, fq * 8), boff = lds_byte(wc * 32 + fr, fq * 8);
#define PG8_SA(b, h) (((b) * 2 + (h)) * HTB)
#define PG8_SB(b, h) ((4 + (b) * 2 + (h)) * HTB)
#define PG8_STAGE(bufoff, gbase, voff) do { _Pragma("unroll") for (int _i = 0; _i < 2; ++_i) \
        __builtin_amdgcn_global_load_lds((const unsigned*)((const char*)(gbase) + (voff)[_i]), (PG8_LAS unsigned*)(lds + (bufoff) + ldsw + _i * 8192), 16, 0, 0); } while (0)
#define PG8_LDA(dst, b, h) do { _Pragma("unroll") for (int m = 0; m < 4; ++m) _Pragma("unroll") for (int k = 0; k < 2; ++k) dst[m][k] = *(const PG8_LAS bf16x8*)(lds + PG8_SA(b, h) + aoff + m * 2048 + k * 1024); } while (0)
#define PG8_LDB(dst, b, h) do { _Pragma("unroll") for (int n = 0; n < 2; ++n) _Pragma("unroll") for (int k = 0; k < 2; ++k) dst[n][k] = *(const PG8_LAS bf16x8*)(lds + PG8_SB(b, h) + boff + n * 2048 + k * 1024); } while (0)
#define PG8_MMA(ai, bj, At, Bt) do { __builtin_amdgcn_s_setprio(1); _Pragma("unroll") for (int m = 0; m < 4; ++m) _Pragma("unroll") for (int n = 0; n < 2; ++n) _Pragma("unroll") for (int k = 0; k < 2; ++k) \
        acc[ai][bj][m][n] = __builtin_amdgcn_mfma_f32_16x16x32_bf16(Bt[n][k], At[m][k], acc[ai][bj][m][n], 0, 0, 0); __builtin_amdgcn_s_setprio(0); } while (0)
#define PG8_WAIT_V(n) asm volatile("s_waitcnt vmcnt(" #n ")" ::: "memory")
#define PG8_WAIT_L(n) asm volatile("s_waitcnt lgkmcnt(" #n ")" ::: "memory")
#define PG8_BAR __builtin_amdgcn_s_barrier()
#define PG8_SCHED __builtin_amdgcn_sched_barrier(0)
    Unit cur, nxt; int ui = 0;
    if (!S.next(0, cur)) return;
    f32x4 acc[2][2][4][2];
#pragma unroll
    for (int a = 0; a < 2; ++a)
#pragma unroll
        for (int b = 0; b < 2; ++b)
#pragma unroll
            for (int m = 0; m < 4; ++m)
#pragma unroll
                for (int n = 0; n < 2; ++n) acc[a][b][m][n] = (f32x4){0.f, 0.f, 0.f, 0.f};
    bf16x8 At[4][2], B0[2][2], B1[2][2];
    const char* cA = (const char*)g.A + (size_t)cur.pm * tstepA; const char* cB = (const char*)g.Bt + (size_t)cur.pn * tstep;
    S.a_ready(cur);
    if constexpr (SP2) {
        PG8_STAGE(PG8_SB(0, 0), cB, voffB); PG8_STAGE(PG8_SB(0, 1), cB + hstep, voffB); PG8_STAGE(PG8_SA(0, 0), cA, voffA); PG8_STAGE(PG8_SA(0, 1), cA + hstepA, voffA);
        if (wr == 1) PG8_BAR;
        PG8_WAIT_V(2); PG8_BAR;
        PG8_STAGE(PG8_SB(1, 0), cB + kstep, voffB); PG8_STAGE(PG8_SA(1, 0), cA + kstep, voffA); PG8_STAGE(PG8_SB(1, 1), cB + hstep + kstep, voffB);
        PG8_WAIT_V(6); PG8_BAR;
    } else {
        PG8_STAGE(PG8_SB(0, 0), cB, voffB); PG8_STAGE(PG8_SA(0, 0), cA, voffA); PG8_STAGE(PG8_SB(0, 1), cB + hstep, voffB); PG8_STAGE(PG8_SA(0, 1), cA + hstepA, voffA);
        if (wr == 1) PG8_BAR;
        PG8_WAIT_V(4); PG8_BAR;
        PG8_STAGE(PG8_SB(1, 0), cB + kstep, voffB); PG8_STAGE(PG8_SA(1, 0), cA + kstep, voffA); PG8_STAGE(PG8_SB(1, 1), cB + hstep + kstep, voffB);
        PG8_WAIT_V(6); PG8_BAR;
    }
    for (;;) {
        const bool has_next = S.next(ui + 1, nxt);
        const char* nA = has_next ? (const char*)g.A + (size_t)nxt.pm * tstepA : cA; const char* nB = has_next ? (const char*)g.Bt + (size_t)nxt.pn * tstep : cB;
        for (int t = 0; t < nt; t += 2) {
            const bool last = (t == nt - 2);
            const char* a1 = cA + (size_t)(t + 1) * kstep;
            const char* a2 = last ? nA : cA + (size_t)(t + 2) * kstep; const char* b2 = last ? nB : cB + (size_t)(t + 2) * kstep;
            const char* a3 = a2 + kstep; const char* b3 = b2 + kstep;
            if (last && has_next) S.a_ready(nxt);
            if constexpr (SP2) {
            PG8_LDB(B0, 0, 0); PG8_LDB(B1, 0, 1); PG8_SCHED; PG8_LDA(At, 0, 0); PG8_STAGE(PG8_SA(1, 1), a1 + hstepA, voffA);
            PG8_WAIT_V(8); PG8_WAIT_L(0); PG8_BAR; PG8_MMA(0, 0, At, B0); PG8_MMA(0, 1, At, B1); PG8_BAR; PG8_SCHED;
            PG8_LDA(At, 0, 1); PG8_STAGE(PG8_SB(0, 0), b2, voffB); PG8_STAGE(PG8_SB(0, 1), b2 + hstep, voffB); PG8_STAGE(PG8_SA(0, 0), a2, voffA);
            PG8_WAIT_V(8); PG8_WAIT_L(0); PG8_BAR; PG8_MMA(1, 0, At, B0); PG8_MMA(1, 1, At, B1); PG8_BAR; PG8_SCHED;
            PG8_LDB(B0, 1, 0); PG8_LDB(B1, 1, 1); PG8_SCHED; PG8_LDA(At, 1, 0); PG8_STAGE(PG8_SA(0, 1), a2 + hstepA, voffA);
            PG8_WAIT_V(8); PG8_WAIT_L(0); PG8_BAR; PG8_MMA(0, 0, At, B0); PG8_MMA(0, 1, At, B1); PG8_BAR; PG8_SCHED;
            PG8_LDA(At, 1, 1); PG8_STAGE(PG8_SB(1, 0), b3, voffB); PG8_STAGE(PG8_SB(1, 1), b3 + hstep, voffB); PG8_STAGE(PG8_SA(1, 0), a3, voffA);
            PG8_WAIT_V(8); PG8_WAIT_L(0); PG8_BAR; PG8_MMA(1, 0, At, B0); PG8_MMA(1, 1, At, B1); PG8_BAR; PG8_SCHED;
            } else {
            PG8_LDB(B0, 0, 0); PG8_SCHED; PG8_LDA(At, 0, 0); PG8_STAGE(PG8_SA(1, 1), a1 + hstepA, voffA);
            PG8_WAIT_L(8); PG8_BAR; PG8_WAIT_L(0); PG8_MMA(0, 0, At, B0); PG8_BAR; PG8_SCHED;
            PG8_LDB(B1, 0, 1); PG8_STAGE(PG8_SB(0, 0), b2, voffB);
            PG8_BAR; PG8_WAIT_L(0); PG8_MMA(0, 1, At, B1); PG8_BAR;
            PG8_LDA(At, 0, 1); PG8_STAGE(PG8_SA(0, 0), a2, voffA);
            PG8_BAR; PG8_WAIT_L(0); PG8_MMA(1, 0, At, B0); PG8_BAR; PG8_SCHED;
            PG8_STAGE(PG8_SB(0, 1), b2 + hstep, voffB);
            PG8_WAIT_V(6); PG8_BAR; PG8_MMA(1, 1, At, B1); PG8_BAR;
            PG8_LDB(B0, 1, 0); PG8_SCHED; PG8_LDA(At, 1, 0); PG8_STAGE(PG8_SA(0, 1), a2 + hstepA, voffA);
            PG8_WAIT_L(8); PG8_BAR; PG8_WAIT_L(0); PG8_MMA(0, 0, At, B0); PG8_BAR; PG8_SCHED;
            PG8_LDB(B1, 1, 1); PG8_STAGE(PG8_SB(1, 0), b3, voffB);
            PG8_BAR; PG8_WAIT_L(0); PG8_MMA(0, 1, At, B1); PG8_BAR;
            PG8_LDA(At, 1, 1); PG8_STAGE(PG8_SA(1, 0), a3, voffA);
            PG8_BAR; PG8_WAIT_L(0); PG8_MMA(1, 0, At, B0); PG8_BAR; PG8_SCHED;
            PG8_STAGE(PG8_SB(1, 1), b3 + hstep, voffB);
            PG8_WAIT_V(6); PG8_BAR; PG8_MMA(1, 1, At, B1); PG8_BAR;
            }
            if constexpr (Epi::FOLD) { if ((((t + 2) & 7) == 0) && !last) E.fold(acc, ((t + 2) >> 3) - 1, cur, wr, wc, fr, fq); }
        }
        if constexpr (ALIGN_EPI) { if (wr == 0) PG8_BAR; }
        if constexpr (!Epi::AFTER_DRAIN) { E(acc, cur, wr, wc, fr, fq); S.done(cur); }
        if (!has_next) break;
#pragma unroll
        for (int a = 0; a < 2; ++a)
#pragma unroll
            for (int b = 0; b < 2; ++b)
#pragma unroll
                for (int m = 0; m < 4; ++m)
#pragma unroll
                    for (int n = 0; n < 2; ++n) acc[a][b][m][n] = (f32x4){0.f, 0.f, 0.f, 0.f};
        cur = nxt; cA = nA; cB = nB; ++ui;
        if constexpr (ALIGN_EPI) { if (wr == 1) PG8_BAR; }
    }
    PG8_WAIT_V(0);
    if constexpr (!ALIGN_EPI) { if (wr == 0) PG8_BAR; }
    PG8_BAR;
    if constexpr (Epi::AFTER_DRAIN) { E.fused(acc, cur, wr, wc, fr, fq, lds, wid, lane); S.done(cur); }
#undef PG8_SA
#undef PG8_SB
#undef PG8_STAGE
#undef PG8_LDA
#undef PG8_LDB
#undef PG8_MMA
#undef PG8_WAIT_V
#undef PG8_WAIT_L
#undef PG8_BAR
#undef PG8_SCHED
}
}
namespace mk {
#define LAS __attribute__((address_space(3)))
#define GAS __attribute__((address_space(1)))
typedef unsigned short bf16;
typedef unsigned v4u __attribute__((ext_vector_type(4)));
typedef unsigned v2u __attribute__((ext_vector_type(2)));
typedef float f32x4 __attribute__((ext_vector_type(4)));
typedef float f32x16 __attribute__((ext_vector_type(16)));
typedef float f32x2v __attribute__((ext_vector_type(2)));
typedef short bf16x8 __attribute__((ext_vector_type(8)));
typedef short s16x4 __attribute__((ext_vector_type(4)));
constexpr int SEQ = 2048, DM = 1024, NIN = 11280;
constexpr int LDP = 7424;
constexpr int PC_SLAB = 0, PC_XBC = 1792, PC_DT = 2816, PC_QKVC = 3072, PC_QKVD = 3840, PC_ZA = 5376, PC_GB = 5888, PC_GC = 6400, PC_GD = 6912;
constexpr int PC_Y = PC_ZA;
constexpr size_t W1T_N = 7424, W2T_N = 4096;
constexpr size_t WOFF_W1 = 0, WOFF_W2 = WOFF_W1 + W1T_N * 1024, WOFF_WB = WOFF_W2 + W2T_N * 1024, WOFF_WO = WOFF_WB + 4ull * 1024 * 512, W_LAYER_ELEMS = WOFF_WO + 1024ull * 1024;
#define LDS_WAIT() asm volatile("s_waitcnt lgkmcnt(0)" ::: "memory")
#define VM_WAIT() asm volatile("s_waitcnt vmcnt(0)" ::: "memory")
__device__ __forceinline__ unsigned f2bf(float f) { unsigned u = __builtin_bit_cast(unsigned, f); return (u + 0x7fffu + ((u >> 16) & 1u)) >> 16; }
__device__ __forceinline__ unsigned pk2(float lo, float hi) { return f2bf(lo) | (f2bf(hi) << 16); }
__device__ __forceinline__ float bf2f(unsigned short b) { return __builtin_bit_cast(float, (unsigned)b << 16); }
__device__ __forceinline__ float bflo(unsigned w) { return __builtin_bit_cast(float, w << 16); }
__device__ __forceinline__ float bfhi(unsigned w) { return __builtin_bit_cast(float, w & 0xffff0000u); }
__device__ __forceinline__ float lane_xor(float v, int lane, int o) { return __builtin_bit_cast(float, __builtin_amdgcn_ds_bpermute((lane ^ o) << 2, __builtin_bit_cast(int, v))); }
#define MK_DPP(x, ctrl) __builtin_bit_cast(float, __builtin_amdgcn_update_dpp(0, __builtin_bit_cast(int, (x)), (ctrl), 0xf, 0xf, true))
__device__ __forceinline__ float sum_l4(float x) { x += MK_DPP(x, 0xB1); x += MK_DPP(x, 0x4E); return x; }
__device__ __forceinline__ float sum_l8(float x) { x = sum_l4(x); x += MK_DPP(x, 0x141); return x; }
__device__ __forceinline__ float sum_l16(float x) { x = sum_l8(x); x += MK_DPP(x, 0x140); return x; }
__device__ __forceinline__ float sum_l32(float x) { x = sum_l16(x); const auto rr = __builtin_amdgcn_permlane16_swap(__float_as_uint(x), __float_as_uint(x), false, false); return __uint_as_float(rr[0]) + __uint_as_float(rr[1]); }
__device__ __forceinline__ float sum_l64(float x) { x = sum_l32(x); const auto rr = __builtin_amdgcn_permlane32_swap(__float_as_uint(x), __float_as_uint(x), false, false); return __uint_as_float(rr[0]) + __uint_as_float(rr[1]); }
__device__ __forceinline__ float wave_sum(float v, int lane) { (void)lane; return sum_l64(v); }
__device__ __forceinline__ float fsilu(float x) { return x * __builtin_amdgcn_rcpf(1.f + __expf(-x)); }
__device__ __forceinline__ float fsigmoid(float x) { return __builtin_amdgcn_rcpf(1.f + __expf(-x)); }

__device__ __forceinline__ void transpose_item(const float* W, int ldw, int ldt, int c0, int nvalid, int ntotal, bf16* WT, int r0, LAS float* scr, int item, int lane) {
    const int nblk = ntotal / 32, kb = item / nblk, nb = item % nblk, k0 = 64 * kb, n0 = 32 * nb;
    const bool ok = (n0 + (lane & 31)) < nvalid;
    float wv[32];
#pragma unroll
    for (int i = 0; i < 32; ++i) { const int kk = 2 * i + (lane >> 5); wv[i] = W[(size_t)(k0 + kk) * ldw + c0 + (ok ? n0 + (lane & 31) : 0)]; }
#pragma unroll
    for (int i = 0; i < 32; ++i) { const int kk = 2 * i + (lane >> 5); scr[kk * 33 + (lane & 31)] = ok ? wv[i] : 0.f; }
    LDS_WAIT(); asm volatile("" ::: "memory");
    const int c = lane & 7;
#pragma unroll
    for (int j = 0; j < 4; ++j) { const int n = (lane >> 3) + 8 * j; const LAS float* s = scr + (8 * c) * 33 + n;
        v4u o; o.x = pk2(s[0 * 33], s[1 * 33]); o.y = pk2(s[2 * 33], s[3 * 33]); o.z = pk2(s[4 * 33], s[5 * 33]); o.w = pk2(s[6 * 33], s[7 * 33]);
        *(GAS v4u*)(WT + (size_t)(r0 + n0 + n) * ldt + k0 + 8 * c) = o; }
    LDS_WAIT(); asm volatile("" ::: "memory");
}
struct WSeg { int src, soff, ldw, c0, nvalid, ntotal; unsigned doff; int ldt, r0, ni; };
constexpr int WCONV_NSEG = 15, WCONV_ITEMS = 16 * (7424 / 32) + 16 * (4096 / 32) + 4 * 8 * (1024 / 32) + 16 * (1024 / 32);
__device__ __forceinline__ void ph_wconv(const float* w_in, const float* w_branch, const float* w_out, bf16* Wall, LAS unsigned char* lds, int gw, int ngw, int wave, int lane) {
    LAS float* scr = (LAS float*)(lds + wave * 16384);
    const WSeg segs[WCONV_NSEG] = {
        {0, 0, NIN, 1552, 1792, 1792, (unsigned)WOFF_W1, 1024, 0, 16 * 56}, {0, 0, NIN, 512, 1024, 1024, (unsigned)WOFF_W1, 1024, 1792, 16 * 32}, {0, 0, NIN, 1536, 16, 256, (unsigned)WOFF_W1, 1024, PC_DT, 16 * 8},
        {0, 0, NIN, 3856, 768, 768, (unsigned)WOFF_W1, 1024, PC_QKVC, 16 * 24}, {0, 0, NIN, 5136, 1536, 1536, (unsigned)WOFF_W1, 1024, PC_QKVD, 16 * 48}, {0, 0, NIN, 0, 512, 512, (unsigned)WOFF_W1, 1024, PC_ZA, 16 * 16},
        {0, 0, NIN, 3344, 512, 512, (unsigned)WOFF_W1, 1024, PC_GB, 16 * 16}, {0, 0, NIN, 4624, 512, 512, (unsigned)WOFF_W1, 1024, PC_GC, 16 * 16}, {0, 0, NIN, 6672, 512, 512, (unsigned)WOFF_W1, 1024, PC_GD, 16 * 16},
        {0, 0, NIN, 7184, 4096, 4096, (unsigned)WOFF_W2, 1024, 0, 16 * 128},
        {1, 0 * 512 * 1024, 1024, 0, 1024, 1024, (unsigned)WOFF_WB + 0 * 512, 2048, 0, 8 * 32}, {1, 1 * 512 * 1024, 1024, 0, 1024, 1024, (unsigned)WOFF_WB + 1 * 512, 2048, 0, 8 * 32},
        {1, 2 * 512 * 1024, 1024, 0, 1024, 1024, (unsigned)WOFF_WB + 2 * 512, 2048, 0, 8 * 32}, {1, 3 * 512 * 1024, 1024, 0, 1024, 1024, (unsigned)WOFF_WB + 3 * 512, 2048, 0, 8 * 32},
        {2, 0, 1024, 0, 1024, 1024, (unsigned)WOFF_WO, 1024, 0, 16 * 32}};
#pragma unroll 1
    for (int it0 = gw; it0 < 2 * WCONV_ITEMS; it0 += ngw) { const int l2 = it0 >= WCONV_ITEMS ? 1 : 0; int it = it0 - l2 * WCONV_ITEMS, s = 0;
#pragma unroll 1
        while (it >= segs[s].ni) { it -= segs[s].ni; ++s; }
        const WSeg g = segs[s];
        const float* src = g.src == 0 ? w_in + (size_t)l2 * 1024 * NIN : (g.src == 1 ? w_branch + (size_t)l2 * 4 * 512 * 1024 + g.soff : w_out + (size_t)l2 * 1024 * 1024);
        transpose_item(src, g.ldw, g.ldt, g.c0, g.nvalid, g.ntotal, Wall + (size_t)l2 * W_LAYER_ELEMS + g.doff, g.r0, scr, it, lane); }
}
__device__ __forceinline__ void rms_row_to_bf16(const float* xrow, const float* w, bf16* orow, int lane) {
    const GAS f32x4* xr = (const GAS f32x4*)xrow + lane; const GAS f32x4* wr = (const GAS f32x4*)w + lane;
    f32x4 v[4]; float s = 0.f;
#pragma unroll
    for (int j = 0; j < 4; ++j) { v[j] = xr[64 * j]; s += (v[j].x * v[j].x + v[j].y * v[j].y) + (v[j].z * v[j].z + v[j].w * v[j].w); }
    const float rstd = __builtin_amdgcn_rsqf(wave_sum(s, lane) * (1.f / 1024.f) + 1e-6f);
    GAS unsigned long long* o8 = (GAS unsigned long long*)orow + lane;
#pragma unroll
    for (int j = 0; j < 4; ++j) { const f32x4 ww = wr[64 * j]; o8[64 * j] = (unsigned long long)pk2(v[j].x * rstd * ww.x, v[j].y * rstd * ww.y) | ((unsigned long long)pk2(v[j].z * rstd * ww.z, v[j].w * rstd * ww.w) << 32); }
}
__device__ __forceinline__ void ph_rmsnorm(const float* x, const float* w, bf16* H, int nrows, int gw, int ngw, int lane) {
    f32x4 wv4[4];
#pragma unroll
    for (int j = 0; j < 4; ++j) wv4[j] = ((const GAS f32x4*)w + lane)[64 * j];
    for (int m = gw; m < nrows; m += 2 * ngw) { const int m2 = m + ngw; const bool two = m2 < nrows;
        const GAS f32x4* xa = (const GAS f32x4*)(x + (size_t)m * 1024) + lane; const GAS f32x4* xb = (const GAS f32x4*)(x + (size_t)(two ? m2 : m) * 1024) + lane;
        f32x4 va[4], vb[4]; float sa = 0.f, sb = 0.f;
#pragma unroll
        for (int j = 0; j < 4; ++j) { va[j] = xa[64 * j]; vb[j] = xb[64 * j]; }
#pragma unroll
        for (int j = 0; j < 4; ++j) { sa += (va[j].x * va[j].x + va[j].y * va[j].y) + (va[j].z * va[j].z + va[j].w * va[j].w); sb += (vb[j].x * vb[j].x + vb[j].y * vb[j].y) + (vb[j].z * vb[j].z + vb[j].w * vb[j].w); }
        const float ra = __builtin_amdgcn_rsqf(sum_l64(sa) * (1.f / 1024.f) + 1e-6f), rb = __builtin_amdgcn_rsqf(sum_l64(sb) * (1.f / 1024.f) + 1e-6f);
        GAS unsigned long long* oa = (GAS unsigned long long*)(H + (size_t)m * 1024) + lane; GAS unsigned long long* ob = (GAS unsigned long long*)(H + (size_t)(two ? m2 : m) * 1024) + lane;
#pragma unroll
        for (int j = 0; j < 4; ++j) { const f32x4 ww = wv4[j];
            oa[64 * j] = (unsigned long long)pk2(va[j].x * ra * ww.x, va[j].y * ra * ww.y) | ((unsigned long long)pk2(va[j].z * ra * ww.z, va[j].w * ra * ww.w) << 32);
            if (two) ob[64 * j] = (unsigned long long)pk2(vb[j].x * rb * ww.x, vb[j].y * rb * ww.y) | ((unsigned long long)pk2(vb[j].z * rb * ww.z, vb[j].w * rb * ww.w) << 32); } }
}
__device__ __forceinline__ void ph_gemm_rsigout(LAS unsigned char* lds, const bf16* A, int lda, const bf16* Bt, int M, int N, int K, bf16* O, int ldo, int tid, int bid) {
    pg8::Gemm g{A, Bt, M, N, K, lda}; pg8::StaticOrder S; S.init(M, N, (int)gridDim.x, bid);
    pg8::EpiBf16<2> E{O, ldo, nullptr, 0, 0, 1.f};
    pg8::gemm_phase<pg8::EpiBf16<2>, pg8::StaticOrder, true, true>(lds, g, S, E, tid);
}
struct RangeOrder : pg8::StaticOrder { int first, count;
    __device__ bool next(int i, pg8::Unit& u) const { return i < count && pg8::StaticOrder::next(i + first, u); } };
__device__ __forceinline__ void ph_gemm_bf16out_range(LAS unsigned char* lds, const bf16* A, int lda, const bf16* Bt, int M, int N, int K, bf16* O, int ldo, int first, int count, int tid, int bid) {
    pg8::Gemm g{A, Bt, M, N, K, lda}; RangeOrder S; S.init(M, N, (int)gridDim.x, bid); S.first = first; S.count = count;
    pg8::EpiBf16<0> E{O, ldo, nullptr, 0, 0, 1.f};
    pg8::gemm_phase<pg8::EpiBf16<0>, RangeOrder, true, true>(lds, g, S, E, tid);
}
__device__ __forceinline__ void ph_gemm_bf16out(LAS unsigned char* lds, const bf16* A, int lda, const bf16* Bt, int M, int N, int K, bf16* O, int ldo, int tid, int bid) {
    pg8::Gemm g{A, Bt, M, N, K, lda}; pg8::StaticOrder S; S.init(M, N, (int)gridDim.x, bid);
    pg8::EpiBf16<0> E{O, ldo, nullptr, 0, 0, 1.f};
    pg8::gemm_phase<pg8::EpiBf16<0>, pg8::StaticOrder, true, true>(lds, g, S, E, tid);
}
}
namespace mk {
constexpr float C2 = 0.125f * 1.4426950408889634f;
struct EpiF32 {
    static constexpr bool PERM = false, AFTER_DRAIN = false, FOLD = false;
    float* C; int ldc;
    __device__ __forceinline__ void operator()(const pg8::f32x4 (&acc)[2][2][4][2], const pg8::Unit& u, int wr, int wc, int fr, int fq) const {
        const int row0 = u.pm * 256 + wr * 64 + fr, col0 = u.pn * 256 + wc * 32 + 4 * fq;
#pragma unroll
        for (int ai = 0; ai < 2; ++ai)
#pragma unroll
            for (int m = 0; m < 4; ++m) { float* rowp = C + (size_t)(row0 + ai * 128 + m * 16) * ldc + col0;
#pragma unroll
                for (int bj = 0; bj < 2; ++bj)
#pragma unroll
                    for (int n = 0; n < 2; ++n) *(pg8::f32x4*)(rowp + bj * 128 + n * 16) = acc[ai][bj][m][n]; }
    }
};
template <int MODE> struct EpiMerge {
    static constexpr bool PERM = false, AFTER_DRAIN = false, FOLD = false;
    float* Mf; bf16* Mb; const bf16* G; int ldg;
    __device__ __forceinline__ void operator()(const pg8::f32x4 (&acc)[2][2][4][2], const pg8::Unit& u, int wr, int wc, int fr, int fq) const {
        const int row0 = u.pm * 256 + wr * 64 + fr, col0 = u.pn * 256 + wc * 32 + 4 * fq;
#pragma unroll
        for (int ai = 0; ai < 2; ++ai)
#pragma unroll
            for (int m = 0; m < 4; ++m) { const size_t r = (size_t)(row0 + ai * 128 + m * 16);
#pragma unroll
                for (int bj = 0; bj < 2; ++bj)
#pragma unroll
                    for (int n = 0; n < 2; ++n) { const int c = col0 + bj * 128 + n * 16;
                        const v2u gw = *(const v2u*)(G + r * ldg + c);
                        pg8::f32x4 v = acc[ai][bj][m][n];
                        v[0] *= fsigmoid(bflo(gw.x)); v[1] *= fsigmoid(bfhi(gw.x)); v[2] *= fsigmoid(bflo(gw.y)); v[3] *= fsigmoid(bfhi(gw.y));
                        if (MODE > 0) v += *(const pg8::f32x4*)(Mf + r * 1024 + c);
                        if (MODE < 2) *(pg8::f32x4*)(Mf + r * 1024 + c) = v;
                        else { v2u o; o.x = pk2(v[0], v[1]); o.y = pk2(v[2], v[3]); *(v2u*)(Mb + r * 1024 + c) = o; } } }
    }
};
__device__ __forceinline__ v4u gload16(const void* base, unsigned off) { v4u r; asm volatile("global_load_dwordx4 %0, %1, %2" : "=v"(r) : "v"(off), "s"(base) : "memory"); return r; }
__device__ __forceinline__ void gwait8(v4u& a, v4u& b, v4u& c, v4u& d, v4u& e, v4u& f, v4u& g, v4u& h) { asm volatile("s_waitcnt vmcnt(0)" : "+v"(a), "+v"(b), "+v"(c), "+v"(d), "+v"(e), "+v"(f), "+v"(g), "+v"(h) :: "memory"); }
struct EpiMergeF {
    static constexpr bool PERM = true, AFTER_DRAIN = false, FOLD = true;
    bf16* Mb; const bf16* S; int lds_;
    __device__ __forceinline__ void fold(pg8::f32x4 (&acc)[2][2][4][2], int seg, const pg8::Unit& u, int wr, int wc, int fr, int fq) const {
        unsigned off0 = (unsigned)((u.pm * 256 + wr * 64 + fr) * lds_ + u.pn * 256 + wc * 32 + 8 * fq + seg * 1024) * 2u; asm volatile("" : "+v"(off0));
#pragma unroll
        for (int ai = 0; ai < 2; ++ai)
#pragma unroll
            for (int mh = 0; mh < 2; ++mh) {
                v4u sa[2][2], sb[2][2];
#pragma unroll
                for (int mm = 0; mm < 2; ++mm)
#pragma unroll
                    for (int bj = 0; bj < 2; ++bj) { const unsigned ro = off0 + (unsigned)((ai * 128 + (2 * mh + mm) * 16) * lds_) * 2u + bj * 256; sa[mm][bj] = gload16(S, ro); sb[mm][bj] = gload16(S, ro + 2048); }
                gwait8(sa[0][0], sa[0][1], sa[1][0], sa[1][1], sb[0][0], sb[0][1], sb[1][0], sb[1][1]);
#pragma unroll
                for (int mm = 0; mm < 2; ++mm)
#pragma unroll
                    for (int bj = 0; bj < 2; ++bj) { const unsigned wa[4] = {sa[mm][bj].x, sa[mm][bj].y, sa[mm][bj].z, sa[mm][bj].w}, wb[4] = {sb[mm][bj].x, sb[mm][bj].y, sb[mm][bj].z, sb[mm][bj].w};
#pragma unroll
                        for (int e = 0; e < 4; ++e) { pg8::f32x4& v = acc[ai][bj][2 * mh + mm][e >> 1]; const int o = 2 * (e & 1);
                            v[o] *= bflo(wb[e]) * __builtin_amdgcn_rcpf(bflo(wa[e])); v[o + 1] *= bfhi(wb[e]) * __builtin_amdgcn_rcpf(bfhi(wa[e])); } } }
    }
    __device__ __forceinline__ void operator()(const pg8::f32x4 (&acc)[2][2][4][2], const pg8::Unit& u, int wr, int wc, int fr, int fq) const {
        const int row0 = u.pm * 256 + wr * 64 + fr, col0 = u.pn * 256 + wc * 32 + 8 * fq;
        const unsigned off0 = (unsigned)(row0 * lds_ + col0 + 3 * 1024) * 2u;
#pragma unroll
        for (int ai = 0; ai < 2; ++ai) { v4u sa[4][2];
#pragma unroll
            for (int m = 0; m < 4; ++m)
#pragma unroll
                for (int bj = 0; bj < 2; ++bj) sa[m][bj] = gload16(S, off0 + (unsigned)((ai * 128 + m * 16) * lds_) * 2u + bj * 256);
            gwait8(sa[0][0], sa[0][1], sa[1][0], sa[1][1], sa[2][0], sa[2][1], sa[3][0], sa[3][1]);
#pragma unroll
            for (int m = 0; m < 4; ++m) { const size_t r = (size_t)(row0 + ai * 128 + m * 16);
#pragma unroll
                for (int bj = 0; bj < 2; ++bj) { const int c = col0 + bj * 128; const v4u s4 = sa[m][bj]; const pg8::f32x4 v0 = acc[ai][bj][m][0], v1 = acc[ai][bj][m][1];
                    v4u o; o.x = pk2(v0[0] * __builtin_amdgcn_rcpf(bflo(s4.x)), v0[1] * __builtin_amdgcn_rcpf(bfhi(s4.x))); o.y = pk2(v0[2] * __builtin_amdgcn_rcpf(bflo(s4.y)), v0[3] * __builtin_amdgcn_rcpf(bfhi(s4.y)));
                    o.z = pk2(v1[0] * __builtin_amdgcn_rcpf(bflo(s4.z)), v1[1] * __builtin_amdgcn_rcpf(bfhi(s4.z))); o.w = pk2(v1[2] * __builtin_amdgcn_rcpf(bflo(s4.w)), v1[3] * __builtin_amdgcn_rcpf(bfhi(s4.w)));
                    *(GAS v4u*)(Mb + r * 1024 + c) = o; } } }
    }
};
template <class Epi> __device__ __forceinline__ void run_gemm(LAS unsigned char* lds, const bf16* A, int lda, const bf16* Bt, int M, int N, int K, const Epi& E, int tid, int bid) {
    pg8::Gemm g{A, Bt, M, N, K, lda}; pg8::StaticOrder S; S.init(M, N, (int)gridDim.x, bid);
    pg8::gemm_phase<Epi, pg8::StaticOrder, true, true>(lds, g, S, E, tid);
}
__device__ __forceinline__ void ph_rope_table(float* rope, int gtid, int nthr) {
    for (int i = gtid; i < SEQ * 32; i += nthr) { const int l = i >> 5, j = i & 31; const float inv = __builtin_amdgcn_exp2f(-(float)(j & 15) * 0.83048202372184f);
        const float ang = (float)(j < 16 ? (l >> 6) : (l & 63)) * inv; rope[i] = __cosf(ang); rope[SEQ * 32 + i] = __sinf(ang); }
}
__device__ __forceinline__ void ph_prep_conv(const bf16* P, int T, const float* cw, const float* cb, const float* dtb, bf16* XC, float* DT, int gtid, int nthr) {
    { const int c = (gtid & 127) * 8;
        float wj[5][8], bb[8];
#pragma unroll
        for (int j = 0; j < 5; ++j) { const f32x4 w0 = *(const GAS f32x4*)(cw + j * 1024 + c), w1 = *(const GAS f32x4*)(cw + j * 1024 + c + 4); wj[j][0] = w0.x; wj[j][1] = w0.y; wj[j][2] = w0.z; wj[j][3] = w0.w; wj[j][4] = w1.x; wj[j][5] = w1.y; wj[j][6] = w1.z; wj[j][7] = w1.w; }
        { const f32x4 b0 = *(const GAS f32x4*)(cb + c), b1 = *(const GAS f32x4*)(cb + c + 4); bb[0] = b0.x; bb[1] = b0.y; bb[2] = b0.z; bb[3] = b0.w; bb[4] = b1.x; bb[5] = b1.y; bb[6] = b1.z; bb[7] = b1.w; }
    for (int it = gtid; it < (T >> 3) * 128; it += nthr) { const int t0 = (it >> 7) * 8, l0 = t0 & (SEQ - 1);
        v4u row[12];
#pragma unroll
        for (int r = 0; r < 12; ++r) { const int ll = l0 + r - 2; const bool ok = (ll >= 0) && (ll < SEQ); const v4u z4 = {0u, 0u, 0u, 0u};
            row[r] = ok ? *(const GAS v4u*)(P + (size_t)(t0 + r - 2) * LDP + PC_XBC + c) : z4; }
#pragma unroll
        for (int q = 0; q < 8; ++q) { float a[8];
#pragma unroll
            for (int e = 0; e < 8; ++e) a[e] = bb[e];
#pragma unroll
            for (int j = 0; j < 5; ++j) { const v4u w = row[q + j];
                a[0] += wj[j][0] * bflo(w.x); a[1] += wj[j][1] * bfhi(w.x); a[2] += wj[j][2] * bflo(w.y); a[3] += wj[j][3] * bfhi(w.y); a[4] += wj[j][4] * bflo(w.z); a[5] += wj[j][5] * bfhi(w.z); a[6] += wj[j][6] * bflo(w.w); a[7] += wj[j][7] * bfhi(w.w); }
            v4u o; o.x = pk2(fsilu(a[0]), fsilu(a[1])); o.y = pk2(fsilu(a[2]), fsilu(a[3])); o.z = pk2(fsilu(a[4]), fsilu(a[5])); o.w = pk2(fsilu(a[6]), fsilu(a[7]));
            *(GAS v4u*)(XC + (size_t)(t0 + q) * 1024 + c) = o; } } }
    for (int it = gtid; it < T * 16; it += nthr) { const int t = it >> 4, j = it & 15; const float x = bf2f(P[(size_t)t * LDP + PC_DT + j]) + dtb[j]; DT[it] = x > 20.f ? x : __logf(1.f + __expf(x)); }
}
__device__ __forceinline__ void ph_prep_gqa(const bf16* P, int T, const float* qw, const float* kw, const float* rope, bf16* Qn, bf16* Kn, int gtid, int nthr) {
    { const int j8 = gtid & 7, g8 = gtid >> 3, ng8 = nthr >> 3;
      const f32x4 qw1 = *(const GAS f32x4*)(qw + 4 * j8), qw2 = *(const GAS f32x4*)(qw + 32 + 4 * j8), kw1 = *(const GAS f32x4*)(kw + 4 * j8), kw2 = *(const GAS f32x4*)(kw + 32 + 4 * j8);
      constexpr int GR = 2;
      for (int it0 = g8; it0 < T * 10; it0 += GR * ng8) {
        int tq[GR], hq[GR]; bool okq[GR]; v2u r1[GR], r2[GR]; f32x4 cs[GR], sn[GR];
#pragma unroll
        for (int q = 0; q < GR; ++q) { const int it = it0 + q * ng8; okq[q] = it < T * 10; const int itc = okq[q] ? it : it0; tq[q] = itc / 10; hq[q] = itc - tq[q] * 10; const int l = tq[q] & (SEQ - 1);
            const bf16* src = P + (size_t)tq[q] * LDP + PC_QKVC + hq[q] * 64 + 4 * j8; r1[q] = *(const GAS v2u*)src; r2[q] = *(const GAS v2u*)(src + 32);
            cs[q] = *(const GAS f32x4*)(rope + l * 32 + 4 * j8); sn[q] = *(const GAS f32x4*)(rope + SEQ * 32 + l * 32 + 4 * j8); }
#pragma unroll
        for (int q = 0; q < GR; ++q) { const int t = tq[q], hh = hq[q]; const f32x4 w1 = hh < 8 ? qw1 : kw1, w2 = hh < 8 ? qw2 : kw2;
            const float x1[4] = {bflo(r1[q].x), bfhi(r1[q].x), bflo(r1[q].y), bfhi(r1[q].y)}, x2[4] = {bflo(r2[q].x), bfhi(r2[q].x), bflo(r2[q].y), bfhi(r2[q].y)};
            float ss = 0.f;
#pragma unroll
            for (int e = 0; e < 4; ++e) ss += x1[e] * x1[e] + x2[e] * x2[e];
            const float rs = __builtin_amdgcn_rsqf(sum_l8(ss) * (1.f / 64.f) + 1e-6f), sc = hh < 8 ? C2 : 1.f; float o1[4], o2[4];
#pragma unroll
            for (int e = 0; e < 4; ++e) { const float y1 = x1[e] * rs * w1[e], y2 = x2[e] * rs * w2[e]; o1[e] = (y1 * cs[q][e] - y2 * sn[q][e]) * sc; o2[e] = (y2 * cs[q][e] + y1 * sn[q][e]) * sc; }
            bf16* dst = (hh < 8 ? Qn + (size_t)t * 512 + hh * 64 : Kn + (size_t)t * 128 + (hh - 8) * 64) + 4 * j8;
            v2u a1, a2; a1.x = pk2(o1[0], o1[1]); a1.y = pk2(o1[2], o1[3]); a2.x = pk2(o2[0], o2[1]); a2.y = pk2(o2[2], o2[3]);
            if (okq[q]) { *(GAS v2u*)dst = a1; *(GAS v2u*)(dst + 32) = a2; } } } }
}
__device__ __forceinline__ void ph_post(bf16* P, int T, const bf16* XC, const bf16* YA  , const float* d_skip, const float* norm_w,
                                        const bf16* YB  , const float* CB  , const bf16* VB  , const float* lnx_w, const float* lnx_b, int gw, int ngw, int lane) {
    const int c = lane * 8, h = lane >> 3;
    const float D = d_skip[c >> 6]; const f32x4 n0 = *(const GAS f32x4*)(norm_w + c), n1 = *(const GAS f32x4*)(norm_w + c + 4);
    const f32x4 lw0 = *(const GAS f32x4*)(lnx_w + c), lw1 = *(const GAS f32x4*)(lnx_w + c + 4), lb0 = *(const GAS f32x4*)(lnx_b + c), lb1 = *(const GAS f32x4*)(lnx_b + c + 4);
    for (int t = gw; t < T; t += ngw) {
        const v4u y0 = *(const GAS v4u*)(YA + (size_t)t * 512 + c), y1 = *(const GAS v4u*)(YA + ((size_t)T + t) * 512 + c), xs = *(const GAS v4u*)(XC + (size_t)t * 1024 + c), zz = *(const GAS v4u*)(P + (size_t)t * LDP + PC_ZA + c);
        const v4u a0 = *(const GAS v4u*)(YB + (size_t)t * 512 + c), a1 = *(const GAS v4u*)(YB + ((size_t)T + t) * 512 + c), vv = *(const GAS v4u*)(VB + (size_t)t * 512 + c), gg = *(const GAS v4u*)(P + (size_t)t * LDP + PC_GB + c);
        const float coef = CB[(size_t)h * T + t] + CB[(size_t)(8 + h) * T + t];
        {
            const unsigned yw0[4] = {y0.x, y0.y, y0.z, y0.w}, yw1[4] = {y1.x, y1.y, y1.z, y1.w}, xw[4] = {xs.x, xs.y, xs.z, xs.w}, zw[4] = {zz.x, zz.y, zz.z, zz.w}; float y[8], ss = 0.f;
#pragma unroll
            for (int e = 0; e < 4; ++e) { y[2 * e] = (bflo(yw0[e]) + bflo(yw1[e]) + bflo(xw[e]) * D) * fsilu(bflo(zw[e])); y[2 * e + 1] = (bfhi(yw0[e]) + bfhi(yw1[e]) + bfhi(xw[e]) * D) * fsilu(bfhi(zw[e])); ss += y[2 * e] * y[2 * e] + y[2 * e + 1] * y[2 * e + 1]; }
            const float r = __builtin_amdgcn_rsqf(sum_l32(ss) * (1.f / 256.f) + 1e-6f);
            v4u o; o.x = pk2(y[0] * r * n0.x, y[1] * r * n0.y); o.y = pk2(y[2] * r * n0.z, y[3] * r * n0.w); o.z = pk2(y[4] * r * n1.x, y[5] * r * n1.y); o.w = pk2(y[6] * r * n1.z, y[7] * r * n1.w);
            *(GAS v4u*)(P + (size_t)t * LDP + PC_ZA + c) = o; }
        {
            float y[8] = {bflo(a0.x) + bflo(a1.x), bfhi(a0.x) + bfhi(a1.x), bflo(a0.y) + bflo(a1.y), bfhi(a0.y) + bfhi(a1.y), bflo(a0.z) + bflo(a1.z), bfhi(a0.z) + bfhi(a1.z), bflo(a0.w) + bflo(a1.w), bfhi(a0.w) + bfhi(a1.w)};
            const float v[8] = {bflo(vv.x), bfhi(vv.x), bflo(vv.y), bfhi(vv.y), bflo(vv.z), bfhi(vv.z), bflo(vv.w), bfhi(vv.w)};
            const float g[8] = {bflo(gg.x), bfhi(gg.x), bflo(gg.y), bfhi(gg.y), bflo(gg.z), bfhi(gg.z), bflo(gg.w), bfhi(gg.w)};
            float s = 0.f;
#pragma unroll
            for (int e = 0; e < 8; ++e) s += y[e];
            const float mu = sum_l8(s) * (1.f / 64.f); float q = 0.f;
#pragma unroll
            for (int e = 0; e < 8; ++e) { y[e] -= mu; q += y[e] * y[e]; }
            const float rs = __builtin_amdgcn_rsqf(sum_l8(q) * (1.f / 64.f) + 64e-5f);
            const float lw[8] = {lw0.x, lw0.y, lw0.z, lw0.w, lw1.x, lw1.y, lw1.z, lw1.w}, lb[8] = {lb0.x, lb0.y, lb0.z, lb0.w, lb1.x, lb1.y, lb1.z, lb1.w}; float o[8];
#pragma unroll
            for (int e = 0; e < 8; ++e) o[e] = (y[e] * rs * lw[e] + lb[e] + coef * v[e]) * fsilu(g[e]);
            v4u ov; ov.x = pk2(o[0], o[1]); ov.y = pk2(o[2], o[3]); ov.z = pk2(o[4], o[5]); ov.w = pk2(o[6], o[7]);
            *(GAS v4u*)(P + (size_t)t * LDP + PC_GB + c) = ov; }
    }
}
__device__ __forceinline__ void ph_fin(const float* xin, const float* outf, const float* w, float* xout, const float* wn, bf16* Hn, int nrows, int gw, int ngw, int lane) {
    f32x4 wpost[4], wpre[4];
#pragma unroll
    for (int j = 0; j < 4; ++j) { wpost[j] = ((const GAS f32x4*)w + lane)[64 * j]; wpre[j] = wn ? ((const GAS f32x4*)wn + lane)[64 * j] : (f32x4){0.f, 0.f, 0.f, 0.f}; }
    for (int m = gw; m < nrows; m += 2 * ngw) { const int m2 = (m + ngw < nrows) ? m + ngw : m; const bool two = m2 != m;
        const GAS f32x4* oa = (const GAS f32x4*)(outf + (size_t)m * 1024) + lane; const GAS f32x4* ob = (const GAS f32x4*)(outf + (size_t)m2 * 1024) + lane;
        const GAS f32x4* xa = (const GAS f32x4*)(xin + (size_t)m * 1024) + lane; const GAS f32x4* xb = (const GAS f32x4*)(xin + (size_t)m2 * 1024) + lane;
        f32x4 va[4], vb[4], ya[4], yb[4]; float sa = 0.f, sb = 0.f;
#pragma unroll
        for (int j = 0; j < 4; ++j) { va[j] = oa[64 * j]; vb[j] = ob[64 * j]; ya[j] = xa[64 * j]; yb[j] = xb[64 * j]; }
#pragma unroll
        for (int j = 0; j < 4; ++j) { sa += (va[j].x * va[j].x + va[j].y * va[j].y) + (va[j].z * va[j].z + va[j].w * va[j].w); sb += (vb[j].x * vb[j].x + vb[j].y * vb[j].y) + (vb[j].z * vb[j].z + vb[j].w * vb[j].w); }
        const float ra = __builtin_amdgcn_rsqf(sum_l64(sa) * (1.f / 1024.f) + 1e-6f), rb = __builtin_amdgcn_rsqf(sum_l64(sb) * (1.f / 1024.f) + 1e-6f);
        GAS f32x4* pa = (GAS f32x4*)(xout + (size_t)m * 1024) + lane; GAS f32x4* pb = (GAS f32x4*)(xout + (size_t)m2 * 1024) + lane;
        float qa = 0.f, qb = 0.f;
#pragma unroll
        for (int j = 0; j < 4; ++j) { const f32x4 ww = wpost[j]; ya[j] = ya[j] + va[j] * ra * ww; yb[j] = yb[j] + vb[j] * rb * ww; pa[64 * j] = ya[j]; if (two) pb[64 * j] = yb[j];
            qa += (ya[j].x * ya[j].x + ya[j].y * ya[j].y) + (ya[j].z * ya[j].z + ya[j].w * ya[j].w); qb += (yb[j].x * yb[j].x + yb[j].y * yb[j].y) + (yb[j].z * yb[j].z + yb[j].w * yb[j].w); }
        if (wn) { const float na = __builtin_amdgcn_rsqf(sum_l64(qa) * (1.f / 1024.f) + 1e-6f), nb = __builtin_amdgcn_rsqf(sum_l64(qb) * (1.f / 1024.f) + 1e-6f);
            GAS unsigned long long* ha = (GAS unsigned long long*)(Hn + (size_t)m * 1024) + lane; GAS unsigned long long* hb = (GAS unsigned long long*)(Hn + (size_t)m2 * 1024) + lane;
#pragma unroll
            for (int j = 0; j < 4; ++j) { const f32x4 ww = wpre[j];
                ha[64 * j] = (unsigned long long)pk2(ya[j].x * na * ww.x, ya[j].y * na * ww.y) | ((unsigned long long)pk2(ya[j].z * na * ww.z, ya[j].w * na * ww.w) << 32);
                if (two) hb[64 * j] = (unsigned long long)pk2(yb[j].x * nb * ww.x, yb[j].y * nb * ww.y) | ((unsigned long long)pk2(yb[j].z * nb * ww.z, yb[j].w * nb * ww.w) << 32); } } }
}
}
namespace mk {
__device__ __forceinline__ void unpack8(const v4u w, float* f) { f[0] = bflo(w.x); f[1] = bfhi(w.x); f[2] = bflo(w.y); f[3] = bfhi(w.y); f[4] = bflo(w.z); f[5] = bfhi(w.z); f[6] = bflo(w.w); f[7] = bfhi(w.w); }
__device__ __forceinline__ void ph_ssd_simple(const bf16* XC, const float* DT, const float* a_log, bf16* YA, int nb, int T, int tid, int bid) {
    if (tid >= 64) return;
    const int i = bid * 64 + tid; if (i >= 2 * nb * 512) return;
    const int p = i % 64, h = (i / 64) % 8, b = (i / 512) % nb, z = i / (512 * nb);
    float s[128];
#pragma unroll
    for (int n = 0; n < 128; ++n) s[n] = 0.f;
    const float an = -expf(a_log[z * 8 + h]); const int g = h >> 2;
    for (int st = 0; st < SEQ; ++st) { const int l = z ? (SEQ - 1 - st) : st; const size_t t = (size_t)b * SEQ + l;
        const float d = DT[t * 16 + z * 8 + h]; const float dec = expf(d * an); const float xd = bf2f(XC[t * 1024 + h * 64 + p]) * d;
        const GAS v4u* Bv = (const GAS v4u*)(XC + t * 1024 + 512 + g * 128); const GAS v4u* Cv = (const GAS v4u*)(XC + t * 1024 + 768 + g * 128);
        float y = 0.f;
#pragma unroll
        for (int n8 = 0; n8 < 16; ++n8) { float bb[8], cc[8]; unpack8(Bv[n8], bb); unpack8(Cv[n8], cc);
#pragma unroll
            for (int e = 0; e < 8; ++e) { s[n8 * 8 + e] = s[n8 * 8 + e] * dec + xd * bb[e]; y += cc[e] * s[n8 * 8 + e]; } }
        YA[((size_t)z * T + t) * 512 + h * 64 + p] = (bf16)f2bf(y); }
}
__device__ __forceinline__ float shiftP(const bf16* P, int t, int ch, const float* mu) {
    const int l = t & (SEQ - 1); const float cur = bf2f(P[(size_t)t * LDP + PC_SLAB + ch]);
    const float prev = l > 0 ? bf2f(P[(size_t)(t - 1) * LDP + PC_SLAB + ch]) : 0.f; const float nxt = l < SEQ - 1 ? bf2f(P[(size_t)(t + 1) * LDP + PC_SLAB + ch]) : 0.f;
    return cur + mu[ch] * (prev - cur) + mu[1792 + ch] * (nxt - cur);
}
struct RwkvS { float *R, *V, *KK, *DEC, *BB, *KD; };
__device__ __forceinline__ void ph_rwkv_prep_simple(const bf16* P, int T, int t0, int Ts, const float* mu, const float* w0, const float* w_up, const float* a0, const float* a_up, const float* k_k, const float* k_a, const float* r_k,
                                                    RwkvS A, bf16* VB, float* CB, int gtid, int nthr) {
    for (int it = gtid; it < Ts * 512; it += nthr) { const int tl = it >> 9, c = it & 511, t = t0 + tl;
        const float r = shiftP(P, t, c, mu), k = shiftP(P, t, 512 + c, mu), v = shiftP(P, t, 1024 + c, mu);
        A.R[it] = r; A.V[it] = v; VB[(size_t)t * 512 + c] = (bf16)f2bf(v);
        const float kx = k * k_k[c]; const float ss = wave_sum(kx * kx, gtid & 63);
        const float kk = kx / sqrtf(fmaxf(ss, 1e-24f)); A.KK[it] = kk;
#pragma unroll 1
        for (int z = 0; z < 2; ++z) { float wr = w0[z * 512 + c], ar = a0[z * 512 + c];
            for (int q = 0; q < 64; ++q) { wr += tanhf(shiftP(P, t, 1536 + z * 64 + q, mu)) * w_up[((size_t)z * 64 + q) * 512 + c]; ar += shiftP(P, t, 1664 + z * 64 + q, mu) * a_up[((size_t)z * 64 + q) * 512 + c]; }
            const float sp = (-wr) > 20.f ? (-wr) : log1pf(expf(-wr)); const float dec = expf(-expf(-sp - 0.5f)); const float a = 1.f / (1.f + expf(-ar));
            const float kd = k * (1.f + (a - 1.f) * k_a[c]);
            A.DEC[(size_t)z * Ts * 512 + it] = dec; A.BB[(size_t)z * Ts * 512 + it] = kk * a; A.KD[(size_t)z * Ts * 512 + it] = kd;
            const float cb = wave_sum(r * kd * r_k[c], gtid & 63); if ((c & 63) == 0) CB[((size_t)(z * 8 + (c >> 6))) * T + t] = cb; } }
}
__device__ __forceinline__ void ph_rwkv_scan_simple(int T, int t0, int nbs, RwkvS A, bf16* YB, int tid, int bid) {
    if (tid >= 64) return;
    const int i = bid * 64 + tid; if (i >= 2 * nbs * 512) return;
    const int v = i % 64, h = (i / 64) % 8, b = (i / 512) % nbs, z = i / (512 * nbs); const int Ts = nbs * SEQ;
    float S[64];
#pragma unroll
    for (int k = 0; k < 64; ++k) S[k] = 0.f;
    for (int st = 0; st < SEQ; ++st) { const int l = z ? (SEQ - 1 - st) : st; const size_t tl = (size_t)b * SEQ + l; const size_t o = tl * 512 + h * 64, oz = ((size_t)z * Ts + tl) * 512 + h * 64;
        float sa = 0.f;
#pragma unroll
        for (int k = 0; k < 64; ++k) sa += S[k] * A.KK[o + k];
        const float vv = A.V[o + v]; float y = 0.f;
#pragma unroll
        for (int k = 0; k < 64; ++k) { S[k] = S[k] * A.DEC[oz + k] - sa * A.BB[oz + k] + vv * A.KD[oz + k]; y += S[k] * A.R[o + k]; }
        YB[((size_t)z * T + t0 + tl) * 512 + h * 64 + v] = (bf16)f2bf(y); }
}
__device__ __forceinline__ void ph_gqa_simple(bf16* P, const bf16* Qn, const bf16* Kn, int nb, int gtid, int nthr) {
    for (int it = gtid; it < nb * 8 * SEQ; it += nthr) { const int ql = it % SEQ, h = (it / SEQ) % 8, b = it / (8 * SEQ), g = h >> 2; const size_t t = (size_t)b * SEQ + ql;
        float q[64], o[64];
#pragma unroll
        for (int d8 = 0; d8 < 8; ++d8) { unpack8(*(const GAS v4u*)(Qn + t * 512 + h * 64 + d8 * 8), q + d8 * 8); }
#pragma unroll
        for (int d = 0; d < 64; ++d) o[d] = 0.f;
        float m = -1e30f, lsum = 0.f;
        for (int k = 0; k < SEQ; ++k) { const size_t tk = (size_t)b * SEQ + k; float s = 0.f;
#pragma unroll
            for (int d8 = 0; d8 < 8; ++d8) { float kf[8]; unpack8(*(const GAS v4u*)(Kn + tk * 128 + g * 64 + d8 * 8), kf);
#pragma unroll
                for (int e = 0; e < 8; ++e) s += q[d8 * 8 + e] * kf[e]; }
            const float mn = fmaxf(m, s); const float al = exp2f(m - mn), p = exp2f(s - mn); m = mn; lsum = lsum * al + p;
#pragma unroll
            for (int d8 = 0; d8 < 8; ++d8) { float vf[8]; unpack8(*(const GAS v4u*)(P + tk * LDP + PC_QKVC + 640 + g * 64 + d8 * 8), vf);
#pragma unroll
                for (int e = 0; e < 8; ++e) o[d8 * 8 + e] = o[d8 * 8 + e] * al + p * vf[e]; } }
        const float il = 1.f / lsum;
#pragma unroll
        for (int d8 = 0; d8 < 8; ++d8) { GAS v4u* dst = (GAS v4u*)(P + t * LDP + PC_GC + h * 64 + d8 * 8); float gf[8]; unpack8(*dst, gf); v4u ov;
            ov.x = pk2(o[d8 * 8 + 0] * il * fsilu(gf[0]), o[d8 * 8 + 1] * il * fsilu(gf[1])); ov.y = pk2(o[d8 * 8 + 2] * il * fsilu(gf[2]), o[d8 * 8 + 3] * il * fsilu(gf[3]));
            ov.z = pk2(o[d8 * 8 + 4] * il * fsilu(gf[4]), o[d8 * 8 + 5] * il * fsilu(gf[5])); ov.w = pk2(o[d8 * 8 + 6] * il * fsilu(gf[6]), o[d8 * 8 + 7] * il * fsilu(gf[7])); *dst = ov; } }
}
__device__ __forceinline__ void ph_na_simple(bf16* P, const float* rpb, int nb, int gtid, int nthr) {
    for (int it = gtid; it < nb * 8 * SEQ; it += nthr) { const int ql = it % SEQ, h = (it / SEQ) % 8, b = it / (8 * SEQ); const size_t t = (size_t)b * SEQ + ql; const int qr = ql >> 6, qc = ql & 63;
        int rs = qr - 4; rs = rs < 0 ? 0 : (rs > 24 ? 24 : rs); int cs = qc - 8; cs = cs < 0 ? 0 : (cs > 48 ? 48 : cs);
        float q[64], o[64];
#pragma unroll
        for (int d8 = 0; d8 < 8; ++d8) { unpack8(*(const GAS v4u*)(P + t * LDP + PC_QKVD + h * 64 + d8 * 8), q + d8 * 8); }
#pragma unroll
        for (int d = 0; d < 64; ++d) { q[d] *= 0.125f; o[d] = 0.f; }
        float m = -1e30f, lsum = 0.f;
        for (int i = 0; i < 128; ++i) { const int kr = rs + (i >> 4), kc = cs + (i & 15); const size_t tk = (size_t)b * SEQ + kr * 64 + kc; float s = 0.f;
#pragma unroll
            for (int d8 = 0; d8 < 8; ++d8) { float kf[8]; unpack8(*(const GAS v4u*)(P + tk * LDP + PC_QKVD + 512 + h * 64 + d8 * 8), kf);
#pragma unroll
                for (int e = 0; e < 8; ++e) s += q[d8 * 8 + e] * kf[e]; }
            s += rpb[h * 465 + (kr - qr + 7) * 31 + (kc - qc + 15)];
            const float mn = fmaxf(m, s); const float al = __expf(m - mn), p = __expf(s - mn); m = mn; lsum = lsum * al + p;
#pragma unroll
            for (int d8 = 0; d8 < 8; ++d8) { float vf[8]; unpack8(*(const GAS v4u*)(P + tk * LDP + PC_QKVD + 1024 + h * 64 + d8 * 8), vf);
#pragma unroll
                for (int e = 0; e < 8; ++e) o[d8 * 8 + e] = o[d8 * 8 + e] * al + p * vf[e]; } }
        const float il = 1.f / lsum;
#pragma unroll
        for (int d8 = 0; d8 < 8; ++d8) { GAS v4u* dst = (GAS v4u*)(P + t * LDP + PC_GD + h * 64 + d8 * 8); float gf[8]; unpack8(*dst, gf); v4u ov;
            ov.x = pk2(o[d8 * 8 + 0] * il * fsilu(gf[0]), o[d8 * 8 + 1] * il * fsilu(gf[1])); ov.y = pk2(o[d8 * 8 + 2] * il * fsilu(gf[2]), o[d8 * 8 + 3] * il * fsilu(gf[3]));
            ov.z = pk2(o[d8 * 8 + 4] * il * fsilu(gf[4]), o[d8 * 8 + 5] * il * fsilu(gf[5])); ov.w = pk2(o[d8 * 8 + 6] * il * fsilu(gf[6]), o[d8 * 8 + 7] * il * fsilu(gf[7])); *dst = ov; } }
}
}
#include <hip/hip_bf16.h>
namespace attn_body {
using bf16=__hip_bfloat16;
using bf16x8=__attribute__((ext_vector_type(8)))short;
using s16x4=__attribute__((ext_vector_type(4)))short;
using f32x16=__attribute__((ext_vector_type(16)))float;
using u32x4=__attribute__((ext_vector_type(4)))unsigned;
constexpr int SEQ=2048,D=64;
constexpr int NW=8,QBLK=32,QB=QBLK*NW,KVBLK=64,NQB=SEQ/QB;
__device__ __forceinline__ int crow(int r,int hi){return (r&3)+8*(r>>2)+4*hi;}
#define SBAR() __builtin_amdgcn_sched_barrier(0)
constexpr int NSLOT=3, SLOTB=8192;
constexpr int LDS_K=0, LDS_V=NSLOT*SLOTB, LDS_WS=2*NSLOT*SLOTB, LDS_OST=LDS_WS+NW*64*4, LDS_RPB=LDS_OST+NW*4096,LDS_BYTES=LDS_RPB+2048;
constexpr float C2=0.125f*1.4426950408889634f;
__device__ __forceinline__ void glds16(const void*gsrc,unsigned lds_dst){unsigned keep;
  asm volatile("s_mov_b32 %0, m0\n\ts_mov_b32 m0, %2\n\ts_nop 0\n\tglobal_load_lds_dwordx4 %1, off\n\ts_mov_b32 m0, %0":"=&s"(keep):"v"(gsrc),"s"(lds_dst):"memory");}
__device__ __forceinline__ float max3f(float a,float b,float c){float r;asm("v_max3_f32 %0, %1, %2, %3":"=v"(r):"v"(a),"v"(b),"v"(c));return r;}
__device__ __forceinline__ float max2f(float a,float b){float r;asm("v_max_f32_e32 %0, %1, %2":"=v"(r):"v"(a),"v"(b));return r;}
__device__ __forceinline__ float fadd_s(float a,float b){float r;asm("v_add_f32_e32 %0, %1, %2":"=v"(r):"v"(a),"v"(b));return r;}
__device__ __forceinline__ float fsub_s(float a,float b){float r;asm("v_sub_f32_e32 %0, %1, %2":"=v"(r):"v"(a),"v"(b));return r;}
typedef float f32x2_t __attribute__((ext_vector_type(2))); typedef __bf16 bf16x2_t __attribute__((ext_vector_type(2)));
__device__ __forceinline__ unsigned cvtpk_s(float lo,float hi){f32x2_t v={lo,hi};bf16x2_t b=__builtin_convertvector(v,bf16x2_t);return __builtin_bit_cast(unsigned,b);}
#define WAIT_BAR(N) asm volatile("s_waitcnt vmcnt(" #N ") lgkmcnt(0)\n\ts_barrier":::"memory")

__device__ __forceinline__ void qkt(f32x16&p0,f32x16&p1,const char*Kslot,const bf16x8*qr,int r32,int hi){ const f32x16 negm=f32x16{};
  const char*kb=Kslot+hi*1024+r32*16;
  #pragma unroll
  for(int d0=0;d0<4;++d0){
    const bf16x8 b0=*reinterpret_cast<const bf16x8*>(kb+d0*2048);
    const bf16x8 b1=*reinterpret_cast<const bf16x8*>(kb+d0*2048+512);
    if(d0==0){p0=__builtin_amdgcn_mfma_f32_32x32x16_bf16(b0,qr[0],negm,0,0,0);p1=__builtin_amdgcn_mfma_f32_32x32x16_bf16(b1,qr[0],negm,0,0,0);}
    else{p0=__builtin_amdgcn_mfma_f32_32x32x16_bf16(b0,qr[d0],p0,0,0,0);p1=__builtin_amdgcn_mfma_f32_32x32x16_bf16(b1,qr[d0],p1,0,0,0);}}
}
typedef __attribute__((address_space(3))) const char* lds_cptr;
typedef short v4i16_t __attribute__((ext_vector_type(4)));
__device__ __forceinline__ void kload8(bf16x8*kf,lds_cptr kp){
  kf[0]=*(const __attribute__((address_space(3))) bf16x8*)(kp);      kf[1]=*(const __attribute__((address_space(3))) bf16x8*)(kp+512);
  kf[2]=*(const __attribute__((address_space(3))) bf16x8*)(kp+2048); kf[3]=*(const __attribute__((address_space(3))) bf16x8*)(kp+2560);
  kf[4]=*(const __attribute__((address_space(3))) bf16x8*)(kp+4096); kf[5]=*(const __attribute__((address_space(3))) bf16x8*)(kp+4608);
  kf[6]=*(const __attribute__((address_space(3))) bf16x8*)(kp+6144); kf[7]=*(const __attribute__((address_space(3))) bf16x8*)(kp+6656);
}
__device__ __forceinline__ void kload2(bf16x8*kf,lds_cptr kp,int j){ kf[2*j]=*(const __attribute__((address_space(3))) bf16x8*)(kp+j*2048); kf[2*j+1]=*(const __attribute__((address_space(3))) bf16x8*)(kp+j*2048+512); }
__device__ __forceinline__ s16x4 vtr(lds_cptr p){ return __builtin_bit_cast(s16x4,__builtin_amdgcn_ds_read_tr16_b64_v4i16((__attribute__((address_space(3))) v4i16_t*)p)); }
__device__ __forceinline__ float rowmax(const f32x16&p0,const f32x16&p1){
  float a=max3f(p0[0],p0[1],p1[0]),b=max3f(p0[2],p0[3],p1[1]);a=max3f(a,p1[2],p1[3]);
  #pragma unroll
  for(int r=4;r<16;r+=4){a=max3f(a,p0[r],p0[r+1]);b=max3f(b,p0[r+2],p0[r+3]);a=max3f(a,p1[r],p1[r+1]);b=max3f(b,p1[r+2],p1[r+3]);}
  const float m=max2f(a,b);
  auto rr=__builtin_amdgcn_permlane32_swap(__float_as_uint(m),__float_as_uint(m),false,false);
  return max2f(__uint_as_float(rr[0]),__uint_as_float(rr[1]));
}
__device__ __forceinline__ void pv(f32x16*o,int vb,bf16x8 pa0,bf16x8 pa1,bf16x8 pa2,bf16x8 pa3){
  #pragma unroll
  for(int d0=0;d0<2;++d0){s16x4 lo[4],hi[4];
    #pragma unroll
    for(int ks=0;ks<4;++ks){
      asm volatile("ds_read_b64_tr_b16 %0,%1 offset:%c2":"=&v"(lo[ks]):"v"(vb),"i"(d0*4096+ks*1024):"memory");
      asm volatile("ds_read_b64_tr_b16 %0,%1 offset:%c2":"=&v"(hi[ks]):"v"(vb),"i"(d0*4096+ks*1024+512):"memory");}
    asm volatile("s_waitcnt lgkmcnt(0)":::"memory");SBAR();
    #define PK(k) (bf16x8){lo[k][0],lo[k][1],lo[k][2],lo[k][3],hi[k][0],hi[k][1],hi[k][2],hi[k][3]}
    o[d0]=__builtin_amdgcn_mfma_f32_32x32x16_bf16(pa0,PK(0),o[d0],0,0,0);
    o[d0]=__builtin_amdgcn_mfma_f32_32x32x16_bf16(pa1,PK(1),o[d0],0,0,0);
    o[d0]=__builtin_amdgcn_mfma_f32_32x32x16_bf16(pa2,PK(2),o[d0],0,0,0);
    o[d0]=__builtin_amdgcn_mfma_f32_32x32x16_bf16(pa3,PK(3),o[d0],0,0,0);
    #undef PK
  }
}

struct AttnP { const bf16* Qw0; const bf16* Kh; const bf16* Vh; bf16* Ow0; int NT; int tbase; int toff; int qr0; float qscale; };
template<int THRL,int MODE,int QP,int KP,int VP,int OP> __device__ __forceinline__ void attn_unit(const AttnP&A,char*shm,const int tid){
  const int lane=tid&63,r32=lane&31,hi=lane>>5; const int wid=__builtin_amdgcn_readfirstlane(tid>>6);
  const bf16*Qw=A.Qw0+(long)(wid*QBLK)*QP;
  const bf16*Kh=A.Kh,*Vh=A.Vh;
  const int NT=A.NT;
  #define TROW(t) ((MODE==1)?(A.tbase+(((t)+A.toff)%NT)):(t))
  const unsigned lds0=(unsigned)(uintptr_t)shm;
  float*wsf=(float*)(shm+LDS_WS)+wid*64;
  const bf16*ksrc=Kh+(long)lane*KP+wid*8;
  const bf16*vsrc=Vh+(long)(16*(wid&3)+(lane>>2))*VP+(wid>>2)*32+(lane&3)*8;
  const unsigned kdst=lds0+LDS_K+wid*1024, vdst=lds0+LDS_V+wid*1024;
  #define DMA_K(t,slot) glds16(ksrc+(long)TROW(t)*KVBLK*KP,(unsigned)__builtin_amdgcn_readfirstlane(kdst+(slot)))
  #define DMA_V(t,slot) glds16(vsrc+(long)TROW(t)*KVBLK*VP,(unsigned)__builtin_amdgcn_readfirstlane(vdst+(slot)))
  const int vb0=(int)(lds0+LDS_V)+((lane>>4)&1)*32+(lane&3)*8+(4*hi+((lane&15)>>2))*64;
  const char*Kbase=shm+LDS_K; bf16x8 kf[8];
  const lds_cptr shm3=(lds_cptr)shm; const lds_cptr kp0=shm3+LDS_K+hi*1024+r32*16; const lds_cptr vp0=shm3+LDS_V+((lane>>4)&1)*32+(lane&3)*8+(4*hi+((lane&15)>>2))*64;
  DMA_K(0,0);DMA_V(0,0);DMA_K(1,SLOTB);
  bf16x8 qr[4];
  #pragma unroll
  for(int d0=0;d0<4;++d0)qr[d0]=*reinterpret_cast<const bf16x8*>(&Qw[(long)r32*QP+d0*16+hi*8]);
  if(MODE==1){
    #pragma unroll
    for(int d0=0;d0<4;++d0){ u32x4 w=__builtin_bit_cast(u32x4,qr[d0]);
      #pragma unroll
      for(int j=0;j<4;++j){ const float lo=__uint_as_float(w[j]<<16)*A.qscale, hv=__uint_as_float(w[j]&0xffff0000u)*A.qscale; w[j]=cvtpk_s(lo,hv);} qr[d0]=__builtin_bit_cast(bf16x8,w);} }
  const int na_qr=A.qr0+(wid>>1), na_qc=32*(wid&1)+r32; int na_rs=na_qr-4; na_rs=na_rs<0?0:(na_rs>24?24:na_rs); int na_cs=na_qc-8; na_cs=na_cs<0?0:(na_cs>48?48:na_cs);
  const float*rpbl=(const float*)(shm+LDS_RPB);
  #define NAMASK(P0,P1,t) do{ if(MODE==1){ const int kr_=TROW(t); const bool wv_=(kr_>=na_rs)&&(kr_<=na_rs+7); const float*tb_=rpbl+(kr_-na_qr+7)*31+(15-na_qc); const float NEG_=-INFINITY; \
      _Pragma("unroll") for(int r=0;r<16;++r){ const int kc_=crow(r,hi); const bool o0_=wv_&&(kc_>=na_cs)&&(kc_<na_cs+16); const bool o1_=wv_&&(kc_+32>=na_cs)&&(kc_+32<na_cs+16); \
        const float b0_=o0_?tb_[kc_]:0.f; const float b1_=o1_?tb_[kc_+32]:0.f; P0[r]=o0_?(P0[r]+b0_):NEG_; P1[r]=o1_?(P1[r]+b1_):NEG_; } } }while(0)
  float mhat=0.f,l_reg=0.f;f32x16 o[2];o[0]=f32x16{};o[1]=f32x16{};
  #define CMASK(P0,P1,t) NAMASK(P0,P1,t)
  bool resc=false;
  #define START(P0,P1) do{ const float rm=rowmax(P0,P1); resc=false; \
    { const float dl=rm; mhat=fadd_s(mhat,dl); \
      _Pragma("unroll") for(int r=0;r<16;++r){P0[r]=fsub_s(P0[r],dl);P1[r]=fsub_s(P1[r],dl);} \
      } \
    _Pragma("unroll") for(int r=0;r<16;++r)P0[r]=__builtin_amdgcn_exp2f(P0[r]); }while(0)
  #define RESC() do{ if(resc){ asm volatile("s_waitcnt lgkmcnt(0)":::"memory"); \
      _Pragma("unroll") for(int d_=0;d_<2;++d_) _Pragma("unroll") for(int r=0;r<16;++r)o[d_][r]*=wsf[crow(r,hi)]; } }while(0)
  f32x16 pA0,pA1,pB0,pB1;
  int sl_prev=0,sl_cur=0,sl_next=SLOTB;
  #define ROT() do{sl_prev=sl_cur;sl_cur=sl_next;sl_next=(sl_next==(NSLOT-1)*SLOTB)?0:sl_next+SLOTB;}while(0)
  DMA_K(2,2*SLOTB);
  WAIT_BAR(3);
  qkt(pA0,pA1,Kbase,qr,r32,hi);asm volatile("s_nop 15\n\ts_nop 7":"+v"(pA0),"+v"(pA1));CMASK(pA0,pA1,0);
  START(pA0,pA1);
  _Pragma("unroll") for(int r=0;r<16;++r)pA1[r]=__builtin_amdgcn_exp2f(pA1[r]);
  WAIT_BAR(0);
  DMA_K(3,0);DMA_V(1,SLOTB);
  ROT();
  kload8(kf,kp0+sl_cur);
  WAIT_BAR(2);
  s16x4 vlo[8],vhi[8]; u32x4 pw0,pw1,pw2,pw3;
  #define PKW(P,B) cvtpk_s(P[B],P[B+1])
  #define PAF(k) __builtin_bit_cast(bf16x8,pw##k)
  #define VFR(i) (bf16x8){vlo[i][0],vlo[i][1],vlo[i][2],vlo[i][3],vhi[i][0],vhi[i][1],vhi[i][2],vhi[i][3]}
  #define PIN(x) asm volatile("":"+v"(x))
  #define MX3(a,b,c) __builtin_fmaxf(__builtin_fmaxf((a),(b)),(c))
  #define GAPA(MF,A0,A1,A2,A3,W0,W1,PW) do{ MF; sacc+=A0; sacc+=A1; sacc+=A2; sacc+=A3; PIN(sacc); W0; W1; PIN(PW); SBAR(); }while(0)
  #define EX(v) __builtin_amdgcn_exp2f(v)
  #define GAPB(MF,X,B) do{ MF; X[B]=EX(X[B]); X[B+1]=EX(X[B+1]); X[B+2]=EX(X[B+2]); X[B+3]=EX(X[B+3]); PIN(X); SBAR(); }while(0)
  #define VRD(i) do{ vlo[i]=vtr(vp_+(((i)>>2)*4096+((i)&3)*1024)); vhi[i]=vtr(vp_+(((i)>>2)*4096+((i)&3)*1024+512)); }while(0)
  #define KRD(G,j) do{ if(G){ kload2(kf,kp0+sl_next,j); SBAR(); } }while(0)
  #define STEP(C0,C1,P0,P1,t,GK,GV,GL) do{ SBAR(); const f32x16 ZC_=f32x16{}; \
    const lds_cptr vp_=vp0+sl_prev; \
    VRD(0); SBAR(); float sacc=(P0[0]+P0[1]); \
    GAPA(C0=__builtin_amdgcn_mfma_f32_32x32x16_bf16(kf[0],qr[0],ZC_,0,0,0), P0[2],P0[3],P0[4],P0[5],     pw0[0]=PKW(P0,0), pw0[1]=PKW(P0,2), pw0); \
    VRD(4); SBAR(); GAPA(C1=__builtin_amdgcn_mfma_f32_32x32x16_bf16(kf[1],qr[0],ZC_,0,0,0), P0[6],P0[7],P0[8],P0[9],     pw0[2]=PKW(P0,4), pw0[3]=PKW(P0,6), pw0); \
    VRD(1); SBAR(); GAPA(C0=__builtin_amdgcn_mfma_f32_32x32x16_bf16(kf[2],qr[1],C0,0,0,0),   P0[10],P0[11],P0[12],P0[13], pw1[0]=PKW(P0,8), pw1[1]=PKW(P0,10), pw1); \
    VRD(5); SBAR(); GAPA(C1=__builtin_amdgcn_mfma_f32_32x32x16_bf16(kf[3],qr[1],C1,0,0,0),   P0[14],P0[15],P1[0],P1[1],   pw1[2]=PKW(P0,12),pw1[3]=PKW(P0,14), pw1); \
    VRD(2); SBAR(); GAPA(C0=__builtin_amdgcn_mfma_f32_32x32x16_bf16(kf[4],qr[2],C0,0,0,0),   P1[2],P1[3],P1[4],P1[5],     pw2[0]=PKW(P1,0), pw2[1]=PKW(P1,2), pw2); \
    VRD(6); SBAR(); GAPA(C1=__builtin_amdgcn_mfma_f32_32x32x16_bf16(kf[5],qr[2],C1,0,0,0),   P1[6],P1[7],P1[8],P1[9],     pw2[2]=PKW(P1,4), pw2[3]=PKW(P1,6), pw2); \
    VRD(3); SBAR(); GAPA(C0=__builtin_amdgcn_mfma_f32_32x32x16_bf16(kf[6],qr[3],C0,0,0,0),   P1[10],P1[11],P1[12],P1[13], pw3[0]=PKW(P1,8), pw3[1]=PKW(P1,10), pw3); \
    VRD(7); SBAR(); GAPA(C1=__builtin_amdgcn_mfma_f32_32x32x16_bf16(kf[7],qr[3],C1,0,0,0),   P1[14],P1[15],0.f,0.f,       pw3[2]=PKW(P1,12),pw3[3]=PKW(P1,14), pw3); \
    l_reg+=sacc; \
    if(GK){DMA_K((t)+3,sl_cur);} if(GV){DMA_V((t)+1,sl_next);} \
    _Pragma("unroll") for(int r=0;r<16;++r){C0[r]-=mhat;C1[r]-=mhat;} \
    CMASK(C0,C1,t); \
    { float a=MX3(C0[0],C0[1],C1[0]),b=MX3(C0[2],C0[3],C1[1]); a=MX3(a,C1[2],C1[3]); \
      _Pragma("unroll") for(int r=4;r<16;r+=4){a=MX3(a,C0[r],C0[r+1]);b=MX3(b,C0[r+2],C0[r+3]);a=MX3(a,C1[r],C1[r+1]);b=MX3(b,C1[r+2],C1[r+3]);} \
      float rm=__builtin_fmaxf(a,b); { auto rr=__builtin_amdgcn_permlane32_swap(__float_as_uint(rm),__float_as_uint(rm),false,false); rm=__builtin_fmaxf(__uint_as_float(rr[0]),__uint_as_float(rr[1])); } \
      resc=false; \
      if(__builtin_expect(__any(rm>(float)THRL),0)){ const float dl=__builtin_fmaxf(rm,0.f); mhat+=dl; \
        _Pragma("unroll") for(int r=0;r<16;++r){C0[r]-=dl;C1[r]-=dl;} \
        const float f=__builtin_amdgcn_exp2f(-dl); l_reg*=f; if(hi==0)wsf[r32]=f; resc=true; } } \
    SBAR(); \
    GAPB(o[0]=__builtin_amdgcn_mfma_f32_32x32x16_bf16(PAF(0),VFR(0),o[0],0,0,0), C0,0); \
    GAPB(o[1]=__builtin_amdgcn_mfma_f32_32x32x16_bf16(PAF(0),VFR(4),o[1],0,0,0), C0,4); \
    KRD(GL,0); GAPB(o[0]=__builtin_amdgcn_mfma_f32_32x32x16_bf16(PAF(1),VFR(1),o[0],0,0,0), C0,8); \
    KRD(GL,1); GAPB(o[1]=__builtin_amdgcn_mfma_f32_32x32x16_bf16(PAF(1),VFR(5),o[1],0,0,0), C0,12); \
    KRD(GL,2); GAPB(o[0]=__builtin_amdgcn_mfma_f32_32x32x16_bf16(PAF(2),VFR(2),o[0],0,0,0), C1,0); \
    KRD(GL,3); GAPB(o[1]=__builtin_amdgcn_mfma_f32_32x32x16_bf16(PAF(2),VFR(6),o[1],0,0,0), C1,4); \
    GAPB(o[0]=__builtin_amdgcn_mfma_f32_32x32x16_bf16(PAF(3),VFR(3),o[0],0,0,0), C1,8); \
    GAPB(o[1]=__builtin_amdgcn_mfma_f32_32x32x16_bf16(PAF(3),VFR(7),o[1],0,0,0), C1,12); \
    }while(0)
  int t=1;
  for(;t+5<NT;t+=2){
    STEP(pB0,pB1,pA0,pA1,t,true,true,true);     WAIT_BAR(2); RESC(); ROT();
    STEP(pA0,pA1,pB0,pB1,t+1,true,true,true);   WAIT_BAR(2); RESC(); ROT();
  }
  #define ENDW(tt) do{ if((tt)+3<NT){WAIT_BAR(2);} else if((tt)+2<NT){WAIT_BAR(1);} else {WAIT_BAR(0);} }while(0)
  for(;t+1<NT;t+=2){
    STEP(pB0,pB1,pA0,pA1,t,(t+3<NT),(t+1<NT),(t+1<NT));       ENDW(t);   RESC(); ROT();
    STEP(pA0,pA1,pB0,pB1,t+1,(t+4<NT),(t+2<NT),(t+2<NT));     ENDW(t+1); RESC(); ROT();
  }
  STEP(pB0,pB1,pA0,pA1,NT-1,false,false,false); RESC();
  { float sacc=pB0[0]+pB0[1]; _Pragma("unroll") for(int r=2;r<16;++r)sacc+=pB0[r]; _Pragma("unroll") for(int r=0;r<16;++r)sacc+=pB1[r]; l_reg+=sacc;
    pw0=(u32x4){PKW(pB0,0),PKW(pB0,2),PKW(pB0,4),PKW(pB0,6)};pw1=(u32x4){PKW(pB0,8),PKW(pB0,10),PKW(pB0,12),PKW(pB0,14)};pw2=(u32x4){PKW(pB1,0),PKW(pB1,2),PKW(pB1,4),PKW(pB1,6)};pw3=(u32x4){PKW(pB1,8),PKW(pB1,10),PKW(pB1,12),PKW(pB1,14)};
    SBAR(); pv(o,vb0+sl_cur,PAF(0),PAF(1),PAF(2),PAF(3)); }
  #undef PKW
  #undef PAF
  #undef VFR
  #undef PIN
  #undef MX3
  #undef GAPA
  #undef GAPB
  #undef EX
  #undef VRD
  #undef KRD
  #undef STEP
  #undef ENDW
  {auto rr=__builtin_amdgcn_permlane32_swap(__float_as_uint(l_reg),__float_as_uint(l_reg),false,false);l_reg=__uint_as_float(rr[0])+__uint_as_float(rr[1]);}
  if(hi==0)wsf[32+r32]=l_reg;asm volatile("s_waitcnt lgkmcnt(0)":::"memory");
  float rli[16];
  #pragma unroll
  for(int r=0;r<16;++r)rli[r]=__builtin_amdgcn_rcpf(wsf[32+crow(r,hi)]);
  bf16*Ow=A.Ow0+(long)(wid*QBLK)*OP;
  { bf16*stg=(bf16*)(shm+LDS_OST)+wid*2048;
    #pragma unroll
    for(int r=0;r<16;++r){const int orow=crow(r,hi);
      #pragma unroll
      for(int d0=0;d0<2;++d0)stg[orow*64+d0*32+r32]=__float2bfloat16(o[d0][r]*rli[r]);}
    asm volatile("s_waitcnt lgkmcnt(0)":::"memory");
    #pragma unroll
    for(int i=0;i<4;++i){const int row=i*8+(lane>>3),ch=lane&7; const u32x4 v=*(const u32x4*)(stg+row*64+ch*8); u32x4*dst=(u32x4*)(Ow+(long)row*OP+ch*8); const u32x4 g=*dst; u32x4 w;
      #pragma unroll
      for(int j=0;j<4;++j){ const float g0=__uint_as_float(g[j]<<16),g1=__uint_as_float(g[j]&0xffff0000u); const float o0=__uint_as_float(v[j]<<16),o1=__uint_as_float(v[j]&0xffff0000u);
        w[j]=cvtpk_s(o0*g0*__builtin_amdgcn_rcpf(1.f+__expf(-g0)),o1*g1*__builtin_amdgcn_rcpf(1.f+__expf(-g1))); }
      *dst=w; } }
  asm volatile("s_waitcnt lgkmcnt(0)\n\ts_barrier":::"memory");
  #undef DMA_K
  #undef DMA_V
  #undef CMASK
  #undef NAMASK
  #undef TROW
  #undef START
  #undef RESC
  #undef ROT
}
constexpr int ATTN_LDS_BYTES=LDS_BYTES;

#undef SBAR
#undef WAIT_BAR
}
namespace mk {
__device__ __forceinline__ void ph_attn(char* shm, bf16* P, const bf16* Qn, const bf16* Kn, const float* rpb, int nb, int tid, unsigned* ticket, volatile LAS unsigned* slot) {
    using attn_body::AttnP; typedef attn_body::bf16 abf;
    const int nunits = nb * 64;
#pragma unroll 1
    for (;;) {
        if (tid == 0) *slot = __hip_atomic_fetch_add(ticket, 1u, __ATOMIC_RELAXED, __HIP_MEMORY_SCOPE_AGENT);
        __syncthreads();
        const int uu = (int)__builtin_amdgcn_readfirstlane((int)*slot);
        __syncthreads();
        if (uu >= 2 * nunits) break;
        if (uu < nunits) { const int u = uu; const int b = u >> 6, h = (u >> 3) & 7, qb = u & 7, g = h >> 2; const size_t rb = (size_t)b * SEQ;
            AttnP A; A.Qw0 = (const abf*)(Qn + (rb + qb * 256) * 512 + h * 64); A.Kh = (const abf*)(Kn + rb * 128 + g * 64);
            A.Vh = (const abf*)(P + rb * LDP + PC_QKVC + 640 + g * 64); A.Ow0 = (abf*)(P + (rb + qb * 256) * LDP + PC_GC + h * 64);
            A.NT = 32; A.tbase = 0; A.toff = 0; A.qr0 = 0; A.qscale = 1.f;
            int tid2 = tid; asm volatile("" : "+v"(tid2)); attn_body::attn_unit<8, 0, 512, 128, LDP, LDP>(A, shm, tid2);
        } else { const int u = uu - nunits; const int b = u >> 6, h = (u >> 3) & 7, qb = u & 7; const size_t rb = (size_t)b * SEQ; const int qr0 = qb * 4;
            { float* tb = (float*)(shm + attn_body::LDS_RPB); for (int i = tid; i < 465; i += 512) tb[i] = rpb[h * 465 + i] * 1.4426950408889634f; }
            int rs0 = qr0 - 4; rs0 = rs0 < 0 ? 0 : (rs0 > 24 ? 24 : rs0); int rs3 = qr0 - 1; rs3 = rs3 < 0 ? 0 : (rs3 > 24 ? 24 : rs3); int NT = rs3 - rs0 + 8; NT += (NT & 1);
            AttnP A; A.Qw0 = (const abf*)(P + (rb + qb * 256) * LDP + PC_QKVD + h * 64); A.Kh = (const abf*)(P + rb * LDP + PC_QKVD + 512 + h * 64);
            A.Vh = (const abf*)(P + rb * LDP + PC_QKVD + 1024 + h * 64); A.Ow0 = (abf*)(P + (rb + qb * 256) * LDP + PC_GD + h * 64);
            A.NT = NT; A.tbase = rs0; A.toff = rs3 - rs0; A.qr0 = qr0; A.qscale = C2;
            int tid2 = tid; asm volatile("" : "+v"(tid2)); attn_body::attn_unit<8, 1, LDP, LDP, LDP, LDP>(A, shm, tid2); }
    }
}
}
namespace mk {
constexpr int RW_CH = 32;
constexpr int RW_P64 = 144, RW_P32 = 80, RW_TA_ROW = 144;
constexpr int RW_CONST = 0;
constexpr int RW_TA_LO = 4 * RW_TA_ROW;
constexpr int RW_PW = RW_CONST + 960 * 4, RW_PWB = 2 * RW_TA_LO + 2 * 4 * 64 * 4;
constexpr int RW_WT = RW_PW + 8 * RW_PWB;
constexpr int RW_WTOT = RW_WT + 2 * 64 * RW_TA_ROW;
constexpr int RW_TAL = RW_WTOT + 8 * 64 * 4;
constexpr int RW_TS = RW_TAL + 32 * RW_P64;
constexpr int O_TRH = 0, O_TBE = O_TRH + 32 * RW_P64, O_TKA = O_TBE + 32 * RW_P64, O_TBP = O_TKA + 32 * RW_P64, O_TKP = O_TBP + 64 * RW_P32, O_VT = O_TKP + 64 * RW_P32, O_GC = O_VT + 64 * RW_P32, RW_TSB = O_GC + 256;
constexpr int RW_S0B = RW_TS + 2 * RW_TSB;
constexpr int RW_UB = RW_S0B + 2 * 64 * RW_P64;
constexpr int RW_RF = RW_UB + 64 * RW_P32;
constexpr int RW_ABF = RW_RF + 64 * 36 * 4;
constexpr int RW_CORR = RW_ABF + 32 * 36 * 4;
constexpr int RW_DUMP = RW_CORR + 64 * 20 * 4;
constexpr int RW_LDS_END = RW_DUMP + 256;
static_assert(RW_LDS_END <= 163840 - 16, "rwkv lds");
#define RW_BAR() do { asm volatile("s_waitcnt lgkmcnt(0)" ::: "memory"); __builtin_amdgcn_s_barrier(); asm volatile("" ::: "memory"); } while (0)
__device__ __forceinline__ float dppf(float x, const int ctrl_sel) {
    const int xi = __builtin_bit_cast(int, x); int r;
    if (ctrl_sel == 0) r = __builtin_amdgcn_update_dpp(0, xi, 0xB1, 0xf, 0xf, true);
    else if (ctrl_sel == 1) r = __builtin_amdgcn_update_dpp(0, xi, 0x4E, 0xf, 0xf, true);
    else if (ctrl_sel == 2) r = __builtin_amdgcn_update_dpp(0, xi, 0x141, 0xf, 0xf, true);
    else r = __builtin_amdgcn_update_dpp(0, xi, 0x140, 0xf, 0xf, true);
    return __builtin_bit_cast(float, r);
}
__device__ __forceinline__ float sum16(float x) { x += dppf(x, 0); x += dppf(x, 1); x += dppf(x, 2); x += dppf(x, 3); return x; }
__device__ __forceinline__ float rw_fma(float a, float b, float c) { float r; asm("v_fma_f32 %0, %1, %2, %3" : "=v"(r) : "v"(a), "v"(b), "v"(c)); return r; }
__device__ __forceinline__ int rwcrow(int r, int hi) { return (r & 3) + 8 * (r >> 2) + 4 * hi; }
__device__ __forceinline__ unsigned rwpk(float lo, float hi) { typedef float f2 __attribute__((ext_vector_type(2))); typedef __bf16 b2 __attribute__((ext_vector_type(2))); f2 v = {lo, hi}; b2 b = __builtin_convertvector(v, b2); return __builtin_bit_cast(unsigned, b); }
__device__ __forceinline__ f32x16 rw_cc(const LAS unsigned char* X, const LAS unsigned char* Y, int r32, int hi) {
    f32x16 d = f32x16{};
#pragma unroll
    for (int s = 0; s < 4; ++s) d = __builtin_amdgcn_mfma_f32_32x32x16_bf16(*(const LAS bf16x8*)(X + r32 * RW_P64 + 32 * s + 16 * hi), *(const LAS bf16x8*)(Y + r32 * RW_P64 + 32 * s + 16 * hi), d, 0, 0, 0);
    return d;
}
__device__ __forceinline__ f32x16 rw_accmul(f32x16 acc, const LAS unsigned char* Lt_row, const f32x16& M, int hi) {
    v4u m0, m1; m0.x = rwpk(M[0], M[1]); m0.y = rwpk(M[2], M[3]); m0.z = rwpk(M[4], M[5]); m0.w = rwpk(M[6], M[7]); m1.x = rwpk(M[8], M[9]); m1.y = rwpk(M[10], M[11]); m1.z = rwpk(M[12], M[13]); m1.w = rwpk(M[14], M[15]);
#pragma unroll
    for (int s = 0; s < 2; ++s) { const LAS unsigned char* p = Lt_row + 2 * (16 * s + 4 * hi); const v2u lo = *(const LAS v2u*)p, hv = *(const LAS v2u*)(p + 16); v4u av; av.x = lo.x; av.y = lo.y; av.z = hv.x; av.w = hv.y;
        acc = __builtin_amdgcn_mfma_f32_32x32x16_bf16(__builtin_bit_cast(bf16x8, av), __builtin_bit_cast(bf16x8, s == 0 ? m0 : m1), acc, 0, 0, 0); }
    return acc;
}
__device__ __forceinline__ void rwkv_item(LAS unsigned char* lds_dyn, const bf16* P, int T, int z, int b, int h, const float* mu, const float* w0, const float* w_up, const float* a0, const float* a_up,
                                          const float* k_k, const float* k_a, const float* r_k, bf16* YB, float* CB, bf16* VB, const int tid_in) {
    (void)lds_dyn; LAS unsigned char* const lds = (LAS unsigned char*)(unsigned)0;
    unsigned mk_ = ~0u; int wv_ = tid_in; asm volatile("" : "+s"(mk_), "+s"(wv_));
    const int tid = wv_ * 64 + (int)__builtin_amdgcn_mbcnt_hi(mk_, __builtin_amdgcn_mbcnt_lo(mk_, 0u));
    const int lane0 = tid & 63, wave = __builtin_amdgcn_readfirstlane(tid >> 6);
    LAS float* CN = (LAS float*)(lds + RW_CONST);
    for (int i = tid; i < 960; i += 512) { float v;
        if (i < 640) { const int m = i / 320, j = i % 320, g = j >> 6, c = j & 63; const int ch = (g < 3 ? g * 512 + h * 64 : (g == 3 ? 1536 + z * 64 : 1664 + z * 64)) + c; v = mu[m * 1792 + ch]; }
        else { const int j = i - 640, g = j >> 6, c = j & 63; v = g == 0 ? w0[z * 512 + h * 64 + c] : g == 1 ? a0[z * 512 + h * 64 + c] : g == 2 ? k_k[h * 64 + c] : g == 3 ? k_a[h * 64 + c] : r_k[h * 64 + c]; }
        CN[i] = v; }
    for (int i = tid; i < 2 * 64 * 64; i += 512) { const int lo = i >> 12, k = (i >> 6) & 63, n = i & 63; const float* U = (lo == 0 ? w_up : a_up) + (size_t)z * 64 * 512 + h * 64;
        *(LAS unsigned short*)(lds + RW_WT + lo * 64 * RW_TA_ROW + n * RW_TA_ROW + 2 * k) = (unsigned short)f2bf(U[(size_t)k * 512 + n]); }
    for (int i = tid; i < 2 * 64 * RW_P64 / 4; i += 512) ((LAS unsigned*)(lds + RW_S0B))[i] = 0u;
    __syncthreads();
    const int NCH = SEQ / RW_CH;
    const int gcol[5] = {PC_SLAB + h * 64, PC_SLAB + 512 + h * 64, PC_SLAB + 1024 + h * 64, PC_SLAB + 1536 + z * 64, PC_SLAB + 1664 + z * 64};
    const size_t tb0 = (size_t)b * SEQ;
    v2u rawc[2][5], rawe[5];
#define RW_ROWOFF(step_) ({ const int i__ = (step_); int l__ = z ? (SEQ - 1 - i__) : i__; l__ = l__ < 0 ? 0 : (l__ > SEQ - 1 ? SEQ - 1 : l__); ((unsigned)(tb0 + l__) * (unsigned)LDP + 4u * (unsigned)cq) * 2u; })
#define RW_LOAD(cc) do { const GAS unsigned char* Pb_ = (const GAS unsigned char*)P; const int s0_ = (cc) * RW_CH + 4 * vw0; \
    const unsigned r0_ = RW_ROWOFF(s0_ + js), r1_ = RW_ROWOFF(s0_ + 4 + js), re_ = RW_ROWOFF(js == 0 ? s0_ - 1 : (js == 3 ? s0_ + 8 : s0_ + js)); \
    _Pragma("unroll") for (int g = 0; g < 5; ++g) { rawc[0][g] = *(const GAS v2u*)(Pb_ + (r0_ + 2u * (unsigned)gcol[g])); rawc[1][g] = *(const GAS v2u*)(Pb_ + (r1_ + 2u * (unsigned)gcol[g])); rawe[g] = *(const GAS v2u*)(Pb_ + (re_ + 2u * (unsigned)gcol[g])); } } while (0)
    { const int lane = lane0, js = lane >> 4, cq = lane & 15, vw0 = wave >= 4 ? 2 * (wave - 4) : 0; RW_LOAD(0); }
    f32x16 accS[2] = {f32x16{}, f32x16{}};
    LAS float* const WTOT = (LAS float*)(lds + RW_WTOT); LAS float* const RF = (LAS float*)(lds + RW_RF); LAS float* const ABF = (LAS float*)(lds + RW_ABF); LAS float* const CORR = (LAS float*)(lds + RW_CORR);
#pragma unroll 1
    for (int it = 0; it <= NCH; ++it) {
        int lane_ = lane0; asm volatile("" : "+v"(lane_));
        const int lane = lane_, r32 = lane & 31, hi = lane >> 5, js = lane >> 4, cq = lane & 15;
        const int cp = it, cc = it - 1;
        const bool prep = (wave >= 4) && (cp < NCH), chain = (wave < 4) && (cc >= 0);
        const int vw0 = 2 * (wave - 4); const int sjv[2] = {4 * vw0 + js, 4 * (vw0 + 1) + js};
        LAS unsigned char* const tsp = lds + RW_TS + (cp & 1) * RW_TSB; const LAS unsigned char* const tsc = lds + RW_TS + (cc & 1) * RW_TSB;
        const LAS unsigned char* S0cur = lds + RW_S0B + (cc & 1) * 64 * RW_P64; LAS unsigned char* S0nxt = lds + RW_S0B + ((cc + 1) & 1) * 64 * RW_P64;
        float sv[2][3][4];
        float o_kk[2][4], o_r[2][4], o_b[2][4], o_kd[2][4], o_v[2][4], lw2[2][4], Lin[2][4];
        if (prep) {
            float sw_[2][2][4];
            asm volatile("s_waitcnt vmcnt(0)" ::: "memory");
#pragma unroll
            for (int g = 0; g < 5; ++g) { const f32x4 m0 = *(const LAS f32x4*)(CN + g * 64 + 4 * cq), m1 = *(const LAS f32x4*)(CN + 320 + g * 64 + 4 * cq);
                const int am = ((lane - 16) & 63) << 2, ap = ((lane + 16) & 63) << 2;
                v2u A0, A1, B0, B1;
                A0.x = (unsigned)__builtin_amdgcn_ds_bpermute(am, (int)rawc[0][g].x); A0.y = (unsigned)__builtin_amdgcn_ds_bpermute(am, (int)rawc[0][g].y); A1.x = (unsigned)__builtin_amdgcn_ds_bpermute(am, (int)rawc[1][g].x); A1.y = (unsigned)__builtin_amdgcn_ds_bpermute(am, (int)rawc[1][g].y);
                B0.x = (unsigned)__builtin_amdgcn_ds_bpermute(ap, (int)rawc[0][g].x); B0.y = (unsigned)__builtin_amdgcn_ds_bpermute(ap, (int)rawc[0][g].y); B1.x = (unsigned)__builtin_amdgcn_ds_bpermute(ap, (int)rawc[1][g].x); B1.y = (unsigned)__builtin_amdgcn_ds_bpermute(ap, (int)rawc[1][g].y);
#pragma unroll
                for (int u = 0; u < 2; ++u) { const int i_ = cp * RW_CH + sjv[u]; const int l_ = z ? (SEQ - 1 - i_) : i_; const bool okp = (l_ - 1 >= 0), okn = (l_ + 1 < SEQ);
                    const v2u sm = u == 0 ? (js == 0 ? rawe[g] : A0) : (js == 0 ? A0 : A1), sp = u == 0 ? (js == 3 ? B1 : B0) : (js == 3 ? rawe[g] : B1);
                    const v2u lm = z ? sp : sm, lp = z ? sm : sp;
                    const v2u rp = {okp ? lm.x : 0u, okp ? lm.y : 0u}, rn_ = {okn ? lp.x : 0u, okn ? lp.y : 0u};
                    const float pr[4] = {bflo(rp.x), bfhi(rp.x), bflo(rp.y), bfhi(rp.y)}, cu[4] = {bflo(rawc[u][g].x), bfhi(rawc[u][g].x), bflo(rawc[u][g].y), bfhi(rawc[u][g].y)}, nx[4] = {bflo(rn_.x), bfhi(rn_.x), bflo(rn_.y), bfhi(rn_.y)};
#pragma unroll
                    for (int e = 0; e < 4; ++e) { const float val = cu[e] + m0[e] * (pr[e] - cu[e]) + m1[e] * (nx[e] - cu[e]); if (g < 3) sv[u][g][e] = val; else sw_[u][g - 3][e] = val; } } }
#pragma unroll
            for (int u = 0; u < 2; ++u) {
#pragma unroll
                for (int g = 0; g < 3; ++g) asm volatile("" : "+v"(sv[u][g][0]), "+v"(sv[u][g][1]), "+v"(sv[u][g][2]), "+v"(sv[u][g][3]) :: "memory");
#pragma unroll
                for (int g = 0; g < 2; ++g) asm volatile("" : "+v"(sw_[u][g][0]), "+v"(sw_[u][g][1]), "+v"(sw_[u][g][2]), "+v"(sw_[u][g][3]) :: "memory"); }
            __builtin_amdgcn_sched_barrier(0);
            LAS unsigned char* const TAw = lds + RW_PW + vw0 * RW_PWB;
            LAS float* const LRw = (LAS float*)(TAw + 2 * 8 * RW_TA_ROW);
#pragma unroll
            for (int u = 0; u < 2; ++u) { float th[4];
#pragma unroll
                for (int e = 0; e < 4; ++e) { const float ex = __builtin_amdgcn_exp2f(sw_[u][0][e] * 2.8853900817779268f); th[e] = 1.f - 2.f * __builtin_amdgcn_rcpf(1.f + ex); }
                v2u t0; t0.x = pk2(th[0], th[1]); t0.y = pk2(th[2], th[3]); *(LAS v2u*)(TAw + (4 * u + js) * RW_TA_ROW + 8 * cq) = t0;
                v2u t1; t1.x = pk2(sw_[u][1][0], sw_[u][1][1]); t1.y = pk2(sw_[u][1][2], sw_[u][1][3]); *(LAS v2u*)(TAw + 8 * RW_TA_ROW + (4 * u + js) * RW_TA_ROW + 8 * cq) = t1; }
        } else if (chain) {
            if (wave < 2) {
                const int v0 = 32 * wave; f32x16 acc = f32x16{};
#pragma unroll
                for (int s = 0; s < 4; ++s) acc = __builtin_amdgcn_mfma_f32_32x32x16_bf16(*(const LAS bf16x8*)(S0cur + (v0 + r32) * RW_P64 + 32 * s + 16 * hi), *(const LAS bf16x8*)(lds + RW_TAL + r32 * RW_P64 + 32 * s + 16 * hi), acc, 0, 0, 0);
                f32x16 ak = rw_cc(tsc + O_TKA, lds + RW_TAL, r32, hi);
#pragma unroll
                for (int r = 0; r < 16; ++r) ak[r] = (rwcrow(r, hi) < r32) ? ak[r] : 0.f;
                acc = rw_accmul(acc, tsc + O_VT + (v0 + r32) * RW_P32, ak, hi);
#pragma unroll
                for (int r = 0; r < 16; ++r) RF[(v0 + rwcrow(r, hi)) * 36 + r32] = acc[r];
            } else if (wave == 2) {
                f32x16 ab = rw_cc(tsc + O_TBE, lds + RW_TAL, r32, hi);
#pragma unroll
                for (int r = 0; r < 16; ++r) ABF[rwcrow(r, hi) * 36 + r32] = (rwcrow(r, hi) < r32) ? ab[r] : 0.f;
            }
        }
        RW_BAR();
        if (prep) {
            {   LAS unsigned char* const TAw = lds + RW_PW + vw0 * RW_PWB; LAS float* const LRw = (LAS float*)(TAw + 2 * 8 * RW_TA_ROW);
            {
                LAS float* const lrb = lane < 32 ? LRw + (4 * (lane >> 4)) * 64 + (lane & 15) : (LAS float*)(lds + RW_DUMP); const int rs = lane < 32 ? 64 : 0, ls = lane < 32 ? 512 : 0, ns = lane < 32 ? 16 : 0;
                bf16x8 Af[2][2], Wf[2][4][2]; f32x4 accL[2][4];
#pragma unroll
                for (int lo = 0; lo < 2; ++lo) { Af[lo][0] = *(const LAS bf16x8*)(TAw + lo * 8 * RW_TA_ROW + (lane & 15) * RW_TA_ROW + 16 * (lane >> 4)); Af[lo][1] = *(const LAS bf16x8*)(TAw + lo * 8 * RW_TA_ROW + (lane & 15) * RW_TA_ROW + 64 + 16 * (lane >> 4));
#pragma unroll
                    for (int nt = 0; nt < 4; ++nt) { const LAS unsigned char* wt = lds + RW_WT + lo * 64 * RW_TA_ROW + (16 * nt + (lane & 15)) * RW_TA_ROW + 16 * (lane >> 4); Wf[lo][nt][0] = *(const LAS bf16x8*)(wt); Wf[lo][nt][1] = *(const LAS bf16x8*)(wt + 64); } }
#pragma unroll
                for (int lo = 0; lo < 2; ++lo)
#pragma unroll
                    for (int nt = 0; nt < 4; ++nt) { f32x4 acc = {0.f, 0.f, 0.f, 0.f}; acc = __builtin_amdgcn_mfma_f32_16x16x32_bf16(Af[lo][0], Wf[lo][nt][0], acc, 0, 0, 0); accL[lo][nt] = __builtin_amdgcn_mfma_f32_16x16x32_bf16(Af[lo][1], Wf[lo][nt][1], acc, 0, 0, 0); }
#pragma unroll
                for (int lo = 0; lo < 2; ++lo)
#pragma unroll
                    for (int nt = 0; nt < 4; ++nt) { LAS float* lr = lrb + lo * ls + nt * ns; lr[0] = accL[lo][nt][0]; lr[rs] = accL[lo][nt][1]; lr[2 * rs] = accL[lo][nt][2]; lr[3 * rs] = accL[lo][nt][3]; } }
            }
            asm volatile("s_waitcnt lgkmcnt(0)" ::: "memory");
            LAS float* const LRw = (LAS float*)(lds + RW_PW + vw0 * RW_PWB + 2 * 8 * RW_TA_ROW); float bo_[2];
            f32x4 lw_[2], la_[2];
#pragma unroll
            for (int u = 0; u < 2; ++u) { lw_[u] = *(const LAS f32x4*)(LRw + (4 * u + js) * 64 + 4 * cq); la_[u] = *(const LAS f32x4*)(LRw + 512 + (4 * u + js) * 64 + 4 * cq); }
            const f32x4 c_w0 = *(const LAS f32x4*)(CN + 640 + 4 * cq), c_a0 = *(const LAS f32x4*)(CN + 704 + 4 * cq), c_kk = *(const LAS f32x4*)(CN + 768 + 4 * cq), c_ka = *(const LAS f32x4*)(CN + 832 + 4 * cq), c_rk = *(const LAS f32x4*)(CN + 896 + 4 * cq);
#pragma unroll
            for (int u = 0; u < 2; ++u) { const f32x4 lw = lw_[u], la = la_[u];
                float kx[4], n2 = 0.f;
#pragma unroll
                for (int e = 0; e < 4; ++e) { kx[e] = sv[u][1][e] * c_kk[e]; n2 += kx[e] * kx[e]; }
                n2 = sum16(n2); const float rn = __builtin_amdgcn_rsqf(fmaxf(n2, 1e-24f));
                float bo = 0.f;
#pragma unroll
                for (int e = 0; e < 4; ++e) { const float wraw = lw[e] + c_w0[e];
                    lw2[u][e] = -0.8750387749480469f * __builtin_amdgcn_rcpf(1.f + __expf(-wraw));
                    const float aa = __builtin_amdgcn_rcpf(1.f + __expf(-(la[e] + c_a0[e]))); o_kk[u][e] = kx[e] * rn; o_kd[u][e] = sv[u][1][e] * (1.f + (aa - 1.f) * c_ka[e]); o_b[u][e] = o_kk[u][e] * aa; o_r[u][e] = sv[u][0][e]; o_v[u][e] = sv[u][2][e];
                    bo += o_r[u][e] * o_kd[u][e] * c_rk[e]; }
                bo_[u] = sum16(bo);
#pragma unroll
                for (int e = 0; e < 4; ++e) { float x = lw2[u][e];
                    const float y1 = __builtin_bit_cast(float, __builtin_amdgcn_ds_bpermute(((lane - 16) & 63) << 2, __builtin_bit_cast(int, x))); x += (js >= 1) ? y1 : 0.f;
                    const float y2 = __builtin_bit_cast(float, __builtin_amdgcn_ds_bpermute(((lane - 32) & 63) << 2, __builtin_bit_cast(int, x))); x += (js >= 2) ? y2 : 0.f; Lin[u][e] = x; } }
#pragma unroll
            for (int u = 0; u < 2; ++u) { LAS float* wp = js == 3 ? WTOT + (vw0 + u) * 64 + 4 * cq : (LAS float*)(lds + RW_DUMP); *(LAS f32x4*)wp = (f32x4){Lin[u][0], Lin[u][1], Lin[u][2], Lin[u][3]}; }
#pragma unroll
            for (int u = 0; u < 2; ++u) { const int i_ = cp * RW_CH + sjv[u]; const int l_ = z ? (SEQ - 1 - i_) : i_; const size_t t = tb0 + l_;
                if (cq == 0) *(GAS float*)(CB + ((size_t)(z * 8 + h)) * T + t) = bo_[u];
                if (z == 0) { v2u vb; vb.x = pk2(o_v[u][0], o_v[u][1]); vb.y = pk2(o_v[u][2], o_v[u][3]); *(GAS v2u*)(VB + t * 512 + h * 64 + 4 * cq) = vb; } }
            __builtin_amdgcn_sched_barrier(0);
            { const int cn = cp + 1 < NCH ? cp + 1 : cp; RW_LOAD(cn); }
            __builtin_amdgcn_sched_barrier(0);
        } else if (chain && wave == 0) {
            LAS float* row = RF + lane * 36;
#define RW_SOLVE16(o_) do { float u[16]; \
            _Pragma("unroll") for (int q4 = 0; q4 < 4; ++q4) { f32x4 rr = *(const LAS f32x4*)(row + (o_) + 4 * q4); if ((o_) != 0) rr += *(const LAS f32x4*)(CORR + lane * 20 + 4 * q4); u[4 * q4] = rr[0]; u[4 * q4 + 1] = rr[1]; u[4 * q4 + 2] = rr[2]; u[4 * q4 + 3] = rr[3]; } \
            _Pragma("unroll") for (int tb = 0; tb < 4; ++tb) { f32x4 A_[4][4]; \
                _Pragma("unroll") for (int r_ = 0; r_ < 4; ++r_) _Pragma("unroll") for (int q4 = tb; q4 < 4; ++q4) A_[r_][q4] = *(const LAS f32x4*)(ABF + ((o_) + 4 * tb + r_) * 36 + (o_) + 4 * q4); \
                _Pragma("unroll") for (int r_ = 0; r_ < 4; ++r_) { const int tt = 4 * tb + r_; if (tt < 15) { const float nut = -u[tt]; \
                    _Pragma("unroll") for (int q4 = (tt + 1) / 4; q4 < 4; ++q4) { const f32x4 aa = A_[r_][q4]; \
                        _Pragma("unroll") for (int e_ = 0; e_ < 4; ++e_) if (4 * q4 + e_ > tt) u[4 * q4 + e_] = rw_fma(nut, aa[e_], u[4 * q4 + e_]); } } } } \
            v4u w0_, w1_; w0_.x = pk2(-u[0], -u[1]); w0_.y = pk2(-u[2], -u[3]); w0_.z = pk2(-u[4], -u[5]); w0_.w = pk2(-u[6], -u[7]); w1_.x = pk2(-u[8], -u[9]); w1_.y = pk2(-u[10], -u[11]); w1_.z = pk2(-u[12], -u[13]); w1_.w = pk2(-u[14], -u[15]); \
            *(LAS v4u*)(lds + RW_UB + lane * RW_P32 + 2 * (o_)) = w0_; *(LAS v4u*)(lds + RW_UB + lane * RW_P32 + 2 * (o_) + 16) = w1_; } while (0)
            RW_SOLVE16(0);
            asm volatile("s_waitcnt lgkmcnt(0)" ::: "memory");
            {
                v4u bw = {0u, 0u, 0u, 0u};
                if (r32 < 16) { const LAS float* ap = ABF + (8 * hi) * 36 + 16 + r32; bw.x = pk2(ap[0], ap[36]); bw.y = pk2(ap[72], ap[108]); bw.z = pk2(ap[144], ap[180]); bw.w = pk2(ap[216], ap[252]); }
#pragma unroll
                for (int vt = 0; vt < 2; ++vt) { f32x16 d = f32x16{};
                    d = __builtin_amdgcn_mfma_f32_32x32x16_bf16(*(const LAS bf16x8*)(lds + RW_UB + (32 * vt + r32) * RW_P32 + 16 * hi), __builtin_bit_cast(bf16x8, bw), d, 0, 0, 0);
                    if (r32 < 16) {
#pragma unroll
                        for (int r = 0; r < 16; ++r) CORR[(32 * vt + rwcrow(r, hi)) * 20 + r32] = d[r]; } }
            }
            asm volatile("s_waitcnt lgkmcnt(0)" ::: "memory");
            RW_SOLVE16(16);
#undef RW_SOLVE16
        }
        RW_BAR();
        if (prep) {
            f32x4 offu[2] = {{0.f, 0.f, 0.f, 0.f}, {0.f, 0.f, 0.f, 0.f}}, tot = {0.f, 0.f, 0.f, 0.f};
#pragma unroll
            for (int w = 0; w < 8; ++w) { const f32x4 tw = *(const LAS f32x4*)(WTOT + w * 64 + 4 * cq); tot += tw; if (w < vw0) offu[0] += tw; if (w < vw0 + 1) offu[1] += tw; }
#pragma unroll
            for (int u = 0; u < 2; ++u) { const int sj = sjv[u]; const f32x4 off = offu[u];
                float al[4], rh[4], be[4], ka[4], bp[4], kp[4];
#pragma unroll
                for (int e = 0; e < 4; ++e) { const float Lt = off[e] + Lin[u][e]; const float gprev = __builtin_amdgcn_exp2f(Lt - lw2[u][e]), gt = __builtin_amdgcn_exp2f(Lt), gi = __builtin_amdgcn_exp2f(-Lt), gp = __builtin_amdgcn_exp2f(tot[e] - Lt);
                    al[e] = gprev * o_kk[u][e]; rh[e] = gt * o_r[u][e]; be[e] = o_b[u][e] * gi; ka[e] = o_kd[u][e] * gi; bp[e] = o_b[u][e] * gp; kp[e] = o_kd[u][e] * gp; }
                v2u w; w.x = pk2(al[0], al[1]); w.y = pk2(al[2], al[3]); *(LAS v2u*)(lds + RW_TAL + sj * RW_P64 + 8 * cq) = w;
                w.x = pk2(rh[0], rh[1]); w.y = pk2(rh[2], rh[3]); *(LAS v2u*)(tsp + O_TRH + sj * RW_P64 + 8 * cq) = w;
                w.x = pk2(be[0], be[1]); w.y = pk2(be[2], be[3]); *(LAS v2u*)(tsp + O_TBE + sj * RW_P64 + 8 * cq) = w;
                w.x = pk2(ka[0], ka[1]); w.y = pk2(ka[2], ka[3]); *(LAS v2u*)(tsp + O_TKA + sj * RW_P64 + 8 * cq) = w;
#pragma unroll
                for (int e = 0; e < 4; ++e) { *(LAS unsigned short*)(tsp + O_TBP + (4 * cq + e) * RW_P32 + 2 * sj) = (unsigned short)f2bf(bp[e]); *(LAS unsigned short*)(tsp + O_TKP + (4 * cq + e) * RW_P32 + 2 * sj) = (unsigned short)f2bf(kp[e]);
                    *(LAS unsigned short*)(tsp + O_VT + (4 * cq + e) * RW_P32 + 2 * sj) = (unsigned short)f2bf(o_v[u][e]); }
                if (u == 1) { LAS float* gp_ = sj == 31 ? (LAS float*)(tsp + O_GC) + 4 * cq : (LAS float*)(lds + RW_DUMP); *(LAS f32x4*)gp_ = (f32x4){__builtin_amdgcn_exp2f(tot[0]), __builtin_amdgcn_exp2f(tot[1]), __builtin_amdgcn_exp2f(tot[2]), __builtin_amdgcn_exp2f(tot[3])}; } }
        } else if (chain) {
            if (wave < 2) {
                const int v0 = 32 * wave; f32x16 accY = f32x16{};
#pragma unroll
                for (int s = 0; s < 4; ++s) accY = __builtin_amdgcn_mfma_f32_32x32x16_bf16(*(const LAS bf16x8*)(S0cur + (v0 + r32) * RW_P64 + 32 * s + 16 * hi), *(const LAS bf16x8*)(tsc + O_TRH + r32 * RW_P64 + 32 * s + 16 * hi), accY, 0, 0, 0);
                { f32x16 bk = rw_cc(tsc + O_TKA, tsc + O_TRH, r32, hi);
#pragma unroll
                  for (int r = 0; r < 16; ++r) bk[r] = (rwcrow(r, hi) <= r32) ? bk[r] : 0.f;
                  accY = rw_accmul(accY, tsc + O_VT + (v0 + r32) * RW_P32, bk, hi); }
                { f32x16 bbm = rw_cc(tsc + O_TBE, tsc + O_TRH, r32, hi);
#pragma unroll
                  for (int r = 0; r < 16; ++r) bbm[r] = (rwcrow(r, hi) <= r32) ? bbm[r] : 0.f;
                  accY = rw_accmul(accY, lds + RW_UB + (v0 + r32) * RW_P32, bbm, hi); }
                {
                    const int iy = cc * RW_CH + r32; const int ly = z ? (SEQ - 1 - iy) : iy; GAS unsigned char* yb = (GAS unsigned char*)YB + (((size_t)z * T + tb0 + ly) * 512 + h * 64 + v0 + 4 * hi) * 2;
#pragma unroll
                    for (int g4 = 0; g4 < 4; ++g4) { v2u o; o.x = pk2(accY[4 * g4], accY[4 * g4 + 1]); o.y = pk2(accY[4 * g4 + 2], accY[4 * g4 + 3]); *(GAS v2u*)(yb + 16 * g4) = o; } }
            } else {
#pragma unroll
                for (int q = 0; q < 2; ++q) { const int sw = 2 * (wave - 2) + q, v0 = 32 * (sw & 1), k0 = 32 * (sw >> 1);
                    const float gcv = ((const LAS float*)(tsc + O_GC))[k0 + r32];
#pragma unroll
                    for (int r = 0; r < 16; ++r) accS[q][r] *= gcv;
#pragma unroll
                    for (int s = 0; s < 2; ++s) {
                        accS[q] = __builtin_amdgcn_mfma_f32_32x32x16_bf16(*(const LAS bf16x8*)(tsc + O_VT + (v0 + r32) * RW_P32 + 32 * s + 16 * hi), *(const LAS bf16x8*)(tsc + O_TKP + (k0 + r32) * RW_P32 + 32 * s + 16 * hi), accS[q], 0, 0, 0);
                        accS[q] = __builtin_amdgcn_mfma_f32_32x32x16_bf16(*(const LAS bf16x8*)(lds + RW_UB + (v0 + r32) * RW_P32 + 32 * s + 16 * hi), *(const LAS bf16x8*)(tsc + O_TBP + (k0 + r32) * RW_P32 + 32 * s + 16 * hi), accS[q], 0, 0, 0); } }
#pragma unroll
                for (int q = 0; q < 2; ++q) { const int sw = 2 * (wave - 2) + q, v0 = 32 * (sw & 1), k0 = 32 * (sw >> 1);
#pragma unroll
                    for (int r = 0; r < 16; ++r) *(LAS unsigned short*)(S0nxt + (v0 + rwcrow(r, hi)) * RW_P64 + 2 * (k0 + r32)) = (unsigned short)f2bf(accS[q][r]); } }
        }
        RW_BAR();
    }
#undef RW_LOAD
#undef RW_ROWOFF
    __syncthreads();
}
__device__ __forceinline__ void ph_rwkv(LAS unsigned char* lds, const bf16* P, int T, int nb, const float* mu, const float* w0, const float* w_up, const float* a0, const float* a_up, const float* k_k, const float* k_a, const float* r_k,
                                        bf16* YB, float* CB, bf16* VB, int tid, int bid, int nblk) {
    const int wv = __builtin_amdgcn_readfirstlane(tid >> 6);
#pragma unroll 1
    for (int it = bid; it < nb * 16; it += nblk) { const int z = it & 1, h = (it >> 1) & 7, b = it >> 4; rwkv_item(lds, P, T, z, b, h, mu, w0, w_up, a0, a_up, k_k, k_a, r_k, YB, CB, VB, wv); }
}
}
namespace mk {
constexpr int SS_RP = 272;
constexpr int SS_XP = 144;
constexpr int SS_BM = 0, SS_CM = SS_BM + 128 * SS_RP, SS_XN = SS_CM + 128 * SS_RP, SS_SB = SS_XN + 128 * SS_XP, SS_CUM = SS_SB + 128 * SS_XP, SS_MT = SS_CUM + 1024, SS_END = SS_MT + 10 * 2048;
__device__ __forceinline__ v2u ss_tr(unsigned addr) { v2u r; asm volatile("ds_read_b64_tr_b16 %0, %1" : "=&v"(r) : "v"(addr) : "memory"); return r; }
__device__ __forceinline__ void ss_wait4(v2u& a, v2u& b, v2u& c, v2u& d) { asm volatile("s_waitcnt lgkmcnt(0)" : "+v"(a), "+v"(b), "+v"(c), "+v"(d) :: "memory"); }
constexpr int SS_YP = 144;
static_assert(SS_END <= 147456, "ssd lds"); static_assert(SS_XP % 8 == 0 && SS_RP % 8 == 0, "transpose reads need 8-byte aligned rows");
__device__ __forceinline__ int crow(int r, int hi) { return (r & 3) + 8 * (r >> 2) + 4 * hi; }
__device__ __forceinline__ bf16x8 ldsA(const LAS unsigned char* base, int row, int colbyte) { return *(const LAS bf16x8*)(base + row * SS_RP + colbyte); }
__device__ __forceinline__ unsigned cvtpk(float lo, float hi) { typedef float f2 __attribute__((ext_vector_type(2))); typedef __bf16 b2 __attribute__((ext_vector_type(2))); f2 v = {lo, hi}; b2 b = __builtin_convertvector(v, b2); return __builtin_bit_cast(unsigned, b); }
__device__ __forceinline__ void ssd_item(LAS unsigned char* lds, const bf16* XC, const float* DT, const float* a_log, bf16* YA, int T, int z, int b, int h, const int tid) {
    const int lane = tid & 63, wave = __builtin_amdgcn_readfirstlane(tid >> 6), r32 = lane & 31, hi = lane >> 5;
    const int pt = wave & 1, qt = wave >> 1, g = h >> 2;
    const float a2 = -__expf(a_log[z * 8 + h]) * 1.4426950408889634f;
    LAS float* CUM = (LAS float*)(lds + SS_CUM);
    for (int i = tid; i < 128 * SS_XP / 4; i += 512) ((LAS unsigned*)(lds + SS_SB))[i] = 0u;
    f32x16 accS = f32x16{};
    const size_t tb0 = (size_t)b * SEQ;
    v4u pwb[4], pwc[4], pwx[2]; float pd[2], pl0, pl1;
#define SS_LOAD(cc) do { const GAS unsigned char* Xb_ = (const GAS unsigned char*)XC; const GAS unsigned char* Db_ = (const GAS unsigned char*)DT;     \
    _Pragma("unroll") for (int i = 0; i < 4; ++i) { const int idx = tid + 512 * i, q = idx >> 4, c8 = idx & 15; const int pos = 128 * (cc) + q; const unsigned t = (unsigned)tb0 + (unsigned)(z ? (SEQ - 1 - pos) : pos); \
        const unsigned o_ = (t * 1024u + 512u + (unsigned)(g * 128 + 8 * c8)) * 2u; pwb[i] = *(const GAS v4u*)(Xb_ + o_); pwc[i] = *(const GAS v4u*)(Xb_ + (o_ + 512u)); } \
    _Pragma("unroll") for (int i = 0; i < 2; ++i) { const int idx = tid + 512 * i, q = idx >> 3, c8 = idx & 7; const int pos = 128 * (cc) + q; const unsigned t = (unsigned)tb0 + (unsigned)(z ? (SEQ - 1 - pos) : pos); \
        pwx[i] = *(const GAS v4u*)(Xb_ + (t * 1024u + (unsigned)(h * 64 + 8 * c8)) * 2u); pd[i] = *(const GAS float*)(Db_ + (t * 16u + (unsigned)(z * 8 + h)) * 4u); } \
    { const int p0 = 128 * (cc) + 2 * lane; const unsigned t0 = (unsigned)tb0 + (unsigned)(z ? (SEQ - 1 - p0) : p0), t1 = (unsigned)tb0 + (unsigned)(z ? (SEQ - 2 - p0) : (p0 + 1)); pl0 = *(const GAS float*)(Db_ + (t0 * 16u + (unsigned)(z * 8 + h)) * 4u); pl1 = *(const GAS float*)(Db_ + (t1 * 16u + (unsigned)(z * 8 + h)) * 4u); } } while (0)
    SS_LOAD(0);
#pragma unroll 1
    for (int c = 0; c < SEQ / 128; ++c) {
        asm volatile("s_waitcnt vmcnt(2)" ::: "memory");
        __syncthreads();
#pragma unroll
        for (int i = 0; i < 4; ++i) { const int idx = tid + 512 * i, q = idx >> 4, c8 = idx & 15;
            *(LAS v4u*)(lds + SS_BM + q * SS_RP + 16 * c8) = pwb[i]; *(LAS v4u*)(lds + SS_CM + q * SS_RP + 16 * c8) = pwc[i]; }
#pragma unroll
        for (int i = 0; i < 2; ++i) { const int idx = tid + 512 * i, q = idx >> 3, c8 = idx & 7; const v4u wx = pwx[i]; const float d = pd[i]; v4u o;
            o.x = pk2(bflo(wx.x) * d, bfhi(wx.x) * d); o.y = pk2(bflo(wx.y) * d, bfhi(wx.y) * d); o.z = pk2(bflo(wx.z) * d, bfhi(wx.z) * d); o.w = pk2(bflo(wx.w) * d, bfhi(wx.w) * d);
            *(LAS v4u*)(lds + SS_XN + q * SS_XP + 16 * c8) = o; }
        if (wave == 0) {
            const float l0 = pl0 * a2, l1 = pl1 * a2; float x = l0 + l1;
#pragma unroll
            for (int o = 1; o < 64; o <<= 1) { const float y = __builtin_bit_cast(float, __builtin_amdgcn_ds_bpermute(((lane - o) & 63) << 2, __builtin_bit_cast(int, x))); x += (lane >= o) ? y : 0.f; }
            *(LAS f32x2v*)(CUM + 2 * lane) = (f32x2v){x - l1, x}; }
        asm volatile("" ::: "memory"); __builtin_amdgcn_sched_barrier(0);
        SS_LOAD(c + 1 < SEQ / 128 ? c + 1 : c);
        __builtin_amdgcn_sched_barrier(0);
        __syncthreads();
        const float cq = CUM[32 * qt + r32], clast = CUM[127];
        f32x16 acc = f32x16{};
        { bf16x8 cf[8];
#pragma unroll
          for (int s = 0; s < 8; ++s) cf[s] = ldsA(lds + SS_CM, 32 * qt + r32, 32 * s + 16 * hi);
          { const unsigned sa = (unsigned)(uintptr_t)(lds + SS_SB) + (unsigned)((8 * hi + ((lane & 15) >> 2)) * SS_XP + (32 * pt + 16 * ((lane >> 4) & 1) + 4 * (lane & 3)) * 2);
            v2u sl[8], sh[8];
#pragma unroll
            for (int s = 0; s < 8; ++s) { sl[s] = ss_tr(sa + 16 * s * SS_XP); sh[s] = ss_tr(sa + (16 * s + 4) * SS_XP); }
#pragma unroll
            for (int s = 0; s < 4; ++s) ss_wait4(sl[2 * s], sh[2 * s], sl[2 * s + 1], sh[2 * s + 1]);
#pragma unroll
            for (int s = 0; s < 8; ++s) { v4u av; av.x = sl[s].x; av.y = sl[s].y; av.z = sh[s].x; av.w = sh[s].y; acc = __builtin_amdgcn_mfma_f32_32x32x16_bf16(__builtin_bit_cast(bf16x8, av), cf[s], acc, 0, 0, 0); } }
          const float eq = __builtin_amdgcn_exp2f(cq);
#pragma unroll
          for (int r = 0; r < 16; ++r) acc[r] *= eq; }
#pragma unroll 1
        for (int tI = wave; tI < 10; tI += 8) { const int q2 = tI < 1 ? 0 : (tI < 3 ? 1 : (tI < 6 ? 2 : 3)), kt = tI - q2 * (q2 + 1) / 2; const float cq2 = CUM[32 * q2 + r32];
            f32x16 gT = f32x16{};
#pragma unroll
            for (int s = 0; s < 8; ++s) gT = __builtin_amdgcn_mfma_f32_32x32x16_bf16(ldsA(lds + SS_BM, 32 * kt + r32, 32 * s + 16 * hi), ldsA(lds + SS_CM, 32 * q2 + r32, 32 * s + 16 * hi), gT, 0, 0, 0);
#pragma unroll
            for (int gq = 0; gq < 4; ++gq) { const f32x4 ck = *(const LAS f32x4*)(CUM + 32 * kt + 8 * gq + 4 * hi);
#pragma unroll
                for (int e = 0; e < 4; ++e) { const int r = 4 * gq + e; const bool ok = (kt < q2) || (8 * gq + 4 * hi + e <= r32); const float m = __builtin_amdgcn_exp2f(cq2 - ck[e]); gT[r] = ok ? gT[r] * m : 0.f; } }
            v4u m0, m1; m0.x = cvtpk(gT[0], gT[1]); m0.y = cvtpk(gT[2], gT[3]); m0.z = cvtpk(gT[4], gT[5]); m0.w = cvtpk(gT[6], gT[7]); m1.x = cvtpk(gT[8], gT[9]); m1.y = cvtpk(gT[10], gT[11]); m1.z = cvtpk(gT[12], gT[13]); m1.w = cvtpk(gT[14], gT[15]);
            *(LAS v4u*)(lds + SS_MT + tI * 2048 + lane * 32) = m0; *(LAS v4u*)(lds + SS_MT + tI * 2048 + lane * 32 + 16) = m1; }
        __syncthreads();
#pragma unroll
        for (int kh = 0; kh < 2; ++kh) {
            v2u xl[2][4]; v4u mm[2][2];
#pragma unroll
            for (int k2 = 0; k2 < 2; ++k2) { const int kt = 2 * kh + k2, ktc = kt <= qt ? kt : qt;
                const unsigned xa = (unsigned)(uintptr_t)(lds + SS_XN) + (unsigned)((32 * ktc + 4 * hi + ((lane & 15) >> 2)) * SS_XP + (32 * pt + 16 * ((lane >> 4) & 1) + 4 * (lane & 3)) * 2);
                xl[k2][0] = ss_tr(xa); xl[k2][1] = ss_tr(xa + 8 * SS_XP); xl[k2][2] = ss_tr(xa + 16 * SS_XP); xl[k2][3] = ss_tr(xa + 24 * SS_XP);
                const LAS unsigned char* mp = lds + SS_MT + (qt * (qt + 1) / 2 + ktc) * 2048 + lane * 32; mm[k2][0] = *(const LAS v4u*)mp; mm[k2][1] = *(const LAS v4u*)(mp + 16); }
#pragma unroll
            for (int k2 = 0; k2 < 2; ++k2) { const int kt = 2 * kh + k2; ss_wait4(xl[k2][0], xl[k2][1], xl[k2][2], xl[k2][3]);
                if (kt <= qt) { v4u a0; a0.x = xl[k2][0].x; a0.y = xl[k2][0].y; a0.z = xl[k2][1].x; a0.w = xl[k2][1].y; v4u a1; a1.x = xl[k2][2].x; a1.y = xl[k2][2].y; a1.z = xl[k2][3].x; a1.w = xl[k2][3].y;
                    acc = __builtin_amdgcn_mfma_f32_32x32x16_bf16(__builtin_bit_cast(bf16x8, a0), __builtin_bit_cast(bf16x8, mm[k2][0]), acc, 0, 0, 0);
                    acc = __builtin_amdgcn_mfma_f32_32x32x16_bf16(__builtin_bit_cast(bf16x8, a1), __builtin_bit_cast(bf16x8, mm[k2][1]), acc, 0, 0, 0); } } }
        __syncthreads();
        { LAS unsigned short* ys = (LAS unsigned short*)(lds + SS_CM + (32 * qt + r32) * SS_YP) + 32 * pt;
#pragma unroll
          for (int g4 = 0; g4 < 4; ++g4) { v2u o; o.x = pk2(acc[4 * g4], acc[4 * g4 + 1]); o.y = pk2(acc[4 * g4 + 2], acc[4 * g4 + 3]); *(LAS v2u*)(ys + 8 * g4 + 4 * hi) = o; } }
        { const int q = tid >> 2, p0 = 16 * (tid & 3); LAS unsigned char* xr = lds + SS_XN + q * SS_XP + 2 * p0; v4u w0 = *(LAS v4u*)xr, w1 = *(LAS v4u*)(xr + 16);
          const float e = __builtin_amdgcn_exp2f(clast - CUM[q]);
          w0.x = pk2(bflo(w0.x) * e, bfhi(w0.x) * e); w0.y = pk2(bflo(w0.y) * e, bfhi(w0.y) * e); w0.z = pk2(bflo(w0.z) * e, bfhi(w0.z) * e); w0.w = pk2(bflo(w0.w) * e, bfhi(w0.w) * e);
          w1.x = pk2(bflo(w1.x) * e, bfhi(w1.x) * e); w1.y = pk2(bflo(w1.y) * e, bfhi(w1.y) * e); w1.z = pk2(bflo(w1.z) * e, bfhi(w1.z) * e); w1.w = pk2(bflo(w1.w) * e, bfhi(w1.w) * e);
          *(LAS v4u*)xr = w0; *(LAS v4u*)(xr + 16) = w1; }
        __syncthreads();
#pragma unroll
        for (int i = 0; i < 2; ++i) { const int idx = tid + 512 * i, q = idx >> 3, c8 = idx & 7; const int pos = 128 * c + q; const size_t t = tb0 + (z ? (SEQ - 1 - pos) : pos);
            *(GAS v4u*)(YA + ((size_t)z * T + t) * 512 + h * 64 + 8 * c8) = *(const LAS v4u*)(lds + SS_CM + q * SS_YP + 16 * c8); }
        { const float dl = __builtin_amdgcn_exp2f(clast);
#pragma unroll
          for (int r = 0; r < 16; ++r) accS[r] *= dl;
          { const int rq = 8 * hi + ((lane & 15) >> 2), cg = 16 * ((lane >> 4) & 1) + 4 * (lane & 3);
            const unsigned xa = (unsigned)(uintptr_t)(lds + SS_XN) + (unsigned)(rq * SS_XP + (32 * pt + cg) * 2), ba = (unsigned)(uintptr_t)(lds + SS_BM) + (unsigned)(rq * SS_RP + (32 * qt + cg) * 2);
            v2u al[8], ah[8], bl[8], bh[8];
#pragma unroll
            for (int s = 0; s < 8; ++s) { al[s] = ss_tr(xa + 16 * s * SS_XP); ah[s] = ss_tr(xa + (16 * s + 4) * SS_XP); bl[s] = ss_tr(ba + 16 * s * SS_RP); bh[s] = ss_tr(ba + (16 * s + 4) * SS_RP); }
#pragma unroll
            for (int s = 0; s < 8; ++s) ss_wait4(al[s], ah[s], bl[s], bh[s]);
#pragma unroll
            for (int s = 0; s < 8; ++s) { v4u av; av.x = al[s].x; av.y = al[s].y; av.z = ah[s].x; av.w = ah[s].y; v4u bv; bv.x = bl[s].x; bv.y = bl[s].y; bv.z = bh[s].x; bv.w = bh[s].y;
                accS = __builtin_amdgcn_mfma_f32_32x32x16_bf16(__builtin_bit_cast(bf16x8, av), __builtin_bit_cast(bf16x8, bv), accS, 0, 0, 0); } }
          LAS unsigned char* sb = lds + SS_SB + (32 * qt + r32) * SS_XP + (32 * pt + 4 * hi) * 2;
#pragma unroll
          for (int g4 = 0; g4 < 4; ++g4) { v2u o; o.x = pk2(accS[4 * g4], accS[4 * g4 + 1]); o.y = pk2(accS[4 * g4 + 2], accS[4 * g4 + 3]); *(LAS v2u*)(sb + 16 * g4) = o; } }
    }
#undef SS_LOAD
    __syncthreads();
}
__device__ __forceinline__ void ph_ssd(LAS unsigned char* lds, const bf16* XC, const float* DT, const float* a_log, bf16* YA, int T, int nb, int tid, int bid, int nblk, int blk0) {
#pragma unroll 1
    for (int it = (bid - blk0 + nblk) % nblk; it < nb * 16; it += nblk) { const int z = it & 1, h = (it >> 1) & 7, b = it >> 4; ssd_item(lds, XC, DT, a_log, YA, T, z, b, h, tid); }
}
}
namespace mk {
#define XB_TMO      128
#define XB_XCNT(j)  (256  + 64 * (j))
#define XB_XSUB(j)  (1280 + 64 * (j))
#define XB_XGEN(j)  (2304 + 64 * (j))
#define XB_TOP      3328
#define XB_TOPGEN   3392
#define XCD_BAR_WORDS 3456
#define XB_SPIN_CAP (1u << 18)

__device__ __forceinline__ unsigned xb_ld(unsigned* p)              { return __hip_atomic_load(p, __ATOMIC_RELAXED, __HIP_MEMORY_SCOPE_AGENT); }
__device__ __forceinline__ unsigned xb_add(unsigned* p, unsigned v) { return __hip_atomic_fetch_add(p, v, __ATOMIC_RELAXED, __HIP_MEMORY_SCOPE_AGENT); }
__device__ __forceinline__ unsigned xb_xcc_id() { return (unsigned)__builtin_amdgcn_s_getreg((3 << 11) | 20) & 0xFu; }
#define XB_SPIN(cond, bar) do { unsigned _sp = 0; while (cond) { __builtin_amdgcn_s_sleep(1); \
    if ((++_sp & 255u) == 0u) { if (xb_ld(&(bar)[XB_TMO])) break; if (_sp > XB_SPIN_CAP) { atomicAdd(&(bar)[XB_TMO], 1u); break; } } } } while (0)

struct XcdBarrier {
    unsigned* bar; unsigned x;
    volatile LAS unsigned* st;
};

__device__ __forceinline__ XcdBarrier xcd_barrier_post(unsigned* bar, volatile LAS unsigned* st) {
    XcdBarrier b; b.bar = bar; b.x = xb_xcc_id(); b.st = st;
    if (threadIdx.x == 0) (void)xb_add(&bar[XB_XCNT(b.x)], 1u);
    return b;
}
__device__ __forceinline__ void xcd_barrier_complete(unsigned* bar, unsigned x, unsigned& nloc, unsigned& nx) {
    const unsigned G = gridDim.x * gridDim.y * gridDim.z;
    unsigned sum, cnt, mine, sp = 0u;
    for (;;) {
        sum = 0u; cnt = 0u; mine = 0u;
#pragma unroll
        for (unsigned j = 0; j < 16; ++j) { const unsigned c = xb_ld(&bar[XB_XCNT(j)]); sum += c; cnt += (c > 0u) ? 1u : 0u; mine = (j == x) ? c : mine; }
        if (sum == G) break;
        __builtin_amdgcn_s_sleep(1);
        if ((++sp & 255u) == 0u) { if (xb_ld(&bar[XB_TMO])) break; if (sp > XB_SPIN_CAP) { atomicAdd(&bar[XB_TMO], 1u); break; } }
    }
    nloc = mine > 0u ? mine : 1u; nx = cnt > 0u ? cnt : 1u;
}

__device__ __forceinline__ void xcd_barrier(const XcdBarrier& b) {
    asm volatile("s_waitcnt vmcnt(0)" ::: "memory");
    __syncthreads();
    if (threadIdx.x == 0) {
        unsigned* bar = b.bar;
        __builtin_amdgcn_s_waitcnt(0);
        unsigned nloc = b.st[0], nx = b.st[1];
        if (nloc == 0u) { xcd_barrier_complete(bar, b.x, nloc, nx); b.st[0] = nloc; b.st[1] = nx; }
        const unsigned old = xb_add(&bar[XB_XSUB(b.x)], 1u);
        const unsigned gen = old / nloc;
        if (old + 1u == (gen + 1u) * nloc) {
            __builtin_amdgcn_fence(__ATOMIC_RELEASE, "agent");
            asm volatile("s_waitcnt vmcnt(0)" ::: "memory");
            const unsigned og = xb_add(&bar[XB_TOP], 1u);
            const unsigned tg = og / nx;
            if (og + 1u == (tg + 1u) * nx) xb_add(&bar[XB_TOPGEN], 1u);
            else XB_SPIN(xb_ld(&bar[XB_TOPGEN]) == tg, bar);
            __builtin_amdgcn_fence(__ATOMIC_ACQUIRE, "agent");
            xb_add(&bar[XB_XGEN(b.x)], 1u);
            asm volatile("s_waitcnt vmcnt(0)" ::: "memory");
        } else {
            XB_SPIN(xb_ld(&bar[XB_XGEN(b.x)]) == gen, bar);
            __builtin_amdgcn_fence(__ATOMIC_ACQUIRE, "agent");
            asm volatile("s_waitcnt vmcnt(0)" ::: "memory");
        }
    }
    __syncthreads();
}


}
#include <hip/hip_cooperative_groups.h>
namespace mk {
namespace cg = cooperative_groups;
constexpr int LDS_BYTES = 163840;
constexpr int NB_HALF = 8, TH = NB_HALF * SEQ;
constexpr size_t al256(size_t x) { return (x + 255) / 256 * 256; }
constexpr size_t WS_CTL = 0, CTL_BYTES = 65536, WS_W = CTL_BYTES, WS_ROPE = al256(WS_W + 2 * W_LAYER_ELEMS * 2), WS_H = al256(WS_ROPE + 2ull * SEQ * 32 * 4), WS_P = al256(WS_H + (size_t)TH * 1024 * 2), WS_X = al256(WS_P + (size_t)TH * LDP * 2);
constexpr size_t X_XC = 0, X_DT = al256(X_XC + (size_t)TH * 1024 * 2), X_QN = al256(X_DT + (size_t)TH * 16 * 4), X_KN = al256(X_QN + (size_t)TH * 512 * 2), X_YA = al256(X_KN + (size_t)TH * 128 * 2),
                 X_YB = al256(X_YA + 2ull * TH * 512 * 2), X_CB = al256(X_YB + 2ull * TH * 512 * 2), X_VB = al256(X_CB + 2ull * TH * 8 * 4), X_RS = al256(X_VB + (size_t)TH * 512 * 2), X_END1 = al256(X_RS + 9ull * SEQ * 512 * 4);
constexpr size_t X_MF = 0, X_MB = al256(X_MF + (size_t)TH * 1024 * 4), X_OF = al256(X_MB + (size_t)TH * 1024 * 2), X_END2 = al256(X_OF + (size_t)TH * 1024 * 4);
constexpr size_t WS_NEED = WS_X + (X_END1 > X_END2 ? X_END1 : X_END2);
static_assert(WS_NEED <= 536870912ull, "workspace map exceeds 512 MiB");
struct MegaArgs { const float* in[25]; float* out; unsigned char* ws; };
__global__ __launch_bounds__(512, 2) void k_mega(MegaArgs a) {
    extern __shared__ __attribute__((aligned(16))) unsigned char lds_[];
    LAS unsigned char* const lds = (LAS unsigned char*)(unsigned)0;
    cg::grid_group grid = cg::this_grid();
    volatile LAS unsigned* xbst = (volatile LAS unsigned*)(lds + LDS_BYTES - 16);
    if (threadIdx.x < 4) xbst[threadIdx.x] = 0u;
    __syncthreads();
    XcdBarrier xbar = xcd_barrier_post((unsigned*)(a.ws + WS_CTL), xbst);
#define GSYNC() xcd_barrier(xbar)
    const int wave0 = __builtin_amdgcn_readfirstlane((int)threadIdx.x >> 6);
#define PV int bid = blockIdx.x, wv_ = wave0; unsigned mk_ = ~0u; unsigned char* ws = a.ws; asm volatile("" : "+s"(bid), "+s"(wv_), "+s"(mk_), "+s"(ws)); int tid = wv_ * 64 + (int)__builtin_amdgcn_mbcnt_hi(mk_, __builtin_amdgcn_mbcnt_lo(mk_, 0u)); asm volatile("" : "+v"(tid)); const int lane = tid & 63, wave = wv_; const int gw = bid * 8 + wave, ngw = gridDim.x * 8, gtid = bid * 512 + tid, nthr = gridDim.x * 512; (void)lane; (void)wave; (void)gw; (void)ngw; (void)gtid; (void)nthr; bf16* Wall = (bf16*)(ws + WS_W); float* rope = (float*)(ws + WS_ROPE); bf16* H = (bf16*)(ws + WS_H); bf16* P = (bf16*)(ws + WS_P); unsigned char* X = ws + WS_X; bf16* XC = (bf16*)(X + X_XC); float* DT = (float*)(X + X_DT); bf16* Qn = (bf16*)(X + X_QN); bf16* Kn = (bf16*)(X + X_KN); bf16* YA = (bf16*)(X + X_YA); bf16* YB = (bf16*)(X + X_YB); float* CB = (float*)(X + X_CB); bf16* VB = (bf16*)(X + X_VB); float* Mf = (float*)(X + X_MF); bf16* Mb = (bf16*)(X + X_MB); float* OF = (float*)(X + X_OF); const bf16* W = Wall + (size_t)l * W_LAYER_ELEMS; (void)rope; (void)H; (void)P; (void)XC; (void)DT; (void)Qn; (void)Kn; (void)YA; (void)YB; (void)CB; (void)VB; (void)Mf; (void)Mb; (void)OF; (void)W;
    { const int l = 0; PV; ph_wconv(a.in[2], a.in[22], a.in[23], Wall, lds, gw, ngw, wave, lane); }
    { const int l = 0; PV; ph_rope_table(rope, gtid, nthr); }
    { const int l = 0; PV; ph_rmsnorm(a.in[0], a.in[1], H, TH, gw, ngw, lane); }
    grid.sync();
#pragma unroll 1
    for (int hf = 0; hf < 2; ++hf) {
#pragma unroll 1
        for (int l = 0; l < 2; ++l) {
            const size_t ro = (size_t)hf * TH * 1024; const float* xin = (l == 0 ? a.in[0] : a.out) + ro; float* xout = a.out + ro;
            { PV; ph_gemm_bf16out_range(lds, H, 1024, W + WOFF_W1, TH, (int)W1T_N, 1024, P, LDP, 0, 7, tid, bid); }
            GSYNC();
            { const int G_ = (int)gridDim.x, nwg_ = (TH / 256) * ((int)W1T_N / 256); int nb8 = nwg_ - 7 * G_; nb8 = nb8 < 0 ? 0 : (nb8 > G_ ? G_ : nb8);
              const bool ov = (7 * G_ >= 960) && (nb8 < G_);
              if (!ov || (int)blockIdx.x < nb8) { PV; ph_gemm_bf16out_range(lds, H, 1024, W + WOFF_W1, TH, (int)W1T_N, 1024, P, LDP, 7, 1 << 20, tid, bid); }
              if (!ov) GSYNC();
              if (!ov || (int)blockIdx.x >= nb8) { PV; const int off = ov ? nb8 * 512 : 0; ph_prep_conv(P, TH, a.in[3] + l * 5 * 1024, a.in[4] + l * 1024, a.in[5] + l * 16, XC, DT, gtid - off, nthr - off); } }
            { PV; ph_prep_gqa(P, TH, a.in[19] + l * 64, a.in[20] + l * 64, rope, Qn, Kn, gtid, nthr); }
            GSYNC();
            { PV; ph_rwkv(lds, P, TH, NB_HALF, a.in[9] + l * 2 * 1792, a.in[10] + l * 1024, a.in[11] + (size_t)l * 2 * 64 * 512, a.in[12] + l * 1024, a.in[13] + (size_t)l * 2 * 64 * 512, a.in[14] + l * 512, a.in[15] + l * 512, a.in[16] + l * 512, YB, CB, VB, tid, bid, (int)gridDim.x); }
            { PV; ph_ssd(lds, XC, DT, a.in[6] + l * 16, YA, TH, NB_HALF, tid, bid, (int)gridDim.x, 128); }
            { PV; ph_attn((char*)lds_, P, Qn, Kn, a.in[21] + l * 8 * 465, NB_HALF, tid, (unsigned*)(ws + WS_CTL) + 8192 + 64 * (2 * l + hf), (volatile LAS unsigned*)(lds + LDS_BYTES - 8)); }
            GSYNC();
            { PV; ph_post(P, TH, XC, YA, a.in[7] + l * 8, a.in[8] + l * 512, YB, CB, VB, a.in[17] + l * 512, a.in[18] + l * 512, gw, ngw, lane); }
            { PV; ph_gemm_rsigout(lds, H, 1024, W + WOFF_W2, TH, (int)W2T_N, 1024, P, LDP, tid, bid); }
            GSYNC();
            { PV; EpiMergeF E{Mb, P, LDP}; run_gemm(lds, P + PC_Y, LDP, W + WOFF_WB, TH, 1024, 2048, E, tid, bid); }
            GSYNC();
            { PV; EpiF32 E{OF, 1024}; run_gemm(lds, Mb, 1024, W + WOFF_WO, TH, 1024, 1024, E, tid, bid); }
            GSYNC();
            { PV; ph_fin(xin, OF, a.in[24] + l * 1024, xout, l == 0 ? a.in[1] + 1024 : nullptr, H, TH, gw, ngw, lane); }
            if (l == 1 && hf == 0) { PV; ph_rmsnorm(a.in[0] + (size_t)TH * 1024, a.in[1], H, TH, gw, ngw, lane); }
            GSYNC();
        }
    }
}
}
extern "C" void kernel_launch(void* const* d_in, const int* in_sizes, int n_in, void* d_out, int out_size, void* d_ws, size_t ws_size, hipStream_t stream) {
    static int grid_blocks = 0;
    if (!grid_blocks) {
        if (ws_size < mk::WS_NEED) { fprintf(stderr, "ws too small: need %zu have %zu\n", (size_t)mk::WS_NEED, ws_size); grid_blocks = -1; return; }
        int dev = 0, cus = 0, per_cu = 0; (void)hipGetDevice(&dev); (void)hipDeviceGetAttribute(&cus, hipDeviceAttributeMultiprocessorCount, dev);
        (void)hipFuncSetAttribute((const void*)mk::k_mega, hipFuncAttributeMaxDynamicSharedMemorySize, mk::LDS_BYTES);
        (void)hipOccupancyMaxActiveBlocksPerMultiprocessor(&per_cu, (const void*)mk::k_mega, 512, mk::LDS_BYTES);
        if (per_cu < 1) { fprintf(stderr, "occupancy query says %d blocks/CU\n", per_cu); per_cu = 1; }
        grid_blocks = cus;
        fprintf(stderr, "k_mega: cus %d per_cu %d grid %d ws_need %zu ws %zu\n", cus, per_cu, grid_blocks, (size_t)mk::WS_NEED, ws_size);
    }
    if (grid_blocks < 0) return;
    mk::MegaArgs a{}; for (int i = 0; i < 25; ++i) a.in[i] = (const float*)d_in[i]; a.out = (float*)d_out; a.ws = (unsigned char*)d_ws;
    (void)hipMemsetAsync((char*)d_ws + mk::WS_CTL, 0, mk::CTL_BYTES, stream);
    void* args[] = {(void*)&a};
    hipError_t e = hipLaunchCooperativeKernel((const void*)mk::k_mega, dim3(grid_blocks), dim3(512), args, mk::LDS_BYTES, stream);
    if (e != hipSuccess) fprintf(stderr, "cooperative launch failed: %s (grid %d)\n", hipGetErrorString(e), grid_blocks);
}
```

```cpp
#include <hip/hip_runtime.h>
#include <cstdio>
#include <cstdint>
#include <cmath>
namespace pg8 {
#define PG8_LAS __attribute__((address_space(3)))
typedef unsigned short bf16_t;
typedef short bf16x8 __attribute__((ext_vector_type(8)));
typedef float f32x4 __attribute__((ext_vector_type(4)));
typedef unsigned u32x4 __attribute__((ext_vector_type(4)));
constexpr int BM = 256, BK = 64, HALF = 128, HTB = HALF * BK * 2  , STAGE_BYTES = 8 * HTB, NXCD = 8, WGM = 8;

__host__ __device__ __forceinline__ int lds_byte(int r, int c) { const int st = (r >> 4) * 2 + (c >> 5), rr = r & 15, cc = c & 31, ob = rr * 64 + cc * 2; return st * 1024 + (ob ^ (((ob >> 9) & 1) << 5)); }
__host__ __device__ __forceinline__ void stage_rc(int b, int& R, int& C) { const int st = b / 1024, sb = b % 1024, swz = sb ^ (((sb >> 9) & 1) << 5); R = (st >> 1) * 16 + swz / 64; C = (st & 1) * 32 + (swz % 64) / 2; }
__host__ __device__ __forceinline__ int perm32(int rho) { const int n = rho >> 4, i = rho & 15; return 8 * (i >> 2) + 4 * n + (i & 3); }

struct Unit { int pm, pn; };
struct Gemm { const bf16_t* A; const bf16_t* Bt; int M, N, K, lda; };

struct StaticOrder {
    int nM, nN, nwg, G, c;
    __host__ __device__ void init(int M, int N, int G_, int c_) { nM = M / BM; nN = N / BM; nwg = nM * nN; G = G_; c = c_; }
    __host__ __device__ bool next(int i, Unit& u) const {
        const long L = (long)i * G + c; if (L >= nwg) return false;
        int wgid = (int)L; { const int q = nwg / NXCD, r = nwg % NXCD, xcd = wgid % NXCD, off = wgid / NXCD; wgid = (xcd < r ? xcd * (q + 1) : r * (q + 1) + (xcd - r) * q) + off; }
        const int nig = WGM * nN, gid = wgid / nig, fm = gid * WGM, gsz = (nM - fm) < WGM ? (nM - fm) : WGM;
        u.pm = fm + ((wgid % nig) % gsz); u.pn = (wgid % nig) / gsz; return true;
    }
    __device__ __forceinline__ void a_ready(const Unit&) const {}
    __device__ __forceinline__ void done(const Unit&) const {}
};

__device__ __forceinline__ unsigned cvt_pk_bf16(float lo, float hi) { unsigned r; asm volatile("v_cvt_pk_bf16_f32 %0, %1, %2" : "=v"(r) : "v"(lo), "v"(hi)); return r; }
typedef float f32x2 __attribute__((ext_vector_type(2)));
__device__ __forceinline__ f32x2 gelu_pk(f32x2 v) {
    const f32x2 av = __builtin_elementwise_abs(v), d = av * 0.2316418882f + 1.0f;
    f32x2 t; t.x = __builtin_amdgcn_rcpf(d.x); t.y = __builtin_amdgcn_rcpf(d.y);
    f32x2 q = t * 0.5307027145f + (-0.7265760135f); q = q * t + 0.7107068705f; q = q * t + (-0.142248368f); q = q * t + 0.127414796f; q = q * t;
    const f32x2 s = (v * v) * (-0.72134752044f);
    f32x2 e; e.x = __builtin_amdgcn_exp2f(s.x); e.y = __builtin_amdgcn_exp2f(s.y);
    const f32x2 m = v * (q * e), r = v - m;
    f32x2 o; o.x = v.x < 0.f ? m.x : r.x; o.y = v.y < 0.f ? m.y : r.y; return o;
}

template <int ACT  > struct EpiBf16 {
    static constexpr bool PERM = true, AFTER_DRAIN = false, FOLD = false; static_assert(ACT >= 0 && ACT <= 2, "EpiBf16: ACT is 0 (none), 1 (gelu_pk) or 2 (1 + exp(-x), the reciprocal sigmoid)");
    bf16_t* O; int ldc; const float* bias; int split_cols; size_t split_stride; float scale0;
    __device__ __forceinline__ void operator()(const f32x4 (&acc)[2][2][4][2], const Unit& u, int wr, int wc, int fr, int fq) const {
        const int row0 = u.pm * BM + wr * 64 + fr; int colt = u.pn * BM; bf16_t* base = O;
        float sc = 1.f; if (split_cols) { const int t = colt / split_cols; base += (size_t)t * split_stride; colt -= t * split_cols; if (t == 0) sc = scale0; }
        const int col0 = colt + wc * 32 + 8 * fq, bcol0 = u.pn * BM + wc * 32 + 8 * fq;
        f32x4 bv[2][2];
#pragma unroll
        for (int bj = 0; bj < 2; ++bj)
#pragma unroll
            for (int n = 0; n < 2; ++n) bv[bj][n] = bias ? *(const f32x4*)(bias + bcol0 + bj * HALF + 4 * n) : (f32x4){0.f, 0.f, 0.f, 0.f};
#pragma unroll
        for (int ai = 0; ai < 2; ++ai)
#pragma unroll
            for (int m = 0; m < 4; ++m) { bf16_t* rowp = base + (size_t)(row0 + ai * HALF + m * 16) * ldc + col0;
#pragma unroll
                for (int bj = 0; bj < 2; ++bj) { f32x4 v0 = acc[ai][bj][m][0] + bv[bj][0], v1 = acc[ai][bj][m][1] + bv[bj][1];
                    if (ACT == 1) { f32x2 a = gelu_pk((f32x2){v0[0], v0[1]}), b = gelu_pk((f32x2){v0[2], v0[3]}), c = gelu_pk((f32x2){v1[0], v1[1]}), d = gelu_pk((f32x2){v1[2], v1[3]});
                        v0 = (f32x4){a.x, a.y, b.x, b.y}; v1 = (f32x4){c.x, c.y, d.x, d.y}; }
                    if (ACT == 2) { _Pragma("unroll") for (int e = 0; e < 4; ++e) { v0[e] = 1.f + __builtin_amdgcn_exp2f(__builtin_fminf(__builtin_fmaxf(v0[e], -60.f), 60.f) * -1.4426950408889634f); v1[e] = 1.f + __builtin_amdgcn_exp2f(__builtin_fminf(__builtin_fmaxf(v1[e], -60.f), 60.f) * -1.4426950408889634f); } }
                    v0 = v0 * sc; v1 = v1 * sc; u32x4 w; w.x = cvt_pk_bf16(v0[0], v0[1]); w.y = cvt_pk_bf16(v0[2], v0[3]); w.z = cvt_pk_bf16(v1[0], v1[1]); w.w = cvt_pk_bf16(v1[2], v1[3]);
                    *(u32x4*)(rowp + bj * HALF) = w; } }
    }
};
template <class Epi, class Sched, bool ALIGN_EPI = false, bool SP2 = false>
__device__ __forceinline__ void gemm_phase(PG8_LAS unsigned char* lds, const Gemm g, const Sched& S, const Epi& E, const int tid) {
    const int wid = __builtin_amdgcn_readfirstlane(tid >> 6), lane = tid & 63, wr = wid >> 2, wc = wid & 3, fr = lane & 15, fq = lane >> 4;
    const int K = g.K, nt = K / BK;
    unsigned voffA[2], voffB[2];
#pragma unroll
    for (int i = 0; i < 2; ++i) { int R, C; stage_rc(tid * 16 + i * 8192, R, C); const int Rb = Epi::PERM ? ((R & ~31) + perm32(R & 31)) : R;
        voffA[i] = (unsigned)(R * g.lda + C) * 2u; voffB[i] = (unsigned)(Rb * K + C) * 2u; }
    const size_t kstep = (size_t)(BK * 2);
    const size_t hstep = (size_t)HALF * K * 2;
    const size_t tstep = 2 * hstep;
    const size_t hstepA = (size_t)HALF * g.lda * 2, tstepA = 2 * hstepA;
    const unsigned ldsw = (unsigned)wid * 1024u;
    const int aoff = lds_byte(wr * 64 + fr, fq * 8), boff = lds_byte(wc * 32 + fr, fq * 8);
#define PG8_SA(b, h) (((b) * 2 + (h)) * HTB)
#define PG8_SB(b, h) ((4 + (b) * 2 + (h)) * HTB)
#define PG8_STAGE(bufoff, gbase, voff) do { _Pragma("unroll") for (int _i = 0; _i < 2; ++_i) \
        __builtin_amdgcn_global_load_lds((const unsigned*)((const char*)(gbase) + (voff)[_i]), (PG8_LAS unsigned*)(lds + (bufoff) + ldsw + _i * 8192), 16, 0, 0); } while (0)
#define PG8_LDA(dst, b, h) do { _Pragma("unroll") for (int m = 0; m < 4; ++m) _Pragma("unroll") for (int k = 0; k < 2; ++k) dst[m][k] = *(const PG8_LAS bf16x8*)(lds + PG8_SA(b, h) + aoff + m * 2048 + k * 1024); } while (0)
#define PG8_LDB(dst, b, h) do { _Pragma("unroll") for (int n = 0; n < 2; ++n) _Pragma("unroll") for (int k = 0; k < 2; ++k) dst[n][k] = *(const PG8_LAS bf16x8*)(lds + PG8_SB(b, h) + boff + n * 2048 + k * 1024); } while (0)
#define PG8_MMA(ai, bj, At, Bt) do { __builtin_amdgcn_s_setprio(1); _Pragma("unroll") for (int m = 0; m < 4; ++m) _Pragma("unroll") for (int n = 0; n < 2; ++n) _Pragma("unroll") for (int k = 0; k < 2; ++k) \
        acc[ai][bj][m][n] = __builtin_amdgcn_mfma_f32_16x16x32_bf16(Bt[n][k], At[m][k], acc[ai][bj][m][n], 0, 0, 0); __builtin_amdgcn_s_setprio(0); } while (0)
#define PG8_WAIT_V(n) asm volatile("s_waitcnt vmcnt(" #n ")" ::: "memory")
#define PG8_WAIT_L(n) asm volatile("s_waitcnt lgkmcnt(" #n ")" ::: "memory")
#define PG8_BAR __builtin_amdgcn_s_barrier()
#define PG8_SCHED __builtin_amdgcn_sched_barrier(0)
    Unit cur, nxt; int ui = 0;
    if (!S.next(0, cur)) return;
    f32x4 acc[2][2][4][2];
#pragma unroll
    for (int a = 0; a < 2; ++a)
#pragma unroll
        for (int b = 0; b < 2; ++b)
#pragma unroll
            for (int m = 0; m < 4; ++m)
#pragma unroll
                for (int n = 0; n < 2; ++n) acc[a][b][m][n] = (f32x4){0.f, 0.f, 0.f, 0.f};
    bf16x8 At[4][2], B0[2][2], B1[2][2];
    const char* cA = (const char*)g.A + (size_t)cur.pm * tstepA; const char* cB = (const char*)g.Bt + (size_t)cur.pn * tstep;
    S.a_ready(cur);
    if constexpr (SP2) {
        PG8_STAGE(PG8_SB(0, 0), cB, voffB); PG8_STAGE(PG8_SB(0, 1), cB + hstep, voffB); PG8_STAGE(PG8_SA(0, 0), cA, voffA); PG8_STAGE(PG8_SA(0, 1), cA + hstepA, voffA);
        if (wr == 1) PG8_BAR;
        PG8_WAIT_V(2); PG8_BAR;
        PG8_STAGE(PG8_SB(1, 0), cB + kstep, voffB); PG8_STAGE(PG8_SA(1, 0), cA + kstep, voffA); PG8_STAGE(PG8_SB(1, 1), cB + hstep + kstep, voffB);
        PG8_WAIT_V(6); PG8_BAR;
    } else {
        PG8_STAGE(PG8_SB(0, 0), cB, voffB); PG8_STAGE(PG8_SA(0, 0), cA, voffA); PG8_STAGE(PG8_SB(0, 1), cB + hstep, voffB); PG8_STAGE(PG8_SA(0, 1), cA + hstepA, voffA);
        if (wr == 1) PG8_BAR;
        PG8_WAIT_V(4); PG8_BAR;
        PG8_STAGE(PG8_SB(1, 0), cB + kstep, voffB); PG8_STAGE(PG8_SA(1, 0), cA + kstep, voffA); PG8_STAGE(PG8_SB(1, 1), cB + hstep + kstep, voffB);
        PG8_WAIT_V(6); PG8_BAR;
    }
    for (;;) {
        const bool has_next = S.next(ui + 1, nxt);
        const char* nA = has_next ? (const char*)g.A + (size_t)nxt.pm * tstepA : cA; const char* nB = has_next ? (const char*)g.Bt + (size_t)nxt.pn * tstep : cB;
        for (int t = 0; t < nt; t += 2) {
            const bool last = (t == nt - 2);
            const char* a1 = cA + (size_t)(t + 1) * kstep;
            const char* a2 = last ? nA : cA + (size_t)(t + 2) * kstep; const char* b2 = last ? nB : cB + (size_t)(t + 2) * kstep;
            const char* a3 = a2 + kstep; const char* b3 = b2 + kstep;
            if (last && has_next) S.a_ready(nxt);
            if constexpr (SP2) {
            PG8_LDB(B0, 0, 0); PG8_LDB(B1, 0, 1); PG8_SCHED; PG8_LDA(At, 0, 0); PG8_STAGE(PG8_SA(1, 1), a1 + hstepA, voffA);
            PG8_WAIT_V(8); PG8_WAIT_L(0); PG8_BAR; PG8_MMA(0, 0, At, B0); PG8_MMA(0, 1, At, B1); PG8_BAR; PG8_SCHED;
            PG8_LDA(At, 0, 1); PG8_STAGE(PG8_SB(0, 0), b2, voffB); PG8_STAGE(PG8_SB(0, 1), b2 + hstep, voffB); PG8_STAGE(PG8_SA(0, 0), a2, voffA);
            PG8_WAIT_V(8); PG8_WAIT_L(0); PG8_BAR; PG8_MMA(1, 0, At, B0); PG8_MMA(1, 1, At, B1); PG8_BAR; PG8_SCHED;
            PG8_LDB(B0, 1, 0); PG8_LDB(B1, 1, 1); PG8_SCHED; PG8_LDA(At, 1, 0); PG8_STAGE(PG8_SA(0, 1), a2 + hstepA, voffA);
            PG8_WAIT_V(8); PG8_WAIT_L(0); PG8_BAR; PG8_MMA(0, 0, At, B0); PG8_MMA(0, 1, At, B1); PG8_BAR; PG8_SCHED;
            PG8_LDA(At, 1, 1); PG8_STAGE(PG8_SB(1, 0), b3, voffB); PG8_STAGE(PG8_SB(1, 1), b3 + hstep, voffB); PG8_STAGE(PG8_SA(1, 0), a3, voffA);
            PG8_WAIT_V(8); PG8_WAIT_L(0); PG8_BAR; PG8_MMA(1, 0, At, B0); PG8_MMA(1, 1, At, B1); PG8_BAR; PG8_SCHED;
            } else {
            PG8_LDB(B0, 0, 0); PG8_SCHED; PG8_LDA(At, 0, 0); PG8_STAGE(PG8_SA(1, 1), a1 + hstepA, voffA);
            PG8_WAIT_L(8); PG8_BAR; PG8_WAIT_L(0); PG8_MMA(0, 0, At, B0); PG8_BAR; PG8_SCHED;
            PG8_LDB(B1, 0, 1); PG8_STAGE(PG8_SB(0, 0), b2, voffB);
            PG8_BAR; PG8_WAIT_L(0); PG8_MMA(0, 1, At, B1); PG8_BAR;
            PG8_LDA(At, 0, 1); PG8_STAGE(PG8_SA(0, 0), a2, voffA);
            PG8_BAR; PG8_WAIT_L(0); PG8_MMA(1, 0, At, B0); PG8_BAR; PG8_SCHED;
            PG8_STAGE(PG8_SB(0, 1), b2 + hstep, voffB);
            PG8_WAIT_V(6); PG8_BAR; PG8_MMA(1, 1, At, B1); PG8_BAR;
            PG8_LDB(B0, 1, 0); PG8_SCHED; PG8_LDA(At, 1, 0); PG8_STAGE(PG8_SA(0, 1), a2 + hstepA, voffA);
            PG8_WAIT_L(8); PG8_BAR; PG8_WAIT_L(0); PG8_MMA(0, 0, At, B0); PG8_BAR; PG8_SCHED;
            PG8_LDB(B1, 1, 1); PG8_STAGE(PG8_SB(1, 0), b3, voffB);
            PG8_BAR; PG8_WAIT_L(0); PG8_MMA(0, 1, At, B1); PG8_BAR;
            PG8_LDA(At, 1, 1); PG8_STAGE(PG8_SA(1, 0), a3, voffA);
            PG8_BAR; PG8_WAIT_L(0); PG8_MMA(1, 0, At, B0); PG8_BAR; PG8_SCHED;
            PG8_STAGE(PG8_SB(1, 1), b3 + hstep, voffB);
            PG8_WAIT_V(6); PG8_BAR; PG8_MMA(1, 1, At, B1); PG8_BAR;
            }
            if constexpr (Epi::FOLD) { if ((((t + 2) & 7) == 0) && !last) E.fold(acc, ((t + 2) >> 3) - 1, cur, wr, wc, fr, fq); }
        }
        if constexpr (ALIGN_EPI) { if (wr == 0) PG8_BAR; }
        if constexpr (!Epi::AFTER_DRAIN) { E(acc, cur, wr, wc, fr, fq); S.done(cur); }
        if (!has_next) break;
#pragma unroll
        for (int a = 0; a < 2; ++a)
#pragma unroll
            for (int b = 0; b < 2; ++b)
#pragma unroll
                for (int m = 0; m < 4; ++m)
#pragma unroll
                    for (int n = 0; n < 2; ++n) acc[a][b][m][n] = (f32x4){0.f, 0.f, 0.f, 0.f};
        cur = nxt; cA = nA; cB = nB; ++ui;
        if constexpr (ALIGN_EPI) { if (wr == 1) PG8_BAR; }
    }
    PG8_WAIT_V(0);
    if constexpr (!ALIGN_EPI) { if (wr == 0) PG8_BAR; }
    PG8_BAR;
    if constexpr (Epi::AFTER_DRAIN) { E.fused(acc, cur, wr, wc, fr, fq, lds, wid, lane); S.done(cur); }
#undef PG8_SA
#undef PG8_SB
#undef PG8_STAGE
#undef PG8_LDA
#undef PG8_LDB
#undef PG8_MMA
#undef PG8_WAIT_V
#undef PG8_WAIT_L
#undef PG8_BAR
#undef PG8_SCHED
}
}
namespace mk {
#define LAS __attribute__((address_space(3)))
#define GAS __attribute__((address_space(1)))
typedef unsigned short bf16;
typedef unsigned v4u __attribute__((ext_vector_type(4)));
typedef unsigned v2u __attribute__((ext_vector_type(2)));
typedef float f32x4 __attribute__((ext_vector_type(4)));
typedef float f32x16 __attribute__((ext_vector_type(16)));
typedef float f32x2v __attribute__((ext_vector_type(2)));
typedef short bf16x8 __attribute__((ext_vector_type(8)));
typedef short s16x4 __attribute__((ext_vector_type(4)));
constexpr int SEQ = 2048, DM = 1024, NIN = 11280;
constexpr int LDP = 7424;
constexpr int PC_SLAB = 0, PC_XBC = 1792, PC_DT = 2816, PC_QKVC = 3072, PC_QKVD = 3840, PC_ZA = 5376, PC_GB = 5888, PC_GC = 6400, PC_GD = 6912;
constexpr int PC_Y = PC_ZA;
constexpr size_t W1T_N = 7424, W2T_N = 4096;
constexpr size_t WOFF_W1 = 0, WOFF_W2 = WOFF_W1 + W1T_N * 1024, WOFF_WB = WOFF_W2 + W2T_N * 1024, WOFF_WO = WOFF_WB + 4ull * 1024 * 512, W_LAYER_ELEMS = WOFF_WO + 1024ull * 1024;
#define LDS_WAIT() asm volatile("s_waitcnt lgkmcnt(0)" ::: "memory")
#define VM_WAIT() asm volatile("s_waitcnt vmcnt(0)" ::: "memory")
__device__ __forceinline__ unsigned pk2(float lo, float hi) { typedef float f2_ __attribute__((ext_vector_type(2))); typedef __bf16 b2_ __attribute__((ext_vector_type(2))); const f2_ v = {lo, hi}; const b2_ b = __builtin_convertvector(v, b2_); return __builtin_bit_cast(unsigned, b); }
__device__ __forceinline__ unsigned f2bf(float f) { return pk2(f, 0.f) & 0xffffu; }
__device__ __forceinline__ float bf2f(unsigned short b) { return __builtin_bit_cast(float, (unsigned)b << 16); }
__device__ __forceinline__ float bflo(unsigned w) { return __builtin_bit_cast(float, w << 16); }
__device__ __forceinline__ float bfhi(unsigned w) { return __builtin_bit_cast(float, w & 0xffff0000u); }
__device__ __forceinline__ float lane_xor(float v, int lane, int o) { return __builtin_bit_cast(float, __builtin_amdgcn_ds_bpermute((lane ^ o) << 2, __builtin_bit_cast(int, v))); }
#define MK_DPP(x, ctrl) __builtin_bit_cast(float, __builtin_amdgcn_update_dpp(0, __builtin_bit_cast(int, (x)), (ctrl), 0xf, 0xf, true))
__device__ __forceinline__ float sum_l4(float x) { x += MK_DPP(x, 0xB1); x += MK_DPP(x, 0x4E); return x; }
__device__ __forceinline__ float sum_l8(float x) { x = sum_l4(x); x += MK_DPP(x, 0x141); return x; }
__device__ __forceinline__ float sum_l16(float x) { x = sum_l8(x); x += MK_DPP(x, 0x140); return x; }
__device__ __forceinline__ float sum_l32(float x) { x = sum_l16(x); const auto rr = __builtin_amdgcn_permlane16_swap(__float_as_uint(x), __float_as_uint(x), false, false); return __uint_as_float(rr[0]) + __uint_as_float(rr[1]); }
__device__ __forceinline__ float sum_l64(float x) { x = sum_l32(x); const auto rr = __builtin_amdgcn_permlane32_swap(__float_as_uint(x), __float_as_uint(x), false, false); return __uint_as_float(rr[0]) + __uint_as_float(rr[1]); }
__device__ __forceinline__ float wave_sum(float v, int lane) { (void)lane; return sum_l64(v); }
__device__ __forceinline__ float fsilu(float x) { return x * __builtin_amdgcn_rcpf(1.f + __expf(-x)); }
__device__ __forceinline__ float fsigmoid(float x) { return __builtin_amdgcn_rcpf(1.f + __expf(-x)); }

__device__ __forceinline__ void transpose_item(const float* W, int ldw, int ldt, int c0, int nvalid, int ntotal, bf16* WT, int r0, LAS float* scr, int item, int lane) {
    const int nblk = ntotal / 32, kb = item / nblk, nb = item % nblk, k0 = 64 * kb, n0 = 32 * nb;
    const bool ok = (n0 + (lane & 31)) < nvalid;
    float wv[32];
#pragma unroll
    for (int i = 0; i < 32; ++i) { const int kk = 2 * i + (lane >> 5); wv[i] = W[(size_t)(k0 + kk) * ldw + c0 + (ok ? n0 + (lane & 31) : 0)]; }
#pragma unroll
    for (int i = 0; i < 32; ++i) { const int kk = 2 * i + (lane >> 5); scr[kk * 33 + (lane & 31)] = ok ? wv[i] : 0.f; }
    LDS_WAIT(); asm volatile("" ::: "memory");
    const int c = lane & 7;
#pragma unroll
    for (int j = 0; j < 4; ++j) { const int n = (lane >> 3) + 8 * j; const LAS float* s = scr + (8 * c) * 33 + n;
        v4u o; o.x = pk2(s[0 * 33], s[1 * 33]); o.y = pk2(s[2 * 33], s[3 * 33]); o.z = pk2(s[4 * 33], s[5 * 33]); o.w = pk2(s[6 * 33], s[7 * 33]);
        *(GAS v4u*)(WT + (size_t)(r0 + n0 + n) * ldt + k0 + 8 * c) = o; }
    LDS_WAIT(); asm volatile("" ::: "memory");
}
struct WSeg { int src, soff, ldw, c0, nvalid, ntotal; unsigned doff; int ldt, r0, ni; };
constexpr int WCONV_NSEG = 15, WCONV_ITEMS = 16 * (7424 / 32) + 16 * (4096 / 32) + 4 * 8 * (1024 / 32) + 16 * (1024 / 32);
__device__ __forceinline__ void ph_wconv(const float* w_in, const float* w_branch, const float* w_out, bf16* Wall, LAS unsigned char* lds, int gw, int ngw, int wave, int lane) {
    LAS float* scr = (LAS float*)(lds + wave * 16384);
    const WSeg segs[WCONV_NSEG] = {
        {0, 0, NIN, 1552, 1792, 1792, (unsigned)WOFF_W1, 1024, 0, 16 * 56}, {0, 0, NIN, 512, 1024, 1024, (unsigned)WOFF_W1, 1024, 1792, 16 * 32}, {0, 0, NIN, 1536, 16, 256, (unsigned)WOFF_W1, 1024, PC_DT, 16 * 8},
        {0, 0, NIN, 3856, 768, 768, (unsigned)WOFF_W1, 1024, PC_QKVC, 16 * 24}, {0, 0, NIN, 5136, 1536, 1536, (unsigned)WOFF_W1, 1024, PC_QKVD, 16 * 48}, {0, 0, NIN, 0, 512, 512, (unsigned)WOFF_W1, 1024, PC_ZA, 16 * 16},
        {0, 0, NIN, 3344, 512, 512, (unsigned)WOFF_W1, 1024, PC_GB, 16 * 16}, {0, 0, NIN, 4624, 512, 512, (unsigned)WOFF_W1, 1024, PC_GC, 16 * 16}, {0, 0, NIN, 6672, 512, 512, (unsigned)WOFF_W1, 1024, PC_GD, 16 * 16},
        {0, 0, NIN, 7184, 4096, 4096, (unsigned)WOFF_W2, 1024, 0, 16 * 128},
        {1, 0 * 512 * 1024, 1024, 0, 1024, 1024, (unsigned)WOFF_WB + 0 * 512, 2048, 0, 8 * 32}, {1, 1 * 512 * 1024, 1024, 0, 1024, 1024, (unsigned)WOFF_WB + 1 * 512, 2048, 0, 8 * 32},
        {1, 2 * 512 * 1024, 1024, 0, 1024, 1024, (unsigned)WOFF_WB + 2 * 512, 2048, 0, 8 * 32}, {1, 3 * 512 * 1024, 1024, 0, 1024, 1024, (unsigned)WOFF_WB + 3 * 512, 2048, 0, 8 * 32},
        {2, 0, 1024, 0, 1024, 1024, (unsigned)WOFF_WO, 1024, 0, 16 * 32}};
#pragma unroll 1
    for (int it0 = gw; it0 < 2 * WCONV_ITEMS; it0 += ngw) { const int l2 = it0 >= WCONV_ITEMS ? 1 : 0; int it = it0 - l2 * WCONV_ITEMS, s = 0;
#pragma unroll 1
        while (it >= segs[s].ni) { it -= segs[s].ni; ++s; }
        const WSeg g = segs[s];
        const float* src = g.src == 0 ? w_in + (size_t)l2 * 1024 * NIN : (g.src == 1 ? w_branch + (size_t)l2 * 4 * 512 * 1024 + g.soff : w_out + (size_t)l2 * 1024 * 1024);
        transpose_item(src, g.ldw, g.ldt, g.c0, g.nvalid, g.ntotal, Wall + (size_t)l2 * W_LAYER_ELEMS + g.doff, g.r0, scr, it, lane); }
}
__device__ __forceinline__ void rms_row_to_bf16(const float* xrow, const float* w, bf16* orow, int lane) {
    const GAS f32x4* xr = (const GAS f32x4*)xrow + lane; const GAS f32x4* wr = (const GAS f32x4*)w + lane;
    f32x4 v[4]; float s = 0.f;
#pragma unroll
    for (int j = 0; j < 4; ++j) { v[j] = xr[64 * j]; s += (v[j].x * v[j].x + v[j].y * v[j].y) + (v[j].z * v[j].z + v[j].w * v[j].w); }
    const float rstd = __builtin_amdgcn_rsqf(wave_sum(s, lane) * (1.f / 1024.f) + 1e-6f);
    GAS unsigned long long* o8 = (GAS unsigned long long*)orow + lane;
#pragma unroll
    for (int j = 0; j < 4; ++j) { const f32x4 ww = wr[64 * j]; o8[64 * j] = (unsigned long long)pk2(v[j].x * rstd * ww.x, v[j].y * rstd * ww.y) | ((unsigned long long)pk2(v[j].z * rstd * ww.z, v[j].w * rstd * ww.w) << 32); }
}
__device__ __forceinline__ void ph_rmsnorm(const float* x, const float* w, bf16* H, int nrows, int gw, int ngw, int lane) {
    f32x4 wv4[4];
#pragma unroll
    for (int j = 0; j < 4; ++j) wv4[j] = ((const GAS f32x4*)w + lane)[64 * j];
    for (int m = gw; m < nrows; m += 2 * ngw) { const int m2 = m + ngw; const bool two = m2 < nrows;
        const GAS f32x4* xa = (const GAS f32x4*)(x + (size_t)m * 1024) + lane; const GAS f32x4* xb = (const GAS f32x4*)(x + (size_t)(two ? m2 : m) * 1024) + lane;
        f32x4 va[4], vb[4]; float sa = 0.f, sb = 0.f;
#pragma unroll
        for (int j = 0; j < 4; ++j) { va[j] = xa[64 * j]; vb[j] = xb[64 * j]; }
#pragma unroll
        for (int j = 0; j < 4; ++j) { sa += (va[j].x * va[j].x + va[j].y * va[j].y) + (va[j].z * va[j].z + va[j].w * va[j].w); sb += (vb[j].x * vb[j].x + vb[j].y * vb[j].y) + (vb[j].z * vb[j].z + vb[j].w * vb[j].w); }
        const float ra = __builtin_amdgcn_rsqf(sum_l64(sa) * (1.f / 1024.f) + 1e-6f), rb = __builtin_amdgcn_rsqf(sum_l64(sb) * (1.f / 1024.f) + 1e-6f);
        GAS unsigned long long* oa = (GAS unsigned long long*)(H + (size_t)m * 1024) + lane; GAS unsigned long long* ob = (GAS unsigned long long*)(H + (size_t)(two ? m2 : m) * 1024) + lane;
#pragma unroll
        for (int j = 0; j < 4; ++j) { const f32x4 ww = wv4[j];
            oa[64 * j] = (unsigned long long)pk2(va[j].x * ra * ww.x, va[j].y * ra * ww.y) | ((unsigned long long)pk2(va[j].z * ra * ww.z, va[j].w * ra * ww.w) << 32);
            if (two) ob[64 * j] = (unsigned long long)pk2(vb[j].x * rb * ww.x, vb[j].y * rb * ww.y) | ((unsigned long long)pk2(vb[j].z * rb * ww.z, vb[j].w * rb * ww.w) << 32); } }
}
__device__ __forceinline__ void ph_gemm_rsigout(LAS unsigned char* lds, const bf16* A, int lda, const bf16* Bt, int M, int N, int K, bf16* O, int ldo, int tid, int bid) {
    pg8::Gemm g{A, Bt, M, N, K, lda}; pg8::StaticOrder S; S.init(M, N, (int)gridDim.x, bid);
    pg8::EpiBf16<2> E{O, ldo, nullptr, 0, 0, 1.f};
    pg8::gemm_phase<pg8::EpiBf16<2>, pg8::StaticOrder, true, true>(lds, g, S, E, tid);
}
struct RangeOrder : pg8::StaticOrder { int first, count;
    __device__ bool next(int i, pg8::Unit& u) const { return i < count && pg8::StaticOrder::next(i + first, u); } };
__device__ __forceinline__ void ph_gemm_bf16out_range(LAS unsigned char* lds, const bf16* A, int lda, const bf16* Bt, int M, int N, int K, bf16* O, int ldo, int first, int count, int tid, int bid) {
    pg8::Gemm g{A, Bt, M, N, K, lda}; RangeOrder S; S.init(M, N, (int)gridDim.x, bid); S.first = first; S.count = count;
    pg8::EpiBf16<0> E{O, ldo, nullptr, 0, 0, 1.f};
    pg8::gemm_phase<pg8::EpiBf16<0>, RangeOrder, true, true>(lds, g, S, E, tid);
}
__device__ __forceinline__ void ph_gemm_bf16out(LAS unsigned char* lds, const bf16* A, int lda, const bf16* Bt, int M, int N, int K, bf16* O, int ldo, int tid, int bid) {
    pg8::Gemm g{A, Bt, M, N, K, lda}; pg8::StaticOrder S; S.init(M, N, (int)gridDim.x, bid);
    pg8::EpiBf16<0> E{O, ldo, nullptr, 0, 0, 1.f};
    pg8::gemm_phase<pg8::EpiBf16<0>, pg8::StaticOrder, true, true>(lds, g, S, E, tid);
}
}
namespace mk {
constexpr float C2 = 0.125f * 1.4426950408889634f;
struct EpiF32 {
    static constexpr bool PERM = false, AFTER_DRAIN = false, FOLD = false;
    float* C; int ldc;
    __device__ __forceinline__ void operator()(const pg8::f32x4 (&acc)[2][2][4][2], const pg8::Unit& u, int wr, int wc, int fr, int fq) const {
        const int row0 = u.pm * 256 + wr * 64 + fr, col0 = u.pn * 256 + wc * 32 + 4 * fq;
#pragma unroll
        for (int ai = 0; ai < 2; ++ai)
#pragma unroll
            for (int m = 0; m < 4; ++m) { float* rowp = C + (size_t)(row0 + ai * 128 + m * 16) * ldc + col0;
#pragma unroll
                for (int bj = 0; bj < 2; ++bj)
#pragma unroll
                    for (int n = 0; n < 2; ++n) *(pg8::f32x4*)(rowp + bj * 128 + n * 16) = acc[ai][bj][m][n]; }
    }
};
template <int MODE> struct EpiMerge {
    static constexpr bool PERM = false, AFTER_DRAIN = false, FOLD = false;
    float* Mf; bf16* Mb; const bf16* G; int ldg;
    __device__ __forceinline__ void operator()(const pg8::f32x4 (&acc)[2][2][4][2], const pg8::Unit& u, int wr, int wc, int fr, int fq) const {
        const int row0 = u.pm * 256 + wr * 64 + fr, col0 = u.pn * 256 + wc * 32 + 4 * fq;
#pragma unroll
        for (int ai = 0; ai < 2; ++ai)
#pragma unroll
            for (int m = 0; m < 4; ++m) { const size_t r = (size_t)(row0 + ai * 128 + m * 16);
#pragma unroll
                for (int bj = 0; bj < 2; ++bj)
#pragma unroll
                    for (int n = 0; n < 2; ++n) { const int c = col0 + bj * 128 + n * 16;
                        const v2u gw = *(const v2u*)(G + r * ldg + c);
                        pg8::f32x4 v = acc[ai][bj][m][n];
                        v[0] *= fsigmoid(bflo(gw.x)); v[1] *= fsigmoid(bfhi(gw.x)); v[2] *= fsigmoid(bflo(gw.y)); v[3] *= fsigmoid(bfhi(gw.y));
                        if (MODE > 0) v += *(const pg8::f32x4*)(Mf + r * 1024 + c);
                        if (MODE < 2) *(pg8::f32x4*)(Mf + r * 1024 + c) = v;
                        else { v2u o; o.x = pk2(v[0], v[1]); o.y = pk2(v[2], v[3]); *(v2u*)(Mb + r * 1024 + c) = o; } } }
    }
};
__device__ __forceinline__ v4u gload16(const void* base, unsigned off) { v4u r; asm volatile("global_load_dwordx4 %0, %1, %2" : "=v"(r) : "v"(off), "s"(base) : "memory"); return r; }
__device__ __forceinline__ void gwait8(v4u& a, v4u& b, v4u& c, v4u& d, v4u& e, v4u& f, v4u& g, v4u& h) { asm volatile("s_waitcnt vmcnt(0)" : "+v"(a), "+v"(b), "+v"(c), "+v"(d), "+v"(e), "+v"(f), "+v"(g), "+v"(h) :: "memory"); }
struct EpiMergeF {
    static constexpr bool PERM = true, AFTER_DRAIN = false, FOLD = true;
    bf16* Mb; const bf16* S; int lds_;
    __device__ __forceinline__ void fold(pg8::f32x4 (&acc)[2][2][4][2], int seg, const pg8::Unit& u, int wr, int wc, int fr, int fq) const {
        unsigned off0 = (unsigned)((u.pm * 256 + wr * 64 + fr) * lds_ + u.pn * 256 + wc * 32 + 8 * fq + seg * 1024) * 2u; asm volatile("" : "+v"(off0));
#pragma unroll
        for (int ai = 0; ai < 2; ++ai)
#pragma unroll
            for (int mh = 0; mh < 2; ++mh) {
                v4u sa[2][2], sb[2][2];
#pragma unroll
                for (int mm = 0; mm < 2; ++mm)
#pragma unroll
                    for (int bj = 0; bj < 2; ++bj) { const unsigned ro = off0 + (unsigned)((ai * 128 + (2 * mh + mm) * 16) * lds_) * 2u + bj * 256; sa[mm][bj] = gload16(S, ro); sb[mm][bj] = gload16(S, ro + 2048); }
                gwait8(sa[0][0], sa[0][1], sa[1][0], sa[1][1], sb[0][0], sb[0][1], sb[1][0], sb[1][1]);
#pragma unroll
                for (int mm = 0; mm < 2; ++mm)
#pragma unroll
                    for (int bj = 0; bj < 2; ++bj) { const unsigned wa[4] = {sa[mm][bj].x, sa[mm][bj].y, sa[mm][bj].z, sa[mm][bj].w}, wb[4] = {sb[mm][bj].x, sb[mm][bj].y, sb[mm][bj].z, sb[mm][bj].w};
#pragma unroll
                        for (int e = 0; e < 4; ++e) { pg8::f32x4& v = acc[ai][bj][2 * mh + mm][e >> 1]; const int o = 2 * (e & 1);
                            v[o] *= bflo(wb[e]) * __builtin_amdgcn_rcpf(bflo(wa[e])); v[o + 1] *= bfhi(wb[e]) * __builtin_amdgcn_rcpf(bfhi(wa[e])); } } }
    }
    __device__ __forceinline__ void operator()(const pg8::f32x4 (&acc)[2][2][4][2], const pg8::Unit& u, int wr, int wc, int fr, int fq) const {
        const int row0 = u.pm * 256 + wr * 64 + fr, col0 = u.pn * 256 + wc * 32 + 8 * fq;
        const unsigned off0 = (unsigned)(row0 * lds_ + col0 + 3 * 1024) * 2u;
#pragma unroll
        for (int ai = 0; ai < 2; ++ai) { v4u sa[4][2];
#pragma unroll
            for (int m = 0; m < 4; ++m)
#pragma unroll
                for (int bj = 0; bj < 2; ++bj) sa[m][bj] = gload16(S, off0 + (unsigned)((ai * 128 + m * 16) * lds_) * 2u + bj * 256);
            gwait8(sa[0][0], sa[0][1], sa[1][0], sa[1][1], sa[2][0], sa[2][1], sa[3][0], sa[3][1]);
#pragma unroll
            for (int m = 0; m < 4; ++m) { const size_t r = (size_t)(row0 + ai * 128 + m * 16);
#pragma unroll
                for (int bj = 0; bj < 2; ++bj) { const int c = col0 + bj * 128; const v4u s4 = sa[m][bj]; const pg8::f32x4 v0 = acc[ai][bj][m][0], v1 = acc[ai][bj][m][1];
                    v4u o; o.x = pk2(v0[0] * __builtin_amdgcn_rcpf(bflo(s4.x)), v0[1] * __builtin_amdgcn_rcpf(bfhi(s4.x))); o.y = pk2(v0[2] * __builtin_amdgcn_rcpf(bflo(s4.y)), v0[3] * __builtin_amdgcn_rcpf(bfhi(s4.y)));
                    o.z = pk2(v1[0] * __builtin_amdgcn_rcpf(bflo(s4.z)), v1[1] * __builtin_amdgcn_rcpf(bfhi(s4.z))); o.w = pk2(v1[2] * __builtin_amdgcn_rcpf(bflo(s4.w)), v1[3] * __builtin_amdgcn_rcpf(bfhi(s4.w)));
                    *(GAS v4u*)(Mb + r * 1024 + c) = o; } } }
    }
};
template <class Epi> __device__ __forceinline__ void run_gemm(LAS unsigned char* lds, const bf16* A, int lda, const bf16* Bt, int M, int N, int K, const Epi& E, int tid, int bid) {
    pg8::Gemm g{A, Bt, M, N, K, lda}; pg8::StaticOrder S; S.init(M, N, (int)gridDim.x, bid);
    pg8::gemm_phase<Epi, pg8::StaticOrder, true, true>(lds, g, S, E, tid);
}
__device__ __forceinline__ void ph_rope_table(float* rope, int gtid, int nthr) {
    for (int i = gtid; i < SEQ * 32; i += nthr) { const int l = i >> 5, j = i & 31; const float inv = __builtin_amdgcn_exp2f(-(float)(j & 15) * 0.83048202372184f);
        const float ang = (float)(j < 16 ? (l >> 6) : (l & 63)) * inv; rope[i] = __cosf(ang); rope[SEQ * 32 + i] = __sinf(ang); }
}
__device__ __forceinline__ void ph_prep_conv(const bf16* P, int T, const float* cw, const float* cb, const float* dtb, bf16* XC, float* DT, int gtid, int nthr) {
    { const int c = (gtid & 127) * 8;
        float wj[5][8], bb[8];
#pragma unroll
        for (int j = 0; j < 5; ++j) { const f32x4 w0 = *(const GAS f32x4*)(cw + j * 1024 + c), w1 = *(const GAS f32x4*)(cw + j * 1024 + c + 4); wj[j][0] = w0.x; wj[j][1] = w0.y; wj[j][2] = w0.z; wj[j][3] = w0.w; wj[j][4] = w1.x; wj[j][5] = w1.y; wj[j][6] = w1.z; wj[j][7] = w1.w; }
        { const f32x4 b0 = *(const GAS f32x4*)(cb + c), b1 = *(const GAS f32x4*)(cb + c + 4); bb[0] = b0.x; bb[1] = b0.y; bb[2] = b0.z; bb[3] = b0.w; bb[4] = b1.x; bb[5] = b1.y; bb[6] = b1.z; bb[7] = b1.w; }
    for (int it = gtid; it < (T >> 3) * 128; it += nthr) { const int t0 = (it >> 7) * 8, l0 = t0 & (SEQ - 1);
        v4u row[12];
#pragma unroll
        for (int r = 0; r < 12; ++r) { const int ll = l0 + r - 2; const bool ok = (ll >= 0) && (ll < SEQ); const v4u z4 = {0u, 0u, 0u, 0u};
            row[r] = ok ? *(const GAS v4u*)(P + (size_t)(t0 + r - 2) * LDP + PC_XBC + c) : z4; }
#pragma unroll
        for (int q = 0; q < 8; ++q) { float a[8];
#pragma unroll
            for (int e = 0; e < 8; ++e) a[e] = bb[e];
#pragma unroll
            for (int j = 0; j < 5; ++j) { const v4u w = row[q + j];
                a[0] += wj[j][0] * bflo(w.x); a[1] += wj[j][1] * bfhi(w.x); a[2] += wj[j][2] * bflo(w.y); a[3] += wj[j][3] * bfhi(w.y); a[4] += wj[j][4] * bflo(w.z); a[5] += wj[j][5] * bfhi(w.z); a[6] += wj[j][6] * bflo(w.w); a[7] += wj[j][7] * bfhi(w.w); }
            v4u o; o.x = pk2(fsilu(a[0]), fsilu(a[1])); o.y = pk2(fsilu(a[2]), fsilu(a[3])); o.z = pk2(fsilu(a[4]), fsilu(a[5])); o.w = pk2(fsilu(a[6]), fsilu(a[7]));
            *(GAS v4u*)(XC + (size_t)(t0 + q) * 1024 + c) = o; } } }
    for (int it = gtid; it < T * 16; it += nthr) { const int t = it >> 4, j = it & 15; const float x = bf2f(P[(size_t)t * LDP + PC_DT + j]) + dtb[j]; DT[it] = x > 20.f ? x : __logf(1.f + __expf(x)); }
}
__device__ __forceinline__ void ph_prep_gqa(const bf16* P, int T, const float* qw, const float* kw, const float* rope, bf16* Qn, bf16* Kn, int gtid, int nthr) {
    { const int j8 = gtid & 7, g8 = gtid >> 3, ng8 = nthr >> 3;
      const f32x4 qw1 = *(const GAS f32x4*)(qw + 4 * j8), qw2 = *(const GAS f32x4*)(qw + 32 + 4 * j8), kw1 = *(const GAS f32x4*)(kw + 4 * j8), kw2 = *(const GAS f32x4*)(kw + 32 + 4 * j8);
      constexpr int GR = 2;
      for (int it0 = g8; it0 < T * 10; it0 += GR * ng8) {
        int tq[GR], hq[GR]; bool okq[GR]; v2u r1[GR], r2[GR]; f32x4 cs[GR], sn[GR];
#pragma unroll
        for (int q = 0; q < GR; ++q) { const int it = it0 + q * ng8; okq[q] = it < T * 10; const int itc = okq[q] ? it : it0; tq[q] = itc / 10; hq[q] = itc - tq[q] * 10; const int l = tq[q] & (SEQ - 1);
            const bf16* src = P + (size_t)tq[q] * LDP + PC_QKVC + hq[q] * 64 + 4 * j8; r1[q] = *(const GAS v2u*)src; r2[q] = *(const GAS v2u*)(src + 32);
            cs[q] = *(const GAS f32x4*)(rope + l * 32 + 4 * j8); sn[q] = *(const GAS f32x4*)(rope + SEQ * 32 + l * 32 + 4 * j8); }
#pragma unroll
        for (int q = 0; q < GR; ++q) { const int t = tq[q], hh = hq[q]; const f32x4 w1 = hh < 8 ? qw1 : kw1, w2 = hh < 8 ? qw2 : kw2;
            const float x1[4] = {bflo(r1[q].x), bfhi(r1[q].x), bflo(r1[q].y), bfhi(r1[q].y)}, x2[4] = {bflo(r2[q].x), bfhi(r2[q].x), bflo(r2[q].y), bfhi(r2[q].y)};
            float ss = 0.f;
#pragma unroll
            for (int e = 0; e < 4; ++e) ss += x1[e] * x1[e] + x2[e] * x2[e];
            const float rs = __builtin_amdgcn_rsqf(sum_l8(ss) * (1.f / 64.f) + 1e-6f), sc = hh < 8 ? C2 : 1.f; float o1[4], o2[4];
#pragma unroll
            for (int e = 0; e < 4; ++e) { const float y1 = x1[e] * rs * w1[e], y2 = x2[e] * rs * w2[e]; o1[e] = (y1 * cs[q][e] - y2 * sn[q][e]) * sc; o2[e] = (y2 * cs[q][e] + y1 * sn[q][e]) * sc; }
            bf16* dst = (hh < 8 ? Qn + (size_t)t * 512 + hh * 64 : Kn + (size_t)t * 128 + (hh - 8) * 64) + 4 * j8;
            v2u a1, a2; a1.x = pk2(o1[0], o1[1]); a1.y = pk2(o1[2], o1[3]); a2.x = pk2(o2[0], o2[1]); a2.y = pk2(o2[2], o2[3]);
            if (okq[q]) { *(GAS v2u*)dst = a1; *(GAS v2u*)(dst + 32) = a2; } } } }
}
__device__ __forceinline__ void ph_post(bf16* P, int T, const bf16* XC, const bf16* YA  , const float* d_skip, const float* norm_w,
                                        const bf16* YB  , const float* CB  , const bf16* VB  , const float* lnx_w, const float* lnx_b, int gw, int ngw, int lane) {
    const int c = lane * 8, h = lane >> 3;
    const float D = d_skip[c >> 6]; const f32x4 n0 = *(const GAS f32x4*)(norm_w + c), n1 = *(const GAS f32x4*)(norm_w + c + 4);
    const f32x4 lw0 = *(const GAS f32x4*)(lnx_w + c), lw1 = *(const GAS f32x4*)(lnx_w + c + 4), lb0 = *(const GAS f32x4*)(lnx_b + c), lb1 = *(const GAS f32x4*)(lnx_b + c + 4);
    for (int t = gw; t < T; t += ngw) {
        const v4u y0 = *(const GAS v4u*)(YA + (size_t)t * 512 + c), y1 = *(const GAS v4u*)(YA + ((size_t)T + t) * 512 + c), xs = *(const GAS v4u*)(XC + (size_t)t * 1024 + c), zz = *(const GAS v4u*)(P + (size_t)t * LDP + PC_ZA + c);
        const v4u a0 = *(const GAS v4u*)(YB + (size_t)t * 512 + c), a1 = *(const GAS v4u*)(YB + ((size_t)T + t) * 512 + c), vv = *(const GAS v4u*)(VB + (size_t)t * 512 + c), gg = *(const GAS v4u*)(P + (size_t)t * LDP + PC_GB + c);
        const float coef = CB[(size_t)h * T + t] + CB[(size_t)(8 + h) * T + t];
        {
            const unsigned yw0[4] = {y0.x, y0.y, y0.z, y0.w}, yw1[4] = {y1.x, y1.y, y1.z, y1.w}, xw[4] = {xs.x, xs.y, xs.z, xs.w}, zw[4] = {zz.x, zz.y, zz.z, zz.w}; float y[8], ss = 0.f;
#pragma unroll
            for (int e = 0; e < 4; ++e) { y[2 * e] = (bflo(yw0[e]) + bflo(yw1[e]) + bflo(xw[e]) * D) * fsilu(bflo(zw[e])); y[2 * e + 1] = (bfhi(yw0[e]) + bfhi(yw1[e]) + bfhi(xw[e]) * D) * fsilu(bfhi(zw[e])); ss += y[2 * e] * y[2 * e] + y[2 * e + 1] * y[2 * e + 1]; }
            const float r = __builtin_amdgcn_rsqf(sum_l32(ss) * (1.f / 256.f) + 1e-6f);
            v4u o; o.x = pk2(y[0] * r * n0.x, y[1] * r * n0.y); o.y = pk2(y[2] * r * n0.z, y[3] * r * n0.w); o.z = pk2(y[4] * r * n1.x, y[5] * r * n1.y); o.w = pk2(y[6] * r * n1.z, y[7] * r * n1.w);
            *(GAS v4u*)(P + (size_t)t * LDP + PC_ZA + c) = o; }
        {
            float y[8] = {bflo(a0.x) + bflo(a1.x), bfhi(a0.x) + bfhi(a1.x), bflo(a0.y) + bflo(a1.y), bfhi(a0.y) + bfhi(a1.y), bflo(a0.z) + bflo(a1.z), bfhi(a0.z) + bfhi(a1.z), bflo(a0.w) + bflo(a1.w), bfhi(a0.w) + bfhi(a1.w)};
            const float v[8] = {bflo(vv.x), bfhi(vv.x), bflo(vv.y), bfhi(vv.y), bflo(vv.z), bfhi(vv.z), bflo(vv.w), bfhi(vv.w)};
            const float g[8] = {bflo(gg.x), bfhi(gg.x), bflo(gg.y), bfhi(gg.y), bflo(gg.z), bfhi(gg.z), bflo(gg.w), bfhi(gg.w)};
            float s = 0.f;
#pragma unroll
            for (int e = 0; e < 8; ++e) s += y[e];
            const float mu = sum_l8(s) * (1.f / 64.f); float q = 0.f;
#pragma unroll
            for (int e = 0; e < 8; ++e) { y[e] -= mu; q += y[e] * y[e]; }
            const float rs = __builtin_amdgcn_rsqf(sum_l8(q) * (1.f / 64.f) + 64e-5f);
            const float lw[8] = {lw0.x, lw0.y, lw0.z, lw0.w, lw1.x, lw1.y, lw1.z, lw1.w}, lb[8] = {lb0.x, lb0.y, lb0.z, lb0.w, lb1.x, lb1.y, lb1.z, lb1.w}; float o[8];
#pragma unroll
            for (int e = 0; e < 8; ++e) o[e] = (y[e] * rs * lw[e] + lb[e] + coef * v[e]) * fsilu(g[e]);
            v4u ov; ov.x = pk2(o[0], o[1]); ov.y = pk2(o[2], o[3]); ov.z = pk2(o[4], o[5]); ov.w = pk2(o[6], o[7]);
            *(GAS v4u*)(P + (size_t)t * LDP + PC_GB + c) = ov; }
    }
}
__device__ __forceinline__ void ph_fin(const float* xin, const float* outf, const float* w, float* xout, const float* wn, bf16* Hn, int nrows, int gw, int ngw, int lane) {
    f32x4 wpost[4], wpre[4];
#pragma unroll
    for (int j = 0; j < 4; ++j) { wpost[j] = ((const GAS f32x4*)w + lane)[64 * j]; wpre[j] = wn ? ((const GAS f32x4*)wn + lane)[64 * j] : (f32x4){0.f, 0.f, 0.f, 0.f}; }
    for (int m = gw; m < nrows; m += 2 * ngw) { const int m2 = (m + ngw < nrows) ? m + ngw : m; const bool two = m2 != m;
        const GAS f32x4* oa = (const GAS f32x4*)(outf + (size_t)m * 1024) + lane; const GAS f32x4* ob = (const GAS f32x4*)(outf + (size_t)m2 * 1024) + lane;
        const GAS f32x4* xa = (const GAS f32x4*)(xin + (size_t)m * 1024) + lane; const GAS f32x4* xb = (const GAS f32x4*)(xin + (size_t)m2 * 1024) + lane;
        f32x4 va[4], vb[4], ya[4], yb[4]; float sa = 0.f, sb = 0.f;
#pragma unroll
        for (int j = 0; j < 4; ++j) { va[j] = oa[64 * j]; vb[j] = ob[64 * j]; ya[j] = xa[64 * j]; yb[j] = xb[64 * j]; }
#pragma unroll
        for (int j = 0; j < 4; ++j) { sa += (va[j].x * va[j].x + va[j].y * va[j].y) + (va[j].z * va[j].z + va[j].w * va[j].w); sb += (vb[j].x * vb[j].x + vb[j].y * vb[j].y) + (vb[j].z * vb[j].z + vb[j].w * vb[j].w); }
        const float ra = __builtin_amdgcn_rsqf(sum_l64(sa) * (1.f / 1024.f) + 1e-6f), rb = __builtin_amdgcn_rsqf(sum_l64(sb) * (1.f / 1024.f) + 1e-6f);
        GAS f32x4* pa = (GAS f32x4*)(xout + (size_t)m * 1024) + lane; GAS f32x4* pb = (GAS f32x4*)(xout + (size_t)m2 * 1024) + lane;
        float qa = 0.f, qb = 0.f;
#pragma unroll
        for (int j = 0; j < 4; ++j) { const f32x4 ww = wpost[j]; ya[j] = ya[j] + va[j] * ra * ww; yb[j] = yb[j] + vb[j] * rb * ww; pa[64 * j] = ya[j]; if (two) pb[64 * j] = yb[j];
            qa += (ya[j].x * ya[j].x + ya[j].y * ya[j].y) + (ya[j].z * ya[j].z + ya[j].w * ya[j].w); qb += (yb[j].x * yb[j].x + yb[j].y * yb[j].y) + (yb[j].z * yb[j].z + yb[j].w * yb[j].w); }
        if (wn) { const float na = __builtin_amdgcn_rsqf(sum_l64(qa) * (1.f / 1024.f) + 1e-6f), nb = __builtin_amdgcn_rsqf(sum_l64(qb) * (1.f / 1024.f) + 1e-6f);
            GAS unsigned long long* ha = (GAS unsigned long long*)(Hn + (size_t)m * 1024) + lane; GAS unsigned long long* hb = (GAS unsigned long long*)(Hn + (size_t)m2 * 1024) + lane;
#pragma unroll
            for (int j = 0; j < 4; ++j) { const f32x4 ww = wpre[j];
                ha[64 * j] = (unsigned long long)pk2(ya[j].x * na * ww.x, ya[j].y * na * ww.y) | ((unsigned long long)pk2(ya[j].z * na * ww.z, ya[j].w * na * ww.w) << 32);
                if (two) hb[64 * j] = (unsigned long long)pk2(yb[j].x * nb * ww.x, yb[j].y * nb * ww.y) | ((unsigned long long)pk2(yb[j].z * nb * ww.z, yb[j].w * nb * ww.w) << 32); } } }
}
}
namespace mk {
__device__ __forceinline__ void unpack8(const v4u w, float* f) { f[0] = bflo(w.x); f[1] = bfhi(w.x); f[2] = bflo(w.y); f[3] = bfhi(w.y); f[4] = bflo(w.z); f[5] = bfhi(w.z); f[6] = bflo(w.w); f[7] = bfhi(w.w); }
__device__ __forceinline__ void ph_ssd_simple(const bf16* XC, const float* DT, const float* a_log, bf16* YA, int nb, int T, int tid, int bid) {
    if (tid >= 64) return;
    const int i = bid * 64 + tid; if (i >= 2 * nb * 512) return;
    const int p = i % 64, h = (i / 64) % 8, b = (i / 512) % nb, z = i / (512 * nb);
    float s[128];
#pragma unroll
    for (int n = 0; n < 128; ++n) s[n] = 0.f;
    const float an = -expf(a_log[z * 8 + h]); const int g = h >> 2;
    for (int st = 0; st < SEQ; ++st) { const int l = z ? (SEQ - 1 - st) : st; const size_t t = (size_t)b * SEQ + l;
        const float d = DT[t * 16 + z * 8 + h]; const float dec = expf(d * an); const float xd = bf2f(XC[t * 1024 + h * 64 + p]) * d;
        const GAS v4u* Bv = (const GAS v4u*)(XC + t * 1024 + 512 + g * 128); const GAS v4u* Cv = (const GAS v4u*)(XC + t * 1024 + 768 + g * 128);
        float y = 0.f;
#pragma unroll
        for (int n8 = 0; n8 < 16; ++n8) { float bb[8], cc[8]; unpack8(Bv[n8], bb); unpack8(Cv[n8], cc);
#pragma unroll
            for (int e = 0; e < 8; ++e) { s[n8 * 8 + e] = s[n8 * 8 + e] * dec + xd * bb[e]; y += cc[e] * s[n8 * 8 + e]; } }
        YA[((size_t)z * T + t) * 512 + h * 64 + p] = (bf16)f2bf(y); }
}
__device__ __forceinline__ float shiftP(const bf16* P, int t, int ch, const float* mu) {
    const int l = t & (SEQ - 1); const float cur = bf2f(P[(size_t)t * LDP + PC_SLAB + ch]);
    const float prev = l > 0 ? bf2f(P[(size_t)(t - 1) * LDP + PC_SLAB + ch]) : 0.f; const float nxt = l < SEQ - 1 ? bf2f(P[(size_t)(t + 1) * LDP + PC_SLAB + ch]) : 0.f;
    return cur + mu[ch] * (prev - cur) + mu[1792 + ch] * (nxt - cur);
}
struct RwkvS { float *R, *V, *KK, *DEC, *BB, *KD; };
__device__ __forceinline__ void ph_rwkv_prep_simple(const bf16* P, int T, int t0, int Ts, const float* mu, const float* w0, const float* w_up, const float* a0, const float* a_up, const float* k_k, const float* k_a, const float* r_k,
                                                    RwkvS A, bf16* VB, float* CB, int gtid, int nthr) {
    for (int it = gtid; it < Ts * 512; it += nthr) { const int tl = it >> 9, c = it & 511, t = t0 + tl;
        const float r = shiftP(P, t, c, mu), k = shiftP(P, t, 512 + c, mu), v = shiftP(P, t, 1024 + c, mu);
        A.R[it] = r; A.V[it] = v; VB[(size_t)t * 512 + c] = (bf16)f2bf(v);
        const float kx = k * k_k[c]; const float ss = wave_sum(kx * kx, gtid & 63);
        const float kk = kx / sqrtf(fmaxf(ss, 1e-24f)); A.KK[it] = kk;
#pragma unroll 1
        for (int z = 0; z < 2; ++z) { float wr = w0[z * 512 + c], ar = a0[z * 512 + c];
            for (int q = 0; q < 64; ++q) { wr += tanhf(shiftP(P, t, 1536 + z * 64 + q, mu)) * w_up[((size_t)z * 64 + q) * 512 + c]; ar += shiftP(P, t, 1664 + z * 64 + q, mu) * a_up[((size_t)z * 64 + q) * 512 + c]; }
            const float sp = (-wr) > 20.f ? (-wr) : log1pf(expf(-wr)); const float dec = expf(-expf(-sp - 0.5f)); const float a = 1.f / (1.f + expf(-ar));
            const float kd = k * (1.f + (a - 1.f) * k_a[c]);
            A.DEC[(size_t)z * Ts * 512 + it] = dec; A.BB[(size_t)z * Ts * 512 + it] = kk * a; A.KD[(size_t)z * Ts * 512 + it] = kd;
            const float cb = wave_sum(r * kd * r_k[c], gtid & 63); if ((c & 63) == 0) CB[((size_t)(z * 8 + (c >> 6))) * T + t] = cb; } }
}
__device__ __forceinline__ void ph_rwkv_scan_simple(int T, int t0, int nbs, RwkvS A, bf16* YB, int tid, int bid) {
    if (tid >= 64) return;
    const int i = bid * 64 + tid; if (i >= 2 * nbs * 512) return;
    const int v = i % 64, h = (i / 64) % 8, b = (i / 512) % nbs, z = i / (512 * nbs); const int Ts = nbs * SEQ;
    float S[64];
#pragma unroll
    for (int k = 0; k < 64; ++k) S[k] = 0.f;
    for (int st = 0; st < SEQ; ++st) { const int l = z ? (SEQ - 1 - st) : st; const size_t tl = (size_t)b * SEQ + l; const size_t o = tl * 512 + h * 64, oz = ((size_t)z * Ts + tl) * 512 + h * 64;
        float sa = 0.f;
#pragma unroll
        for (int k = 0; k < 64; ++k) sa += S[k] * A.KK[o + k];
        const float vv = A.V[o + v]; float y = 0.f;
#pragma unroll
        for (int k = 0; k < 64; ++k) { S[k] = S[k] * A.DEC[oz + k] - sa * A.BB[oz + k] + vv * A.KD[oz + k]; y += S[k] * A.R[o + k]; }
        YB[((size_t)z * T + t0 + tl) * 512 + h * 64 + v] = (bf16)f2bf(y); }
}
__device__ __forceinline__ void ph_gqa_simple(bf16* P, const bf16* Qn, const bf16* Kn, int nb, int gtid, int nthr) {
    for (int it = gtid; it < nb * 8 * SEQ; it += nthr) { const int ql = it % SEQ, h = (it / SEQ) % 8, b = it / (8 * SEQ), g = h >> 2; const size_t t = (size_t)b * SEQ + ql;
        float q[64], o[64];
#pragma unroll
        for (int d8 = 0; d8 < 8; ++d8) { unpack8(*(const GAS v4u*)(Qn + t * 512 + h * 64 + d8 * 8), q + d8 * 8); }
#pragma unroll
        for (int d = 0; d < 64; ++d) o[d] = 0.f;
        float m = -1e30f, lsum = 0.f;
        for (int k = 0; k < SEQ; ++k) { const size_t tk = (size_t)b * SEQ + k; float s = 0.f;
#pragma unroll
            for (int d8 = 0; d8 < 8; ++d8) { float kf[8]; unpack8(*(const GAS v4u*)(Kn + tk * 128 + g * 64 + d8 * 8), kf);
#pragma unroll
                for (int e = 0; e < 8; ++e) s += q[d8 * 8 + e] * kf[e]; }
            const float mn = fmaxf(m, s); const float al = exp2f(m - mn), p = exp2f(s - mn); m = mn; lsum = lsum * al + p;
#pragma unroll
            for (int d8 = 0; d8 < 8; ++d8) { float vf[8]; unpack8(*(const GAS v4u*)(P + tk * LDP + PC_QKVC + 640 + g * 64 + d8 * 8), vf);
#pragma unroll
                for (int e = 0; e < 8; ++e) o[d8 * 8 + e] = o[d8 * 8 + e] * al + p * vf[e]; } }
        const float il = 1.f / lsum;
#pragma unroll
        for (int d8 = 0; d8 < 8; ++d8) { GAS v4u* dst = (GAS v4u*)(P + t * LDP + PC_GC + h * 64 + d8 * 8); float gf[8]; unpack8(*dst, gf); v4u ov;
            ov.x = pk2(o[d8 * 8 + 0] * il * fsilu(gf[0]), o[d8 * 8 + 1] * il * fsilu(gf[1])); ov.y = pk2(o[d8 * 8 + 2] * il * fsilu(gf[2]), o[d8 * 8 + 3] * il * fsilu(gf[3]));
            ov.z = pk2(o[d8 * 8 + 4] * il * fsilu(gf[4]), o[d8 * 8 + 5] * il * fsilu(gf[5])); ov.w = pk2(o[d8 * 8 + 6] * il * fsilu(gf[6]), o[d8 * 8 + 7] * il * fsilu(gf[7])); *dst = ov; } }
}
__device__ __forceinline__ void ph_na_simple(bf16* P, const float* rpb, int nb, int gtid, int nthr) {
    for (int it = gtid; it < nb * 8 * SEQ; it += nthr) { const int ql = it % SEQ, h = (it / SEQ) % 8, b = it / (8 * SEQ); const size_t t = (size_t)b * SEQ + ql; const int qr = ql >> 6, qc = ql & 63;
        int rs = qr - 4; rs = rs < 0 ? 0 : (rs > 24 ? 24 : rs); int cs = qc - 8; cs = cs < 0 ? 0 : (cs > 48 ? 48 : cs);
        float q[64], o[64];
#pragma unroll
        for (int d8 = 0; d8 < 8; ++d8) { unpack8(*(const GAS v4u*)(P + t * LDP + PC_QKVD + h * 64 + d8 * 8), q + d8 * 8); }
#pragma unroll
        for (int d = 0; d < 64; ++d) { q[d] *= 0.125f; o[d] = 0.f; }
        float m = -1e30f, lsum = 0.f;
        for (int i = 0; i < 128; ++i) { const int kr = rs + (i >> 4), kc = cs + (i & 15); const size_t tk = (size_t)b * SEQ + kr * 64 + kc; float s = 0.f;
#pragma unroll
            for (int d8 = 0; d8 < 8; ++d8) { float kf[8]; unpack8(*(const GAS v4u*)(P + tk * LDP + PC_QKVD + 512 + h * 64 + d8 * 8), kf);
#pragma unroll
                for (int e = 0; e < 8; ++e) s += q[d8 * 8 + e] * kf[e]; }
            s += rpb[h * 465 + (kr - qr + 7) * 31 + (kc - qc + 15)];
            const float mn = fmaxf(m, s); const float al = __expf(m - mn), p = __expf(s - mn); m = mn; lsum = lsum * al + p;
#pragma unroll
            for (int d8 = 0; d8 < 8; ++d8) { float vf[8]; unpack8(*(const GAS v4u*)(P + tk * LDP + PC_QKVD + 1024 + h * 64 + d8 * 8), vf);
#pragma unroll
                for (int e = 0; e < 8; ++e) o[d8 * 8 + e] = o[d8 * 8 + e] * al + p * vf[e]; } }
        const float il = 1.f / lsum;
#pragma unroll
        for (int d8 = 0; d8 < 8; ++d8) { GAS v4u* dst = (GAS v4u*)(P + t * LDP + PC_GD + h * 64 + d8 * 8); float gf[8]; unpack8(*dst, gf); v4u ov;
            ov.x = pk2(o[d8 * 8 + 0] * il * fsilu(gf[0]), o[d8 * 8 + 1] * il * fsilu(gf[1])); ov.y = pk2(o[d8 * 8 + 2] * il * fsilu(gf[2]), o[d8 * 8 + 3] * il * fsilu(gf[3]));
            ov.z = pk2(o[d8 * 8 + 4] * il * fsilu(gf[4]), o[d8 * 8 + 5] * il * fsilu(gf[5])); ov.w = pk2(o[d8 * 8 + 6] * il * fsilu(gf[6]), o[d8 * 8 + 7] * il * fsilu(gf[7])); *dst = ov; } }
}
}
#include <hip/hip_bf16.h>
namespace attn_body {
using bf16=__hip_bfloat16;
using bf16x8=__attribute__((ext_vector_type(8)))short;
using s16x4=__attribute__((ext_vector_type(4)))short;
using f32x16=__attribute__((ext_vector_type(16)))float;
using u32x4=__attribute__((ext_vector_type(4)))unsigned;
constexpr int SEQ=2048,D=64;
constexpr int NW=8,QBLK=32,QB=QBLK*NW,KVBLK=64,NQB=SEQ/QB;
__device__ __forceinline__ int crow(int r,int hi){return (r&3)+8*(r>>2)+4*hi;}
#define SBAR() __builtin_amdgcn_sched_barrier(0)
constexpr int NSLOT=3, SLOTB=8192;
constexpr int LDS_K=0, LDS_V=NSLOT*SLOTB, LDS_WS=2*NSLOT*SLOTB, LDS_OST=LDS_WS+NW*64*4, LDS_RPB=LDS_OST+NW*4096,LDS_BYTES=LDS_RPB+2048;
constexpr float C2=0.125f*1.4426950408889634f;
__device__ __forceinline__ void glds16(const void*gsrc,unsigned lds_dst){unsigned keep;
  asm volatile("s_mov_b32 %0, m0\n\ts_mov_b32 m0, %2\n\ts_nop 0\n\tglobal_load_lds_dwordx4 %1, off\n\ts_mov_b32 m0, %0":"=&s"(keep):"v"(gsrc),"s"(lds_dst):"memory");}
__device__ __forceinline__ float max3f(float a,float b,float c){float r;asm("v_max3_f32 %0, %1, %2, %3":"=v"(r):"v"(a),"v"(b),"v"(c));return r;}
__device__ __forceinline__ float max2f(float a,float b){float r;asm("v_max_f32_e32 %0, %1, %2":"=v"(r):"v"(a),"v"(b));return r;}
__device__ __forceinline__ float fadd_s(float a,float b){float r;asm("v_add_f32_e32 %0, %1, %2":"=v"(r):"v"(a),"v"(b));return r;}
__device__ __forceinline__ float fsub_s(float a,float b){float r;asm("v_sub_f32_e32 %0, %1, %2":"=v"(r):"v"(a),"v"(b));return r;}
typedef float f32x2_t __attribute__((ext_vector_type(2))); typedef __bf16 bf16x2_t __attribute__((ext_vector_type(2)));
__device__ __forceinline__ unsigned cvtpk_s(float lo,float hi){f32x2_t v={lo,hi};bf16x2_t b=__builtin_convertvector(v,bf16x2_t);return __builtin_bit_cast(unsigned,b);}
#define WAIT_BAR(N) asm volatile("s_waitcnt vmcnt(" #N ") lgkmcnt(0)\n\ts_barrier":::"memory")

__device__ __forceinline__ void qkt(f32x16&p0,f32x16&p1,const char*Kslot,const bf16x8*qr,int r32,int hi){ const f32x16 negm=f32x16{};
  const char*kb=Kslot+hi*1024+r32*16;
  #pragma unroll
  for(int d0=0;d0<4;++d0){
    const bf16x8 b0=*reinterpret_cast<const bf16x8*>(kb+d0*2048);
    const bf16x8 b1=*reinterpret_cast<const bf16x8*>(kb+d0*2048+512);
    if(d0==0){p0=__builtin_amdgcn_mfma_f32_32x32x16_bf16(b0,qr[0],negm,0,0,0);p1=__builtin_amdgcn_mfma_f32_32x32x16_bf16(b1,qr[0],negm,0,0,0);}
    else{p0=__builtin_amdgcn_mfma_f32_32x32x16_bf16(b0,qr[d0],p0,0,0,0);p1=__builtin_amdgcn_mfma_f32_32x32x16_bf16(b1,qr[d0],p1,0,0,0);}}
}
typedef __attribute__((address_space(3))) const char* lds_cptr;
typedef short v4i16_t __attribute__((ext_vector_type(4)));
__device__ __forceinline__ void kload8(bf16x8*kf,lds_cptr kp){
  kf[0]=*(const __attribute__((address_space(3))) bf16x8*)(kp);      kf[1]=*(const __attribute__((address_space(3))) bf16x8*)(kp+512);
  kf[2]=*(const __attribute__((address_space(3))) bf16x8*)(kp+2048); kf[3]=*(const __attribute__((address_space(3))) bf16x8*)(kp+2560);
  kf[4]=*(const __attribute__((address_space(3))) bf16x8*)(kp+4096); kf[5]=*(const __attribute__((address_space(3))) bf16x8*)(kp+4608);
  kf[6]=*(const __attribute__((address_space(3))) bf16x8*)(kp+6144); kf[7]=*(const __attribute__((address_space(3))) bf16x8*)(kp+6656);
}
__device__ __forceinline__ void kload2(bf16x8*kf,lds_cptr kp,int j){ kf[2*j]=*(const __attribute__((address_space(3))) bf16x8*)(kp+j*2048); kf[2*j+1]=*(const __attribute__((address_space(3))) bf16x8*)(kp+j*2048+512); }
__device__ __forceinline__ s16x4 vtr(lds_cptr p){ return __builtin_bit_cast(s16x4,__builtin_amdgcn_ds_read_tr16_b64_v4i16((__attribute__((address_space(3))) v4i16_t*)p)); }
__device__ __forceinline__ float rowmax(const f32x16&p0,const f32x16&p1){
  float a=max3f(p0[0],p0[1],p1[0]),b=max3f(p0[2],p0[3],p1[1]);a=max3f(a,p1[2],p1[3]);
  #pragma unroll
  for(int r=4;r<16;r+=4){a=max3f(a,p0[r],p0[r+1]);b=max3f(b,p0[r+2],p0[r+3]);a=max3f(a,p1[r],p1[r+1]);b=max3f(b,p1[r+2],p1[r+3]);}
  const float m=max2f(a,b);
  auto rr=__builtin_amdgcn_permlane32_swap(__float_as_uint(m),__float_as_uint(m),false,false);
  return max2f(__uint_as_float(rr[0]),__uint_as_float(rr[1]));
}
__device__ __forceinline__ void pv(f32x16*o,int vb,bf16x8 pa0,bf16x8 pa1,bf16x8 pa2,bf16x8 pa3){
  #pragma unroll
  for(int d0=0;d0<2;++d0){s16x4 lo[4],hi[4];
    #pragma unroll
    for(int ks=0;ks<4;++ks){
      asm volatile("ds_read_b64_tr_b16 %0,%1 offset:%c2":"=&v"(lo[ks]):"v"(vb),"i"(d0*4096+ks*1024):"memory");
      asm volatile("ds_read_b64_tr_b16 %0,%1 offset:%c2":"=&v"(hi[ks]):"v"(vb),"i"(d0*4096+ks*1024+512):"memory");}
    asm volatile("s_waitcnt lgkmcnt(0)":::"memory");SBAR();
    #define PK(k) (bf16x8){lo[k][0],lo[k][1],lo[k][2],lo[k][3],hi[k][0],hi[k][1],hi[k][2],hi[k][3]}
    o[d0]=__builtin_amdgcn_mfma_f32_32x32x16_bf16(pa0,PK(0),o[d0],0,0,0);
    o[d0]=__builtin_amdgcn_mfma_f32_32x32x16_bf16(pa1,PK(1),o[d0],0,0,0);
    o[d0]=__builtin_amdgcn_mfma_f32_32x32x16_bf16(pa2,PK(2),o[d0],0,0,0);
    o[d0]=__builtin_amdgcn_mfma_f32_32x32x16_bf16(pa3,PK(3),o[d0],0,0,0);
    #undef PK
  }
}

struct AttnP { const bf16* Qw0; const bf16* Kh; const bf16* Vh; bf16* Ow0; int NT; int tbase; int toff; int qr0; float qscale; };
template<int THRL,int MODE,int QP,int KP,int VP,int OP> __device__ __forceinline__ void attn_unit(const AttnP&A,char*shm,const int tid){
  const int lane=tid&63,r32=lane&31,hi=lane>>5; const int wid=__builtin_amdgcn_readfirstlane(tid>>6);
  const bf16*Qw=A.Qw0+(long)(wid*QBLK)*QP;
  const bf16*Kh=A.Kh,*Vh=A.Vh;
  const int NT=A.NT;
  #define TROW(t) ((MODE==1)?(A.tbase+(((t)+A.toff)%NT)):(t))
  const unsigned lds0=(unsigned)(uintptr_t)shm;
  float*wsf=(float*)(shm+LDS_WS)+wid*64;
  const bf16*ksrc=Kh+(long)lane*KP+wid*8;
  const bf16*vsrc=Vh+(long)(16*(wid&3)+(lane>>2))*VP+(wid>>2)*32+(lane&3)*8;
  const unsigned kdst=lds0+LDS_K+wid*1024, vdst=lds0+LDS_V+wid*1024;
  #define DMA_K(t,slot) glds16(ksrc+(long)TROW(t)*KVBLK*KP,(unsigned)__builtin_amdgcn_readfirstlane(kdst+(slot)))
  #define DMA_V(t,slot) glds16(vsrc+(long)TROW(t)*KVBLK*VP,(unsigned)__builtin_amdgcn_readfirstlane(vdst+(slot)))
  const int vb0=(int)(lds0+LDS_V)+((lane>>4)&1)*32+(lane&3)*8+(4*hi+((lane&15)>>2))*64;
  const char*Kbase=shm+LDS_K; bf16x8 kf[8];
  const lds_cptr shm3=(lds_cptr)shm; const lds_cptr kp0=shm3+LDS_K+hi*1024+r32*16; const lds_cptr vp0=shm3+LDS_V+((lane>>4)&1)*32+(lane&3)*8+(4*hi+((lane&15)>>2))*64;
  DMA_K(0,0);DMA_V(0,0);DMA_K(1,SLOTB);
  bf16x8 qr[4];
  #pragma unroll
  for(int d0=0;d0<4;++d0)qr[d0]=*reinterpret_cast<const bf16x8*>(&Qw[(long)r32*QP+d0*16+hi*8]);
  if(MODE==1){
    #pragma unroll
    for(int d0=0;d0<4;++d0){ u32x4 w=__builtin_bit_cast(u32x4,qr[d0]);
      #pragma unroll
      for(int j=0;j<4;++j){ const float lo=__uint_as_float(w[j]<<16)*A.qscale, hv=__uint_as_float(w[j]&0xffff0000u)*A.qscale; w[j]=cvtpk_s(lo,hv);} qr[d0]=__builtin_bit_cast(bf16x8,w);} }
  const int na_qr=A.qr0+(wid>>1), na_qc=32*(wid&1)+r32; int na_rs=na_qr-4; na_rs=na_rs<0?0:(na_rs>24?24:na_rs); int na_cs=na_qc-8; na_cs=na_cs<0?0:(na_cs>48?48:na_cs);
  const float*rpbl=(const float*)(shm+LDS_RPB);
  #define NAMASK(P0,P1,t) do{ if(MODE==1){ const int kr_=TROW(t); const bool wv_=(kr_>=na_rs)&&(kr_<=na_rs+7); const float*tb_=rpbl+(kr_-na_qr+7)*31+(15-na_qc); const float NEG_=-INFINITY; \
      _Pragma("unroll") for(int r=0;r<16;++r){ const int kc_=crow(r,hi); const bool o0_=wv_&&(kc_>=na_cs)&&(kc_<na_cs+16); const bool o1_=wv_&&(kc_+32>=na_cs)&&(kc_+32<na_cs+16); \
        const float b0_=o0_?tb_[kc_]:0.f; const float b1_=o1_?tb_[kc_+32]:0.f; P0[r]=o0_?(P0[r]+b0_):NEG_; P1[r]=o1_?(P1[r]+b1_):NEG_; } } }while(0)
  float mhat=0.f,l_reg=0.f;f32x16 o[2];o[0]=f32x16{};o[1]=f32x16{};
  #define CMASK(P0,P1,t) NAMASK(P0,P1,t)
  bool resc=false;
  #define START(P0,P1) do{ const float rm=rowmax(P0,P1); resc=false; \
    { const float dl=rm; mhat=fadd_s(mhat,dl); \
      _Pragma("unroll") for(int r=0;r<16;++r){P0[r]=fsub_s(P0[r],dl);P1[r]=fsub_s(P1[r],dl);} \
      } \
    _Pragma("unroll") for(int r=0;r<16;++r)P0[r]=__builtin_amdgcn_exp2f(P0[r]); }while(0)
  #define RESC() do{ if(resc){ asm volatile("s_waitcnt lgkmcnt(0)":::"memory"); \
      _Pragma("unroll") for(int d_=0;d_<2;++d_) _Pragma("unroll") for(int r=0;r<16;++r)o[d_][r]*=wsf[crow(r,hi)]; } }while(0)
  f32x16 pA0,pA1,pB0,pB1;
  int sl_prev=0,sl_cur=0,sl_next=SLOTB;
  #define ROT() do{sl_prev=sl_cur;sl_cur=sl_next;sl_next=(sl_next==(NSLOT-1)*SLOTB)?0:sl_next+SLOTB;}while(0)
  DMA_K(2,2*SLOTB);
  WAIT_BAR(3);
  qkt(pA0,pA1,Kbase,qr,r32,hi);asm volatile("s_nop 15\n\ts_nop 7":"+v"(pA0),"+v"(pA1));CMASK(pA0,pA1,0);
  START(pA0,pA1);
  _Pragma("unroll") for(int r=0;r<16;++r)pA1[r]=__builtin_amdgcn_exp2f(pA1[r]);
  WAIT_BAR(0);
  DMA_K(3,0);DMA_V(1,SLOTB);
  ROT();
  kload8(kf,kp0+sl_cur);
  WAIT_BAR(2);
  s16x4 vlo[8],vhi[8]; u32x4 pw0,pw1,pw2,pw3;
  #define PKW(P,B) cvtpk_s(P[B],P[B+1])
  #define PAF(k) __builtin_bit_cast(bf16x8,pw##k)
  #define VFR(i) (bf16x8){vlo[i][0],vlo[i][1],vlo[i][2],vlo[i][3],vhi[i][0],vhi[i][1],vhi[i][2],vhi[i][3]}
  #define PIN(x) asm volatile("":"+v"(x))
  #define MX3(a,b,c) __builtin_fmaxf(__builtin_fmaxf((a),(b)),(c))
  #define GAPA(MF,A0,A1,A2,A3,W0,W1,PW) do{ MF; sacc+=A0; sacc+=A1; sacc+=A2; sacc+=A3; PIN(sacc); W0; W1; PIN(PW); SBAR(); }while(0)
  #define EX(v) __builtin_amdgcn_exp2f(v)
  #define GAPB(MF,X,B) do{ MF; X[B]=EX(X[B]); X[B+1]=EX(X[B+1]); X[B+2]=EX(X[B+2]); X[B+3]=EX(X[B+3]); PIN(X); SBAR(); }while(0)
  #define VRD(i) do{ vlo[i]=vtr(vp_+(((i)>>2)*4096+((i)&3)*1024)); vhi[i]=vtr(vp_+(((i)>>2)*4096+((i)&3)*1024+512)); }while(0)
  #define KRD(G,j) do{ if(G){ kload2(kf,kp0+sl_next,j); SBAR(); } }while(0)
  #define STEP(C0,C1,P0,P1,t,GK,GV,GL) do{ SBAR(); const f32x16 ZC_=f32x16{}; \
    const lds_cptr vp_=vp0+sl_prev; \
    VRD(0); SBAR(); float sacc=(P0[0]+P0[1]); \
    GAPA(C0=__builtin_amdgcn_mfma_f32_32x32x16_bf16(kf[0],qr[0],ZC_,0,0,0), P0[2],P0[3],P0[4],P0[5],     pw0[0]=PKW(P0,0), pw0[1]=PKW(P0,2), pw0); \
    VRD(4); SBAR(); GAPA(C1=__builtin_amdgcn_mfma_f32_32x32x16_bf16(kf[1],qr[0],ZC_,0,0,0), P0[6],P0[7],P0[8],P0[9],     pw0[2]=PKW(P0,4), pw0[3]=PKW(P0,6), pw0); \
    VRD(1); SBAR(); GAPA(C0=__builtin_amdgcn_mfma_f32_32x32x16_bf16(kf[2],qr[1],C0,0,0,0),   P0[10],P0[11],P0[12],P0[13], pw1[0]=PKW(P0,8), pw1[1]=PKW(P0,10), pw1); \
    VRD(5); SBAR(); GAPA(C1=__builtin_amdgcn_mfma_f32_32x32x16_bf16(kf[3],qr[1],C1,0,0,0),   P0[14],P0[15],P1[0],P1[1],   pw1[2]=PKW(P0,12),pw1[3]=PKW(P0,14), pw1); \
    VRD(2); SBAR(); GAPA(C0=__builtin_amdgcn_mfma_f32_32x32x16_bf16(kf[4],qr[2],C0,0,0,0),   P1[2],P1[3],P1[4],P1[5],     pw2[0]=PKW(P1,0), pw2[1]=PKW(P1,2), pw2); \
    VRD(6); SBAR(); GAPA(C1=__builtin_amdgcn_mfma_f32_32x32x16_bf16(kf[5],qr[2],C1,0,0,0),   P1[6],P1[7],P1[8],P1[9],     pw2[2]=PKW(P1,4), pw2[3]=PKW(P1,6), pw2); \
    VRD(3); SBAR(); GAPA(C0=__builtin_amdgcn_mfma_f32_32x32x16_bf16(kf[6],qr[3],C0,0,0,0),   P1[10],P1[11],P1[12],P1[13], pw3[0]=PKW(P1,8), pw3[1]=PKW(P1,10), pw3); \
    VRD(7); SBAR(); GAPA(C1=__builtin_amdgcn_mfma_f32_32x32x16_bf16(kf[7],qr[3],C1,0,0,0),   P1[14],P1[15],0.f,0.f,       pw3[2]=PKW(P1,12),pw3[3]=PKW(P1,14), pw3); \
    l_reg+=sacc; \
    if(GK){DMA_K((t)+3,sl_cur);} if(GV){DMA_V((t)+1,sl_next);} \
    _Pragma("unroll") for(int r=0;r<16;++r){C0[r]-=mhat;C1[r]-=mhat;} \
    CMASK(C0,C1,t); \
    { float a=MX3(C0[0],C0[1],C1[0]),b=MX3(C0[2],C0[3],C1[1]); a=MX3(a,C1[2],C1[3]); \
      _Pragma("unroll") for(int r=4;r<16;r+=4){a=MX3(a,C0[r],C0[r+1]);b=MX3(b,C0[r+2],C0[r+3]);a=MX3(a,C1[r],C1[r+1]);b=MX3(b,C1[r+2],C1[r+3]);} \
      float rm=__builtin_fmaxf(a,b); { auto rr=__builtin_amdgcn_permlane32_swap(__float_as_uint(rm),__float_as_uint(rm),false,false); rm=__builtin_fmaxf(__uint_as_float(rr[0]),__uint_as_float(rr[1])); } \
      resc=false; \
      if(__builtin_expect(__any(rm>(float)THRL),0)){ const float dl=__builtin_fmaxf(rm,0.f); mhat+=dl; \
        _Pragma("unroll") for(int r=0;r<16;++r){C0[r]-=dl;C1[r]-=dl;} \
        const float f=__builtin_amdgcn_exp2f(-dl); l_reg*=f; if(hi==0)wsf[r32]=f; resc=true; } } \
    SBAR(); \
    GAPB(o[0]=__builtin_amdgcn_mfma_f32_32x32x16_bf16(PAF(0),VFR(0),o[0],0,0,0), C0,0); \
    GAPB(o[1]=__builtin_amdgcn_mfma_f32_32x32x16_bf16(PAF(0),VFR(4),o[1],0,0,0), C0,4); \
    KRD(GL,0); GAPB(o[0]=__builtin_amdgcn_mfma_f32_32x32x16_bf16(PAF(1),VFR(1),o[0],0,0,0), C0,8); \
    KRD(GL,1); GAPB(o[1]=__builtin_amdgcn_mfma_f32_32x32x16_bf16(PAF(1),VFR(5),o[1],0,0,0), C0,12); \
    KRD(GL,2); GAPB(o[0]=__builtin_amdgcn_mfma_f32_32x32x16_bf16(PAF(2),VFR(2),o[0],0,0,0), C1,0); \
    KRD(GL,3); GAPB(o[1]=__builtin_amdgcn_mfma_f32_32x32x16_bf16(PAF(2),VFR(6),o[1],0,0,0), C1,4); \
    GAPB(o[0]=__builtin_amdgcn_mfma_f32_32x32x16_bf16(PAF(3),VFR(3),o[0],0,0,0), C1,8); \
    GAPB(o[1]=__builtin_amdgcn_mfma_f32_32x32x16_bf16(PAF(3),VFR(7),o[1],0,0,0), C1,12); \
    }while(0)
  int t=1;
  for(;t+5<NT;t+=2){
    STEP(pB0,pB1,pA0,pA1,t,true,true,true);     WAIT_BAR(2); RESC(); ROT();
    STEP(pA0,pA1,pB0,pB1,t+1,true,true,true);   WAIT_BAR(2); RESC(); ROT();
  }
  #define ENDW(tt) do{ if((tt)+3<NT){WAIT_BAR(2);} else if((tt)+2<NT){WAIT_BAR(1);} else {WAIT_BAR(0);} }while(0)
  for(;t+1<NT;t+=2){
    STEP(pB0,pB1,pA0,pA1,t,(t+3<NT),(t+1<NT),(t+1<NT));       ENDW(t);   RESC(); ROT();
    STEP(pA0,pA1,pB0,pB1,t+1,(t+4<NT),(t+2<NT),(t+2<NT));     ENDW(t+1); RESC(); ROT();
  }
  STEP(pB0,pB1,pA0,pA1,NT-1,false,false,false); RESC();
  { float sacc=pB0[0]+pB0[1]; _Pragma("unroll") for(int r=2;r<16;++r)sacc+=pB0[r]; _Pragma("unroll") for(int r=0;r<16;++r)sacc+=pB1[r]; l_reg+=sacc;
    pw0=(u32x4){PKW(pB0,0),PKW(pB0,2),PKW(pB0,4),PKW(pB0,6)};pw1=(u32x4){PKW(pB0,8),PKW(pB0,10),PKW(pB0,12),PKW(pB0,14)};pw2=(u32x4){PKW(pB1,0),PKW(pB1,2),PKW(pB1,4),PKW(pB1,6)};pw3=(u32x4){PKW(pB1,8),PKW(pB1,10),PKW(pB1,12),PKW(pB1,14)};
    SBAR(); pv(o,vb0+sl_cur,PAF(0),PAF(1),PAF(2),PAF(3)); }
  #undef PKW
  #undef PAF
  #undef VFR
  #undef PIN
  #undef MX3
  #undef GAPA
  #undef GAPB
  #undef EX
  #undef VRD
  #undef KRD
  #undef STEP
  #undef ENDW
  {auto rr=__builtin_amdgcn_permlane32_swap(__float_as_uint(l_reg),__float_as_uint(l_reg),false,false);l_reg=__uint_as_float(rr[0])+__uint_as_float(rr[1]);}
  if(hi==0)wsf[32+r32]=l_reg;asm volatile("s_waitcnt lgkmcnt(0)":::"memory");
  float rli[16];
  #pragma unroll
  for(int r=0;r<16;++r)rli[r]=__builtin_amdgcn_rcpf(wsf[32+crow(r,hi)]);
  bf16*Ow=A.Ow0+(long)(wid*QBLK)*OP;
  { bf16*stg=(bf16*)(shm+LDS_OST)+wid*2048;
    #pragma unroll
    for(int r=0;r<16;++r){const int orow=crow(r,hi);
      #pragma unroll
      for(int d0=0;d0<2;++d0)stg[orow*64+d0*32+r32]=__float2bfloat16(o[d0][r]*rli[r]);}
    asm volatile("s_waitcnt lgkmcnt(0)":::"memory");
    #pragma unroll
    for(int i=0;i<4;++i){const int row=i*8+(lane>>3),ch=lane&7; const u32x4 v=*(const u32x4*)(stg+row*64+ch*8); u32x4*dst=(u32x4*)(Ow+(long)row*OP+ch*8); const u32x4 g=*dst; u32x4 w;
      #pragma unroll
      for(int j=0;j<4;++j){ const float g0=__uint_as_float(g[j]<<16),g1=__uint_as_float(g[j]&0xffff0000u); const float o0=__uint_as_float(v[j]<<16),o1=__uint_as_float(v[j]&0xffff0000u);
        w[j]=cvtpk_s(o0*g0*__builtin_amdgcn_rcpf(1.f+__expf(-g0)),o1*g1*__builtin_amdgcn_rcpf(1.f+__expf(-g1))); }
      *dst=w; } }
  asm volatile("s_waitcnt lgkmcnt(0)\n\ts_barrier":::"memory");
  #undef DMA_K
  #undef DMA_V
  #undef CMASK
  #undef NAMASK
  #undef TROW
  #undef START
  #undef RESC
  #undef ROT
}
constexpr int ATTN_LDS_BYTES=LDS_BYTES;

#undef SBAR
#undef WAIT_BAR
}
namespace mk {
__device__ __forceinline__ void ph_attn(char* shm, bf16* P, const bf16* Qn, const bf16* Kn, const float* rpb, int nb, int tid, unsigned* ticket, volatile LAS unsigned* slot) {
    using attn_body::AttnP; typedef attn_body::bf16 abf;
    const int nunits = nb * 64;
#pragma unroll 1
    for (;;) {
        if (tid == 0) *slot = __hip_atomic_fetch_add(ticket, 1u, __ATOMIC_RELAXED, __HIP_MEMORY_SCOPE_AGENT);
        __syncthreads();
        const int uu = (int)__builtin_amdgcn_readfirstlane((int)*slot);
        __syncthreads();
        if (uu >= 2 * nunits) break;
        if (uu < nunits) { const int u = uu; const int b = u >> 6, h = (u >> 3) & 7, qb = u & 7, g = h >> 2; const size_t rb = (size_t)b * SEQ;
            AttnP A; A.Qw0 = (const abf*)(Qn + (rb + qb * 256) * 512 + h * 64); A.Kh = (const abf*)(Kn + rb * 128 + g * 64);
            A.Vh = (const abf*)(P + rb * LDP + PC_QKVC + 640 + g * 64); A.Ow0 = (abf*)(P + (rb + qb * 256) * LDP + PC_GC + h * 64);
            A.NT = 32; A.tbase = 0; A.toff = 0; A.qr0 = 0; A.qscale = 1.f;
            int tid2 = tid; asm volatile("" : "+v"(tid2)); attn_body::attn_unit<8, 0, 512, 128, LDP, LDP>(A, shm, tid2);
        } else { const int u = uu - nunits; const int b = u >> 6, h = (u >> 3) & 7, qb = u & 7; const size_t rb = (size_t)b * SEQ; const int qr0 = qb * 4;
            { float* tb = (float*)(shm + attn_body::LDS_RPB); for (int i = tid; i < 465; i += 512) tb[i] = rpb[h * 465 + i] * 1.4426950408889634f; }
            int rs0 = qr0 - 4; rs0 = rs0 < 0 ? 0 : (rs0 > 24 ? 24 : rs0); int rs3 = qr0 - 1; rs3 = rs3 < 0 ? 0 : (rs3 > 24 ? 24 : rs3); int NT = rs3 - rs0 + 8; NT += (NT & 1);
            AttnP A; A.Qw0 = (const abf*)(P + (rb + qb * 256) * LDP + PC_QKVD + h * 64); A.Kh = (const abf*)(P + rb * LDP + PC_QKVD + 512 + h * 64);
            A.Vh = (const abf*)(P + rb * LDP + PC_QKVD + 1024 + h * 64); A.Ow0 = (abf*)(P + (rb + qb * 256) * LDP + PC_GD + h * 64);
            A.NT = NT; A.tbase = rs0; A.toff = rs3 - rs0; A.qr0 = qr0; A.qscale = C2;
            int tid2 = tid; asm volatile("" : "+v"(tid2)); attn_body::attn_unit<8, 1, LDP, LDP, LDP, LDP>(A, shm, tid2); }
    }
}
}
namespace mk {
constexpr int RW_CH = 32;
constexpr int RW_P64 = 144, RW_P32 = 80, RW_TA_ROW = 144;
constexpr int RW_CONST = 0;
constexpr int RW_TA_LO = 4 * RW_TA_ROW;
constexpr int RW_PW = RW_CONST + 960 * 4, RW_PWB = 2 * RW_TA_LO + 2 * 4 * 64 * 4;
constexpr int RW_WT = RW_PW + 8 * RW_PWB;
constexpr int RW_WTOT = RW_WT + 2 * 64 * RW_TA_ROW;
constexpr int RW_TAL = RW_WTOT + 8 * 64 * 4;
constexpr int RW_TS = RW_TAL + 32 * RW_P64;
constexpr int O_TRH = 0, O_TBE = O_TRH + 32 * RW_P64, O_TKA = O_TBE + 32 * RW_P64, O_TBP = O_TKA + 32 * RW_P64, O_TKP = O_TBP + 64 * RW_P32, O_VT = O_TKP + 64 * RW_P32, O_GC = O_VT + 64 * RW_P32, RW_TSB = O_GC + 256;
constexpr int RW_S0B = RW_TS + 2 * RW_TSB;
constexpr int RW_UB = RW_S0B + 2 * 64 * RW_P64;
constexpr int RW_RF = RW_UB + 64 * RW_P32;
constexpr int RW_ABF = RW_RF + 64 * 36 * 4;
constexpr int RW_CORR = RW_ABF + 32 * 36 * 4;
constexpr int RW_DUMP = RW_CORR + 64 * 20 * 4;
constexpr int RW_LDS_END = RW_DUMP + 256;
static_assert(RW_LDS_END <= 163840 - 16, "rwkv lds");
#define RW_BAR() do { asm volatile("s_waitcnt lgkmcnt(0)" ::: "memory"); __builtin_amdgcn_s_barrier(); asm volatile("" ::: "memory"); } while (0)
__device__ __forceinline__ float dppf(float x, const int ctrl_sel) {
    const int xi = __builtin_bit_cast(int, x); int r;
    if (ctrl_sel == 0) r = __builtin_amdgcn_update_dpp(0, xi, 0xB1, 0xf, 0xf, true);
    else if (ctrl_sel == 1) r = __builtin_amdgcn_update_dpp(0, xi, 0x4E, 0xf, 0xf, true);
    else if (ctrl_sel == 2) r = __builtin_amdgcn_update_dpp(0, xi, 0x141, 0xf, 0xf, true);
    else r = __builtin_amdgcn_update_dpp(0, xi, 0x140, 0xf, 0xf, true);
    return __builtin_bit_cast(float, r);
}
__device__ __forceinline__ float sum16(float x) { x += dppf(x, 0); x += dppf(x, 1); x += dppf(x, 2); x += dppf(x, 3); return x; }
__device__ __forceinline__ float rw_fma(float a, float b, float c) { float r; asm("v_fma_f32 %0, %1, %2, %3" : "=v"(r) : "v"(a), "v"(b), "v"(c)); return r; }
__device__ __forceinline__ int rwcrow(int r, int hi) { return (r & 3) + 8 * (r >> 2) + 4 * hi; }
__device__ __forceinline__ unsigned rwpk(float lo, float hi) { typedef float f2 __attribute__((ext_vector_type(2))); typedef __bf16 b2 __attribute__((ext_vector_type(2))); f2 v = {lo, hi}; b2 b = __builtin_convertvector(v, b2); return __builtin_bit_cast(unsigned, b); }
__device__ __forceinline__ f32x16 rw_cc(const LAS unsigned char* X, const LAS unsigned char* Y, int r32, int hi) {
    f32x16 d = f32x16{};
#pragma unroll
    for (int s = 0; s < 4; ++s) d = __builtin_amdgcn_mfma_f32_32x32x16_bf16(*(const LAS bf16x8*)(X + r32 * RW_P64 + 32 * s + 16 * hi), *(const LAS bf16x8*)(Y + r32 * RW_P64 + 32 * s + 16 * hi), d, 0, 0, 0);
    return d;
}
__device__ __forceinline__ f32x16 rw_accmul(f32x16 acc, const LAS unsigned char* Lt_row, const f32x16& M, int hi) {
    v4u m0, m1; m0.x = rwpk(M[0], M[1]); m0.y = rwpk(M[2], M[3]); m0.z = rwpk(M[4], M[5]); m0.w = rwpk(M[6], M[7]); m1.x = rwpk(M[8], M[9]); m1.y = rwpk(M[10], M[11]); m1.z = rwpk(M[12], M[13]); m1.w = rwpk(M[14], M[15]);
#pragma unroll
    for (int s = 0; s < 2; ++s) { const LAS unsigned char* p = Lt_row + 2 * (16 * s + 4 * hi); const v2u lo = *(const LAS v2u*)p, hv = *(const LAS v2u*)(p + 16); v4u av; av.x = lo.x; av.y = lo.y; av.z = hv.x; av.w = hv.y;
        acc = __builtin_amdgcn_mfma_f32_32x32x16_bf16(__builtin_bit_cast(bf16x8, av), __builtin_bit_cast(bf16x8, s == 0 ? m0 : m1), acc, 0, 0, 0); }
    return acc;
}
__device__ __forceinline__ void rwkv_item(LAS unsigned char* lds_dyn, const bf16* P, int T, int z, int b, int h, const float* mu, const float* w0, const float* w_up, const float* a0, const float* a_up,
                                          const float* k_k, const float* k_a, const float* r_k, bf16* YB, float* CB, bf16* VB, const int tid_in) {
    (void)lds_dyn; LAS unsigned char* const lds = (LAS unsigned char*)(unsigned)0;
    unsigned mk_ = ~0u; int wv_ = tid_in; asm volatile("" : "+s"(mk_), "+s"(wv_));
    const int tid = wv_ * 64 + (int)__builtin_amdgcn_mbcnt_hi(mk_, __builtin_amdgcn_mbcnt_lo(mk_, 0u));
    const int lane0 = tid & 63, wave = __builtin_amdgcn_readfirstlane(tid >> 6);
    LAS float* CN = (LAS float*)(lds + RW_CONST);
    for (int i = tid; i < 960; i += 512) { float v;
        if (i < 640) { const int m = i / 320, j = i % 320, g = j >> 6, c = j & 63; const int ch = (g < 3 ? g * 512 + h * 64 : (g == 3 ? 1536 + z * 64 : 1664 + z * 64)) + c; v = mu[m * 1792 + ch]; }
        else { const int j = i - 640, g = j >> 6, c = j & 63; v = g == 0 ? w0[z * 512 + h * 64 + c] : g == 1 ? a0[z * 512 + h * 64 + c] : g == 2 ? k_k[h * 64 + c] : g == 3 ? k_a[h * 64 + c] : r_k[h * 64 + c]; }
        CN[i] = v; }
    for (int i = tid; i < 2 * 64 * 64; i += 512) { const int lo = i >> 12, k = (i >> 6) & 63, n = i & 63; const float* U = (lo == 0 ? w_up : a_up) + (size_t)z * 64 * 512 + h * 64;
        *(LAS unsigned short*)(lds + RW_WT + lo * 64 * RW_TA_ROW + n * RW_TA_ROW + 2 * k) = (unsigned short)f2bf(U[(size_t)k * 512 + n]); }
    for (int i = tid; i < 2 * 64 * RW_P64 / 4; i += 512) ((LAS unsigned*)(lds + RW_S0B))[i] = 0u;
    __syncthreads();
    const int NCH = SEQ / RW_CH;
    const int gcol[5] = {PC_SLAB + h * 64, PC_SLAB + 512 + h * 64, PC_SLAB + 1024 + h * 64, PC_SLAB + 1536 + z * 64, PC_SLAB + 1664 + z * 64};
    const size_t tb0 = (size_t)b * SEQ;
    v2u rawc[2][5], rawe[5];
#define RW_ROWOFF(step_) ({ const int i__ = (step_); int l__ = z ? (SEQ - 1 - i__) : i__; l__ = l__ < 0 ? 0 : (l__ > SEQ - 1 ? SEQ - 1 : l__); ((unsigned)(tb0 + l__) * (unsigned)LDP + 4u * (unsigned)cq) * 2u; })
#define RW_LOAD(cc) do { const GAS unsigned char* Pb_ = (const GAS unsigned char*)P; const int s0_ = (cc) * RW_CH + 4 * vw0; \
    const unsigned r0_ = RW_ROWOFF(s0_ + js), r1_ = RW_ROWOFF(s0_ + 4 + js), re_ = RW_ROWOFF(js == 0 ? s0_ - 1 : (js == 3 ? s0_ + 8 : s0_ + js)); \
    _Pragma("unroll") for (int g = 0; g < 5; ++g) { rawc[0][g] = *(const GAS v2u*)(Pb_ + (r0_ + 2u * (unsigned)gcol[g])); rawc[1][g] = *(const GAS v2u*)(Pb_ + (r1_ + 2u * (unsigned)gcol[g])); rawe[g] = *(const GAS v2u*)(Pb_ + (re_ + 2u * (unsigned)gcol[g])); } } while (0)
    { const int lane = lane0, js = lane >> 4, cq = lane & 15, vw0 = wave >= 4 ? 2 * (wave - 4) : 0; RW_LOAD(0); }
    f32x16 accS[2] = {f32x16{}, f32x16{}};
    LAS float* const WTOT = (LAS float*)(lds + RW_WTOT); LAS float* const RF = (LAS float*)(lds + RW_RF); LAS float* const ABF = (LAS float*)(lds + RW_ABF); LAS float* const CORR = (LAS float*)(lds + RW_CORR);
#pragma unroll 1
    for (int it = 0; it <= NCH; ++it) {
        int lane_ = lane0; asm volatile("" : "+v"(lane_));
        const int lane = lane_, r32 = lane & 31, hi = lane >> 5, js = lane >> 4, cq = lane & 15;
        const int cp = it, cc = it - 1;
        const bool prep = (wave >= 4) && (cp < NCH), chain = (wave < 4) && (cc >= 0);
        const int vw0 = 2 * (wave - 4); const int sjv[2] = {4 * vw0 + js, 4 * (vw0 + 1) + js};
        LAS unsigned char* const tsp = lds + RW_TS + (cp & 1) * RW_TSB; const LAS unsigned char* const tsc = lds + RW_TS + (cc & 1) * RW_TSB;
        const LAS unsigned char* S0cur = lds + RW_S0B + (cc & 1) * 64 * RW_P64; LAS unsigned char* S0nxt = lds + RW_S0B + ((cc + 1) & 1) * 64 * RW_P64;
        float sv[2][3][4];
        float o_kk[2][4], o_r[2][4], o_b[2][4], o_kd[2][4], o_v[2][4], lw2[2][4], Lin[2][4];
        if (prep) {
            float sw_[2][2][4];
            asm volatile("s_waitcnt vmcnt(0)" ::: "memory");
#pragma unroll
            for (int g = 0; g < 5; ++g) { const f32x4 m0 = *(const LAS f32x4*)(CN + g * 64 + 4 * cq), m1 = *(const LAS f32x4*)(CN + 320 + g * 64 + 4 * cq);
                const int am = ((lane - 16) & 63) << 2, ap = ((lane + 16) & 63) << 2;
                v2u A0, A1, B0, B1;
                A0.x = (unsigned)__builtin_amdgcn_ds_bpermute(am, (int)rawc[0][g].x); A0.y = (unsigned)__builtin_amdgcn_ds_bpermute(am, (int)rawc[0][g].y); A1.x = (unsigned)__builtin_amdgcn_ds_bpermute(am, (int)rawc[1][g].x); A1.y = (unsigned)__builtin_amdgcn_ds_bpermute(am, (int)rawc[1][g].y);
                B0.x = (unsigned)__builtin_amdgcn_ds_bpermute(ap, (int)rawc[0][g].x); B0.y = (unsigned)__builtin_amdgcn_ds_bpermute(ap, (int)rawc[0][g].y); B1.x = (unsigned)__builtin_amdgcn_ds_bpermute(ap, (int)rawc[1][g].x); B1.y = (unsigned)__builtin_amdgcn_ds_bpermute(ap, (int)rawc[1][g].y);
#pragma unroll
                for (int u = 0; u < 2; ++u) { const int i_ = cp * RW_CH + sjv[u]; const int l_ = z ? (SEQ - 1 - i_) : i_; const bool okp = (l_ - 1 >= 0), okn = (l_ + 1 < SEQ);
                    const v2u sm = u == 0 ? (js == 0 ? rawe[g] : A0) : (js == 0 ? A0 : A1), sp = u == 0 ? (js == 3 ? B1 : B0) : (js == 3 ? rawe[g] : B1);
                    const v2u lm = z ? sp : sm, lp = z ? sm : sp;
                    const v2u rp = {okp ? lm.x : 0u, okp ? lm.y : 0u}, rn_ = {okn ? lp.x : 0u, okn ? lp.y : 0u};
                    const float pr[4] = {bflo(rp.x), bfhi(rp.x), bflo(rp.y), bfhi(rp.y)}, cu[4] = {bflo(rawc[u][g].x), bfhi(rawc[u][g].x), bflo(rawc[u][g].y), bfhi(rawc[u][g].y)}, nx[4] = {bflo(rn_.x), bfhi(rn_.x), bflo(rn_.y), bfhi(rn_.y)};
#pragma unroll
                    for (int e = 0; e < 4; ++e) { const float val = cu[e] + m0[e] * (pr[e] - cu[e]) + m1[e] * (nx[e] - cu[e]); if (g < 3) sv[u][g][e] = val; else sw_[u][g - 3][e] = val; } } }
#pragma unroll
            for (int u = 0; u < 2; ++u) {
#pragma unroll
                for (int g = 0; g < 3; ++g) asm volatile("" : "+v"(sv[u][g][0]), "+v"(sv[u][g][1]), "+v"(sv[u][g][2]), "+v"(sv[u][g][3]) :: "memory");
#pragma unroll
                for (int g = 0; g < 2; ++g) asm volatile("" : "+v"(sw_[u][g][0]), "+v"(sw_[u][g][1]), "+v"(sw_[u][g][2]), "+v"(sw_[u][g][3]) :: "memory"); }
            __builtin_amdgcn_sched_barrier(0);
            LAS unsigned char* const TAw = lds + RW_PW + vw0 * RW_PWB;
            LAS float* const LRw = (LAS float*)(TAw + 2 * 8 * RW_TA_ROW);
#pragma unroll
            for (int u = 0; u < 2; ++u) { float th[4];
#pragma unroll
                for (int e = 0; e < 4; ++e) { const float ex = __builtin_amdgcn_exp2f(sw_[u][0][e] * 2.8853900817779268f); th[e] = 1.f - 2.f * __builtin_amdgcn_rcpf(1.f + ex); }
                v2u t0; t0.x = pk2(th[0], th[1]); t0.y = pk2(th[2], th[3]); *(LAS v2u*)(TAw + (4 * u + js) * RW_TA_ROW + 8 * cq) = t0;
                v2u t1; t1.x = pk2(sw_[u][1][0], sw_[u][1][1]); t1.y = pk2(sw_[u][1][2], sw_[u][1][3]); *(LAS v2u*)(TAw + 8 * RW_TA_ROW + (4 * u + js) * RW_TA_ROW + 8 * cq) = t1; }
        } else if (chain) {
            if (wave < 2) {
                const int v0 = 32 * wave; f32x16 acc = f32x16{};
#pragma unroll
                for (int s = 0; s < 4; ++s) acc = __builtin_amdgcn_mfma_f32_32x32x16_bf16(*(const LAS bf16x8*)(S0cur + (v0 + r32) * RW_P64 + 32 * s + 16 * hi), *(const LAS bf16x8*)(lds + RW_TAL + r32 * RW_P64 + 32 * s + 16 * hi), acc, 0, 0, 0);
                f32x16 ak = rw_cc(tsc + O_TKA, lds + RW_TAL, r32, hi);
#pragma unroll
                for (int r = 0; r < 16; ++r) ak[r] = (rwcrow(r, hi) < r32) ? ak[r] : 0.f;
                acc = rw_accmul(acc, tsc + O_VT + (v0 + r32) * RW_P32, ak, hi);
#pragma unroll
                for (int r = 0; r < 16; ++r) RF[(v0 + rwcrow(r, hi)) * 36 + r32] = acc[r];
            } else if (wave == 2) {
                f32x16 ab = rw_cc(tsc + O_TBE, lds + RW_TAL, r32, hi);
#pragma unroll
                for (int r = 0; r < 16; ++r) ABF[rwcrow(r, hi) * 36 + r32] = (rwcrow(r, hi) < r32) ? ab[r] : 0.f;
            }
        }
        RW_BAR();
        if (prep) {
            {   LAS unsigned char* const TAw = lds + RW_PW + vw0 * RW_PWB; LAS float* const LRw = (LAS float*)(TAw + 2 * 8 * RW_TA_ROW);
            {
                LAS float* const lrb = lane < 32 ? LRw + (4 * (lane >> 4)) * 64 + (lane & 15) : (LAS float*)(lds + RW_DUMP); const int rs = lane < 32 ? 64 : 0, ls = lane < 32 ? 512 : 0, ns = lane < 32 ? 16 : 0;
                bf16x8 Af[2][2], Wf[2][4][2]; f32x4 accL[2][4];
#pragma unroll
                for (int lo = 0; lo < 2; ++lo) { Af[lo][0] = *(const LAS bf16x8*)(TAw + lo * 8 * RW_TA_ROW + (lane & 15) * RW_TA_ROW + 16 * (lane >> 4)); Af[lo][1] = *(const LAS bf16x8*)(TAw + lo * 8 * RW_TA_ROW + (lane & 15) * RW_TA_ROW + 64 + 16 * (lane >> 4));
#pragma unroll
                    for (int nt = 0; nt < 4; ++nt) { const LAS unsigned char* wt = lds + RW_WT + lo * 64 * RW_TA_ROW + (16 * nt + (lane & 15)) * RW_TA_ROW + 16 * (lane >> 4); Wf[lo][nt][0] = *(const LAS bf16x8*)(wt); Wf[lo][nt][1] = *(const LAS bf16x8*)(wt + 64); } }
#pragma unroll
                for (int lo = 0; lo < 2; ++lo)
#pragma unroll
                    for (int nt = 0; nt < 4; ++nt) { f32x4 acc = {0.f, 0.f, 0.f, 0.f}; acc = __builtin_amdgcn_mfma_f32_16x16x32_bf16(Af[lo][0], Wf[lo][nt][0], acc, 0, 0, 0); accL[lo][nt] = __builtin_amdgcn_mfma_f32_16x16x32_bf16(Af[lo][1], Wf[lo][nt][1], acc, 0, 0, 0); }
#pragma unroll
                for (int lo = 0; lo < 2; ++lo)
#pragma unroll
                    for (int nt = 0; nt < 4; ++nt) { LAS float* lr = lrb + lo * ls + nt * ns; lr[0] = accL[lo][nt][0]; lr[rs] = accL[lo][nt][1]; lr[2 * rs] = accL[lo][nt][2]; lr[3 * rs] = accL[lo][nt][3]; } }
            }
            asm volatile("s_waitcnt lgkmcnt(0)" ::: "memory");
            LAS float* const LRw = (LAS float*)(lds + RW_PW + vw0 * RW_PWB + 2 * 8 * RW_TA_ROW); float bo_[2];
            f32x4 lw_[2], la_[2];
#pragma unroll
            for (int u = 0; u < 2; ++u) { lw_[u] = *(const LAS f32x4*)(LRw + (4 * u + js) * 64 + 4 * cq); la_[u] = *(const LAS f32x4*)(LRw + 512 + (4 * u + js) * 64 + 4 * cq); }
            const f32x4 c_w0 = *(const LAS f32x4*)(CN + 640 + 4 * cq), c_a0 = *(const LAS f32x4*)(CN + 704 + 4 * cq), c_kk = *(const LAS f32x4*)(CN + 768 + 4 * cq), c_ka = *(const LAS f32x4*)(CN + 832 + 4 * cq), c_rk = *(const LAS f32x4*)(CN + 896 + 4 * cq);
#pragma unroll
            for (int u = 0; u < 2; ++u) { const f32x4 lw = lw_[u], la = la_[u];
                float kx[4], n2 = 0.f;
#pragma unroll
                for (int e = 0; e < 4; ++e) { kx[e] = sv[u][1][e] * c_kk[e]; n2 += kx[e] * kx[e]; }
                n2 = sum16(n2); const float rn = __builtin_amdgcn_rsqf(fmaxf(n2, 1e-24f));
                float bo = 0.f;
#pragma unroll
                for (int e = 0; e < 4; ++e) { const float wraw = lw[e] + c_w0[e];
                    lw2[u][e] = -0.8750387749480469f * __builtin_amdgcn_rcpf(1.f + __expf(-wraw));
                    const float aa = __builtin_amdgcn_rcpf(1.f + __expf(-(la[e] + c_a0[e]))); o_kk[u][e] = kx[e] * rn; o_kd[u][e] = sv[u][1][e] * (1.f + (aa - 1.f) * c_ka[e]); o_b[u][e] = o_kk[u][e] * aa; o_r[u][e] = sv[u][0][e]; o_v[u][e] = sv[u][2][e];
                    bo += o_r[u][e] * o_kd[u][e] * c_rk[e]; }
                bo_[u] = sum16(bo);
#pragma unroll
                for (int e = 0; e < 4; ++e) { float x = lw2[u][e];
                    const float y1 = __builtin_bit_cast(float, __builtin_amdgcn_ds_bpermute(((lane - 16) & 63) << 2, __builtin_bit_cast(int, x))); x += (js >= 1) ? y1 : 0.f;
                    const float y2 = __builtin_bit_cast(float, __builtin_amdgcn_ds_bpermute(((lane - 32) & 63) << 2, __builtin_bit_cast(int, x))); x += (js >= 2) ? y2 : 0.f; Lin[u][e] = x; } }
#pragma unroll
            for (int u = 0; u < 2; ++u) { LAS float* wp = js == 3 ? WTOT + (vw0 + u) * 64 + 4 * cq : (LAS float*)(lds + RW_DUMP); *(LAS f32x4*)wp = (f32x4){Lin[u][0], Lin[u][1], Lin[u][2], Lin[u][3]}; }
#pragma unroll
            for (int u = 0; u < 2; ++u) { const int i_ = cp * RW_CH + sjv[u]; const int l_ = z ? (SEQ - 1 - i_) : i_; const size_t t = tb0 + l_;
                if (cq == 0) *(GAS float*)(CB + ((size_t)(z * 8 + h)) * T + t) = bo_[u];
                if (z == 0) { v2u vb; vb.x = pk2(o_v[u][0], o_v[u][1]); vb.y = pk2(o_v[u][2], o_v[u][3]); *(GAS v2u*)(VB + t * 512 + h * 64 + 4 * cq) = vb; } }
            __builtin_amdgcn_sched_barrier(0);
            { const int cn = cp + 1 < NCH ? cp + 1 : cp; RW_LOAD(cn); }
            __builtin_amdgcn_sched_barrier(0);
        } else if (chain && wave == 0) {
            LAS float* row = RF + lane * 36;
#define RW_SOLVE16(o_) do { float u[16]; \
            _Pragma("unroll") for (int q4 = 0; q4 < 4; ++q4) { f32x4 rr = *(const LAS f32x4*)(row + (o_) + 4 * q4); if ((o_) != 0) rr += *(const LAS f32x4*)(CORR + lane * 20 + 4 * q4); u[4 * q4] = rr[0]; u[4 * q4 + 1] = rr[1]; u[4 * q4 + 2] = rr[2]; u[4 * q4 + 3] = rr[3]; } \
            _Pragma("unroll") for (int tb = 0; tb < 4; ++tb) { f32x4 A_[4][4]; \
                _Pragma("unroll") for (int r_ = 0; r_ < 4; ++r_) _Pragma("unroll") for (int q4 = tb; q4 < 4; ++q4) A_[r_][q4] = *(const LAS f32x4*)(ABF + ((o_) + 4 * tb + r_) * 36 + (o_) + 4 * q4); \
                _Pragma("unroll") for (int r_ = 0; r_ < 4; ++r_) { const int tt = 4 * tb + r_; if (tt < 15) { const float nut = -u[tt]; \
                    _Pragma("unroll") for (int q4 = (tt + 1) / 4; q4 < 4; ++q4) { const f32x4 aa = A_[r_][q4]; \
                        _Pragma("unroll") for (int e_ = 0; e_ < 4; ++e_) if (4 * q4 + e_ > tt) u[4 * q4 + e_] = rw_fma(nut, aa[e_], u[4 * q4 + e_]); } } } } \
            v4u w0_, w1_; w0_.x = pk2(-u[0], -u[1]); w0_.y = pk2(-u[2], -u[3]); w0_.z = pk2(-u[4], -u[5]); w0_.w = pk2(-u[6], -u[7]); w1_.x = pk2(-u[8], -u[9]); w1_.y = pk2(-u[10], -u[11]); w1_.z = pk2(-u[12], -u[13]); w1_.w = pk2(-u[14], -u[15]); \
            *(LAS v4u*)(lds + RW_UB + lane * RW_P32 + 2 * (o_)) = w0_; *(LAS v4u*)(lds + RW_UB + lane * RW_P32 + 2 * (o_) + 16) = w1_; } while (0)
            RW_SOLVE16(0);
            asm volatile("s_waitcnt lgkmcnt(0)" ::: "memory");
            {
                v4u bw = {0u, 0u, 0u, 0u};
                if (r32 < 16) { const LAS float* ap = ABF + (8 * hi) * 36 + 16 + r32; bw.x = pk2(ap[0], ap[36]); bw.y = pk2(ap[72], ap[108]); bw.z = pk2(ap[144], ap[180]); bw.w = pk2(ap[216], ap[252]); }
#pragma unroll
                for (int vt = 0; vt < 2; ++vt) { f32x16 d = f32x16{};
                    d = __builtin_amdgcn_mfma_f32_32x32x16_bf16(*(const LAS bf16x8*)(lds + RW_UB + (32 * vt + r32) * RW_P32 + 16 * hi), __builtin_bit_cast(bf16x8, bw), d, 0, 0, 0);
                    if (r32 < 16) {
#pragma unroll
                        for (int r = 0; r < 16; ++r) CORR[(32 * vt + rwcrow(r, hi)) * 20 + r32] = d[r]; } }
            }
            asm volatile("s_waitcnt lgkmcnt(0)" ::: "memory");
            RW_SOLVE16(16);
#undef RW_SOLVE16
        }
        RW_BAR();
        if (prep) {
            f32x4 offu[2] = {{0.f, 0.f, 0.f, 0.f}, {0.f, 0.f, 0.f, 0.f}}, tot = {0.f, 0.f, 0.f, 0.f};
#pragma unroll
            for (int w = 0; w < 8; ++w) { const f32x4 tw = *(const LAS f32x4*)(WTOT + w * 64 + 4 * cq); tot += tw; if (w < vw0) offu[0] += tw; if (w < vw0 + 1) offu[1] += tw; }
#pragma unroll
            for (int u = 0; u < 2; ++u) { const int sj = sjv[u]; const f32x4 off = offu[u];
                float al[4], rh[4], be[4], ka[4], bp[4], kp[4];
#pragma unroll
                for (int e = 0; e < 4; ++e) { const float Lt = off[e] + Lin[u][e]; const float gprev = __builtin_amdgcn_exp2f(Lt - lw2[u][e]), gt = __builtin_amdgcn_exp2f(Lt), gi = __builtin_amdgcn_exp2f(-Lt), gp = __builtin_amdgcn_exp2f(tot[e] - Lt);
                    al[e] = gprev * o_kk[u][e]; rh[e] = gt * o_r[u][e]; be[e] = o_b[u][e] * gi; ka[e] = o_kd[u][e] * gi; bp[e] = o_b[u][e] * gp; kp[e] = o_kd[u][e] * gp; }
                v2u w; w.x = pk2(al[0], al[1]); w.y = pk2(al[2], al[3]); *(LAS v2u*)(lds + RW_TAL + sj * RW_P64 + 8 * cq) = w;
                w.x = pk2(rh[0], rh[1]); w.y = pk2(rh[2], rh[3]); *(LAS v2u*)(tsp + O_TRH + sj * RW_P64 + 8 * cq) = w;
                w.x = pk2(be[0], be[1]); w.y = pk2(be[2], be[3]); *(LAS v2u*)(tsp + O_TBE + sj * RW_P64 + 8 * cq) = w;
                w.x = pk2(ka[0], ka[1]); w.y = pk2(ka[2], ka[3]); *(LAS v2u*)(tsp + O_TKA + sj * RW_P64 + 8 * cq) = w;
#pragma unroll
                for (int e = 0; e < 4; ++e) { *(LAS unsigned short*)(tsp + O_TBP + (4 * cq + e) * RW_P32 + 2 * sj) = (unsigned short)f2bf(bp[e]); *(LAS unsigned short*)(tsp + O_TKP + (4 * cq + e) * RW_P32 + 2 * sj) = (unsigned short)f2bf(kp[e]);
                    *(LAS unsigned short*)(tsp + O_VT + (4 * cq + e) * RW_P32 + 2 * sj) = (unsigned short)f2bf(o_v[u][e]); }
                if (u == 1) { LAS float* gp_ = sj == 31 ? (LAS float*)(tsp + O_GC) + 4 * cq : (LAS float*)(lds + RW_DUMP); *(LAS f32x4*)gp_ = (f32x4){__builtin_amdgcn_exp2f(tot[0]), __builtin_amdgcn_exp2f(tot[1]), __builtin_amdgcn_exp2f(tot[2]), __builtin_amdgcn_exp2f(tot[3])}; } }
        } else if (chain) {
            if (wave < 2) {
                const int v0 = 32 * wave; f32x16 accY = f32x16{};
#pragma unroll
                for (int s = 0; s < 4; ++s) accY = __builtin_amdgcn_mfma_f32_32x32x16_bf16(*(const LAS bf16x8*)(S0cur + (v0 + r32) * RW_P64 + 32 * s + 16 * hi), *(const LAS bf16x8*)(tsc + O_TRH + r32 * RW_P64 + 32 * s + 16 * hi), accY, 0, 0, 0);
                { f32x16 bk = rw_cc(tsc + O_TKA, tsc + O_TRH, r32, hi);
#pragma unroll
                  for (int r = 0; r < 16; ++r) bk[r] = (rwcrow(r, hi) <= r32) ? bk[r] : 0.f;
                  accY = rw_accmul(accY, tsc + O_VT + (v0 + r32) * RW_P32, bk, hi); }
                { f32x16 bbm = rw_cc(tsc + O_TBE, tsc + O_TRH, r32, hi);
#pragma unroll
                  for (int r = 0; r < 16; ++r) bbm[r] = (rwcrow(r, hi) <= r32) ? bbm[r] : 0.f;
                  accY = rw_accmul(accY, lds + RW_UB + (v0 + r32) * RW_P32, bbm, hi); }
                {
                    const int iy = cc * RW_CH + r32; const int ly = z ? (SEQ - 1 - iy) : iy; GAS unsigned char* yb = (GAS unsigned char*)YB + (((size_t)z * T + tb0 + ly) * 512 + h * 64 + v0 + 4 * hi) * 2;
#pragma unroll
                    for (int g4 = 0; g4 < 4; ++g4) { v2u o; o.x = pk2(accY[4 * g4], accY[4 * g4 + 1]); o.y = pk2(accY[4 * g4 + 2], accY[4 * g4 + 3]); *(GAS v2u*)(yb + 16 * g4) = o; } }
            } else {
#pragma unroll
                for (int q = 0; q < 2; ++q) { const int sw = 2 * (wave - 2) + q, v0 = 32 * (sw & 1), k0 = 32 * (sw >> 1);
                    const float gcv = ((const LAS float*)(tsc + O_GC))[k0 + r32];
#pragma unroll
                    for (int r = 0; r < 16; ++r) accS[q][r] *= gcv;
#pragma unroll
                    for (int s = 0; s < 2; ++s) {
                        accS[q] = __builtin_amdgcn_mfma_f32_32x32x16_bf16(*(const LAS bf16x8*)(tsc + O_VT + (v0 + r32) * RW_P32 + 32 * s + 16 * hi), *(const LAS bf16x8*)(tsc + O_TKP + (k0 + r32) * RW_P32 + 32 * s + 16 * hi), accS[q], 0, 0, 0);
                        accS[q] = __builtin_amdgcn_mfma_f32_32x32x16_bf16(*(const LAS bf16x8*)(lds + RW_UB + (v0 + r32) * RW_P32 + 32 * s + 16 * hi), *(const LAS bf16x8*)(tsc + O_TBP + (k0 + r32) * RW_P32 + 32 * s + 16 * hi), accS[q], 0, 0, 0); } }
#pragma unroll
                for (int q = 0; q < 2; ++q) { const int sw = 2 * (wave - 2) + q, v0 = 32 * (sw & 1), k0 = 32 * (sw >> 1);
#pragma unroll
                    for (int r = 0; r < 16; ++r) *(LAS unsigned short*)(S0nxt + (v0 + rwcrow(r, hi)) * RW_P64 + 2 * (k0 + r32)) = (unsigned short)f2bf(accS[q][r]); } }
        }
        RW_BAR();
    }
#undef RW_LOAD
#undef RW_ROWOFF
    __syncthreads();
}
__device__ __forceinline__ void ph_rwkv(LAS unsigned char* lds, const bf16* P, int T, int nb, const float* mu, const float* w0, const float* w_up, const float* a0, const float* a_up, const float* k_k, const float* k_a, const float* r_k,
                                        bf16* YB, float* CB, bf16* VB, int tid, int bid, int nblk) {
    const int wv = __builtin_amdgcn_readfirstlane(tid >> 6);
#pragma unroll 1
    for (int it = bid; it < nb * 16; it += nblk) { const int z = it & 1, h = (it >> 1) & 7, b = it >> 4; rwkv_item(lds, P, T, z, b, h, mu, w0, w_up, a0, a_up, k_k, k_a, r_k, YB, CB, VB, wv); }
}
}
namespace mk {
constexpr int SS_RP = 272;
constexpr int SS_XP = 144;
constexpr int SS_BM = 0, SS_CM = SS_BM + 128 * SS_RP, SS_XN = SS_CM + 128 * SS_RP, SS_SB = SS_XN + 128 * SS_XP, SS_CUM = SS_SB + 128 * SS_XP, SS_MT = SS_CUM + 1024, SS_END = SS_MT + 10 * 2048;
__device__ __forceinline__ v2u ss_tr(unsigned addr) { v2u r; asm volatile("ds_read_b64_tr_b16 %0, %1" : "=&v"(r) : "v"(addr) : "memory"); return r; }
__device__ __forceinline__ void ss_wait4(v2u& a, v2u& b, v2u& c, v2u& d) { asm volatile("s_waitcnt lgkmcnt(0)" : "+v"(a), "+v"(b), "+v"(c), "+v"(d) :: "memory"); }
constexpr int SS_YP = 144;
static_assert(SS_END <= 147456, "ssd lds"); static_assert(SS_XP % 8 == 0 && SS_RP % 8 == 0, "transpose reads need 8-byte aligned rows");
__device__ __forceinline__ int crow(int r, int hi) { return (r & 3) + 8 * (r >> 2) + 4 * hi; }
__device__ __forceinline__ bf16x8 ldsA(const LAS unsigned char* base, int row, int colbyte) { return *(const LAS bf16x8*)(base + row * SS_RP + colbyte); }
__device__ __forceinline__ unsigned cvtpk(float lo, float hi) { typedef float f2 __attribute__((ext_vector_type(2))); typedef __bf16 b2 __attribute__((ext_vector_type(2))); f2 v = {lo, hi}; b2 b = __builtin_convertvector(v, b2); return __builtin_bit_cast(unsigned, b); }
__device__ __forceinline__ void ssd_item(LAS unsigned char* lds, const bf16* XC, const float* DT, const float* a_log, bf16* YA, int T, int z, int b, int h, const int tid) {
    const int lane = tid & 63, wave = __builtin_amdgcn_readfirstlane(tid >> 6), r32 = lane & 31, hi = lane >> 5;
    const int pt = wave & 1, qt = wave >> 1, g = h >> 2;
    const float a2 = -__expf(a_log[z * 8 + h]) * 1.4426950408889634f;
    LAS float* CUM = (LAS float*)(lds + SS_CUM);
    for (int i = tid; i < 128 * SS_XP / 4; i += 512) ((LAS unsigned*)(lds + SS_SB))[i] = 0u;
    f32x16 accS = f32x16{};
    const size_t tb0 = (size_t)b * SEQ;
    v4u pwb[4], pwc[4], pwx[2]; float pd[2], pl0, pl1;
#define SS_LOAD(cc) do { const GAS unsigned char* Xb_ = (const GAS unsigned char*)XC; const GAS unsigned char* Db_ = (const GAS unsigned char*)DT;     \
    _Pragma("unroll") for (int i = 0; i < 4; ++i) { const int idx = tid + 512 * i, q = idx >> 4, c8 = idx & 15; const int pos = 128 * (cc) + q; const unsigned t = (unsigned)tb0 + (unsigned)(z ? (SEQ - 1 - pos) : pos); \
        const unsigned o_ = (t * 1024u + 512u + (unsigned)(g * 128 + 8 * c8)) * 2u; pwb[i] = *(const GAS v4u*)(Xb_ + o_); pwc[i] = *(const GAS v4u*)(Xb_ + (o_ + 512u)); } \
    _Pragma("unroll") for (int i = 0; i < 2; ++i) { const int idx = tid + 512 * i, q = idx >> 3, c8 = idx & 7; const int pos = 128 * (cc) + q; const unsigned t = (unsigned)tb0 + (unsigned)(z ? (SEQ - 1 - pos) : pos); \
        pwx[i] = *(const GAS v4u*)(Xb_ + (t * 1024u + (unsigned)(h * 64 + 8 * c8)) * 2u); pd[i] = *(const GAS float*)(Db_ + (t * 16u + (unsigned)(z * 8 + h)) * 4u); } \
    { const int p0 = 128 * (cc) + 2 * lane; const unsigned t0 = (unsigned)tb0 + (unsigned)(z ? (SEQ - 1 - p0) : p0), t1 = (unsigned)tb0 + (unsigned)(z ? (SEQ - 2 - p0) : (p0 + 1)); pl0 = *(const GAS float*)(Db_ + (t0 * 16u + (unsigned)(z * 8 + h)) * 4u); pl1 = *(const GAS float*)(Db_ + (t1 * 16u + (unsigned)(z * 8 + h)) * 4u); } } while (0)
    SS_LOAD(0);
#pragma unroll 1
    for (int c = 0; c < SEQ / 128; ++c) {
        asm volatile("s_waitcnt vmcnt(2)" ::: "memory");
        __syncthreads();
#pragma unroll
        for (int i = 0; i < 4; ++i) { const int idx = tid + 512 * i, q = idx >> 4, c8 = idx & 15;
            *(LAS v4u*)(lds + SS_BM + q * SS_RP + 16 * c8) = pwb[i]; *(LAS v4u*)(lds + SS_CM + q * SS_RP + 16 * c8) = pwc[i]; }
#pragma unroll
        for (int i = 0; i < 2; ++i) { const int idx = tid + 512 * i, q = idx >> 3, c8 = idx & 7; const v4u wx = pwx[i]; const float d = pd[i]; v4u o;
            o.x = pk2(bflo(wx.x) * d, bfhi(wx.x) * d); o.y = pk2(bflo(wx.y) * d, bfhi(wx.y) * d); o.z = pk2(bflo(wx.z) * d, bfhi(wx.z) * d); o.w = pk2(bflo(wx.w) * d, bfhi(wx.w) * d);
            *(LAS v4u*)(lds + SS_XN + q * SS_XP + 16 * c8) = o; }
        if (wave == 0) {
            const float l0 = pl0 * a2, l1 = pl1 * a2; float x = l0 + l1;
#pragma unroll
            for (int o = 1; o < 64; o <<= 1) { const float y = __builtin_bit_cast(float, __builtin_amdgcn_ds_bpermute(((lane - o) & 63) << 2, __builtin_bit_cast(int, x))); x += (lane >= o) ? y : 0.f; }
            *(LAS f32x2v*)(CUM + 2 * lane) = (f32x2v){x - l1, x}; }
        asm volatile("" ::: "memory"); __builtin_amdgcn_sched_barrier(0);
        SS_LOAD(c + 1 < SEQ / 128 ? c + 1 : c);
        __builtin_amdgcn_sched_barrier(0);
        __syncthreads();
        const float cq = CUM[32 * qt + r32], clast = CUM[127];
        f32x16 acc = f32x16{};
        { bf16x8 cf[8];
#pragma unroll
          for (int s = 0; s < 8; ++s) cf[s] = ldsA(lds + SS_CM, 32 * qt + r32, 32 * s + 16 * hi);
          { const unsigned sa = (unsigned)(uintptr_t)(lds + SS_SB) + (unsigned)((8 * hi + ((lane & 15) >> 2)) * SS_XP + (32 * pt + 16 * ((lane >> 4) & 1) + 4 * (lane & 3)) * 2);
            v2u sl[8], sh[8];
#pragma unroll
            for (int s = 0; s < 8; ++s) { sl[s] = ss_tr(sa + 16 * s * SS_XP); sh[s] = ss_tr(sa + (16 * s + 4) * SS_XP); }
#pragma unroll
            for (int s = 0; s < 4; ++s) ss_wait4(sl[2 * s], sh[2 * s], sl[2 * s + 1], sh[2 * s + 1]);
#pragma unroll
            for (int s = 0; s < 8; ++s) { v4u av; av.x = sl[s].x; av.y = sl[s].y; av.z = sh[s].x; av.w = sh[s].y; acc = __builtin_amdgcn_mfma_f32_32x32x16_bf16(__builtin_bit_cast(bf16x8, av), cf[s], acc, 0, 0, 0); } }
          const float eq = __builtin_amdgcn_exp2f(cq);
#pragma unroll
          for (int r = 0; r < 16; ++r) acc[r] *= eq; }
#pragma unroll 1
        for (int tI = wave; tI < 10; tI += 8) { const int q2 = tI < 1 ? 0 : (tI < 3 ? 1 : (tI < 6 ? 2 : 3)), kt = tI - q2 * (q2 + 1) / 2; const float cq2 = CUM[32 * q2 + r32];
            f32x16 gT = f32x16{};
#pragma unroll
            for (int s = 0; s < 8; ++s) gT = __builtin_amdgcn_mfma_f32_32x32x16_bf16(ldsA(lds + SS_BM, 32 * kt + r32, 32 * s + 16 * hi), ldsA(lds + SS_CM, 32 * q2 + r32, 32 * s + 16 * hi), gT, 0, 0, 0);
#pragma unroll
            for (int gq = 0; gq < 4; ++gq) { const f32x4 ck = *(const LAS f32x4*)(CUM + 32 * kt + 8 * gq + 4 * hi);
#pragma unroll
                for (int e = 0; e < 4; ++e) { const int r = 4 * gq + e; const bool ok = (kt < q2) || (8 * gq + 4 * hi + e <= r32); const float m = __builtin_amdgcn_exp2f(cq2 - ck[e]); gT[r] = ok ? gT[r] * m : 0.f; } }
            v4u m0, m1; m0.x = cvtpk(gT[0], gT[1]); m0.y = cvtpk(gT[2], gT[3]); m0.z = cvtpk(gT[4], gT[5]); m0.w = cvtpk(gT[6], gT[7]); m1.x = cvtpk(gT[8], gT[9]); m1.y = cvtpk(gT[10], gT[11]); m1.z = cvtpk(gT[12], gT[13]); m1.w = cvtpk(gT[14], gT[15]);
            *(LAS v4u*)(lds + SS_MT + tI * 2048 + lane * 32) = m0; *(LAS v4u*)(lds + SS_MT + tI * 2048 + lane * 32 + 16) = m1; }
        __syncthreads();
#pragma unroll
        for (int kh = 0; kh < 2; ++kh) {
            v2u xl[2][4]; v4u mm[2][2];
#pragma unroll
            for (int k2 = 0; k2 < 2; ++k2) { const int kt = 2 * kh + k2, ktc = kt <= qt ? kt : qt;
                const unsigned xa = (unsigned)(uintptr_t)(lds + SS_XN) + (unsigned)((32 * ktc + 4 * hi + ((lane & 15) >> 2)) * SS_XP + (32 * pt + 16 * ((lane >> 4) & 1) + 4 * (lane & 3)) * 2);
                xl[k2][0] = ss_tr(xa); xl[k2][1] = ss_tr(xa + 8 * SS_XP); xl[k2][2] = ss_tr(xa + 16 * SS_XP); xl[k2][3] = ss_tr(xa + 24 * SS_XP);
                const LAS unsigned char* mp = lds + SS_MT + (qt * (qt + 1) / 2 + ktc) * 2048 + lane * 32; mm[k2][0] = *(const LAS v4u*)mp; mm[k2][1] = *(const LAS v4u*)(mp + 16); }
#pragma unroll
            for (int k2 = 0; k2 < 2; ++k2) { const int kt = 2 * kh + k2; ss_wait4(xl[k2][0], xl[k2][1], xl[k2][2], xl[k2][3]);
                if (kt <= qt) { v4u a0; a0.x = xl[k2][0].x; a0.y = xl[k2][0].y; a0.z = xl[k2][1].x; a0.w = xl[k2][1].y; v4u a1; a1.x = xl[k2][2].x; a1.y = xl[k2][2].y; a1.z = xl[k2][3].x; a1.w = xl[k2][3].y;
                    acc = __builtin_amdgcn_mfma_f32_32x32x16_bf16(__builtin_bit_cast(bf16x8, a0), __builtin_bit_cast(bf16x8, mm[k2][0]), acc, 0, 0, 0);
                    acc = __builtin_amdgcn_mfma_f32_32x32x16_bf16(__builtin_bit_cast(bf16x8, a1), __builtin_bit_cast(bf16x8, mm[k2][1]), acc, 0, 0, 0); } } }
        __syncthreads();
        { LAS unsigned short* ys = (LAS unsigned short*)(lds + SS_CM + (32 * qt + r32) * SS_YP) + 32 * pt;
#pragma unroll
          for (int g4 = 0; g4 < 4; ++g4) { v2u o; o.x = pk2(acc[4 * g4], acc[4 * g4 + 1]); o.y = pk2(acc[4 * g4 + 2], acc[4 * g4 + 3]); *(LAS v2u*)(ys + 8 * g4 + 4 * hi) = o; } }
        { const int q = tid >> 2, p0 = 16 * (tid & 3); LAS unsigned char* xr = lds + SS_XN + q * SS_XP + 2 * p0; v4u w0 = *(LAS v4u*)xr, w1 = *(LAS v4u*)(xr + 16);
          const float e = __builtin_amdgcn_exp2f(clast - CUM[q]);
          w0.x = pk2(bflo(w0.x) * e, bfhi(w0.x) * e); w0.y = pk2(bflo(w0.y) * e, bfhi(w0.y) * e); w0.z = pk2(bflo(w0.z) * e, bfhi(w0.z) * e); w0.w = pk2(bflo(w0.w) * e, bfhi(w0.w) * e);
          w1.x = pk2(bflo(w1.x) * e, bfhi(w1.x) * e); w1.y = pk2(bflo(w1.y) * e, bfhi(w1.y) * e); w1.z = pk2(bflo(w1.z) * e, bfhi(w1.z) * e); w1.w = pk2(bflo(w1.w) * e, bfhi(w1.w) * e);
          *(LAS v4u*)xr = w0; *(LAS v4u*)(xr + 16) = w1; }
        __syncthreads();
#pragma unroll
        for (int i = 0; i < 2; ++i) { const int idx = tid + 512 * i, q = idx >> 3, c8 = idx & 7; const int pos = 128 * c + q; const size_t t = tb0 + (z ? (SEQ - 1 - pos) : pos);
            *(GAS v4u*)(YA + ((size_t)z * T + t) * 512 + h * 64 + 8 * c8) = *(const LAS v4u*)(lds + SS_CM + q * SS_YP + 16 * c8); }
        { const float dl = __builtin_amdgcn_exp2f(clast);
#pragma unroll
          for (int r = 0; r < 16; ++r) accS[r] *= dl;
          { const int rq = 8 * hi + ((lane & 15) >> 2), cg = 16 * ((lane >> 4) & 1) + 4 * (lane & 3);
            const unsigned xa = (unsigned)(uintptr_t)(lds + SS_XN) + (unsigned)(rq * SS_XP + (32 * pt + cg) * 2), ba = (unsigned)(uintptr_t)(lds + SS_BM) + (unsigned)(rq * SS_RP + (32 * qt + cg) * 2);
            v2u al[8], ah[8], bl[8], bh[8];
#pragma unroll
            for (int s = 0; s < 8; ++s) { al[s] = ss_tr(xa + 16 * s * SS_XP); ah[s] = ss_tr(xa + (16 * s + 4) * SS_XP); bl[s] = ss_tr(ba + 16 * s * SS_RP); bh[s] = ss_tr(ba + (16 * s + 4) * SS_RP); }
#pragma unroll
            for (int s = 0; s < 8; ++s) ss_wait4(al[s], ah[s], bl[s], bh[s]);
#pragma unroll
            for (int s = 0; s < 8; ++s) { v4u av; av.x = al[s].x; av.y = al[s].y; av.z = ah[s].x; av.w = ah[s].y; v4u bv; bv.x = bl[s].x; bv.y = bl[s].y; bv.z = bh[s].x; bv.w = bh[s].y;
                accS = __builtin_amdgcn_mfma_f32_32x32x16_bf16(__builtin_bit_cast(bf16x8, av), __builtin_bit_cast(bf16x8, bv), accS, 0, 0, 0); } }
          LAS unsigned char* sb = lds + SS_SB + (32 * qt + r32) * SS_XP + (32 * pt + 4 * hi) * 2;
#pragma unroll
          for (int g4 = 0; g4 < 4; ++g4) { v2u o; o.x = pk2(accS[4 * g4], accS[4 * g4 + 1]); o.y = pk2(accS[4 * g4 + 2], accS[4 * g4 + 3]); *(LAS v2u*)(sb + 16 * g4) = o; } }
    }
#undef SS_LOAD
    __syncthreads();
}
__device__ __forceinline__ void ph_ssd(LAS unsigned char* lds, const bf16* XC, const float* DT, const float* a_log, bf16* YA, int T, int nb, int tid, int bid, int nblk, int blk0) {
#pragma unroll 1
    for (int it = (bid - blk0 + nblk) % nblk; it < nb * 16; it += nblk) { const int z = it & 1, h = (it >> 1) & 7, b = it >> 4; ssd_item(lds, XC, DT, a_log, YA, T, z, b, h, tid); }
}
}
namespace mk {
#define XB_TMO      128
#define XB_XCNT(j)  (256  + 64 * (j))
#define XB_XSUB(j)  (1280 + 64 * (j))
#define XB_XGEN(j)  (2304 + 64 * (j))
#define XB_TOP      3328
#define XB_TOPGEN   3392
#define XCD_BAR_WORDS 3456
#define XB_SPIN_CAP (1u << 18)

__device__ __forceinline__ unsigned xb_ld(unsigned* p)              { return __hip_atomic_load(p, __ATOMIC_RELAXED, __HIP_MEMORY_SCOPE_AGENT); }
__device__ __forceinline__ unsigned xb_add(unsigned* p, unsigned v) { return __hip_atomic_fetch_add(p, v, __ATOMIC_RELAXED, __HIP_MEMORY_SCOPE_AGENT); }
__device__ __forceinline__ unsigned xb_xcc_id() { return (unsigned)__builtin_amdgcn_s_getreg((3 << 11) | 20) & 0xFu; }
#define XB_SPIN(cond, bar) do { unsigned _sp = 0; while (cond) { __builtin_amdgcn_s_sleep(1); \
    if ((++_sp & 255u) == 0u) { if (xb_ld(&(bar)[XB_TMO])) break; if (_sp > XB_SPIN_CAP) { atomicAdd(&(bar)[XB_TMO], 1u); break; } } } } while (0)

struct XcdBarrier {
    unsigned* bar; unsigned x;
    volatile LAS unsigned* st;
};

__device__ __forceinline__ XcdBarrier xcd_barrier_post(unsigned* bar, volatile LAS unsigned* st) {
    XcdBarrier b; b.bar = bar; b.x = xb_xcc_id(); b.st = st;
    if (threadIdx.x == 0) (void)xb_add(&bar[XB_XCNT(b.x)], 1u);
    return b;
}
__device__ __forceinline__ void xcd_barrier_complete(unsigned* bar, unsigned x, unsigned& nloc, unsigned& nx) {
    const unsigned G = gridDim.x * gridDim.y * gridDim.z;
    unsigned sum, cnt, mine, sp = 0u;
    for (;;) {
        sum = 0u; cnt = 0u; mine = 0u;
#pragma unroll
        for (unsigned j = 0; j < 16; ++j) { const unsigned c = xb_ld(&bar[XB_XCNT(j)]); sum += c; cnt += (c > 0u) ? 1u : 0u; mine = (j == x) ? c : mine; }
        if (sum == G) break;
        __builtin_amdgcn_s_sleep(1);
        if ((++sp & 255u) == 0u) { if (xb_ld(&bar[XB_TMO])) break; if (sp > XB_SPIN_CAP) { atomicAdd(&bar[XB_TMO], 1u); break; } }
    }
    nloc = mine > 0u ? mine : 1u; nx = cnt > 0u ? cnt : 1u;
}

__device__ __forceinline__ void xcd_barrier(const XcdBarrier& b) {
    asm volatile("s_waitcnt vmcnt(0)" ::: "memory");
    __syncthreads();
    if (threadIdx.x == 0) {
        unsigned* bar = b.bar;
        __builtin_amdgcn_s_waitcnt(0);
        unsigned nloc = b.st[0], nx = b.st[1];
        if (nloc == 0u) { xcd_barrier_complete(bar, b.x, nloc, nx); b.st[0] = nloc; b.st[1] = nx; }
        const unsigned old = xb_add(&bar[XB_XSUB(b.x)], 1u);
        const unsigned gen = old / nloc;
        if (old + 1u == (gen + 1u) * nloc) {
            __builtin_amdgcn_fence(__ATOMIC_RELEASE, "agent");
            asm volatile("s_waitcnt vmcnt(0)" ::: "memory");
            const unsigned og = xb_add(&bar[XB_TOP], 1u);
            const unsigned tg = og / nx;
            if (og + 1u == (tg + 1u) * nx) xb_add(&bar[XB_TOPGEN], 1u);
            else XB_SPIN(xb_ld(&bar[XB_TOPGEN]) == tg, bar);
            __builtin_amdgcn_fence(__ATOMIC_ACQUIRE, "agent");
            xb_add(&bar[XB_XGEN(b.x)], 1u);
            asm volatile("s_waitcnt vmcnt(0)" ::: "memory");
        } else {
            XB_SPIN(xb_ld(&bar[XB_XGEN(b.x)]) == gen, bar);
            __builtin_amdgcn_fence(__ATOMIC_ACQUIRE, "agent");
            asm volatile("s_waitcnt vmcnt(0)" ::: "memory");
        }
    }
    __syncthreads();
}


}
#include <hip/hip_cooperative_groups.h>
namespace mk {
namespace cg = cooperative_groups;
constexpr int LDS_BYTES = 163840;
constexpr int NB_HALF = 8, TH = NB_HALF * SEQ;
constexpr size_t al256(size_t x) { return (x + 255) / 256 * 256; }
constexpr size_t WS_CTL = 0, CTL_BYTES = 65536, WS_W = CTL_BYTES, WS_ROPE = al256(WS_W + 2 * W_LAYER_ELEMS * 2), WS_H = al256(WS_ROPE + 2ull * SEQ * 32 * 4), WS_P = al256(WS_H + (size_t)TH * 1024 * 2), WS_X = al256(WS_P + (size_t)TH * LDP * 2);
constexpr size_t X_XC = 0, X_DT = al256(X_XC + (size_t)TH * 1024 * 2), X_QN = al256(X_DT + (size_t)TH * 16 * 4), X_KN = al256(X_QN + (size_t)TH * 512 * 2), X_YA = al256(X_KN + (size_t)TH * 128 * 2),
                 X_YB = al256(X_YA + 2ull * TH * 512 * 2), X_CB = al256(X_YB + 2ull * TH * 512 * 2), X_VB = al256(X_CB + 2ull * TH * 8 * 4), X_RS = al256(X_VB + (size_t)TH * 512 * 2), X_END1 = al256(X_RS + 9ull * SEQ * 512 * 4);
constexpr size_t X_MF = 0, X_MB = al256(X_MF + (size_t)TH * 1024 * 4), X_OF = al256(X_MB + (size_t)TH * 1024 * 2), X_END2 = al256(X_OF + (size_t)TH * 1024 * 4);
constexpr size_t WS_NEED = WS_X + (X_END1 > X_END2 ? X_END1 : X_END2);
static_assert(WS_NEED <= 536870912ull, "workspace map exceeds 512 MiB");
struct MegaArgs { const float* in[25]; float* out; unsigned char* ws; };
__global__ __launch_bounds__(512, 2) void k_mega(MegaArgs a) {
    extern __shared__ __attribute__((aligned(16))) unsigned char lds_[];
    LAS unsigned char* const lds = (LAS unsigned char*)(unsigned)0;
    cg::grid_group grid = cg::this_grid();
    volatile LAS unsigned* xbst = (volatile LAS unsigned*)(lds + LDS_BYTES - 16);
    if (threadIdx.x < 4) xbst[threadIdx.x] = 0u;
    __syncthreads();
    XcdBarrier xbar = xcd_barrier_post((unsigned*)(a.ws + WS_CTL), xbst);
#define GSYNC() xcd_barrier(xbar)
    const int wave0 = __builtin_amdgcn_readfirstlane((int)threadIdx.x >> 6);
#define PV int bid = blockIdx.x, wv_ = wave0; unsigned mk_ = ~0u; unsigned char* ws = a.ws; asm volatile("" : "+s"(bid), "+s"(wv_), "+s"(mk_), "+s"(ws)); int tid = wv_ * 64 + (int)__builtin_amdgcn_mbcnt_hi(mk_, __builtin_amdgcn_mbcnt_lo(mk_, 0u)); asm volatile("" : "+v"(tid)); const int lane = tid & 63, wave = wv_; const int gw = bid * 8 + wave, ngw = gridDim.x * 8, gtid = bid * 512 + tid, nthr = gridDim.x * 512; (void)lane; (void)wave; (void)gw; (void)ngw; (void)gtid; (void)nthr; bf16* Wall = (bf16*)(ws + WS_W); float* rope = (float*)(ws + WS_ROPE); bf16* H = (bf16*)(ws + WS_H); bf16* P = (bf16*)(ws + WS_P); unsigned char* X = ws + WS_X; bf16* XC = (bf16*)(X + X_XC); float* DT = (float*)(X + X_DT); bf16* Qn = (bf16*)(X + X_QN); bf16* Kn = (bf16*)(X + X_KN); bf16* YA = (bf16*)(X + X_YA); bf16* YB = (bf16*)(X + X_YB); float* CB = (float*)(X + X_CB); bf16* VB = (bf16*)(X + X_VB); float* Mf = (float*)(X + X_MF); bf16* Mb = (bf16*)(X + X_MB); float* OF = (float*)(X + X_OF); const bf16* W = Wall + (size_t)l * W_LAYER_ELEMS; (void)rope; (void)H; (void)P; (void)XC; (void)DT; (void)Qn; (void)Kn; (void)YA; (void)YB; (void)CB; (void)VB; (void)Mf; (void)Mb; (void)OF; (void)W;
    { const int l = 0; PV; ph_wconv(a.in[2], a.in[22], a.in[23], Wall, lds, gw, ngw, wave, lane); }
    { const int l = 0; PV; ph_rope_table(rope, gtid, nthr); }
    { const int l = 0; PV; ph_rmsnorm(a.in[0], a.in[1], H, TH, gw, ngw, lane); }
    grid.sync();
#pragma unroll 1
    for (int hf = 0; hf < 2; ++hf) {
#pragma unroll 1
        for (int l = 0; l < 2; ++l) {
            const size_t ro = (size_t)hf * TH * 1024; const float* xin = (l == 0 ? a.in[0] : a.out) + ro; float* xout = a.out + ro;
            { PV; ph_gemm_bf16out_range(lds, H, 1024, W + WOFF_W1, TH, (int)W1T_N, 1024, P, LDP, 0, 7, tid, bid); }
            GSYNC();
            { const int G_ = (int)gridDim.x, nwg_ = (TH / 256) * ((int)W1T_N / 256); int nb8 = nwg_ - 7 * G_; nb8 = nb8 < 0 ? 0 : (nb8 > G_ ? G_ : nb8);
              const bool ov = (7 * G_ >= 960) && (nb8 < G_);
              if (!ov || (int)blockIdx.x < nb8) { PV; ph_gemm_bf16out_range(lds, H, 1024, W + WOFF_W1, TH, (int)W1T_N, 1024, P, LDP, 7, 1 << 20, tid, bid); }
              if (!ov) GSYNC();
              if (!ov || (int)blockIdx.x >= nb8) { PV; const int off = ov ? nb8 * 512 : 0; ph_prep_conv(P, TH, a.in[3] + l * 5 * 1024, a.in[4] + l * 1024, a.in[5] + l * 16, XC, DT, gtid - off, nthr - off); } }
            { PV; ph_prep_gqa(P, TH, a.in[19] + l * 64, a.in[20] + l * 64, rope, Qn, Kn, gtid, nthr); }
            GSYNC();
            { PV; ph_rwkv(lds, P, TH, NB_HALF, a.in[9] + l * 2 * 1792, a.in[10] + l * 1024, a.in[11] + (size_t)l * 2 * 64 * 512, a.in[12] + l * 1024, a.in[13] + (size_t)l * 2 * 64 * 512, a.in[14] + l * 512, a.in[15] + l * 512, a.in[16] + l * 512, YB, CB, VB, tid, bid, (int)gridDim.x); }
            { PV; ph_ssd(lds, XC, DT, a.in[6] + l * 16, YA, TH, NB_HALF, tid, bid, (int)gridDim.x, 128); }
            { PV; ph_attn((char*)lds_, P, Qn, Kn, a.in[21] + l * 8 * 465, NB_HALF, tid, (unsigned*)(ws + WS_CTL) + 8192 + 64 * (2 * l + hf), (volatile LAS unsigned*)(lds + LDS_BYTES - 8)); }
            GSYNC();
            { PV; ph_post(P, TH, XC, YA, a.in[7] + l * 8, a.in[8] + l * 512, YB, CB, VB, a.in[17] + l * 512, a.in[18] + l * 512, gw, ngw, lane); }
            { PV; ph_gemm_rsigout(lds, H, 1024, W + WOFF_W2, TH, (int)W2T_N, 1024, P, LDP, tid, bid); }
            GSYNC();
            { PV; EpiMergeF E{Mb, P, LDP}; run_gemm(lds, P + PC_Y, LDP, W + WOFF_WB, TH, 1024, 2048, E, tid, bid); }
            GSYNC();
            { PV; EpiF32 E{OF, 1024}; run_gemm(lds, Mb, 1024, W + WOFF_WO, TH, 1024, 1024, E, tid, bid); }
            GSYNC();
            { PV; ph_fin(xin, OF, a.in[24] + l * 1024, xout, l == 0 ? a.in[1] + 1024 : nullptr, H, TH, gw, ngw, lane); }
            if (l == 1 && hf == 0) { PV; ph_rmsnorm(a.in[0] + (size_t)TH * 1024, a.in[1], H, TH, gw, ngw, lane); }
            GSYNC();
        }
    }
}
}
extern "C" void kernel_launch(void* const* d_in, const int* in_sizes, int n_in, void* d_out, int out_size, void* d_ws, size_t ws_size, hipStream_t stream) {
    static int grid_blocks = 0;
    if (!grid_blocks) {
        if (ws_size < mk::WS_NEED) { fprintf(stderr, "ws too small: need %zu have %zu\n", (size_t)mk::WS_NEED, ws_size); grid_blocks = -1; return; }
        int dev = 0, cus = 0, per_cu = 0; (void)hipGetDevice(&dev); (void)hipDeviceGetAttribute(&cus, hipDeviceAttributeMultiprocessorCount, dev);
        (void)hipFuncSetAttribute((const void*)mk::k_mega, hipFuncAttributeMaxDynamicSharedMemorySize, mk::LDS_BYTES);
        (void)hipOccupancyMaxActiveBlocksPerMultiprocessor(&per_cu, (const void*)mk::k_mega, 512, mk::LDS_BYTES);
        if (per_cu < 1) { fprintf(stderr, "occupancy query says %d blocks/CU\n", per_cu); per_cu = 1; }
        grid_blocks = cus;
        fprintf(stderr, "k_mega: cus %d per_cu %d grid %d ws_need %zu ws %zu\n", cus, per_cu, grid_blocks, (size_t)mk::WS_NEED, ws_size);
    }
    if (grid_blocks < 0) return;
    mk::MegaArgs a{}; for (int i = 0; i < 25; ++i) a.in[i] = (const float*)d_in[i]; a.out = (float*)d_out; a.ws = (unsigned char*)d_ws;
    (void)hipMemsetAsync((char*)d_ws + mk::WS_CTL, 0, mk::CTL_BYTES, stream);
    void* args[] = {(void*)&a};
    hipError_t e = hipLaunchCooperativeKernel((const void*)mk::k_mega, dim3(grid_blocks), dim3(512), args, mk::LDS_BYTES, stream);
    if (e != hipSuccess) fprintf(stderr, "cooperative launch failed: %s (grid %d)\n", hipGetErrorString(e), grid_blocks);
}
```

```cpp
#include <hip/hip_runtime.h>
#include <cstdio>
#include <cstdint>
#include <cmath>
namespace pg8 {
#define PG8_LAS __attribute__((address_space(3)))
typedef unsigned short bf16_t;
typedef short bf16x8 __attribute__((ext_vector_type(8)));
typedef float f32x4 __attribute__((ext_vector_type(4)));
typedef unsigned u32x4 __attribute__((ext_vector_type(4)));
constexpr int BM = 256, BK = 64, HALF = 128, HTB = HALF * BK * 2  , STAGE_BYTES = 8 * HTB, NXCD = 8, WGM = 8;

__host__ __device__ __forceinline__ int lds_byte(int r, int c) { const int st = (r >> 4) * 2 + (c >> 5), rr = r & 15, cc = c & 31, ob = rr * 64 + cc * 2; return st * 1024 + (ob ^ (((ob >> 9) & 1) << 5)); }
__host__ __device__ __forceinline__ void stage_rc(int b, int& R, int& C) { const int st = b / 1024, sb = b % 1024, swz = sb ^ (((sb >> 9) & 1) << 5); R = (st >> 1) * 16 + swz / 64; C = (st & 1) * 32 + (swz % 64) / 2; }
__host__ __device__ __forceinline__ int perm32(int rho) { const int n = rho >> 4, i = rho & 15; return 8 * (i >> 2) + 4 * n + (i & 3); }

struct Unit { int pm, pn; };
struct Gemm { const bf16_t* A; const bf16_t* Bt; int M, N, K, lda; };

struct StaticOrder {
    int nM, nN, nwg, G, c;
    __host__ __device__ void init(int M, int N, int G_, int c_) { nM = M / BM; nN = N / BM; nwg = nM * nN; G = G_; c = c_; }
    __host__ __device__ bool next(int i, Unit& u) const {
        const long L = (long)i * G + c; if (L >= nwg) return false;
        int wgid = (int)L; { const int q = nwg / NXCD, r = nwg % NXCD, xcd = wgid % NXCD, off = wgid / NXCD; wgid = (xcd < r ? xcd * (q + 1) : r * (q + 1) + (xcd - r) * q) + off; }
        const int nig = WGM * nN, gid = wgid / nig, fm = gid * WGM, gsz = (nM - fm) < WGM ? (nM - fm) : WGM;
        u.pm = fm + ((wgid % nig) % gsz); u.pn = (wgid % nig) / gsz; return true;
    }
    __device__ __forceinline__ void a_ready(const Unit&) const {}
    __device__ __forceinline__ void done(const Unit&) const {}
};

__device__ __forceinline__ unsigned cvt_pk_bf16(float lo, float hi) { unsigned r; asm volatile("v_cvt_pk_bf16_f32 %0, %1, %2" : "=v"(r) : "v"(lo), "v"(hi)); return r; }
typedef float f32x2 __attribute__((ext_vector_type(2)));
__device__ __forceinline__ f32x2 gelu_pk(f32x2 v) {
    const f32x2 av = __builtin_elementwise_abs(v), d = av * 0.2316418882f + 1.0f;
    f32x2 t; t.x = __builtin_amdgcn_rcpf(d.x); t.y = __builtin_amdgcn_rcpf(d.y);
    f32x2 q = t * 0.5307027145f + (-0.7265760135f); q = q * t + 0.7107068705f; q = q * t + (-0.142248368f); q = q * t + 0.127414796f; q = q * t;
    const f32x2 s = (v * v) * (-0.72134752044f);
    f32x2 e; e.x = __builtin_amdgcn_exp2f(s.x); e.y = __builtin_amdgcn_exp2f(s.y);
    const f32x2 m = v * (q * e), r = v - m;
    f32x2 o; o.x = v.x < 0.f ? m.x : r.x; o.y = v.y < 0.f ? m.y : r.y; return o;
}

template <int ACT  > struct EpiBf16 {
    static constexpr bool PERM = true, AFTER_DRAIN = false, FOLD = false; static_assert(ACT >= 0 && ACT <= 2, "EpiBf16: ACT is 0 (none), 1 (gelu_pk) or 2 (1 + exp(-x), the reciprocal sigmoid)");
    bf16_t* O; int ldc; const float* bias; int split_cols; size_t split_stride; float scale0;
    __device__ __forceinline__ void operator()(const f32x4 (&acc)[2][2][4][2], const Unit& u, int wr, int wc, int fr, int fq) const {
        const int row0 = u.pm * BM + wr * 64 + fr; int colt = u.pn * BM; bf16_t* base = O;
        float sc = 1.f; if (split_cols) { const int t = colt / split_cols; base += (size_t)t * split_stride; colt -= t * split_cols; if (t == 0) sc = scale0; }
        const int col0 = colt + wc * 32 + 8 * fq, bcol0 = u.pn * BM + wc * 32 + 8 * fq;
        f32x4 bv[2][2];
#pragma unroll
        for (int bj = 0; bj < 2; ++bj)
#pragma unroll
            for (int n = 0; n < 2; ++n) bv[bj][n] = bias ? *(const f32x4*)(bias + bcol0 + bj * HALF + 4 * n) : (f32x4){0.f, 0.f, 0.f, 0.f};
#pragma unroll
        for (int ai = 0; ai < 2; ++ai)
#pragma unroll
            for (int m = 0; m < 4; ++m) { bf16_t* rowp = base + (size_t)(row0 + ai * HALF + m * 16) * ldc + col0;
#pragma unroll
                for (int bj = 0; bj < 2; ++bj) { f32x4 v0 = acc[ai][bj][m][0] + bv[bj][0], v1 = acc[ai][bj][m][1] + bv[bj][1];
                    if (ACT == 1) { f32x2 a = gelu_pk((f32x2){v0[0], v0[1]}), b = gelu_pk((f32x2){v0[2], v0[3]}), c = gelu_pk((f32x2){v1[0], v1[1]}), d = gelu_pk((f32x2){v1[2], v1[3]});
                        v0 = (f32x4){a.x, a.y, b.x, b.y}; v1 = (f32x4){c.x, c.y, d.x, d.y}; }
                    if (ACT == 2) { _Pragma("unroll") for (int e = 0; e < 4; ++e) { v0[e] = 1.f + __builtin_amdgcn_exp2f(__builtin_fminf(__builtin_fmaxf(v0[e], -60.f), 60.f) * -1.4426950408889634f); v1[e] = 1.f + __builtin_amdgcn_exp2f(__builtin_fminf(__builtin_fmaxf(v1[e], -60.f), 60.f) * -1.4426950408889634f); } }
                    v0 = v0 * sc; v1 = v1 * sc; u32x4 w; w.x = cvt_pk_bf16(v0[0], v0[1]); w.y = cvt_pk_bf16(v0[2], v0[3]); w.z = cvt_pk_bf16(v1[0], v1[1]); w.w = cvt_pk_bf16(v1[2], v1[3]);
                    *(u32x4*)(rowp + bj * HALF) = w; } }
    }
};
template <class Epi, class Sched, bool ALIGN_EPI = false, bool SP2 = false>
__device__ __forceinline__ void gemm_phase(PG8_LAS unsigned char* lds, const Gemm g, const Sched& S, const Epi& E, const int tid) {
    const int wid = __builtin_amdgcn_readfirstlane(tid >> 6), lane = tid & 63, wr = wid >> 2, wc = wid & 3, fr = lane & 15, fq = lane >> 4;
    const int K = g.K, nt = K / BK;
    unsigned voffA[2], voffB[2];
#pragma unroll
    for (int i = 0; i < 2; ++i) { int R, C; stage_rc(tid * 16 + i * 8192, R, C); const int Rb = Epi::PERM ? ((R & ~31) + perm32(R & 31)) : R;
        voffA[i] = (unsigned)(R * g.lda + C) * 2u; voffB[i] = (unsigned)(Rb * K + C) * 2u; }
    const size_t kstep = (size_t)(BK * 2);
    const size_t hstep = (size_t)HALF * K * 2;
    const size_t tstep = 2 * hstep;
    const size_t hstepA = (size_t)HALF * g.lda * 2, tstepA = 2 * hstepA;
    const unsigned ldsw = (unsigned)wid * 1024u;
    const int aoff = lds_byte(wr * 64 + fr, fq * 8), boff = lds_byte(wc * 32 + fr, fq * 8);
#define PG8_SA(b, h) (((b) * 2 + (h)) * HTB)
#define PG8_SB(b, h) ((4 + (b) * 2 + (h)) * HTB)
#define PG8_STAGE(bufoff, gbase, voff) do { _Pragma("unroll") for (int _i = 0; _i < 2; ++_i) \
        __builtin_amdgcn_global_load_lds((const unsigned*)((const char*)(gbase) + (voff)[_i]), (PG8_LAS unsigned*)(lds + (bufoff) + ldsw + _i * 8192), 16, 0, 0); } while (0)
#define PG8_LDA(dst, b, h) do { _Pragma("unroll") for (int m = 0; m < 4; ++m) _Pragma("unroll") for (int k = 0; k < 2; ++k) dst[m][k] = *(const PG8_LAS bf16x8*)(lds + PG8_SA(b, h) + aoff + m * 2048 + k * 1024); } while (0)
#define PG8_LDB(dst, b, h) do { _Pragma("unroll") for (int n = 0; n < 2; ++n) _Pragma("unroll") for (int k = 0; k < 2; ++k) dst[n][k] = *(const PG8_LAS bf16x8*)(lds + PG8_SB(b, h) + boff + n * 2048 + k * 1024); } while (0)
#define PG8_MMA(ai, bj, At, Bt) do { __builtin_amdgcn_s_setprio(1); _Pragma("unroll") for (int m = 0; m < 4; ++m) _Pragma("unroll") for (int n = 0; n < 2; ++n) _Pragma("unroll") for (int k = 0; k < 2; ++k) \
        acc[ai][bj][m][n] = __builtin_amdgcn_mfma_f32_16x16x32_bf16(Bt[n][k], At[m][k], acc[ai][bj][m][n], 0, 0, 0); __builtin_amdgcn_s_setprio(0); } while (0)
#define PG8_WAIT_V(n) asm volatile("s_waitcnt vmcnt(" #n ")" ::: "memory")
#define PG8_WAIT_L(n) asm volatile("s_waitcnt lgkmcnt(" #n ")" ::: "memory")
#define PG8_BAR __builtin_amdgcn_s_barrier()
#define PG8_SCHED __builtin_amdgcn_sched_barrier(0)
    Unit cur, nxt; int ui = 0;
    if (!S.next(0, cur)) return;
    f32x4 acc[2][2][4][2];
#pragma unroll
    for (int a = 0; a < 2; ++a)
#pragma unroll
        for (int b = 0; b < 2; ++b)
#pragma unroll
            for (int m = 0; m < 4; ++m)
#pragma unroll
                for (int n = 0; n < 2; ++n) acc[a][b][m][n] = (f32x4){0.f, 0.f, 0.f, 0.f};
    bf16x8 At[4][2], B0[2][2], B1[2][2];
    const char* cA = (const char*)g.A + (size_t)cur.pm * tstepA; const char* cB = (const char*)g.Bt + (size_t)cur.pn * tstep;
    S.a_ready(cur);
    if constexpr (SP2) {
        PG8_STAGE(PG8_SB(0, 0), cB, voffB); PG8_STAGE(PG8_SB(0, 1), cB + hstep, voffB); PG8_STAGE(PG8_SA(0, 0), cA, voffA); PG8_STAGE(PG8_SA(0, 1), cA + hstepA, voffA);
        if (wr == 1) PG8_BAR;
        PG8_WAIT_V(2); PG8_BAR;
        PG8_STAGE(PG8_SB(1, 0), cB + kstep, voffB); PG8_STAGE(PG8_SA(1, 0), cA + kstep, voffA); PG8_STAGE(PG8_SB(1, 1), cB + hstep + kstep, voffB);
        PG8_WAIT_V(6); PG8_BAR;
    } else {
        PG8_STAGE(PG8_SB(0, 0), cB, voffB); PG8_STAGE(PG8_SA(0, 0), cA, voffA); PG8_STAGE(PG8_SB(0, 1), cB + hstep, voffB); PG8_STAGE(PG8_SA(0, 1), cA + hstepA, voffA);
        if (wr == 1) PG8_BAR;
        PG8_WAIT_V(4); PG8_BAR;
        PG8_STAGE(PG8_SB(1, 0), cB + kstep, voffB); PG8_STAGE(PG8_SA(1, 0), cA + kstep, voffA); PG8_STAGE(PG8_SB(1, 1), cB + hstep + kstep, voffB);
        PG8_WAIT_V(6); PG8_BAR;
    }
    for (;;) {
        const bool has_next = S.next(ui + 1, nxt);
        const char* nA = has_next ? (const char*)g.A + (size_t)nxt.pm * tstepA : cA; const char* nB = has_next ? (const char*)g.Bt + (size_t)nxt.pn * tstep : cB;
        for (int t = 0; t < nt; t += 2) {
            const bool last = (t == nt - 2);
            const char* a1 = cA + (size_t)(t + 1) * kstep;
            const char* a2 = last ? nA : cA + (size_t)(t + 2) * kstep; const char* b2 = last ? nB : cB + (size_t)(t + 2) * kstep;
            const char* a3 = a2 + kstep; const char* b3 = b2 + kstep;
            if (last && has_next) S.a_ready(nxt);
            if constexpr (SP2) {
            PG8_LDB(B0, 0, 0); PG8_LDB(B1, 0, 1); PG8_SCHED; PG8_LDA(At, 0, 0); PG8_STAGE(PG8_SA(1, 1), a1 + hstepA, voffA);
            PG8_WAIT_V(8); PG8_WAIT_L(0); PG8_BAR; PG8_MMA(0, 0, At, B0); PG8_MMA(0, 1, At, B1); PG8_BAR; PG8_SCHED;
            PG8_LDA(At, 0, 1); PG8_STAGE(PG8_SB(0, 0), b2, voffB); PG8_STAGE(PG8_SB(0, 1), b2 + hstep, voffB); PG8_STAGE(PG8_SA(0, 0), a2, voffA);
            PG8_WAIT_V(8); PG8_WAIT_L(0); PG8_BAR; PG8_MMA(1, 0, At, B0); PG8_MMA(1, 1, At, B1); PG8_BAR; PG8_SCHED;
            PG8_LDB(B0, 1, 0); PG8_LDB(B1, 1, 1); PG8_SCHED; PG8_LDA(At, 1, 0); PG8_STAGE(PG8_SA(0, 1), a2 + hstepA, voffA);
            PG8_WAIT_V(8); PG8_WAIT_L(0); PG8_BAR; PG8_MMA(0, 0, At, B0); PG8_MMA(0, 1, At, B1); PG8_BAR; PG8_SCHED;
            PG8_LDA(At, 1, 1); PG8_STAGE(PG8_SB(1, 0), b3, voffB); PG8_STAGE(PG8_SB(1, 1), b3 + hstep, voffB); PG8_STAGE(PG8_SA(1, 0), a3, voffA);
            PG8_WAIT_V(8); PG8_WAIT_L(0); PG8_BAR; PG8_MMA(1, 0, At, B0); PG8_MMA(1, 1, At, B1); PG8_BAR; PG8_SCHED;
            } else {
            PG8_LDB(B0, 0, 0); PG8_SCHED; PG8_LDA(At, 0, 0); PG8_STAGE(PG8_SA(1, 1), a1 + hstepA, voffA);
            PG8_WAIT_L(8); PG8_BAR; PG8_WAIT_L(0); PG8_MMA(0, 0, At, B0); PG8_BAR; PG8_SCHED;
            PG8_LDB(B1, 0, 1); PG8_STAGE(PG8_SB(0, 0), b2, voffB);
            PG8_BAR; PG8_WAIT_L(0); PG8_MMA(0, 1, At, B1); PG8_BAR;
            PG8_LDA(At, 0, 1); PG8_STAGE(PG8_SA(0, 0), a2, voffA);
            PG8_BAR; PG8_WAIT_L(0); PG8_MMA(1, 0, At, B0); PG8_BAR; PG8_SCHED;
            PG8_STAGE(PG8_SB(0, 1), b2 + hstep, voffB);
            PG8_WAIT_V(6); PG8_BAR; PG8_MMA(1, 1, At, B1); PG8_BAR;
            PG8_LDB(B0, 1, 0); PG8_SCHED; PG8_LDA(At, 1, 0); PG8_STAGE(PG8_SA(0, 1), a2 + hstepA, voffA);
            PG8_WAIT_L(8); PG8_BAR; PG8_WAIT_L(0); PG8_MMA(0, 0, At, B0); PG8_BAR; PG8_SCHED;
            PG8_LDB(B1, 1, 1); PG8_STAGE(PG8_SB(1, 0), b3, voffB);
            PG8_BAR; PG8_WAIT_L(0); PG8_MMA(0, 1, At, B1); PG8_BAR;
            PG8_LDA(At, 1, 1); PG8_STAGE(PG8_SA(1, 0), a3, voffA);
            PG8_BAR; PG8_WAIT_L(0); PG8_MMA(1, 0, At, B0); PG8_BAR; PG8_SCHED;
            PG8_STAGE(PG8_SB(1, 1), b3 + hstep, voffB);
            PG8_WAIT_V(6); PG8_BAR; PG8_MMA(1, 1, At, B1); PG8_BAR;
            }
            if constexpr (Epi::FOLD) { if ((((t + 2) & 7) == 0) && !last) E.fold(acc, ((t + 2) >> 3) - 1, cur, wr, wc, fr, fq); }
        }
        if constexpr (ALIGN_EPI) { if (wr == 0) PG8_BAR; }
        if constexpr (!Epi::AFTER_DRAIN) { E(acc, cur, wr, wc, fr, fq); S.done(cur); }
        if (!has_next) break;
#pragma unroll
        for (int a = 0; a < 2; ++a)
#pragma unroll
            for (int b = 0; b < 2; ++b)
#pragma unroll
                for (int m = 0; m < 4; ++m)
#pragma unroll
                    for (int n = 0; n < 2; ++n) acc[a][b][m][n] = (f32x4){0.f, 0.f, 0.f, 0.f};
        cur = nxt; cA = nA; cB = nB; ++ui;
        if constexpr (ALIGN_EPI) { if (wr == 1) PG8_BAR; }
    }
    PG8_WAIT_V(0);
    if constexpr (!ALIGN_EPI) { if (wr == 0) PG8_BAR; }
    PG8_BAR;
    if constexpr (Epi::AFTER_DRAIN) { E.fused(acc, cur, wr, wc, fr, fq, lds, wid, lane); S.done(cur); }
#undef PG8_SA
#undef PG8_SB
#undef PG8_STAGE
#undef PG8_LDA
#undef PG8_LDB
#undef PG8_MMA
#undef PG8_WAIT_V
#undef PG8_WAIT_L
#undef PG8_BAR
#undef PG8_SCHED
}
}
namespace mk {
#define LAS __attribute__((address_space(3)))
#define GAS __attribute__((address_space(1)))
typedef unsigned short bf16;
typedef unsigned v4u __attribute__((ext_vector_type(4)));
typedef unsigned v2u __attribute__((ext_vector_type(2)));
typedef float f32x4 __attribute__((ext_vector_type(4)));
typedef float f32x16 __attribute__((ext_vector_type(16)));
typedef float f32x2v __attribute__((ext_vector_type(2)));
typedef short bf16x8 __attribute__((ext_vector_type(8)));
typedef short s16x4 __attribute__((ext_vector_type(4)));
constexpr int SEQ = 2048, DM = 1024, NIN = 11280;
constexpr int LDP = 7424;
constexpr int PC_SLAB = 0, PC_XBC = 1792, PC_DT = 2816, PC_QKVC = 3072, PC_QKVD = 3840, PC_ZA = 5376, PC_GB = 5888, PC_GC = 6400, PC_GD = 6912;
constexpr int PC_Y = PC_ZA;
constexpr size_t W1T_N = 7424, W2T_N = 4096;
constexpr size_t WOFF_W1 = 0, WOFF_W2 = WOFF_W1 + W1T_N * 1024, WOFF_WB = WOFF_W2 + W2T_N * 1024, WOFF_WO = WOFF_WB + 4ull * 1024 * 512, W_LAYER_ELEMS = WOFF_WO + 1024ull * 1024;
#define LDS_WAIT() asm volatile("s_waitcnt lgkmcnt(0)" ::: "memory")
#define VM_WAIT() asm volatile("s_waitcnt vmcnt(0)" ::: "memory")
__device__ __forceinline__ unsigned pk2(float lo, float hi) { typedef float f2_ __attribute__((ext_vector_type(2))); typedef __bf16 b2_ __attribute__((ext_vector_type(2))); const f2_ v = {lo, hi}; const b2_ b = __builtin_convertvector(v, b2_); return __builtin_bit_cast(unsigned, b); }
__device__ __forceinline__ unsigned f2bf(float f) { return pk2(f, 0.f) & 0xffffu; }
__device__ __forceinline__ float bf2f(unsigned short b) { return __builtin_bit_cast(float, (unsigned)b << 16); }
__device__ __forceinline__ float bflo(unsigned w) { return __builtin_bit_cast(float, w << 16); }
__device__ __forceinline__ float bfhi(unsigned w) { return __builtin_bit_cast(float, w & 0xffff0000u); }
__device__ __forceinline__ float lane_xor(float v, int lane, int o) { return __builtin_bit_cast(float, __builtin_amdgcn_ds_bpermute((lane ^ o) << 2, __builtin_bit_cast(int, v))); }
#define MK_DPP(x, ctrl) __builtin_bit_cast(float, __builtin_amdgcn_update_dpp(0, __builtin_bit_cast(int, (x)), (ctrl), 0xf, 0xf, true))
__device__ __forceinline__ float sum_l4(float x) { x += MK_DPP(x, 0xB1); x += MK_DPP(x, 0x4E); return x; }
__device__ __forceinline__ float sum_l8(float x) { x = sum_l4(x); x += MK_DPP(x, 0x141); return x; }
__device__ __forceinline__ float sum_l16(float x) { x = sum_l8(x); x += MK_DPP(x, 0x140); return x; }
__device__ __forceinline__ float sum_l32(float x) { x = sum_l16(x); const auto rr = __builtin_amdgcn_permlane16_swap(__float_as_uint(x), __float_as_uint(x), false, false); return __uint_as_float(rr[0]) + __uint_as_float(rr[1]); }
__device__ __forceinline__ float sum_l64(float x) { x = sum_l32(x); const auto rr = __builtin_amdgcn_permlane32_swap(__float_as_uint(x), __float_as_uint(x), false, false); return __uint_as_float(rr[0]) + __uint_as_float(rr[1]); }
__device__ __forceinline__ float wave_sum(float v, int lane) { (void)lane; return sum_l64(v); }
__device__ __forceinline__ float fsilu(float x) { return x * __builtin_amdgcn_rcpf(1.f + __expf(-x)); }
__device__ __forceinline__ float fsigmoid(float x) { return __builtin_amdgcn_rcpf(1.f + __expf(-x)); }

__device__ __forceinline__ void transpose_item(const float* W, int ldw, int ldt, int c0, int nvalid, int ntotal, bf16* WT, int r0, LAS float* scr, int item, int lane) {
    const int nblk = ntotal / 32, kb = item / nblk, nb = item % nblk, k0 = 64 * kb, n0 = 32 * nb;
    const bool ok = (n0 + (lane & 31)) < nvalid;
    float wv[32];
#pragma unroll
    for (int i = 0; i < 32; ++i) { const int kk = 2 * i + (lane >> 5); wv[i] = W[(size_t)(k0 + kk) * ldw + c0 + (ok ? n0 + (lane & 31) : 0)]; }
#pragma unroll
    for (int i = 0; i < 32; ++i) { const int kk = 2 * i + (lane >> 5); scr[kk * 33 + (lane & 31)] = ok ? wv[i] : 0.f; }
    LDS_WAIT(); asm volatile("" ::: "memory");
    const int c = lane & 7;
#pragma unroll
    for (int j = 0; j < 4; ++j) { const int n = (lane >> 3) + 8 * j; const LAS float* s = scr + (8 * c) * 33 + n;
        v4u o; o.x = pk2(s[0 * 33], s[1 * 33]); o.y = pk2(s[2 * 33], s[3 * 33]); o.z = pk2(s[4 * 33], s[5 * 33]); o.w = pk2(s[6 * 33], s[7 * 33]);
        *(GAS v4u*)(WT + (size_t)(r0 + n0 + n) * ldt + k0 + 8 * c) = o; }
    LDS_WAIT(); asm volatile("" ::: "memory");
}
struct WSeg { int src, soff, ldw, c0, nvalid, ntotal; unsigned doff; int ldt, r0, ni; };
constexpr int WCONV_NSEG = 15, WCONV_ITEMS = 16 * (7424 / 32) + 16 * (4096 / 32) + 4 * 8 * (1024 / 32) + 16 * (1024 / 32);
__device__ __forceinline__ void ph_wconv(const float* w_in, const float* w_branch, const float* w_out, bf16* Wall, LAS unsigned char* lds, int gw, int ngw, int wave, int lane) {
    LAS float* scr = (LAS float*)(lds + wave * 16384);
    const WSeg segs[WCONV_NSEG] = {
        {0, 0, NIN, 1552, 1792, 1792, (unsigned)WOFF_W1, 1024, 0, 16 * 56}, {0, 0, NIN, 512, 1024, 1024, (unsigned)WOFF_W1, 1024, 1792, 16 * 32}, {0, 0, NIN, 1536, 16, 256, (unsigned)WOFF_W1, 1024, PC_DT, 16 * 8},
        {0, 0, NIN, 3856, 768, 768, (unsigned)WOFF_W1, 1024, PC_QKVC, 16 * 24}, {0, 0, NIN, 5136, 1536, 1536, (unsigned)WOFF_W1, 1024, PC_QKVD, 16 * 48}, {0, 0, NIN, 0, 512, 512, (unsigned)WOFF_W1, 1024, PC_ZA, 16 * 16},
        {0, 0, NIN, 3344, 512, 512, (unsigned)WOFF_W1, 1024, PC_GB, 16 * 16}, {0, 0, NIN, 4624, 512, 512, (unsigned)WOFF_W1, 1024, PC_GC, 16 * 16}, {0, 0, NIN, 6672, 512, 512, (unsigned)WOFF_W1, 1024, PC_GD, 16 * 16},
        {0, 0, NIN, 7184, 4096, 4096, (unsigned)WOFF_W2, 1024, 0, 16 * 128},
        {1, 0 * 512 * 1024, 1024, 0, 1024, 1024, (unsigned)WOFF_WB + 0 * 512, 2048, 0, 8 * 32}, {1, 1 * 512 * 1024, 1024, 0, 1024, 1024, (unsigned)WOFF_WB + 1 * 512, 2048, 0, 8 * 32},
        {1, 2 * 512 * 1024, 1024, 0, 1024, 1024, (unsigned)WOFF_WB + 2 * 512, 2048, 0, 8 * 32}, {1, 3 * 512 * 1024, 1024, 0, 1024, 1024, (unsigned)WOFF_WB + 3 * 512, 2048, 0, 8 * 32},
        {2, 0, 1024, 0, 1024, 1024, (unsigned)WOFF_WO, 1024, 0, 16 * 32}};
#pragma unroll 1
    for (int it0 = gw; it0 < 2 * WCONV_ITEMS; it0 += ngw) { const int l2 = it0 >= WCONV_ITEMS ? 1 : 0; int it = it0 - l2 * WCONV_ITEMS, s = 0;
#pragma unroll 1
        while (it >= segs[s].ni) { it -= segs[s].ni; ++s; }
        const WSeg g = segs[s];
        const float* src = g.src == 0 ? w_in + (size_t)l2 * 1024 * NIN : (g.src == 1 ? w_branch + (size_t)l2 * 4 * 512 * 1024 + g.soff : w_out + (size_t)l2 * 1024 * 1024);
        transpose_item(src, g.ldw, g.ldt, g.c0, g.nvalid, g.ntotal, Wall + (size_t)l2 * W_LAYER_ELEMS + g.doff, g.r0, scr, it, lane); }
}
__device__ __forceinline__ void rms_row_to_bf16(const float* xrow, const float* w, bf16* orow, int lane) {
    const GAS f32x4* xr = (const GAS f32x4*)xrow + lane; const GAS f32x4* wr = (const GAS f32x4*)w + lane;
    f32x4 v[4]; float s = 0.f;
#pragma unroll
    for (int j = 0; j < 4; ++j) { v[j] = xr[64 * j]; s += (v[j].x * v[j].x + v[j].y * v[j].y) + (v[j].z * v[j].z + v[j].w * v[j].w); }
    const float rstd = __builtin_amdgcn_rsqf(wave_sum(s, lane) * (1.f / 1024.f) + 1e-6f);
    GAS unsigned long long* o8 = (GAS unsigned long long*)orow + lane;
#pragma unroll
    for (int j = 0; j < 4; ++j) { const f32x4 ww = wr[64 * j]; o8[64 * j] = (unsigned long long)pk2(v[j].x * rstd * ww.x, v[j].y * rstd * ww.y) | ((unsigned long long)pk2(v[j].z * rstd * ww.z, v[j].w * rstd * ww.w) << 32); }
}
__device__ __forceinline__ void ph_rmsnorm(const float* x, const float* w, bf16* H, int nrows, int gw, int ngw, int lane) {
    f32x4 wv4[4];
#pragma unroll
    for (int j = 0; j < 4; ++j) wv4[j] = ((const GAS f32x4*)w + lane)[64 * j];
    for (int m = gw; m < nrows; m += 2 * ngw) { const int m2 = m + ngw; const bool two = m2 < nrows;
        const GAS f32x4* xa = (const GAS f32x4*)(x + (size_t)m * 1024) + lane; const GAS f32x4* xb = (const GAS f32x4*)(x + (size_t)(two ? m2 : m) * 1024) + lane;
        f32x4 va[4], vb[4]; float sa = 0.f, sb = 0.f;
#pragma unroll
        for (int j = 0; j < 4; ++j) { va[j] = xa[64 * j]; vb[j] = xb[64 * j]; }
#pragma unroll
        for (int j = 0; j < 4; ++j) { sa += (va[j].x * va[j].x + va[j].y * va[j].y) + (va[j].z * va[j].z + va[j].w * va[j].w); sb += (vb[j].x * vb[j].x + vb[j].y * vb[j].y) + (vb[j].z * vb[j].z + vb[j].w * vb[j].w); }
        const float ra = __builtin_amdgcn_rsqf(sum_l64(sa) * (1.f / 1024.f) + 1e-6f), rb = __builtin_amdgcn_rsqf(sum_l64(sb) * (1.f / 1024.f) + 1e-6f);
        GAS unsigned long long* oa = (GAS unsigned long long*)(H + (size_t)m * 1024) + lane; GAS unsigned long long* ob = (GAS unsigned long long*)(H + (size_t)(two ? m2 : m) * 1024) + lane;
#pragma unroll
        for (int j = 0; j < 4; ++j) { const f32x4 ww = wv4[j];
            oa[64 * j] = (unsigned long long)pk2(va[j].x * ra * ww.x, va[j].y * ra * ww.y) | ((unsigned long long)pk2(va[j].z * ra * ww.z, va[j].w * ra * ww.w) << 32);
            if (two) ob[64 * j] = (unsigned long long)pk2(vb[j].x * rb * ww.x, vb[j].y * rb * ww.y) | ((unsigned long long)pk2(vb[j].z * rb * ww.z, vb[j].w * rb * ww.w) << 32); } }
}
__device__ __forceinline__ void ph_gemm_rsigout(LAS unsigned char* lds, const bf16* A, int lda, const bf16* Bt, int M, int N, int K, bf16* O, int ldo, int tid, int bid) {
    pg8::Gemm g{A, Bt, M, N, K, lda}; pg8::StaticOrder S; S.init(M, N, (int)gridDim.x, bid);
    pg8::EpiBf16<2> E{O, ldo, nullptr, 0, 0, 1.f};
    pg8::gemm_phase<pg8::EpiBf16<2>, pg8::StaticOrder, true, true>(lds, g, S, E, tid);
}
struct RangeOrder : pg8::StaticOrder { int first, count;
    __device__ bool next(int i, pg8::Unit& u) const { return i < count && pg8::StaticOrder::next(i + first, u); } };
__device__ __forceinline__ void ph_gemm_bf16out_range(LAS unsigned char* lds, const bf16* A, int lda, const bf16* Bt, int M, int N, int K, bf16* O, int ldo, int first, int count, int tid, int bid) {
    pg8::Gemm g{A, Bt, M, N, K, lda}; RangeOrder S; S.init(M, N, (int)gridDim.x, bid); S.first = first; S.count = count;
    pg8::EpiBf16<0> E{O, ldo, nullptr, 0, 0, 1.f};
    pg8::gemm_phase<pg8::EpiBf16<0>, RangeOrder, true, true>(lds, g, S, E, tid);
}
__device__ __forceinline__ void ph_gemm_bf16out(LAS unsigned char* lds, const bf16* A, int lda, const bf16* Bt, int M, int N, int K, bf16* O, int ldo, int tid, int bid) {
    pg8::Gemm g{A, Bt, M, N, K, lda}; pg8::StaticOrder S; S.init(M, N, (int)gridDim.x, bid);
    pg8::EpiBf16<0> E{O, ldo, nullptr, 0, 0, 1.f};
    pg8::gemm_phase<pg8::EpiBf16<0>, pg8::StaticOrder, true, true>(lds, g, S, E, tid);
}
}
namespace mk {
constexpr float C2 = 0.125f * 1.4426950408889634f;
struct EpiF32 {
    static constexpr bool PERM = false, AFTER_DRAIN = false, FOLD = false;
    float* C; int ldc;
    __device__ __forceinline__ void operator()(const pg8::f32x4 (&acc)[2][2][4][2], const pg8::Unit& u, int wr, int wc, int fr, int fq) const {
        const int row0 = u.pm * 256 + wr * 64 + fr, col0 = u.pn * 256 + wc * 32 + 4 * fq;
#pragma unroll
        for (int ai = 0; ai < 2; ++ai)
#pragma unroll
            for (int m = 0; m < 4; ++m) { float* rowp = C + (size_t)(row0 + ai * 128 + m * 16) * ldc + col0;
#pragma unroll
                for (int bj = 0; bj < 2; ++bj)
#pragma unroll
                    for (int n = 0; n < 2; ++n) *(pg8::f32x4*)(rowp + bj * 128 + n * 16) = acc[ai][bj][m][n]; }
    }
};
template <int MODE> struct EpiMerge {
    static constexpr bool PERM = false, AFTER_DRAIN = false, FOLD = false;
    float* Mf; bf16* Mb; const bf16* G; int ldg;
    __device__ __forceinline__ void operator()(const pg8::f32x4 (&acc)[2][2][4][2], const pg8::Unit& u, int wr, int wc, int fr, int fq) const {
        const int row0 = u.pm * 256 + wr * 64 + fr, col0 = u.pn * 256 + wc * 32 + 4 * fq;
#pragma unroll
        for (int ai = 0; ai < 2; ++ai)
#pragma unroll
            for (int m = 0; m < 4; ++m) { const size_t r = (size_t)(row0 + ai * 128 + m * 16);
#pragma unroll
                for (int bj = 0; bj < 2; ++bj)
#pragma unroll
                    for (int n = 0; n < 2; ++n) { const int c = col0 + bj * 128 + n * 16;
                        const v2u gw = *(const v2u*)(G + r * ldg + c);
                        pg8::f32x4 v = acc[ai][bj][m][n];
                        v[0] *= fsigmoid(bflo(gw.x)); v[1] *= fsigmoid(bfhi(gw.x)); v[2] *= fsigmoid(bflo(gw.y)); v[3] *= fsigmoid(bfhi(gw.y));
                        if (MODE > 0) v += *(const pg8::f32x4*)(Mf + r * 1024 + c);
                        if (MODE < 2) *(pg8::f32x4*)(Mf + r * 1024 + c) = v;
                        else { v2u o; o.x = pk2(v[0], v[1]); o.y = pk2(v[2], v[3]); *(v2u*)(Mb + r * 1024 + c) = o; } } }
    }
};
__device__ __forceinline__ v4u gload16(const void* base, unsigned off) { v4u r; asm volatile("global_load_dwordx4 %0, %1, %2" : "=v"(r) : "v"(off), "s"(base) : "memory"); return r; }
__device__ __forceinline__ void gwait8(v4u& a, v4u& b, v4u& c, v4u& d, v4u& e, v4u& f, v4u& g, v4u& h) { asm volatile("s_waitcnt vmcnt(0)" : "+v"(a), "+v"(b), "+v"(c), "+v"(d), "+v"(e), "+v"(f), "+v"(g), "+v"(h) :: "memory"); }
struct EpiMergeF {
    static constexpr bool PERM = true, AFTER_DRAIN = false, FOLD = true;
    bf16* Mb; const bf16* S; int lds_;
    __device__ __forceinline__ void fold(pg8::f32x4 (&acc)[2][2][4][2], int seg, const pg8::Unit& u, int wr, int wc, int fr, int fq) const {
        unsigned off0 = (unsigned)((u.pm * 256 + wr * 64 + fr) * lds_ + u.pn * 256 + wc * 32 + 8 * fq + seg * 1024) * 2u; asm volatile("" : "+v"(off0));
#pragma unroll
        for (int ai = 0; ai < 2; ++ai)
#pragma unroll
            for (int mh = 0; mh < 2; ++mh) {
                v4u sa[2][2], sb[2][2];
#pragma unroll
                for (int mm = 0; mm < 2; ++mm)
#pragma unroll
                    for (int bj = 0; bj < 2; ++bj) { const unsigned ro = off0 + (unsigned)((ai * 128 + (2 * mh + mm) * 16) * lds_) * 2u + bj * 256; sa[mm][bj] = gload16(S, ro); sb[mm][bj] = gload16(S, ro + 2048); }
                gwait8(sa[0][0], sa[0][1], sa[1][0], sa[1][1], sb[0][0], sb[0][1], sb[1][0], sb[1][1]);
#pragma unroll
                for (int mm = 0; mm < 2; ++mm)
#pragma unroll
                    for (int bj = 0; bj < 2; ++bj) { const unsigned wa[4] = {sa[mm][bj].x, sa[mm][bj].y, sa[mm][bj].z, sa[mm][bj].w}, wb[4] = {sb[mm][bj].x, sb[mm][bj].y, sb[mm][bj].z, sb[mm][bj].w};
#pragma unroll
                        for (int e = 0; e < 4; ++e) { pg8::f32x4& v = acc[ai][bj][2 * mh + mm][e >> 1]; const int o = 2 * (e & 1);
                            v[o] *= bflo(wb[e]) * __builtin_amdgcn_rcpf(bflo(wa[e])); v[o + 1] *= bfhi(wb[e]) * __builtin_amdgcn_rcpf(bfhi(wa[e])); } } }
    }
    __device__ __forceinline__ void operator()(const pg8::f32x4 (&acc)[2][2][4][2], const pg8::Unit& u, int wr, int wc, int fr, int fq) const {
        const int row0 = u.pm * 256 + wr * 64 + fr, col0 = u.pn * 256 + wc * 32 + 8 * fq;
        const unsigned off0 = (unsigned)(row0 * lds_ + col0 + 3 * 1024) * 2u;
#pragma unroll
        for (int ai = 0; ai < 2; ++ai) { v4u sa[4][2];
#pragma unroll
            for (int m = 0; m < 4; ++m)
#pragma unroll
                for (int bj = 0; bj < 2; ++bj) sa[m][bj] = gload16(S, off0 + (unsigned)((ai * 128 + m * 16) * lds_) * 2u + bj * 256);
            gwait8(sa[0][0], sa[0][1], sa[1][0], sa[1][1], sa[2][0], sa[2][1], sa[3][0], sa[3][1]);
#pragma unroll
            for (int m = 0; m < 4; ++m) { const size_t r = (size_t)(row0 + ai * 128 + m * 16);
#pragma unroll
                for (int bj = 0; bj < 2; ++bj) { const int c = col0 + bj * 128; const v4u s4 = sa[m][bj]; const pg8::f32x4 v0 = acc[ai][bj][m][0], v1 = acc[ai][bj][m][1];
                    v4u o; o.x = pk2(v0[0] * __builtin_amdgcn_rcpf(bflo(s4.x)), v0[1] * __builtin_amdgcn_rcpf(bfhi(s4.x))); o.y = pk2(v0[2] * __builtin_amdgcn_rcpf(bflo(s4.y)), v0[3] * __builtin_amdgcn_rcpf(bfhi(s4.y)));
                    o.z = pk2(v1[0] * __builtin_amdgcn_rcpf(bflo(s4.z)), v1[1] * __builtin_amdgcn_rcpf(bfhi(s4.z))); o.w = pk2(v1[2] * __builtin_amdgcn_rcpf(bflo(s4.w)), v1[3] * __builtin_amdgcn_rcpf(bfhi(s4.w)));
                    *(GAS v4u*)(Mb + r * 1024 + c) = o; } } }
    }
};
template <class Epi> __device__ __forceinline__ void run_gemm(LAS unsigned char* lds, const bf16* A, int lda, const bf16* Bt, int M, int N, int K, const Epi& E, int tid, int bid) {
    pg8::Gemm g{A, Bt, M, N, K, lda}; pg8::StaticOrder S; S.init(M, N, (int)gridDim.x, bid);
    pg8::gemm_phase<Epi, pg8::StaticOrder, true, true>(lds, g, S, E, tid);
}
__device__ __forceinline__ void ph_rope_table(float* rope, int gtid, int nthr) {
    for (int i = gtid; i < SEQ * 32; i += nthr) { const int l = i >> 5, j = i & 31; const float inv = __builtin_amdgcn_exp2f(-(float)(j & 15) * 0.83048202372184f);
        const float ang = (float)(j < 16 ? (l >> 6) : (l & 63)) * inv; rope[i] = __cosf(ang); rope[SEQ * 32 + i] = __sinf(ang); }
}
__device__ __forceinline__ void ph_prep_conv(const bf16* P, int T, const float* cw, const float* cb, const float* dtb, bf16* XC, float* DT, int gtid, int nthr) {
    { const int c = (gtid & 127) * 8;
        float wj[5][8], bb[8];
#pragma unroll
        for (int j = 0; j < 5; ++j) { const f32x4 w0 = *(const GAS f32x4*)(cw + j * 1024 + c), w1 = *(const GAS f32x4*)(cw + j * 1024 + c + 4); wj[j][0] = w0.x; wj[j][1] = w0.y; wj[j][2] = w0.z; wj[j][3] = w0.w; wj[j][4] = w1.x; wj[j][5] = w1.y; wj[j][6] = w1.z; wj[j][7] = w1.w; }
        { const f32x4 b0 = *(const GAS f32x4*)(cb + c), b1 = *(const GAS f32x4*)(cb + c + 4); bb[0] = b0.x; bb[1] = b0.y; bb[2] = b0.z; bb[3] = b0.w; bb[4] = b1.x; bb[5] = b1.y; bb[6] = b1.z; bb[7] = b1.w; }
    for (int it = gtid; it < (T >> 3) * 128; it += nthr) { const int t0 = (it >> 7) * 8, l0 = t0 & (SEQ - 1);
        v4u row[12];
#pragma unroll
        for (int r = 0; r < 12; ++r) { const int ll = l0 + r - 2; const bool ok = (ll >= 0) && (ll < SEQ); const v4u z4 = {0u, 0u, 0u, 0u};
            row[r] = ok ? *(const GAS v4u*)(P + (size_t)(t0 + r - 2) * LDP + PC_XBC + c) : z4; }
#pragma unroll
        for (int q = 0; q < 8; ++q) { float a[8];
#pragma unroll
            for (int e = 0; e < 8; ++e) a[e] = bb[e];
#pragma unroll
            for (int j = 0; j < 5; ++j) { const v4u w = row[q + j];
                a[0] += wj[j][0] * bflo(w.x); a[1] += wj[j][1] * bfhi(w.x); a[2] += wj[j][2] * bflo(w.y); a[3] += wj[j][3] * bfhi(w.y); a[4] += wj[j][4] * bflo(w.z); a[5] += wj[j][5] * bfhi(w.z); a[6] += wj[j][6] * bflo(w.w); a[7] += wj[j][7] * bfhi(w.w); }
            v4u o; o.x = pk2(fsilu(a[0]), fsilu(a[1])); o.y = pk2(fsilu(a[2]), fsilu(a[3])); o.z = pk2(fsilu(a[4]), fsilu(a[5])); o.w = pk2(fsilu(a[6]), fsilu(a[7]));
            *(GAS v4u*)(XC + (size_t)(t0 + q) * 1024 + c) = o; } } }
    for (int it = gtid; it < T * 16; it += nthr) { const int t = it >> 4, j = it & 15; const float x = bf2f(P[(size_t)t * LDP + PC_DT + j]) + dtb[j]; DT[it] = x > 20.f ? x : __logf(1.f + __expf(x)); }
}
__device__ __forceinline__ void ph_prep_gqa(const bf16* P, int T, const float* qw, const float* kw, const float* rope, bf16* Qn, bf16* Kn, int gtid, int nthr) {
    { const int j8 = gtid & 7, g8 = gtid >> 3, ng8 = nthr >> 3;
      const f32x4 qw1 = *(const GAS f32x4*)(qw + 4 * j8), qw2 = *(const GAS f32x4*)(qw + 32 + 4 * j8), kw1 = *(const GAS f32x4*)(kw + 4 * j8), kw2 = *(const GAS f32x4*)(kw + 32 + 4 * j8);
      constexpr int GR = 2;
      for (int it0 = g8; it0 < T * 10; it0 += GR * ng8) {
        int tq[GR], hq[GR]; bool okq[GR]; v2u r1[GR], r2[GR]; f32x4 cs[GR], sn[GR];
#pragma unroll
        for (int q = 0; q < GR; ++q) { const int it = it0 + q * ng8; okq[q] = it < T * 10; const int itc = okq[q] ? it : it0; tq[q] = itc / 10; hq[q] = itc - tq[q] * 10; const int l = tq[q] & (SEQ - 1);
            const bf16* src = P + (size_t)tq[q] * LDP + PC_QKVC + hq[q] * 64 + 4 * j8; r1[q] = *(const GAS v2u*)src; r2[q] = *(const GAS v2u*)(src + 32);
            cs[q] = *(const GAS f32x4*)(rope + l * 32 + 4 * j8); sn[q] = *(const GAS f32x4*)(rope + SEQ * 32 + l * 32 + 4 * j8); }
#pragma unroll
        for (int q = 0; q < GR; ++q) { const int t = tq[q], hh = hq[q]; const f32x4 w1 = hh < 8 ? qw1 : kw1, w2 = hh < 8 ? qw2 : kw2;
            const float x1[4] = {bflo(r1[q].x), bfhi(r1[q].x), bflo(r1[q].y), bfhi(r1[q].y)}, x2[4] = {bflo(r2[q].x), bfhi(r2[q].x), bflo(r2[q].y), bfhi(r2[q].y)};
            float ss = 0.f;
#pragma unroll
            for (int e = 0; e < 4; ++e) ss += x1[e] * x1[e] + x2[e] * x2[e];
            const float rs = __builtin_amdgcn_rsqf(sum_l8(ss) * (1.f / 64.f) + 1e-6f), sc = hh < 8 ? C2 : 1.f; float o1[4], o2[4];
#pragma unroll
            for (int e = 0; e < 4; ++e) { const float y1 = x1[e] * rs * w1[e], y2 = x2[e] * rs * w2[e]; o1[e] = (y1 * cs[q][e] - y2 * sn[q][e]) * sc; o2[e] = (y2 * cs[q][e] + y1 * sn[q][e]) * sc; }
            bf16* dst = (hh < 8 ? Qn + (size_t)t * 512 + hh * 64 : Kn + (size_t)t * 128 + (hh - 8) * 64) + 4 * j8;
            v2u a1, a2; a1.x = pk2(o1[0], o1[1]); a1.y = pk2(o1[2], o1[3]); a2.x = pk2(o2[0], o2[1]); a2.y = pk2(o2[2], o2[3]);
            if (okq[q]) { *(GAS v2u*)dst = a1; *(GAS v2u*)(dst + 32) = a2; } } } }
}
__device__ __forceinline__ void ph_post(bf16* P, int T, const bf16* XC, const bf16* YA  , const float* d_skip, const float* norm_w,
                                        const bf16* YB  , const float* CB  , const bf16* VB  , const float* lnx_w, const float* lnx_b, int gw, int ngw, int lane) {
    const int c = lane * 8, h = lane >> 3;
    const float D = d_skip[c >> 6]; const f32x4 n0 = *(const GAS f32x4*)(norm_w + c), n1 = *(const GAS f32x4*)(norm_w + c + 4);
    const f32x4 lw0 = *(const GAS f32x4*)(lnx_w + c), lw1 = *(const GAS f32x4*)(lnx_w + c + 4), lb0 = *(const GAS f32x4*)(lnx_b + c), lb1 = *(const GAS f32x4*)(lnx_b + c + 4);
    for (int t = gw; t < T; t += ngw) {
        const v4u y0 = *(const GAS v4u*)(YA + (size_t)t * 512 + c), y1 = *(const GAS v4u*)(YA + ((size_t)T + t) * 512 + c), xs = *(const GAS v4u*)(XC + (size_t)t * 1024 + c), zz = *(const GAS v4u*)(P + (size_t)t * LDP + PC_ZA + c);
        const v4u a0 = *(const GAS v4u*)(YB + (size_t)t * 512 + c), a1 = *(const GAS v4u*)(YB + ((size_t)T + t) * 512 + c), vv = *(const GAS v4u*)(VB + (size_t)t * 512 + c), gg = *(const GAS v4u*)(P + (size_t)t * LDP + PC_GB + c);
        const float coef = CB[(size_t)h * T + t] + CB[(size_t)(8 + h) * T + t];
        {
            const unsigned yw0[4] = {y0.x, y0.y, y0.z, y0.w}, yw1[4] = {y1.x, y1.y, y1.z, y1.w}, xw[4] = {xs.x, xs.y, xs.z, xs.w}, zw[4] = {zz.x, zz.y, zz.z, zz.w}; float y[8], ss = 0.f;
#pragma unroll
            for (int e = 0; e < 4; ++e) { y[2 * e] = (bflo(yw0[e]) + bflo(yw1[e]) + bflo(xw[e]) * D) * fsilu(bflo(zw[e])); y[2 * e + 1] = (bfhi(yw0[e]) + bfhi(yw1[e]) + bfhi(xw[e]) * D) * fsilu(bfhi(zw[e])); ss += y[2 * e] * y[2 * e] + y[2 * e + 1] * y[2 * e + 1]; }
            const float r = __builtin_amdgcn_rsqf(sum_l32(ss) * (1.f / 256.f) + 1e-6f);
            v4u o; o.x = pk2(y[0] * r * n0.x, y[1] * r * n0.y); o.y = pk2(y[2] * r * n0.z, y[3] * r * n0.w); o.z = pk2(y[4] * r * n1.x, y[5] * r * n1.y); o.w = pk2(y[6] * r * n1.z, y[7] * r * n1.w);
            *(GAS v4u*)(P + (size_t)t * LDP + PC_ZA + c) = o; }
        {
            float y[8] = {bflo(a0.x) + bflo(a1.x), bfhi(a0.x) + bfhi(a1.x), bflo(a0.y) + bflo(a1.y), bfhi(a0.y) + bfhi(a1.y), bflo(a0.z) + bflo(a1.z), bfhi(a0.z) + bfhi(a1.z), bflo(a0.w) + bflo(a1.w), bfhi(a0.w) + bfhi(a1.w)};
            const float v[8] = {bflo(vv.x), bfhi(vv.x), bflo(vv.y), bfhi(vv.y), bflo(vv.z), bfhi(vv.z), bflo(vv.w), bfhi(vv.w)};
            const float g[8] = {bflo(gg.x), bfhi(gg.x), bflo(gg.y), bfhi(gg.y), bflo(gg.z), bfhi(gg.z), bflo(gg.w), bfhi(gg.w)};
            float s = 0.f;
#pragma unroll
            for (int e = 0; e < 8; ++e) s += y[e];
            const float mu = sum_l8(s) * (1.f / 64.f); float q = 0.f;
#pragma unroll
            for (int e = 0; e < 8; ++e) { y[e] -= mu; q += y[e] * y[e]; }
            const float rs = __builtin_amdgcn_rsqf(sum_l8(q) * (1.f / 64.f) + 64e-5f);
            const float lw[8] = {lw0.x, lw0.y, lw0.z, lw0.w, lw1.x, lw1.y, lw1.z, lw1.w}, lb[8] = {lb0.x, lb0.y, lb0.z, lb0.w, lb1.x, lb1.y, lb1.z, lb1.w}; float o[8];
#pragma unroll
            for (int e = 0; e < 8; ++e) o[e] = (y[e] * rs * lw[e] + lb[e] + coef * v[e]) * fsilu(g[e]);
            v4u ov; ov.x = pk2(o[0], o[1]); ov.y = pk2(o[2], o[3]); ov.z = pk2(o[4], o[5]); ov.w = pk2(o[6], o[7]);
            *(GAS v4u*)(P + (size_t)t * LDP + PC_GB + c) = ov; }
    }
}
__device__ __forceinline__ void ph_fin(const float* xin, const float* outf, const float* w, float* xout, const float* wn, bf16* Hn, int nrows, int gw, int ngw, int lane) {
    f32x4 wpost[4], wpre[4];
#pragma unroll
    for (int j = 0; j < 4; ++j) { wpost[j] = ((const GAS f32x4*)w + lane)[64 * j]; wpre[j] = wn ? ((const GAS f32x4*)wn + lane)[64 * j] : (f32x4){0.f, 0.f, 0.f, 0.f}; }
    for (int m = gw; m < nrows; m += 2 * ngw) { const int m2 = (m + ngw < nrows) ? m + ngw : m; const bool two = m2 != m;
        const GAS f32x4* oa = (const GAS f32x4*)(outf + (size_t)m * 1024) + lane; const GAS f32x4* ob = (const GAS f32x4*)(outf + (size_t)m2 * 1024) + lane;
        const GAS f32x4* xa = (const GAS f32x4*)(xin + (size_t)m * 1024) + lane; const GAS f32x4* xb = (const GAS f32x4*)(xin + (size_t)m2 * 1024) + lane;
        f32x4 va[4], vb[4], ya[4], yb[4]; float sa = 0.f, sb = 0.f;
#pragma unroll
        for (int j = 0; j < 4; ++j) { va[j] = oa[64 * j]; vb[j] = ob[64 * j]; ya[j] = xa[64 * j]; yb[j] = xb[64 * j]; }
#pragma unroll
        for (int j = 0; j < 4; ++j) { sa += (va[j].x * va[j].x + va[j].y * va[j].y) + (va[j].z * va[j].z + va[j].w * va[j].w); sb += (vb[j].x * vb[j].x + vb[j].y * vb[j].y) + (vb[j].z * vb[j].z + vb[j].w * vb[j].w); }
        const float ra = __builtin_amdgcn_rsqf(sum_l64(sa) * (1.f / 1024.f) + 1e-6f), rb = __builtin_amdgcn_rsqf(sum_l64(sb) * (1.f / 1024.f) + 1e-6f);
        GAS f32x4* pa = (GAS f32x4*)(xout + (size_t)m * 1024) + lane; GAS f32x4* pb = (GAS f32x4*)(xout + (size_t)m2 * 1024) + lane;
        float qa = 0.f, qb = 0.f;
#pragma unroll
        for (int j = 0; j < 4; ++j) { const f32x4 ww = wpost[j]; ya[j] = ya[j] + va[j] * ra * ww; yb[j] = yb[j] + vb[j] * rb * ww; pa[64 * j] = ya[j]; if (two) pb[64 * j] = yb[j];
            qa += (ya[j].x * ya[j].x + ya[j].y * ya[j].y) + (ya[j].z * ya[j].z + ya[j].w * ya[j].w); qb += (yb[j].x * yb[j].x + yb[j].y * yb[j].y) + (yb[j].z * yb[j].z + yb[j].w * yb[j].w); }
        if (wn) { const float na = __builtin_amdgcn_rsqf(sum_l64(qa) * (1.f / 1024.f) + 1e-6f), nb = __builtin_amdgcn_rsqf(sum_l64(qb) * (1.f / 1024.f) + 1e-6f);
            GAS unsigned long long* ha = (GAS unsigned long long*)(Hn + (size_t)m * 1024) + lane; GAS unsigned long long* hb = (GAS unsigned long long*)(Hn + (size_t)m2 * 1024) + lane;
#pragma unroll
            for (int j = 0; j < 4; ++j) { const f32x4 ww = wpre[j];
                ha[64 * j] = (unsigned long long)pk2(ya[j].x * na * ww.x, ya[j].y * na * ww.y) | ((unsigned long long)pk2(ya[j].z * na * ww.z, ya[j].w * na * ww.w) << 32);
                if (two) hb[64 * j] = (unsigned long long)pk2(yb[j].x * nb * ww.x, yb[j].y * nb * ww.y) | ((unsigned long long)pk2(yb[j].z * nb * ww.z, yb[j].w * nb * ww.w) << 32); } } }
}
}
namespace mk {
__device__ __forceinline__ void unpack8(const v4u w, float* f) { f[0] = bflo(w.x); f[1] = bfhi(w.x); f[2] = bflo(w.y); f[3] = bfhi(w.y); f[4] = bflo(w.z); f[5] = bfhi(w.z); f[6] = bflo(w.w); f[7] = bfhi(w.w); }
__device__ __forceinline__ void ph_ssd_simple(const bf16* XC, const float* DT, const float* a_log, bf16* YA, int nb, int T, int tid, int bid) {
    if (tid >= 64) return;
    const int i = bid * 64 + tid; if (i >= 2 * nb * 512) return;
    const int p = i % 64, h = (i / 64) % 8, b = (i / 512) % nb, z = i / (512 * nb);
    float s[128];
#pragma unroll
    for (int n = 0; n < 128; ++n) s[n] = 0.f;
    const float an = -expf(a_log[z * 8 + h]); const int g = h >> 2;
    for (int st = 0; st < SEQ; ++st) { const int l = z ? (SEQ - 1 - st) : st; const size_t t = (size_t)b * SEQ + l;
        const float d = DT[t * 16 + z * 8 + h]; const float dec = expf(d * an); const float xd = bf2f(XC[t * 1024 + h * 64 + p]) * d;
        const GAS v4u* Bv = (const GAS v4u*)(XC + t * 1024 + 512 + g * 128); const GAS v4u* Cv = (const GAS v4u*)(XC + t * 1024 + 768 + g * 128);
        float y = 0.f;
#pragma unroll
        for (int n8 = 0; n8 < 16; ++n8) { float bb[8], cc[8]; unpack8(Bv[n8], bb); unpack8(Cv[n8], cc);
#pragma unroll
            for (int e = 0; e < 8; ++e) { s[n8 * 8 + e] = s[n8 * 8 + e] * dec + xd * bb[e]; y += cc[e] * s[n8 * 8 + e]; } }
        YA[((size_t)z * T + t) * 512 + h * 64 + p] = (bf16)f2bf(y); }
}
__device__ __forceinline__ float shiftP(const bf16* P, int t, int ch, const float* mu) {
    const int l = t & (SEQ - 1); const float cur = bf2f(P[(size_t)t * LDP + PC_SLAB + ch]);
    const float prev = l > 0 ? bf2f(P[(size_t)(t - 1) * LDP + PC_SLAB + ch]) : 0.f; const float nxt = l < SEQ - 1 ? bf2f(P[(size_t)(t + 1) * LDP + PC_SLAB + ch]) : 0.f;
    return cur + mu[ch] * (prev - cur) + mu[1792 + ch] * (nxt - cur);
}
struct RwkvS { float *R, *V, *KK, *DEC, *BB, *KD; };
__device__ __forceinline__ void ph_rwkv_prep_simple(const bf16* P, int T, int t0, int Ts, const float* mu, const float* w0, const float* w_up, const float* a0, const float* a_up, const float* k_k, const float* k_a, const float* r_k,
                                                    RwkvS A, bf16* VB, float* CB, int gtid, int nthr) {
    for (int it = gtid; it < Ts * 512; it += nthr) { const int tl = it >> 9, c = it & 511, t = t0 + tl;
        const float r = shiftP(P, t, c, mu), k = shiftP(P, t, 512 + c, mu), v = shiftP(P, t, 1024 + c, mu);
        A.R[it] = r; A.V[it] = v; VB[(size_t)t * 512 + c] = (bf16)f2bf(v);
        const float kx = k * k_k[c]; const float ss = wave_sum(kx * kx, gtid & 63);
        const float kk = kx / sqrtf(fmaxf(ss, 1e-24f)); A.KK[it] = kk;
#pragma unroll 1
        for (int z = 0; z < 2; ++z) { float wr = w0[z * 512 + c], ar = a0[z * 512 + c];
            for (int q = 0; q < 64; ++q) { wr += tanhf(shiftP(P, t, 1536 + z * 64 + q, mu)) * w_up[((size_t)z * 64 + q) * 512 + c]; ar += shiftP(P, t, 1664 + z * 64 + q, mu) * a_up[((size_t)z * 64 + q) * 512 + c]; }
            const float sp = (-wr) > 20.f ? (-wr) : log1pf(expf(-wr)); const float dec = expf(-expf(-sp - 0.5f)); const float a = 1.f / (1.f + expf(-ar));
            const float kd = k * (1.f + (a - 1.f) * k_a[c]);
            A.DEC[(size_t)z * Ts * 512 + it] = dec; A.BB[(size_t)z * Ts * 512 + it] = kk * a; A.KD[(size_t)z * Ts * 512 + it] = kd;
            const float cb = wave_sum(r * kd * r_k[c], gtid & 63); if ((c & 63) == 0) CB[((size_t)(z * 8 + (c >> 6))) * T + t] = cb; } }
}
__device__ __forceinline__ void ph_rwkv_scan_simple(int T, int t0, int nbs, RwkvS A, bf16* YB, int tid, int bid) {
    if (tid >= 64) return;
    const int i = bid * 64 + tid; if (i >= 2 * nbs * 512) return;
    const int v = i % 64, h = (i / 64) % 8, b = (i / 512) % nbs, z = i / (512 * nbs); const int Ts = nbs * SEQ;
    float S[64];
#pragma unroll
    for (int k = 0; k < 64; ++k) S[k] = 0.f;
    for (int st = 0; st < SEQ; ++st) { const int l = z ? (SEQ - 1 - st) : st; const size_t tl = (size_t)b * SEQ + l; const size_t o = tl * 512 + h * 64, oz = ((size_t)z * Ts + tl) * 512 + h * 64;
        float sa = 0.f;
#pragma unroll
        for (int k = 0; k < 64; ++k) sa += S[k] * A.KK[o + k];
        const float vv = A.V[o + v]; float y = 0.f;
#pragma unroll
        for (int k = 0; k < 64; ++k) { S[k] = S[k] * A.DEC[oz + k] - sa * A.BB[oz + k] + vv * A.KD[oz + k]; y += S[k] * A.R[o + k]; }
        YB[((size_t)z * T + t0 + tl) * 512 + h * 64 + v] = (bf16)f2bf(y); }
}
__device__ __forceinline__ void ph_gqa_simple(bf16* P, const bf16* Qn, const bf16* Kn, int nb, int gtid, int nthr) {
    for (int it = gtid; it < nb * 8 * SEQ; it += nthr) { const int ql = it % SEQ, h = (it / SEQ) % 8, b = it / (8 * SEQ), g = h >> 2; const size_t t = (size_t)b * SEQ + ql;
        float q[64], o[64];
#pragma unroll
        for (int d8 = 0; d8 < 8; ++d8) { unpack8(*(const GAS v4u*)(Qn + t * 512 + h * 64 + d8 * 8), q + d8 * 8); }
#pragma unroll
        for (int d = 0; d < 64; ++d) o[d] = 0.f;
        float m = -1e30f, lsum = 0.f;
        for (int k = 0; k < SEQ; ++k) { const size_t tk = (size_t)b * SEQ + k; float s = 0.f;
#pragma unroll
            for (int d8 = 0; d8 < 8; ++d8) { float kf[8]; unpack8(*(const GAS v4u*)(Kn + tk * 128 + g * 64 + d8 * 8), kf);
#pragma unroll
                for (int e = 0; e < 8; ++e) s += q[d8 * 8 + e] * kf[e]; }
            const float mn = fmaxf(m, s); const float al = exp2f(m - mn), p = exp2f(s - mn); m = mn; lsum = lsum * al + p;
#pragma unroll
            for (int d8 = 0; d8 < 8; ++d8) { float vf[8]; unpack8(*(const GAS v4u*)(P + tk * LDP + PC_QKVC + 640 + g * 64 + d8 * 8), vf);
#pragma unroll
                for (int e = 0; e < 8; ++e) o[d8 * 8 + e] = o[d8 * 8 + e] * al + p * vf[e]; } }
        const float il = 1.f / lsum;
#pragma unroll
        for (int d8 = 0; d8 < 8; ++d8) { GAS v4u* dst = (GAS v4u*)(P + t * LDP + PC_GC + h * 64 + d8 * 8); float gf[8]; unpack8(*dst, gf); v4u ov;
            ov.x = pk2(o[d8 * 8 + 0] * il * fsilu(gf[0]), o[d8 * 8 + 1] * il * fsilu(gf[1])); ov.y = pk2(o[d8 * 8 + 2] * il * fsilu(gf[2]), o[d8 * 8 + 3] * il * fsilu(gf[3]));
            ov.z = pk2(o[d8 * 8 + 4] * il * fsilu(gf[4]), o[d8 * 8 + 5] * il * fsilu(gf[5])); ov.w = pk2(o[d8 * 8 + 6] * il * fsilu(gf[6]), o[d8 * 8 + 7] * il * fsilu(gf[7])); *dst = ov; } }
}
__device__ __forceinline__ void ph_na_simple(bf16* P, const float* rpb, int nb, int gtid, int nthr) {
    for (int it = gtid; it < nb * 8 * SEQ; it += nthr) { const int ql = it % SEQ, h = (it / SEQ) % 8, b = it / (8 * SEQ); const size_t t = (size_t)b * SEQ + ql; const int qr = ql >> 6, qc = ql & 63;
        int rs = qr - 4; rs = rs < 0 ? 0 : (rs > 24 ? 24 : rs); int cs = qc - 8; cs = cs < 0 ? 0 : (cs > 48 ? 48 : cs);
        float q[64], o[64];
#pragma unroll
        for (int d8 = 0; d8 < 8; ++d8) { unpack8(*(const GAS v4u*)(P + t * LDP + PC_QKVD + h * 64 + d8 * 8), q + d8 * 8); }
#pragma unroll
        for (int d = 0; d < 64; ++d) { q[d] *= 0.125f; o[d] = 0.f; }
        float m = -1e30f, lsum = 0.f;
        for (int i = 0; i < 128; ++i) { const int kr = rs + (i >> 4), kc = cs + (i & 15); const size_t tk = (size_t)b * SEQ + kr * 64 + kc; float s = 0.f;
#pragma unroll
            for (int d8 = 0; d8 < 8; ++d8) { float kf[8]; unpack8(*(const GAS v4u*)(P + tk * LDP + PC_QKVD + 512 + h * 64 + d8 * 8), kf);
#pragma unroll
                for (int e = 0; e < 8; ++e) s += q[d8 * 8 + e] * kf[e]; }
            s += rpb[h * 465 + (kr - qr + 7) * 31 + (kc - qc + 15)];
            const float mn = fmaxf(m, s); const float al = __expf(m - mn), p = __expf(s - mn); m = mn; lsum = lsum * al + p;
#pragma unroll
            for (int d8 = 0; d8 < 8; ++d8) { float vf[8]; unpack8(*(const GAS v4u*)(P + tk * LDP + PC_QKVD + 1024 + h * 64 + d8 * 8), vf);
#pragma unroll
                for (int e = 0; e < 8; ++e) o[d8 * 8 + e] = o[d8 * 8 + e] * al + p * vf[e]; } }
        const float il = 1.f / lsum;
#pragma unroll
        for (int d8 = 0; d8 < 8; ++d8) { GAS v4u* dst = (GAS v4u*)(P + t * LDP + PC_GD + h * 64 + d8 * 8); float gf[8]; unpack8(*dst, gf); v4u ov;
            ov.x = pk2(o[d8 * 8 + 0] * il * fsilu(gf[0]), o[d8 * 8 + 1] * il * fsilu(gf[1])); ov.y = pk2(o[d8 * 8 + 2] * il * fsilu(gf[2]), o[d8 * 8 + 3] * il * fsilu(gf[3]));
            ov.z = pk2(o[d8 * 8 + 4] * il * fsilu(gf[4]), o[d8 * 8 + 5] * il * fsilu(gf[5])); ov.w = pk2(o[d8 * 8 + 6] * il * fsilu(gf[6]), o[d8 * 8 + 7] * il * fsilu(gf[7])); *dst = ov; } }
}
}
#include <hip/hip_bf16.h>
namespace attn_body {
using bf16=__hip_bfloat16;
using bf16x8=__attribute__((ext_vector_type(8)))short;
using s16x4=__attribute__((ext_vector_type(4)))short;
using f32x16=__attribute__((ext_vector_type(16)))float;
using u32x4=__attribute__((ext_vector_type(4)))unsigned;
constexpr int SEQ=2048,D=64;
constexpr int NW=8,QBLK=32,QB=QBLK*NW,KVBLK=64,NQB=SEQ/QB;
__device__ __forceinline__ int crow(int r,int hi){return (r&3)+8*(r>>2)+4*hi;}
#define SBAR() __builtin_amdgcn_sched_barrier(0)
constexpr int NSLOT=3, SLOTB=8192;
constexpr int LDS_K=0, LDS_V=NSLOT*SLOTB, LDS_WS=2*NSLOT*SLOTB, LDS_OST=LDS_WS+NW*64*4, LDS_RPB=LDS_OST+NW*4096,LDS_BYTES=LDS_RPB+2048;
constexpr float C2=0.125f*1.4426950408889634f;
__device__ __forceinline__ void glds16(const void*gsrc,unsigned lds_dst){unsigned keep;
  asm volatile("s_mov_b32 %0, m0\n\ts_mov_b32 m0, %2\n\ts_nop 0\n\tglobal_load_lds_dwordx4 %1, off\n\ts_mov_b32 m0, %0":"=&s"(keep):"v"(gsrc),"s"(lds_dst):"memory");}
__device__ __forceinline__ float max3f(float a,float b,float c){float r;asm("v_max3_f32 %0, %1, %2, %3":"=v"(r):"v"(a),"v"(b),"v"(c));return r;}
__device__ __forceinline__ float max2f(float a,float b){float r;asm("v_max_f32_e32 %0, %1, %2":"=v"(r):"v"(a),"v"(b));return r;}
__device__ __forceinline__ float fadd_s(float a,float b){float r;asm("v_add_f32_e32 %0, %1, %2":"=v"(r):"v"(a),"v"(b));return r;}
__device__ __forceinline__ float fsub_s(float a,float b){float r;asm("v_sub_f32_e32 %0, %1, %2":"=v"(r):"v"(a),"v"(b));return r;}
typedef float f32x2_t __attribute__((ext_vector_type(2))); typedef __bf16 bf16x2_t __attribute__((ext_vector_type(2)));
__device__ __forceinline__ unsigned cvtpk_s(float lo,float hi){f32x2_t v={lo,hi};bf16x2_t b=__builtin_convertvector(v,bf16x2_t);return __builtin_bit_cast(unsigned,b);}
#define WAIT_BAR(N) asm volatile("s_waitcnt vmcnt(" #N ") lgkmcnt(0)\n\ts_barrier":::"memory")

__device__ __forceinline__ void qkt(f32x16&p0,f32x16&p1,const char*Kslot,const bf16x8*qr,int r32,int hi){ const f32x16 negm=f32x16{};
  const char*kb=Kslot+hi*1024+r32*16;
  #pragma unroll
  for(int d0=0;d0<4;++d0){
    const bf16x8 b0=*reinterpret_cast<const bf16x8*>(kb+d0*2048);
    const bf16x8 b1=*reinterpret_cast<const bf16x8*>(kb+d0*2048+512);
    if(d0==0){p0=__builtin_amdgcn_mfma_f32_32x32x16_bf16(b0,qr[0],negm,0,0,0);p1=__builtin_amdgcn_mfma_f32_32x32x16_bf16(b1,qr[0],negm,0,0,0);}
    else{p0=__builtin_amdgcn_mfma_f32_32x32x16_bf16(b0,qr[d0],p0,0,0,0);p1=__builtin_amdgcn_mfma_f32_32x32x16_bf16(b1,qr[d0],p1,0,0,0);}}
}
typedef __attribute__((address_space(3))) const char* lds_cptr;
typedef short v4i16_t __attribute__((ext_vector_type(4)));
__device__ __forceinline__ void kload8(bf16x8*kf,lds_cptr kp){
  kf[0]=*(const __attribute__((address_space(3))) bf16x8*)(kp);      kf[1]=*(const __attribute__((address_space(3))) bf16x8*)(kp+512);
  kf[2]=*(const __attribute__((address_space(3))) bf16x8*)(kp+2048); kf[3]=*(const __attribute__((address_space(3))) bf16x8*)(kp+2560);
  kf[4]=*(const __attribute__((address_space(3))) bf16x8*)(kp+4096); kf[5]=*(const __attribute__((address_space(3))) bf16x8*)(kp+4608);
  kf[6]=*(const __attribute__((address_space(3))) bf16x8*)(kp+6144); kf[7]=*(const __attribute__((address_space(3))) bf16x8*)(kp+6656);
}
__device__ __forceinline__ void kload2(bf16x8*kf,lds_cptr kp,int j){ kf[2*j]=*(const __attribute__((address_space(3))) bf16x8*)(kp+j*2048); kf[2*j+1]=*(const __attribute__((address_space(3))) bf16x8*)(kp+j*2048+512); }
__device__ __forceinline__ s16x4 vtr(lds_cptr p){ return __builtin_bit_cast(s16x4,__builtin_amdgcn_ds_read_tr16_b64_v4i16((__attribute__((address_space(3))) v4i16_t*)p)); }
__device__ __forceinline__ float rowmax(const f32x16&p0,const f32x16&p1){
  float a=max3f(p0[0],p0[1],p1[0]),b=max3f(p0[2],p0[3],p1[1]);a=max3f(a,p1[2],p1[3]);
  #pragma unroll
  for(int r=4;r<16;r+=4){a=max3f(a,p0[r],p0[r+1]);b=max3f(b,p0[r+2],p0[r+3]);a=max3f(a,p1[r],p1[r+1]);b=max3f(b,p1[r+2],p1[r+3]);}
  const float m=max2f(a,b);
  auto rr=__builtin_amdgcn_permlane32_swap(__float_as_uint(m),__float_as_uint(m),false,false);
  return max2f(__uint_as_float(rr[0]),__uint_as_float(rr[1]));
}
__device__ __forceinline__ void pv(f32x16*o,int vb,bf16x8 pa0,bf16x8 pa1,bf16x8 pa2,bf16x8 pa3){
  #pragma unroll
  for(int d0=0;d0<2;++d0){s16x4 lo[4],hi[4];
    #pragma unroll
    for(int ks=0;ks<4;++ks){
      asm volatile("ds_read_b64_tr_b16 %0,%1 offset:%c2":"=&v"(lo[ks]):"v"(vb),"i"(d0*4096+ks*1024):"memory");
      asm volatile("ds_read_b64_tr_b16 %0,%1 offset:%c2":"=&v"(hi[ks]):"v"(vb),"i"(d0*4096+ks*1024+512):"memory");}
    asm volatile("s_waitcnt lgkmcnt(0)":::"memory");SBAR();
    #define PK(k) (bf16x8){lo[k][0],lo[k][1],lo[k][2],lo[k][3],hi[k][0],hi[k][1],hi[k][2],hi[k][3]}
    o[d0]=__builtin_amdgcn_mfma_f32_32x32x16_bf16(pa0,PK(0),o[d0],0,0,0);
    o[d0]=__builtin_amdgcn_mfma_f32_32x32x16_bf16(pa1,PK(1),o[d0],0,0,0);
    o[d0]=__builtin_amdgcn_mfma_f32_32x32x16_bf16(pa2,PK(2),o[d0],0,0,0);
    o[d0]=__builtin_amdgcn_mfma_f32_32x32x16_bf16(pa3,PK(3),o[d0],0,0,0);
    #undef PK
  }
}

struct AttnP { const bf16* Qw0; const bf16* Kh; const bf16* Vh; bf16* Ow0; int NT; int tbase; int toff; int qr0; float qscale; };
template<int THRL,int MODE,int QP,int KP,int VP,int OP> __device__ __forceinline__ void attn_unit(const AttnP&A,char*shm,const int tid){
  const int lane=tid&63,r32=lane&31,hi=lane>>5; const int wid=__builtin_amdgcn_readfirstlane(tid>>6);
  const bf16*Qw=A.Qw0+(long)(wid*QBLK)*QP;
  const bf16*Kh=A.Kh,*Vh=A.Vh;
  const int NT=A.NT;
  #define TROW(t) ((MODE==1)?(A.tbase+(((t)+A.toff)%NT)):(t))
  const unsigned lds0=(unsigned)(uintptr_t)shm;
  float*wsf=(float*)(shm+LDS_WS)+wid*64;
  const bf16*ksrc=Kh+(long)lane*KP+wid*8;
  const bf16*vsrc=Vh+(long)(16*(wid&3)+(lane>>2))*VP+(wid>>2)*32+(lane&3)*8;
  const unsigned kdst=lds0+LDS_K+wid*1024, vdst=lds0+LDS_V+wid*1024;
  #define DMA_K(t,slot) glds16(ksrc+(long)TROW(t)*KVBLK*KP,(unsigned)__builtin_amdgcn_readfirstlane(kdst+(slot)))
  #define DMA_V(t,slot) glds16(vsrc+(long)TROW(t)*KVBLK*VP,(unsigned)__builtin_amdgcn_readfirstlane(vdst+(slot)))
  const int vb0=(int)(lds0+LDS_V)+((lane>>4)&1)*32+(lane&3)*8+(4*hi+((lane&15)>>2))*64;
  const char*Kbase=shm+LDS_K; bf16x8 kf[8];
  const lds_cptr shm3=(lds_cptr)shm; const lds_cptr kp0=shm3+LDS_K+hi*1024+r32*16; const lds_cptr vp0=shm3+LDS_V+((lane>>4)&1)*32+(lane&3)*8+(4*hi+((lane&15)>>2))*64;
  DMA_K(0,0);DMA_V(0,0);DMA_K(1,SLOTB);
  bf16x8 qr[4];
  #pragma unroll
  for(int d0=0;d0<4;++d0)qr[d0]=*reinterpret_cast<const bf16x8*>(&Qw[(long)r32*QP+d0*16+hi*8]);
  if(MODE==1){
    #pragma unroll
    for(int d0=0;d0<4;++d0){ u32x4 w=__builtin_bit_cast(u32x4,qr[d0]);
      #pragma unroll
      for(int j=0;j<4;++j){ const float lo=__uint_as_float(w[j]<<16)*A.qscale, hv=__uint_as_float(w[j]&0xffff0000u)*A.qscale; w[j]=cvtpk_s(lo,hv);} qr[d0]=__builtin_bit_cast(bf16x8,w);} }
  const int na_qr=A.qr0+(wid>>1), na_qc=32*(wid&1)+r32; int na_rs=na_qr-4; na_rs=na_rs<0?0:(na_rs>24?24:na_rs); int na_cs=na_qc-8; na_cs=na_cs<0?0:(na_cs>48?48:na_cs);
  const float*rpbl=(const float*)(shm+LDS_RPB);
  #define NAMASK(P0,P1,t) do{ if(MODE==1){ const int kr_=TROW(t); const bool wv_=(kr_>=na_rs)&&(kr_<=na_rs+7); const float*tb_=rpbl+(kr_-na_qr+7)*31+(15-na_qc); const float NEG_=-INFINITY; \
      _Pragma("unroll") for(int r=0;r<16;++r){ const int kc_=crow(r,hi); const bool o0_=wv_&&(kc_>=na_cs)&&(kc_<na_cs+16); const bool o1_=wv_&&(kc_+32>=na_cs)&&(kc_+32<na_cs+16); \
        const float b0_=o0_?tb_[kc_]:0.f; const float b1_=o1_?tb_[kc_+32]:0.f; P0[r]=o0_?(P0[r]+b0_):NEG_; P1[r]=o1_?(P1[r]+b1_):NEG_; } } }while(0)
  float mhat=0.f,l_reg=0.f;f32x16 o[2];o[0]=f32x16{};o[1]=f32x16{};
  #define CMASK(P0,P1,t) NAMASK(P0,P1,t)
  bool resc=false;
  #define START(P0,P1) do{ const float rm=rowmax(P0,P1); resc=false; \
    { const float dl=rm; mhat=fadd_s(mhat,dl); \
      _Pragma("unroll") for(int r=0;r<16;++r){P0[r]=fsub_s(P0[r],dl);P1[r]=fsub_s(P1[r],dl);} \
      } \
    _Pragma("unroll") for(int r=0;r<16;++r)P0[r]=__builtin_amdgcn_exp2f(P0[r]); }while(0)
  #define RESC() do{ if(resc){ asm volatile("s_waitcnt lgkmcnt(0)":::"memory"); \
      _Pragma("unroll") for(int d_=0;d_<2;++d_) _Pragma("unroll") for(int r=0;r<16;++r)o[d_][r]*=wsf[crow(r,hi)]; } }while(0)
  f32x16 pA0,pA1,pB0,pB1;
  int sl_prev=0,sl_cur=0,sl_next=SLOTB;
  #define ROT() do{sl_prev=sl_cur;sl_cur=sl_next;sl_next=(sl_next==(NSLOT-1)*SLOTB)?0:sl_next+SLOTB;}while(0)
  DMA_K(2,2*SLOTB);
  WAIT_BAR(3);
  qkt(pA0,pA1,Kbase,qr,r32,hi);asm volatile("s_nop 15\n\ts_nop 7":"+v"(pA0),"+v"(pA1));CMASK(pA0,pA1,0);
  START(pA0,pA1);
  _Pragma("unroll") for(int r=0;r<16;++r)pA1[r]=__builtin_amdgcn_exp2f(pA1[r]);
  WAIT_BAR(0);
  DMA_K(3,0);DMA_V(1,SLOTB);
  ROT();
  kload8(kf,kp0+sl_cur);
  WAIT_BAR(2);
  s16x4 vlo[8],vhi[8]; u32x4 pw0,pw1,pw2,pw3;
  #define PKW(P,B) cvtpk_s(P[B],P[B+1])
  #define PAF(k) __builtin_bit_cast(bf16x8,pw##k)
  #define VFR(i) (bf16x8){vlo[i][0],vlo[i][1],vlo[i][2],vlo[i][3],vhi[i][0],vhi[i][1],vhi[i][2],vhi[i][3]}
  #define PIN(x) asm volatile("":"+v"(x))
  #define MX3(a,b,c) __builtin_fmaxf(__builtin_fmaxf((a),(b)),(c))
  #define GAPA(MF,A0,A1,A2,A3,W0,W1,PW) do{ MF; sacc+=A0; sacc+=A1; sacc+=A2; sacc+=A3; PIN(sacc); W0; W1; PIN(PW); SBAR(); }while(0)
  #define EX(v) __builtin_amdgcn_exp2f(v)
  #define GAPB(MF,X,B) do{ MF; X[B]=EX(X[B]); X[B+1]=EX(X[B+1]); X[B+2]=EX(X[B+2]); X[B+3]=EX(X[B+3]); PIN(X); SBAR(); }while(0)
  #define VRD(i) do{ vlo[i]=vtr(vp_+(((i)>>2)*4096+((i)&3)*1024)); vhi[i]=vtr(vp_+(((i)>>2)*4096+((i)&3)*1024+512)); }while(0)
  #define KRD(G,j) do{ if(G){ kload2(kf,kp0+sl_next,j); SBAR(); } }while(0)
  #define STEP(C0,C1,P0,P1,t,GK,GV,GL) do{ SBAR(); const f32x16 ZC_=f32x16{}; \
    const lds_cptr vp_=vp0+sl_prev; \
    VRD(0); SBAR(); float sacc=(P0[0]+P0[1]); \
    GAPA(C0=__builtin_amdgcn_mfma_f32_32x32x16_bf16(kf[0],qr[0],ZC_,0,0,0), P0[2],P0[3],P0[4],P0[5],     pw0[0]=PKW(P0,0), pw0[1]=PKW(P0,2), pw0); \
    VRD(4); SBAR(); GAPA(C1=__builtin_amdgcn_mfma_f32_32x32x16_bf16(kf[1],qr[0],ZC_,0,0,0), P0[6],P0[7],P0[8],P0[9],     pw0[2]=PKW(P0,4), pw0[3]=PKW(P0,6), pw0); \
    VRD(1); SBAR(); GAPA(C0=__builtin_amdgcn_mfma_f32_32x32x16_bf16(kf[2],qr[1],C0,0,0,0),   P0[10],P0[11],P0[12],P0[13], pw1[0]=PKW(P0,8), pw1[1]=PKW(P0,10), pw1); \
    VRD(5); SBAR(); GAPA(C1=__builtin_amdgcn_mfma_f32_32x32x16_bf16(kf[3],qr[1],C1,0,0,0),   P0[14],P0[15],P1[0],P1[1],   pw1[2]=PKW(P0,12),pw1[3]=PKW(P0,14), pw1); \
    VRD(2); SBAR(); GAPA(C0=__builtin_amdgcn_mfma_f32_32x32x16_bf16(kf[4],qr[2],C0,0,0,0),   P1[2],P1[3],P1[4],P1[5],     pw2[0]=PKW(P1,0), pw2[1]=PKW(P1,2), pw2); \
    VRD(6); SBAR(); GAPA(C1=__builtin_amdgcn_mfma_f32_32x32x16_bf16(kf[5],qr[2],C1,0,0,0),   P1[6],P1[7],P1[8],P1[9],     pw2[2]=PKW(P1,4), pw2[3]=PKW(P1,6), pw2); \
    VRD(3); SBAR(); GAPA(C0=__builtin_amdgcn_mfma_f32_32x32x16_bf16(kf[6],qr[3],C0,0,0,0),   P1[10],P1[11],P1[12],P1[13], pw3[0]=PKW(P1,8), pw3[1]=PKW(P1,10), pw3); \
    VRD(7); SBAR(); GAPA(C1=__builtin_amdgcn_mfma_f32_32x32x16_bf16(kf[7],qr[3],C1,0,0,0),   P1[14],P1[15],0.f,0.f,       pw3[2]=PKW(P1,12),pw3[3]=PKW(P1,14), pw3); \
    l_reg+=sacc; \
    if(GK){DMA_K((t)+3,sl_cur);} if(GV){DMA_V((t)+1,sl_next);} \
    _Pragma("unroll") for(int r=0;r<16;++r){C0[r]-=mhat;C1[r]-=mhat;} \
    CMASK(C0,C1,t); \
    { float a=MX3(C0[0],C0[1],C1[0]),b=MX3(C0[2],C0[3],C1[1]); a=MX3(a,C1[2],C1[3]); \
      _Pragma("unroll") for(int r=4;r<16;r+=4){a=MX3(a,C0[r],C0[r+1]);b=MX3(b,C0[r+2],C0[r+3]);a=MX3(a,C1[r],C1[r+1]);b=MX3(b,C1[r+2],C1[r+3]);} \
      float rm=__builtin_fmaxf(a,b); { auto rr=__builtin_amdgcn_permlane32_swap(__float_as_uint(rm),__float_as_uint(rm),false,false); rm=__builtin_fmaxf(__uint_as_float(rr[0]),__uint_as_float(rr[1])); } \
      resc=false; \
      if(__builtin_expect(__any(rm>(float)THRL),0)){ const float dl=__builtin_fmaxf(rm,0.f); mhat+=dl; \
        _Pragma("unroll") for(int r=0;r<16;++r){C0[r]-=dl;C1[r]-=dl;} \
        const float f=__builtin_amdgcn_exp2f(-dl); l_reg*=f; if(hi==0)wsf[r32]=f; resc=true; } } \
    SBAR(); \
    GAPB(o[0]=__builtin_amdgcn_mfma_f32_32x32x16_bf16(PAF(0),VFR(0),o[0],0,0,0), C0,0); \
    GAPB(o[1]=__builtin_amdgcn_mfma_f32_32x32x16_bf16(PAF(0),VFR(4),o[1],0,0,0), C0,4); \
    KRD(GL,0); GAPB(o[0]=__builtin_amdgcn_mfma_f32_32x32x16_bf16(PAF(1),VFR(1),o[0],0,0,0), C0,8); \
    KRD(GL,1); GAPB(o[1]=__builtin_amdgcn_mfma_f32_32x32x16_bf16(PAF(1),VFR(5),o[1],0,0,0), C0,12); \
    KRD(GL,2); GAPB(o[0]=__builtin_amdgcn_mfma_f32_32x32x16_bf16(PAF(2),VFR(2),o[0],0,0,0), C1,0); \
    KRD(GL,3); GAPB(o[1]=__builtin_amdgcn_mfma_f32_32x32x16_bf16(PAF(2),VFR(6),o[1],0,0,0), C1,4); \
    GAPB(o[0]=__builtin_amdgcn_mfma_f32_32x32x16_bf16(PAF(3),VFR(3),o[0],0,0,0), C1,8); \
    GAPB(o[1]=__builtin_amdgcn_mfma_f32_32x32x16_bf16(PAF(3),VFR(7),o[1],0,0,0), C1,12); \
    }while(0)
  int t=1;
  for(;t+5<NT;t+=2){
    STEP(pB0,pB1,pA0,pA1,t,true,true,true);     WAIT_BAR(2); RESC(); ROT();
    STEP(pA0,pA1,pB0,pB1,t+1,true,true,true);   WAIT_BAR(2); RESC(); ROT();
  }
  #define ENDW(tt) do{ if((tt)+3<NT){WAIT_BAR(2);} else if((tt)+2<NT){WAIT_BAR(1);} else {WAIT_BAR(0);} }while(0)
  for(;t+1<NT;t+=2){
    STEP(pB0,pB1,pA0,pA1,t,(t+3<NT),(t+1<NT),(t+1<NT));       ENDW(t);   RESC(); ROT();
    STEP(pA0,pA1,pB0,pB1,t+1,(t+4<NT),(t+2<NT),(t+2<NT));     ENDW(t+1); RESC(); ROT();
  }
  STEP(pB0,pB1,pA0,pA1,NT-1,false,false,false); RESC();
  { float sacc=pB0[0]+pB0[1]; _Pragma("unroll") for(int r=2;r<16;++r)sacc+=pB0[r]; _Pragma("unroll") for(int r=0;r<16;++r)sacc+=pB1[r]; l_reg+=sacc;
    pw0=(u32x4){PKW(pB0,0),PKW(pB0,2),PKW(pB0,4),PKW(pB0,6)};pw1=(u32x4){PKW(pB0,8),PKW(pB0,10),PKW(pB0,12),PKW(pB0,14)};pw2=(u32x4){PKW(pB1,0),PKW(pB1,2),PKW(pB1,4),PKW(pB1,6)};pw3=(u32x4){PKW(pB1,8),PKW(pB1,10),PKW(pB1,12),PKW(pB1,14)};
    SBAR(); pv(o,vb0+sl_cur,PAF(0),PAF(1),PAF(2),PAF(3)); }
  #undef PKW
  #undef PAF
  #undef VFR
  #undef PIN
  #undef MX3
  #undef GAPA
  #undef GAPB
  #undef EX
  #undef VRD
  #undef KRD
  #undef STEP
  #undef ENDW
  {auto rr=__builtin_amdgcn_permlane32_swap(__float_as_uint(l_reg),__float_as_uint(l_reg),false,false);l_reg=__uint_as_float(rr[0])+__uint_as_float(rr[1]);}
  if(hi==0)wsf[32+r32]=l_reg;asm volatile("s_waitcnt lgkmcnt(0)":::"memory");
  float rli[16];
  #pragma unroll
  for(int r=0;r<16;++r)rli[r]=__builtin_amdgcn_rcpf(wsf[32+crow(r,hi)]);
  bf16*Ow=A.Ow0+(long)(wid*QBLK)*OP;
  { bf16*stg=(bf16*)(shm+LDS_OST)+wid*2048;
    #pragma unroll
    for(int r=0;r<16;++r){const int orow=crow(r,hi);
      #pragma unroll
      for(int d0=0;d0<2;++d0)stg[orow*64+d0*32+r32]=__float2bfloat16(o[d0][r]*rli[r]);}
    asm volatile("s_waitcnt lgkmcnt(0)":::"memory");
    #pragma unroll
    for(int i=0;i<4;++i){const int row=i*8+(lane>>3),ch=lane&7; const u32x4 v=*(const u32x4*)(stg+row*64+ch*8); u32x4*dst=(u32x4*)(Ow+(long)row*OP+ch*8); const u32x4 g=*dst; u32x4 w;
      #pragma unroll
      for(int j=0;j<4;++j){ const float g0=__uint_as_float(g[j]<<16),g1=__uint_as_float(g[j]&0xffff0000u); const float o0=__uint_as_float(v[j]<<16),o1=__uint_as_float(v[j]&0xffff0000u);
        w[j]=cvtpk_s(o0*g0*__builtin_amdgcn_rcpf(1.f+__expf(-g0)),o1*g1*__builtin_amdgcn_rcpf(1.f+__expf(-g1))); }
      *dst=w; } }
  asm volatile("s_waitcnt lgkmcnt(0)\n\ts_barrier":::"memory");
  #undef DMA_K
  #undef DMA_V
  #undef CMASK
  #undef NAMASK
  #undef TROW
  #undef START
  #undef RESC
  #undef ROT
}
constexpr int ATTN_LDS_BYTES=LDS_BYTES;

#undef SBAR
#undef WAIT_BAR
}
namespace mk {
__device__ __forceinline__ void ph_attn(char* shm, bf16* P, const bf16* Qn, const bf16* Kn, const float* rpb, int nb, int tid, unsigned* ticket, volatile LAS unsigned* slot) {
    using attn_body::AttnP; typedef attn_body::bf16 abf;
    const int nunits = nb * 64;
#pragma unroll 1
    for (;;) {
        if (tid == 0) *slot = __hip_atomic_fetch_add(ticket, 1u, __ATOMIC_RELAXED, __HIP_MEMORY_SCOPE_AGENT);
        __syncthreads();
        const int uu = (int)__builtin_amdgcn_readfirstlane((int)*slot);
        __syncthreads();
        if (uu >= 2 * nunits) break;
        if (uu < nunits) { const int u = uu; const int b = u >> 6, h = (u >> 3) & 7, qb = u & 7, g = h >> 2; const size_t rb = (size_t)b * SEQ;
            AttnP A; A.Qw0 = (const abf*)(Qn + (rb + qb * 256) * 512 + h * 64); A.Kh = (const abf*)(Kn + rb * 128 + g * 64);
            A.Vh = (const abf*)(P + rb * LDP + PC_QKVC + 640 + g * 64); A.Ow0 = (abf*)(P + (rb + qb * 256) * LDP + PC_GC + h * 64);
            A.NT = 32; A.tbase = 0; A.toff = 0; A.qr0 = 0; A.qscale = 1.f;
            int tid2 = tid; asm volatile("" : "+v"(tid2)); attn_body::attn_unit<8, 0, 512, 128, LDP, LDP>(A, shm, tid2);
        } else { const int u = uu - nunits; const int b = u >> 6, h = (u >> 3) & 7, qb = u & 7; const size_t rb = (size_t)b * SEQ; const int qr0 = qb * 4;
            { float* tb = (float*)(shm + attn_body::LDS_RPB); for (int i = tid; i < 465; i += 512) tb[i] = rpb[h * 465 + i] * 1.4426950408889634f; }
            int rs0 = qr0 - 4; rs0 = rs0 < 0 ? 0 : (rs0 > 24 ? 24 : rs0); int rs3 = qr0 - 1; rs3 = rs3 < 0 ? 0 : (rs3 > 24 ? 24 : rs3); int NT = rs3 - rs0 + 8; NT += (NT & 1);
            AttnP A; A.Qw0 = (const abf*)(P + (rb + qb * 256) * LDP + PC_QKVD + h * 64); A.Kh = (const abf*)(P + rb * LDP + PC_QKVD + 512 + h * 64);
            A.Vh = (const abf*)(P + rb * LDP + PC_QKVD + 1024 + h * 64); A.Ow0 = (abf*)(P + (rb + qb * 256) * LDP + PC_GD + h * 64);
            A.NT = NT; A.tbase = rs0; A.toff = rs3 - rs0; A.qr0 = qr0; A.qscale = C2;
            int tid2 = tid; asm volatile("" : "+v"(tid2)); attn_body::attn_unit<8, 1, LDP, LDP, LDP, LDP>(A, shm, tid2); }
    }
}
}
namespace mk {
constexpr int RW_CH = 32;
constexpr int RW_P64 = 144, RW_P32 = 80, RW_TA_ROW = 144;
constexpr int RW_CONST = 0;
constexpr int RW_TA_LO = 4 * RW_TA_ROW;
constexpr int RW_PW = RW_CONST + 960 * 4, RW_PWB = 2 * RW_TA_LO + 2 * 4 * 64 * 4;
constexpr int RW_WT = RW_PW + 8 * RW_PWB;
constexpr int RW_WTOT = RW_WT + 2 * 64 * RW_TA_ROW;
constexpr int RW_TAL = RW_WTOT + 8 * 64 * 4;
constexpr int RW_TS = RW_TAL + 32 * RW_P64;
constexpr int O_TRH = 0, O_TBE = O_TRH + 32 * RW_P64, O_TKA = O_TBE + 32 * RW_P64, O_TBP = O_TKA + 32 * RW_P64, O_TKP = O_TBP + 64 * RW_P32, O_VT = O_TKP + 64 * RW_P32, O_GC = O_VT + 64 * RW_P32, RW_TSB = O_GC + 256;
constexpr int RW_S0B = RW_TS + 2 * RW_TSB;
constexpr int RW_UB = RW_S0B + 2 * 64 * RW_P64;
constexpr int RW_RF = RW_UB + 64 * RW_P32;
constexpr int RW_ABF = RW_RF + 64 * 36 * 4;
constexpr int RW_CORR = RW_ABF + 32 * 36 * 4;
constexpr int RW_DUMP = RW_CORR + 64 * 20 * 4;
constexpr int RW_LDS_END = RW_DUMP + 256;
static_assert(RW_LDS_END <= 163840 - 16, "rwkv lds");
#define RW_BAR() do { asm volatile("s_waitcnt lgkmcnt(0)" ::: "memory"); __builtin_amdgcn_s_barrier(); asm volatile("" ::: "memory"); } while (0)
__device__ __forceinline__ float dppf(float x, const int ctrl_sel) {
    const int xi = __builtin_bit_cast(int, x); int r;
    if (ctrl_sel == 0) r = __builtin_amdgcn_update_dpp(0, xi, 0xB1, 0xf, 0xf, true);
    else if (ctrl_sel == 1) r = __builtin_amdgcn_update_dpp(0, xi, 0x4E, 0xf, 0xf, true);
    else if (ctrl_sel == 2) r = __builtin_amdgcn_update_dpp(0, xi, 0x141, 0xf, 0xf, true);
    else r = __builtin_amdgcn_update_dpp(0, xi, 0x140, 0xf, 0xf, true);
    return __builtin_bit_cast(float, r);
}
__device__ __forceinline__ float sum16(float x) { x += dppf(x, 0); x += dppf(x, 1); x += dppf(x, 2); x += dppf(x, 3); return x; }
__device__ __forceinline__ float rw_fma(float a, float b, float c) { float r; asm("v_fma_f32 %0, %1, %2, %3" : "=v"(r) : "v"(a), "v"(b), "v"(c)); return r; }
__device__ __forceinline__ int rwcrow(int r, int hi) { return (r & 3) + 8 * (r >> 2) + 4 * hi; }
__device__ __forceinline__ unsigned rwpk(float lo, float hi) { typedef float f2 __attribute__((ext_vector_type(2))); typedef __bf16 b2 __attribute__((ext_vector_type(2))); f2 v = {lo, hi}; b2 b = __builtin_convertvector(v, b2); return __builtin_bit_cast(unsigned, b); }
__device__ __forceinline__ f32x16 rw_cc(const LAS unsigned char* X, const LAS unsigned char* Y, int r32, int hi) {
    f32x16 d = f32x16{};
#pragma unroll
    for (int s = 0; s < 4; ++s) d = __builtin_amdgcn_mfma_f32_32x32x16_bf16(*(const LAS bf16x8*)(X + r32 * RW_P64 + 32 * s + 16 * hi), *(const LAS bf16x8*)(Y + r32 * RW_P64 + 32 * s + 16 * hi), d, 0, 0, 0);
    return d;
}
__device__ __forceinline__ f32x16 rw_accmul(f32x16 acc, const LAS unsigned char* Lt_row, const f32x16& M, int hi) {
    v4u m0, m1; m0.x = rwpk(M[0], M[1]); m0.y = rwpk(M[2], M[3]); m0.z = rwpk(M[4], M[5]); m0.w = rwpk(M[6], M[7]); m1.x = rwpk(M[8], M[9]); m1.y = rwpk(M[10], M[11]); m1.z = rwpk(M[12], M[13]); m1.w = rwpk(M[14], M[15]);
#pragma unroll
    for (int s = 0; s < 2; ++s) { const LAS unsigned char* p = Lt_row + 2 * (16 * s + 4 * hi); const v2u lo = *(const LAS v2u*)p, hv = *(const LAS v2u*)(p + 16); v4u av; av.x = lo.x; av.y = lo.y; av.z = hv.x; av.w = hv.y;
        acc = __builtin_amdgcn_mfma_f32_32x32x16_bf16(__builtin_bit_cast(bf16x8, av), __builtin_bit_cast(bf16x8, s == 0 ? m0 : m1), acc, 0, 0, 0); }
    return acc;
}
__device__ __forceinline__ void rwkv_item(LAS unsigned char* lds_dyn, const bf16* P, int T, int z, int b, int h, const float* mu, const float* w0, const float* w_up, const float* a0, const float* a_up,
                                          const float* k_k, const float* k_a, const float* r_k, bf16* YB, float* CB, bf16* VB, const int tid_in) {
    (void)lds_dyn; LAS unsigned char* const lds = (LAS unsigned char*)(unsigned)0;
    unsigned mk_ = ~0u; int wv_ = tid_in; asm volatile("" : "+s"(mk_), "+s"(wv_));
    const int tid = wv_ * 64 + (int)__builtin_amdgcn_mbcnt_hi(mk_, __builtin_amdgcn_mbcnt_lo(mk_, 0u));
    const int lane0 = tid & 63, wave = __builtin_amdgcn_readfirstlane(tid >> 6);
    LAS float* CN = (LAS float*)(lds + RW_CONST);
    for (int i = tid; i < 960; i += 512) { float v;
        if (i < 640) { const int m = i / 320, j = i % 320, g = j >> 6, c = j & 63; const int ch = (g < 3 ? g * 512 + h * 64 : (g == 3 ? 1536 + z * 64 : 1664 + z * 64)) + c; v = mu[m * 1792 + ch]; }
        else { const int j = i - 640, g = j >> 6, c = j & 63; v = g == 0 ? w0[z * 512 + h * 64 + c] : g == 1 ? a0[z * 512 + h * 64 + c] : g == 2 ? k_k[h * 64 + c] : g == 3 ? k_a[h * 64 + c] : r_k[h * 64 + c]; }
        CN[i] = v; }
    for (int i = tid; i < 2 * 64 * 64; i += 512) { const int lo = i >> 12, k = (i >> 6) & 63, n = i & 63; const float* U = (lo == 0 ? w_up : a_up) + (size_t)z * 64 * 512 + h * 64;
        *(LAS unsigned short*)(lds + RW_WT + lo * 64 * RW_TA_ROW + n * RW_TA_ROW + 2 * k) = (unsigned short)f2bf(U[(size_t)k * 512 + n]); }
    for (int i = tid; i < 2 * 64 * RW_P64 / 4; i += 512) ((LAS unsigned*)(lds + RW_S0B))[i] = 0u;
    __syncthreads();
    const int NCH = SEQ / RW_CH;
    const int gcol[5] = {PC_SLAB + h * 64, PC_SLAB + 512 + h * 64, PC_SLAB + 1024 + h * 64, PC_SLAB + 1536 + z * 64, PC_SLAB + 1664 + z * 64};
    const size_t tb0 = (size_t)b * SEQ;
    v2u rawc[2][5], rawe[5];
#define RW_ROWOFF(step_) ({ const int i__ = (step_); int l__ = z ? (SEQ - 1 - i__) : i__; l__ = l__ < 0 ? 0 : (l__ > SEQ - 1 ? SEQ - 1 : l__); ((unsigned)(tb0 + l__) * (unsigned)LDP + 4u * (unsigned)cq) * 2u; })
#define RW_LOAD(cc) do { const GAS unsigned char* Pb_ = (const GAS unsigned char*)P; const int s0_ = (cc) * RW_CH + 4 * vw0; \
    const unsigned r0_ = RW_ROWOFF(s0_ + js), r1_ = RW_ROWOFF(s0_ + 4 + js), re_ = RW_ROWOFF(js == 0 ? s0_ - 1 : (js == 3 ? s0_ + 8 : s0_ + js)); \
    _Pragma("unroll") for (int g = 0; g < 5; ++g) { rawc[0][g] = *(const GAS v2u*)(Pb_ + (r0_ + 2u * (unsigned)gcol[g])); rawc[1][g] = *(const GAS v2u*)(Pb_ + (r1_ + 2u * (unsigned)gcol[g])); rawe[g] = *(const GAS v2u*)(Pb_ + (re_ + 2u * (unsigned)gcol[g])); } } while (0)
    { const int lane = lane0, js = lane >> 4, cq = lane & 15, vw0 = wave >= 4 ? 2 * (wave - 4) : 0; RW_LOAD(0); }
    f32x16 accS[2] = {f32x16{}, f32x16{}};
    LAS float* const WTOT = (LAS float*)(lds + RW_WTOT); LAS float* const RF = (LAS float*)(lds + RW_RF); LAS float* const ABF = (LAS float*)(lds + RW_ABF); LAS float* const CORR = (LAS float*)(lds + RW_CORR);
#pragma unroll 1
    for (int it = 0; it <= NCH; ++it) {
        int lane_ = lane0; asm volatile("" : "+v"(lane_));
        const int lane = lane_, r32 = lane & 31, hi = lane >> 5, js = lane >> 4, cq = lane & 15;
        const int cp = it, cc = it - 1;
        const bool prep = (wave >= 4) && (cp < NCH), chain = (wave < 4) && (cc >= 0);
        const int vw0 = 2 * (wave - 4); const int sjv[2] = {4 * vw0 + js, 4 * (vw0 + 1) + js};
        LAS unsigned char* const tsp = lds + RW_TS + (cp & 1) * RW_TSB; const LAS unsigned char* const tsc = lds + RW_TS + (cc & 1) * RW_TSB;
        const LAS unsigned char* S0cur = lds + RW_S0B + (cc & 1) * 64 * RW_P64; LAS unsigned char* S0nxt = lds + RW_S0B + ((cc + 1) & 1) * 64 * RW_P64;
        float sv[2][3][4];
        float o_kk[2][4], o_r[2][4], o_b[2][4], o_kd[2][4], o_v[2][4], lw2[2][4], Lin[2][4];
        if (prep) {
            float sw_[2][2][4];
            asm volatile("s_waitcnt vmcnt(0)" ::: "memory");
#pragma unroll
            for (int g = 0; g < 5; ++g) { const f32x4 m0 = *(const LAS f32x4*)(CN + g * 64 + 4 * cq), m1 = *(const LAS f32x4*)(CN + 320 + g * 64 + 4 * cq);
                const int am = ((lane - 16) & 63) << 2, ap = ((lane + 16) & 63) << 2;
                v2u A0, A1, B0, B1;
                A0.x = (unsigned)__builtin_amdgcn_ds_bpermute(am, (int)rawc[0][g].x); A0.y = (unsigned)__builtin_amdgcn_ds_bpermute(am, (int)rawc[0][g].y); A1.x = (unsigned)__builtin_amdgcn_ds_bpermute(am, (int)rawc[1][g].x); A1.y = (unsigned)__builtin_amdgcn_ds_bpermute(am, (int)rawc[1][g].y);
                B0.x = (unsigned)__builtin_amdgcn_ds_bpermute(ap, (int)rawc[0][g].x); B0.y = (unsigned)__builtin_amdgcn_ds_bpermute(ap, (int)rawc[0][g].y); B1.x = (unsigned)__builtin_amdgcn_ds_bpermute(ap, (int)rawc[1][g].x); B1.y = (unsigned)__builtin_amdgcn_ds_bpermute(ap, (int)rawc[1][g].y);
#pragma unroll
                for (int u = 0; u < 2; ++u) { const int i_ = cp * RW_CH + sjv[u]; const int l_ = z ? (SEQ - 1 - i_) : i_; const bool okp = (l_ - 1 >= 0), okn = (l_ + 1 < SEQ);
                    const v2u sm = u == 0 ? (js == 0 ? rawe[g] : A0) : (js == 0 ? A0 : A1), sp = u == 0 ? (js == 3 ? B1 : B0) : (js == 3 ? rawe[g] : B1);
                    const v2u lm = z ? sp : sm, lp = z ? sm : sp;
                    const v2u rp = {okp ? lm.x : 0u, okp ? lm.y : 0u}, rn_ = {okn ? lp.x : 0u, okn ? lp.y : 0u};
                    const float pr[4] = {bflo(rp.x), bfhi(rp.x), bflo(rp.y), bfhi(rp.y)}, cu[4] = {bflo(rawc[u][g].x), bfhi(rawc[u][g].x), bflo(rawc[u][g].y), bfhi(rawc[u][g].y)}, nx[4] = {bflo(rn_.x), bfhi(rn_.x), bflo(rn_.y), bfhi(rn_.y)};
#pragma unroll
                    for (int e = 0; e < 4; ++e) { const float val = cu[e] + m0[e] * (pr[e] - cu[e]) + m1[e] * (nx[e] - cu[e]); if (g < 3) sv[u][g][e] = val; else sw_[u][g - 3][e] = val; } } }
#pragma unroll
            for (int u = 0; u < 2; ++u) {
#pragma unroll
                for (int g = 0; g < 3; ++g) asm volatile("" : "+v"(sv[u][g][0]), "+v"(sv[u][g][1]), "+v"(sv[u][g][2]), "+v"(sv[u][g][3]) :: "memory");
#pragma unroll
                for (int g = 0; g < 2; ++g) asm volatile("" : "+v"(sw_[u][g][0]), "+v"(sw_[u][g][1]), "+v"(sw_[u][g][2]), "+v"(sw_[u][g][3]) :: "memory"); }
            __builtin_amdgcn_sched_barrier(0);
            LAS unsigned char* const TAw = lds + RW_PW + vw0 * RW_PWB;
            LAS float* const LRw = (LAS float*)(TAw + 2 * 8 * RW_TA_ROW);
#pragma unroll
            for (int u = 0; u < 2; ++u) { float th[4];
#pragma unroll
                for (int e = 0; e < 4; ++e) { const float ex = __builtin_amdgcn_exp2f(sw_[u][0][e] * 2.8853900817779268f); th[e] = 1.f - 2.f * __builtin_amdgcn_rcpf(1.f + ex); }
                v2u t0; t0.x = pk2(th[0], th[1]); t0.y = pk2(th[2], th[3]); *(LAS v2u*)(TAw + (4 * u + js) * RW_TA_ROW + 8 * cq) = t0;
                v2u t1; t1.x = pk2(sw_[u][1][0], sw_[u][1][1]); t1.y = pk2(sw_[u][1][2], sw_[u][1][3]); *(LAS v2u*)(TAw + 8 * RW_TA_ROW + (4 * u + js) * RW_TA_ROW + 8 * cq) = t1; }
        } else if (chain) {
            if (wave < 2) {
                const int v0 = 32 * wave; f32x16 acc = f32x16{};
#pragma unroll
                for (int s = 0; s < 4; ++s) acc = __builtin_amdgcn_mfma_f32_32x32x16_bf16(*(const LAS bf16x8*)(S0cur + (v0 + r32) * RW_P64 + 32 * s + 16 * hi), *(const LAS bf16x8*)(lds + RW_TAL + r32 * RW_P64 + 32 * s + 16 * hi), acc, 0, 0, 0);
                f32x16 ak = rw_cc(tsc + O_TKA, lds + RW_TAL, r32, hi);
#pragma unroll
                for (int r = 0; r < 16; ++r) ak[r] = (rwcrow(r, hi) < r32) ? ak[r] : 0.f;
                acc = rw_accmul(acc, tsc + O_VT + (v0 + r32) * RW_P32, ak, hi);
#pragma unroll
                for (int r = 0; r < 16; ++r) RF[(v0 + rwcrow(r, hi)) * 36 + r32] = acc[r];
            } else if (wave == 2) {
                f32x16 ab = rw_cc(tsc + O_TBE, lds + RW_TAL, r32, hi);
#pragma unroll
                for (int r = 0; r < 16; ++r) ABF[rwcrow(r, hi) * 36 + r32] = (rwcrow(r, hi) < r32) ? ab[r] : 0.f;
            }
        }
        RW_BAR();
        if (prep) {
            {   LAS unsigned char* const TAw = lds + RW_PW + vw0 * RW_PWB; LAS float* const LRw = (LAS float*)(TAw + 2 * 8 * RW_TA_ROW);
            {
                LAS float* const lrb = lane < 32 ? LRw + (4 * (lane >> 4)) * 64 + (lane & 15) : (LAS float*)(lds + RW_DUMP); const int rs = lane < 32 ? 64 : 0, ls = lane < 32 ? 512 : 0, ns = lane < 32 ? 16 : 0;
                bf16x8 Af[2][2], Wf[2][4][2]; f32x4 accL[2][4];
#pragma unroll
                for (int lo = 0; lo < 2; ++lo) { Af[lo][0] = *(const LAS bf16x8*)(TAw + lo * 8 * RW_TA_ROW + (lane & 15) * RW_TA_ROW + 16 * (lane >> 4)); Af[lo][1] = *(const LAS bf16x8*)(TAw + lo * 8 * RW_TA_ROW + (lane & 15) * RW_TA_ROW + 64 + 16 * (lane >> 4));
#pragma unroll
                    for (int nt = 0; nt < 4; ++nt) { const LAS unsigned char* wt = lds + RW_WT + lo * 64 * RW_TA_ROW + (16 * nt + (lane & 15)) * RW_TA_ROW + 16 * (lane >> 4); Wf[lo][nt][0] = *(const LAS bf16x8*)(wt); Wf[lo][nt][1] = *(const LAS bf16x8*)(wt + 64); } }
#pragma unroll
                for (int lo = 0; lo < 2; ++lo)
#pragma unroll
                    for (int nt = 0; nt < 4; ++nt) { f32x4 acc = {0.f, 0.f, 0.f, 0.f}; acc = __builtin_amdgcn_mfma_f32_16x16x32_bf16(Af[lo][0], Wf[lo][nt][0], acc, 0, 0, 0); accL[lo][nt] = __builtin_amdgcn_mfma_f32_16x16x32_bf16(Af[lo][1], Wf[lo][nt][1], acc, 0, 0, 0); }
#pragma unroll
                for (int lo = 0; lo < 2; ++lo)
#pragma unroll
                    for (int nt = 0; nt < 4; ++nt) { LAS float* lr = lrb + lo * ls + nt * ns; lr[0] = accL[lo][nt][0]; lr[rs] = accL[lo][nt][1]; lr[2 * rs] = accL[lo][nt][2]; lr[3 * rs] = accL[lo][nt][3]; } }
            }
            asm volatile("s_waitcnt lgkmcnt(0)" ::: "memory");
            LAS float* const LRw = (LAS float*)(lds + RW_PW + vw0 * RW_PWB + 2 * 8 * RW_TA_ROW); float bo_[2];
            f32x4 lw_[2], la_[2];
#pragma unroll
            for (int u = 0; u < 2; ++u) { lw_[u] = *(const LAS f32x4*)(LRw + (4 * u + js) * 64 + 4 * cq); la_[u] = *(const LAS f32x4*)(LRw + 512 + (4 * u + js) * 64 + 4 * cq); }
            const f32x4 c_w0 = *(const LAS f32x4*)(CN + 640 + 4 * cq), c_a0 = *(const LAS f32x4*)(CN + 704 + 4 * cq), c_kk = *(const LAS f32x4*)(CN + 768 + 4 * cq), c_ka = *(const LAS f32x4*)(CN + 832 + 4 * cq), c_rk = *(const LAS f32x4*)(CN + 896 + 4 * cq);
#pragma unroll
            for (int u = 0; u < 2; ++u) { const f32x4 lw = lw_[u], la = la_[u];
                float kx[4], n2 = 0.f;
#pragma unroll
                for (int e = 0; e < 4; ++e) { kx[e] = sv[u][1][e] * c_kk[e]; n2 += kx[e] * kx[e]; }
                n2 = sum16(n2); const float rn = __builtin_amdgcn_rsqf(fmaxf(n2, 1e-24f));
                float bo = 0.f;
#pragma unroll
                for (int e = 0; e < 4; ++e) { const float wraw = lw[e] + c_w0[e];
                    lw2[u][e] = -0.8750387749480469f * __builtin_amdgcn_rcpf(1.f + __expf(-wraw));
                    const float aa = __builtin_amdgcn_rcpf(1.f + __expf(-(la[e] + c_a0[e]))); o_kk[u][e] = kx[e] * rn; o_kd[u][e] = sv[u][1][e] * (1.f + (aa - 1.f) * c_ka[e]); o_b[u][e] = o_kk[u][e] * aa; o_r[u][e] = sv[u][0][e]; o_v[u][e] = sv[u][2][e];
                    bo += o_r[u][e] * o_kd[u][e] * c_rk[e]; }
                bo_[u] = sum16(bo);
#pragma unroll
                for (int e = 0; e < 4; ++e) { float x = lw2[u][e];
                    const float y1 = __builtin_bit_cast(float, __builtin_amdgcn_ds_bpermute(((lane - 16) & 63) << 2, __builtin_bit_cast(int, x))); x += (js >= 1) ? y1 : 0.f;
                    const float y2 = __builtin_bit_cast(float, __builtin_amdgcn_ds_bpermute(((lane - 32) & 63) << 2, __builtin_bit_cast(int, x))); x += (js >= 2) ? y2 : 0.f; Lin[u][e] = x; } }
#pragma unroll
            for (int u = 0; u < 2; ++u) { LAS float* wp = js == 3 ? WTOT + (vw0 + u) * 64 + 4 * cq : (LAS float*)(lds + RW_DUMP); *(LAS f32x4*)wp = (f32x4){Lin[u][0], Lin[u][1], Lin[u][2], Lin[u][3]}; }
#pragma unroll
            for (int u = 0; u < 2; ++u) { const int i_ = cp * RW_CH + sjv[u]; const int l_ = z ? (SEQ - 1 - i_) : i_; const size_t t = tb0 + l_;
                if (cq == 0) *(GAS float*)(CB + ((size_t)(z * 8 + h)) * T + t) = bo_[u];
                if (z == 0) { v2u vb; vb.x = pk2(o_v[u][0], o_v[u][1]); vb.y = pk2(o_v[u][2], o_v[u][3]); *(GAS v2u*)(VB + t * 512 + h * 64 + 4 * cq) = vb; } }
            __builtin_amdgcn_sched_barrier(0);
            { const int cn = cp + 1 < NCH ? cp + 1 : cp; RW_LOAD(cn); }
            __builtin_amdgcn_sched_barrier(0);
        } else if (chain && wave == 0) {
            LAS float* row = RF + lane * 36;
#define RW_SOLVE16(o_) do { float u[16]; \
            _Pragma("unroll") for (int q4 = 0; q4 < 4; ++q4) { f32x4 rr = *(const LAS f32x4*)(row + (o_) + 4 * q4); if ((o_) != 0) rr += *(const LAS f32x4*)(CORR + lane * 20 + 4 * q4); u[4 * q4] = rr[0]; u[4 * q4 + 1] = rr[1]; u[4 * q4 + 2] = rr[2]; u[4 * q4 + 3] = rr[3]; } \
            _Pragma("unroll") for (int tb = 0; tb < 4; ++tb) { f32x4 A_[4][4]; \
                _Pragma("unroll") for (int r_ = 0; r_ < 4; ++r_) _Pragma("unroll") for (int q4 = tb; q4 < 4; ++q4) A_[r_][q4] = *(const LAS f32x4*)(ABF + ((o_) + 4 * tb + r_) * 36 + (o_) + 4 * q4); \
                _Pragma("unroll") for (int r_ = 0; r_ < 4; ++r_) { const int tt = 4 * tb + r_; if (tt < 15) { const float nut = -u[tt]; \
                    _Pragma("unroll") for (int q4 = (tt + 1) / 4; q4 < 4; ++q4) { const f32x4 aa = A_[r_][q4]; \
                        _Pragma("unroll") for (int e_ = 0; e_ < 4; ++e_) if (4 * q4 + e_ > tt) u[4 * q4 + e_] = rw_fma(nut, aa[e_], u[4 * q4 + e_]); } } } } \
            v4u w0_, w1_; w0_.x = pk2(-u[0], -u[1]); w0_.y = pk2(-u[2], -u[3]); w0_.z = pk2(-u[4], -u[5]); w0_.w = pk2(-u[6], -u[7]); w1_.x = pk2(-u[8], -u[9]); w1_.y = pk2(-u[10], -u[11]); w1_.z = pk2(-u[12], -u[13]); w1_.w = pk2(-u[14], -u[15]); \
            *(LAS v4u*)(lds + RW_UB + lane * RW_P32 + 2 * (o_)) = w0_; *(LAS v4u*)(lds + RW_UB + lane * RW_P32 + 2 * (o_) + 16) = w1_; } while (0)
            RW_SOLVE16(0);
            asm volatile("s_waitcnt lgkmcnt(0)" ::: "memory");
            {
                v4u bw = {0u, 0u, 0u, 0u};
                if (r32 < 16) { const LAS float* ap = ABF + (8 * hi) * 36 + 16 + r32; bw.x = pk2(ap[0], ap[36]); bw.y = pk2(ap[72], ap[108]); bw.z = pk2(ap[144], ap[180]); bw.w = pk2(ap[216], ap[252]); }
#pragma unroll
                for (int vt = 0; vt < 2; ++vt) { f32x16 d = f32x16{};
                    d = __builtin_amdgcn_mfma_f32_32x32x16_bf16(*(const LAS bf16x8*)(lds + RW_UB + (32 * vt + r32) * RW_P32 + 16 * hi), __builtin_bit_cast(bf16x8, bw), d, 0, 0, 0);
                    if (r32 < 16) {
#pragma unroll
                        for (int r = 0; r < 16; ++r) CORR[(32 * vt + rwcrow(r, hi)) * 20 + r32] = d[r]; } }
            }
            asm volatile("s_waitcnt lgkmcnt(0)" ::: "memory");
            RW_SOLVE16(16);
#undef RW_SOLVE16
        }
        RW_BAR();
        if (prep) {
            f32x4 offu[2] = {{0.f, 0.f, 0.f, 0.f}, {0.f, 0.f, 0.f, 0.f}}, tot = {0.f, 0.f, 0.f, 0.f};
#pragma unroll
            for (int w = 0; w < 8; ++w) { const f32x4 tw = *(const LAS f32x4*)(WTOT + w * 64 + 4 * cq); tot += tw; if (w < vw0) offu[0] += tw; if (w < vw0 + 1) offu[1] += tw; }
#pragma unroll
            for (int u = 0; u < 2; ++u) { const int sj = sjv[u]; const f32x4 off = offu[u];
                float al[4], rh[4], be[4], ka[4], bp[4], kp[4];
#pragma unroll
                for (int e = 0; e < 4; ++e) { const float Lt = off[e] + Lin[u][e]; const float gprev = __builtin_amdgcn_exp2f(Lt - lw2[u][e]), gt = __builtin_amdgcn_exp2f(Lt), gi = __builtin_amdgcn_exp2f(-Lt), gp = __builtin_amdgcn_exp2f(tot[e] - Lt);
                    al[e] = gprev * o_kk[u][e]; rh[e] = gt * o_r[u][e]; be[e] = o_b[u][e] * gi; ka[e] = o_kd[u][e] * gi; bp[e] = o_b[u][e] * gp; kp[e] = o_kd[u][e] * gp; }
                v2u w; w.x = pk2(al[0], al[1]); w.y = pk2(al[2], al[3]); *(LAS v2u*)(lds + RW_TAL + sj * RW_P64 + 8 * cq) = w;
                w.x = pk2(rh[0], rh[1]); w.y = pk2(rh[2], rh[3]); *(LAS v2u*)(tsp + O_TRH + sj * RW_P64 + 8 * cq) = w;
                w.x = pk2(be[0], be[1]); w.y = pk2(be[2], be[3]); *(LAS v2u*)(tsp + O_TBE + sj * RW_P64 + 8 * cq) = w;
                w.x = pk2(ka[0], ka[1]); w.y = pk2(ka[2], ka[3]); *(LAS v2u*)(tsp + O_TKA + sj * RW_P64 + 8 * cq) = w;
#pragma unroll
                for (int e = 0; e < 4; ++e) { *(LAS unsigned short*)(tsp + O_TBP + (4 * cq + e) * RW_P32 + 2 * sj) = (unsigned short)f2bf(bp[e]); *(LAS unsigned short*)(tsp + O_TKP + (4 * cq + e) * RW_P32 + 2 * sj) = (unsigned short)f2bf(kp[e]);
                    *(LAS unsigned short*)(tsp + O_VT + (4 * cq + e) * RW_P32 + 2 * sj) = (unsigned short)f2bf(o_v[u][e]); }
                if (u == 1) { LAS float* gp_ = sj == 31 ? (LAS float*)(tsp + O_GC) + 4 * cq : (LAS float*)(lds + RW_DUMP); *(LAS f32x4*)gp_ = (f32x4){__builtin_amdgcn_exp2f(tot[0]), __builtin_amdgcn_exp2f(tot[1]), __builtin_amdgcn_exp2f(tot[2]), __builtin_amdgcn_exp2f(tot[3])}; } }
        } else if (chain) {
            if (wave < 2) {
                const int v0 = 32 * wave; f32x16 accY = f32x16{};
#pragma unroll
                for (int s = 0; s < 4; ++s) accY = __builtin_amdgcn_mfma_f32_32x32x16_bf16(*(const LAS bf16x8*)(S0cur + (v0 + r32) * RW_P64 + 32 * s + 16 * hi), *(const LAS bf16x8*)(tsc + O_TRH + r32 * RW_P64 + 32 * s + 16 * hi), accY, 0, 0, 0);
                { f32x16 bk = rw_cc(tsc + O_TKA, tsc + O_TRH, r32, hi);
#pragma unroll
                  for (int r = 0; r < 16; ++r) bk[r] = (rwcrow(r, hi) <= r32) ? bk[r] : 0.f;
                  accY = rw_accmul(accY, tsc + O_VT + (v0 + r32) * RW_P32, bk, hi); }
                { f32x16 bbm = rw_cc(tsc + O_TBE, tsc + O_TRH, r32, hi);
#pragma unroll
                  for (int r = 0; r < 16; ++r) bbm[r] = (rwcrow(r, hi) <= r32) ? bbm[r] : 0.f;
                  accY = rw_accmul(accY, lds + RW_UB + (v0 + r32) * RW_P32, bbm, hi); }
                {
                    const int iy = cc * RW_CH + r32; const int ly = z ? (SEQ - 1 - iy) : iy; GAS unsigned char* yb = (GAS unsigned char*)YB + (((size_t)z * T + tb0 + ly) * 512 + h * 64 + v0 + 4 * hi) * 2;
#pragma unroll
                    for (int g4 = 0; g4 < 4; ++g4) { v2u o; o.x = pk2(accY[4 * g4], accY[4 * g4 + 1]); o.y = pk2(accY[4 * g4 + 2], accY[4 * g4 + 3]); *(GAS v2u*)(yb + 16 * g4) = o; } }
            } else {
#pragma unroll
                for (int q = 0; q < 2; ++q) { const int sw = 2 * (wave - 2) + q, v0 = 32 * (sw & 1), k0 = 32 * (sw >> 1);
                    const float gcv = ((const LAS float*)(tsc + O_GC))[k0 + r32];
#pragma unroll
                    for (int r = 0; r < 16; ++r) accS[q][r] *= gcv;
#pragma unroll
                    for (int s = 0; s < 2; ++s) {
                        accS[q] = __builtin_amdgcn_mfma_f32_32x32x16_bf16(*(const LAS bf16x8*)(tsc + O_VT + (v0 + r32) * RW_P32 + 32 * s + 16 * hi), *(const LAS bf16x8*)(tsc + O_TKP + (k0 + r32) * RW_P32 + 32 * s + 16 * hi), accS[q], 0, 0, 0);
                        accS[q] = __builtin_amdgcn_mfma_f32_32x32x16_bf16(*(const LAS bf16x8*)(lds + RW_UB + (v0 + r32) * RW_P32 + 32 * s + 16 * hi), *(const LAS bf16x8*)(tsc + O_TBP + (k0 + r32) * RW_P32 + 32 * s + 16 * hi), accS[q], 0, 0, 0); } }
#pragma unroll
                for (int q = 0; q < 2; ++q) { const int sw = 2 * (wave - 2) + q, v0 = 32 * (sw & 1), k0 = 32 * (sw >> 1);
#pragma unroll
                    for (int r = 0; r < 16; ++r) *(LAS unsigned short*)(S0nxt + (v0 + rwcrow(r, hi)) * RW_P64 + 2 * (k0 + r32)) = (unsigned short)f2bf(accS[q][r]); } }
        }
        RW_BAR();
    }
#undef RW_LOAD
#undef RW_ROWOFF
    __syncthreads();
}
__device__ __forceinline__ void ph_rwkv(LAS unsigned char* lds, const bf16* P, int T, int nb, const float* mu, const float* w0, const float* w_up, const float* a0, const float* a_up, const float* k_k, const float* k_a, const float* r_k,
                                        bf16* YB, float* CB, bf16* VB, int tid, int bid, int nblk) {
    const int wv = __builtin_amdgcn_readfirstlane(tid >> 6);
#pragma unroll 1
    for (int it = bid; it < nb * 16; it += nblk) { const int z = it & 1, h = (it >> 1) & 7, b = it >> 4; rwkv_item(lds, P, T, z, b, h, mu, w0, w_up, a0, a_up, k_k, k_a, r_k, YB, CB, VB, wv); }
}
}
namespace mk {
constexpr int SS_RP = 272;
constexpr int SS_XP = 144;
constexpr int SS_BM = 0, SS_CM = SS_BM + 128 * SS_RP, SS_XN = SS_CM + 128 * SS_RP, SS_SB = SS_XN + 128 * SS_XP, SS_CUM = SS_SB + 128 * SS_XP, SS_MT = SS_CUM + 1024, SS_END = SS_MT + 10 * 2048;
__device__ __forceinline__ v2u ss_tr(unsigned addr) { v2u r; asm volatile("ds_read_b64_tr_b16 %0, %1" : "=&v"(r) : "v"(addr) : "memory"); return r; }
__device__ __forceinline__ void ss_wait4(v2u& a, v2u& b, v2u& c, v2u& d) { asm volatile("s_waitcnt lgkmcnt(0)" : "+v"(a), "+v"(b), "+v"(c), "+v"(d) :: "memory"); }
constexpr int SS_YP = 144;
static_assert(SS_END <= 147456, "ssd lds"); static_assert(SS_XP % 8 == 0 && SS_RP % 8 == 0, "transpose reads need 8-byte aligned rows");
__device__ __forceinline__ int crow(int r, int hi) { return (r & 3) + 8 * (r >> 2) + 4 * hi; }
__device__ __forceinline__ bf16x8 ldsA(const LAS unsigned char* base, int row, int colbyte) { return *(const LAS bf16x8*)(base + row * SS_RP + colbyte); }
__device__ __forceinline__ unsigned cvtpk(float lo, float hi) { typedef float f2 __attribute__((ext_vector_type(2))); typedef __bf16 b2 __attribute__((ext_vector_type(2))); f2 v = {lo, hi}; b2 b = __builtin_convertvector(v, b2); return __builtin_bit_cast(unsigned, b); }
__device__ __forceinline__ void ssd_item(LAS unsigned char* lds, const bf16* XC, const float* DT, const float* a_log, bf16* YA, int T, int z, int b, int h, const int tid) {
    const int lane = tid & 63, wave = __builtin_amdgcn_readfirstlane(tid >> 6), r32 = lane & 31, hi = lane >> 5;
    const int pt = wave & 1, qt = wave >> 1, g = h >> 2;
    const float a2 = -__expf(a_log[z * 8 + h]) * 1.4426950408889634f;
    LAS float* CUM = (LAS float*)(lds + SS_CUM);
    for (int i = tid; i < 128 * SS_XP / 4; i += 512) ((LAS unsigned*)(lds + SS_SB))[i] = 0u;
    f32x16 accS = f32x16{};
    const size_t tb0 = (size_t)b * SEQ;
    v4u pwb[4], pwc[4], pwx[2]; float pd[2], pl0, pl1;
#define SS_LOAD(cc) do { const GAS unsigned char* Xb_ = (const GAS unsigned char*)XC; const GAS unsigned char* Db_ = (const GAS unsigned char*)DT;     \
    _Pragma("unroll") for (int i = 0; i < 4; ++i) { const int idx = tid + 512 * i, q = idx >> 4, c8 = idx & 15; const int pos = 128 * (cc) + q; const unsigned t = (unsigned)tb0 + (unsigned)(z ? (SEQ - 1 - pos) : pos); \
        const unsigned o_ = (t * 1024u + 512u + (unsigned)(g * 128 + 8 * c8)) * 2u; pwb[i] = *(const GAS v4u*)(Xb_ + o_); pwc[i] = *(const GAS v4u*)(Xb_ + (o_ + 512u)); } \
    _Pragma("unroll") for (int i = 0; i < 2; ++i) { const int idx = tid + 512 * i, q = idx >> 3, c8 = idx & 7; const int pos = 128 * (cc) + q; const unsigned t = (unsigned)tb0 + (unsigned)(z ? (SEQ - 1 - pos) : pos); \
        pwx[i] = *(const GAS v4u*)(Xb_ + (t * 1024u + (unsigned)(h * 64 + 8 * c8)) * 2u); pd[i] = *(const GAS float*)(Db_ + (t * 16u + (unsigned)(z * 8 + h)) * 4u); } \
    { const int p0 = 128 * (cc) + 2 * lane; const unsigned t0 = (unsigned)tb0 + (unsigned)(z ? (SEQ - 1 - p0) : p0), t1 = (unsigned)tb0 + (unsigned)(z ? (SEQ - 2 - p0) : (p0 + 1)); pl0 = *(const GAS float*)(Db_ + (t0 * 16u + (unsigned)(z * 8 + h)) * 4u); pl1 = *(const GAS float*)(Db_ + (t1 * 16u + (unsigned)(z * 8 + h)) * 4u); } } while (0)
    SS_LOAD(0);
#pragma unroll 1
    for (int c = 0; c < SEQ / 128; ++c) {
        asm volatile("s_waitcnt vmcnt(2)" ::: "memory");
        __syncthreads();
#pragma unroll
        for (int i = 0; i < 4; ++i) { const int idx = tid + 512 * i, q = idx >> 4, c8 = idx & 15;
            *(LAS v4u*)(lds + SS_BM + q * SS_RP + 16 * c8) = pwb[i]; *(LAS v4u*)(lds + SS_CM + q * SS_RP + 16 * c8) = pwc[i]; }
#pragma unroll
        for (int i = 0; i < 2; ++i) { const int idx = tid + 512 * i, q = idx >> 3, c8 = idx & 7; const v4u wx = pwx[i]; const float d = pd[i]; v4u o;
            o.x = pk2(bflo(wx.x) * d, bfhi(wx.x) * d); o.y = pk2(bflo(wx.y) * d, bfhi(wx.y) * d); o.z = pk2(bflo(wx.z) * d, bfhi(wx.z) * d); o.w = pk2(bflo(wx.w) * d, bfhi(wx.w) * d);
            *(LAS v4u*)(lds + SS_XN + q * SS_XP + 16 * c8) = o; }
        if (wave == 0) {
            const float l0 = pl0 * a2, l1 = pl1 * a2; float x = l0 + l1;
#pragma unroll
            for (int o = 1; o < 64; o <<= 1) { const float y = __builtin_bit_cast(float, __builtin_amdgcn_ds_bpermute(((lane - o) & 63) << 2, __builtin_bit_cast(int, x))); x += (lane >= o) ? y : 0.f; }
            *(LAS f32x2v*)(CUM + 2 * lane) = (f32x2v){x - l1, x}; }
        __syncthreads();
        asm volatile("" ::: "memory"); __builtin_amdgcn_sched_barrier(0);
        SS_LOAD(c + 1 < SEQ / 128 ? c + 1 : c);
        __builtin_amdgcn_sched_barrier(0);
        const float cq = CUM[32 * qt + r32], clast = CUM[127];
        f32x16 acc = f32x16{};
        { bf16x8 cf[8];
#pragma unroll
          for (int s = 0; s < 8; ++s) cf[s] = ldsA(lds + SS_CM, 32 * qt + r32, 32 * s + 16 * hi);
          { const unsigned sa = (unsigned)(uintptr_t)(lds + SS_SB) + (unsigned)((8 * hi + ((lane & 15) >> 2)) * SS_XP + (32 * pt + 16 * ((lane >> 4) & 1) + 4 * (lane & 3)) * 2);
            v2u sl[8], sh[8];
#pragma unroll
            for (int s = 0; s < 8; ++s) { sl[s] = ss_tr(sa + 16 * s * SS_XP); sh[s] = ss_tr(sa + (16 * s + 4) * SS_XP); }
#pragma unroll
            for (int s = 0; s < 4; ++s) ss_wait4(sl[2 * s], sh[2 * s], sl[2 * s + 1], sh[2 * s + 1]);
#pragma unroll
            for (int s = 0; s < 8; ++s) { v4u av; av.x = sl[s].x; av.y = sl[s].y; av.z = sh[s].x; av.w = sh[s].y; acc = __builtin_amdgcn_mfma_f32_32x32x16_bf16(__builtin_bit_cast(bf16x8, av), cf[s], acc, 0, 0, 0); } }
          const float eq = __builtin_amdgcn_exp2f(cq);
#pragma unroll
          for (int r = 0; r < 16; ++r) acc[r] *= eq; }
#pragma unroll 1
        for (int tI = wave; tI < 10; tI += 8) { const int q2 = tI < 1 ? 0 : (tI < 3 ? 1 : (tI < 6 ? 2 : 3)), kt = tI - q2 * (q2 + 1) / 2; const float cq2 = CUM[32 * q2 + r32];
            f32x16 gT = f32x16{};
#pragma unroll
            for (int s = 0; s < 8; ++s) gT = __builtin_amdgcn_mfma_f32_32x32x16_bf16(ldsA(lds + SS_BM, 32 * kt + r32, 32 * s + 16 * hi), ldsA(lds + SS_CM, 32 * q2 + r32, 32 * s + 16 * hi), gT, 0, 0, 0);
#pragma unroll
            for (int gq = 0; gq < 4; ++gq) { const f32x4 ck = *(const LAS f32x4*)(CUM + 32 * kt + 8 * gq + 4 * hi);
#pragma unroll
                for (int e = 0; e < 4; ++e) { const int r = 4 * gq + e; const bool ok = (kt < q2) || (8 * gq + 4 * hi + e <= r32); const float m = __builtin_amdgcn_exp2f(cq2 - ck[e]); gT[r] = ok ? gT[r] * m : 0.f; } }
            v4u m0, m1; m0.x = cvtpk(gT[0], gT[1]); m0.y = cvtpk(gT[2], gT[3]); m0.z = cvtpk(gT[4], gT[5]); m0.w = cvtpk(gT[6], gT[7]); m1.x = cvtpk(gT[8], gT[9]); m1.y = cvtpk(gT[10], gT[11]); m1.z = cvtpk(gT[12], gT[13]); m1.w = cvtpk(gT[14], gT[15]);
            *(LAS v4u*)(lds + SS_MT + tI * 2048 + lane * 32) = m0; *(LAS v4u*)(lds + SS_MT + tI * 2048 + lane * 32 + 16) = m1; }
        __syncthreads();
#pragma unroll
        for (int kh = 0; kh < 2; ++kh) {
            v2u xl[2][4]; v4u mm[2][2];
#pragma unroll
            for (int k2 = 0; k2 < 2; ++k2) { const int kt = 2 * kh + k2, ktc = kt <= qt ? kt : qt;
                const unsigned xa = (unsigned)(uintptr_t)(lds + SS_XN) + (unsigned)((32 * ktc + 4 * hi + ((lane & 15) >> 2)) * SS_XP + (32 * pt + 16 * ((lane >> 4) & 1) + 4 * (lane & 3)) * 2);
                xl[k2][0] = ss_tr(xa); xl[k2][1] = ss_tr(xa + 8 * SS_XP); xl[k2][2] = ss_tr(xa + 16 * SS_XP); xl[k2][3] = ss_tr(xa + 24 * SS_XP);
                const LAS unsigned char* mp = lds + SS_MT + (qt * (qt + 1) / 2 + ktc) * 2048 + lane * 32; mm[k2][0] = *(const LAS v4u*)mp; mm[k2][1] = *(const LAS v4u*)(mp + 16); }
#pragma unroll
            for (int k2 = 0; k2 < 2; ++k2) { const int kt = 2 * kh + k2; ss_wait4(xl[k2][0], xl[k2][1], xl[k2][2], xl[k2][3]);
                if (kt <= qt) { v4u a0; a0.x = xl[k2][0].x; a0.y = xl[k2][0].y; a0.z = xl[k2][1].x; a0.w = xl[k2][1].y; v4u a1; a1.x = xl[k2][2].x; a1.y = xl[k2][2].y; a1.z = xl[k2][3].x; a1.w = xl[k2][3].y;
                    acc = __builtin_amdgcn_mfma_f32_32x32x16_bf16(__builtin_bit_cast(bf16x8, a0), __builtin_bit_cast(bf16x8, mm[k2][0]), acc, 0, 0, 0);
                    acc = __builtin_amdgcn_mfma_f32_32x32x16_bf16(__builtin_bit_cast(bf16x8, a1), __builtin_bit_cast(bf16x8, mm[k2][1]), acc, 0, 0, 0); } } }
        __syncthreads();
        { LAS unsigned short* ys = (LAS unsigned short*)(lds + SS_CM + (32 * qt + r32) * SS_YP) + 32 * pt;
#pragma unroll
          for (int g4 = 0; g4 < 4; ++g4) { v2u o; o.x = pk2(acc[4 * g4], acc[4 * g4 + 1]); o.y = pk2(acc[4 * g4 + 2], acc[4 * g4 + 3]); *(LAS v2u*)(ys + 8 * g4 + 4 * hi) = o; } }
        { const int q = tid >> 2, p0 = 16 * (tid & 3); LAS unsigned char* xr = lds + SS_XN + q * SS_XP + 2 * p0; v4u w0 = *(LAS v4u*)xr, w1 = *(LAS v4u*)(xr + 16);
          const float e = __builtin_amdgcn_exp2f(clast - CUM[q]);
          w0.x = pk2(bflo(w0.x) * e, bfhi(w0.x) * e); w0.y = pk2(bflo(w0.y) * e, bfhi(w0.y) * e); w0.z = pk2(bflo(w0.z) * e, bfhi(w0.z) * e); w0.w = pk2(bflo(w0.w) * e, bfhi(w0.w) * e);
          w1.x = pk2(bflo(w1.x) * e, bfhi(w1.x) * e); w1.y = pk2(bflo(w1.y) * e, bfhi(w1.y) * e); w1.z = pk2(bflo(w1.z) * e, bfhi(w1.z) * e); w1.w = pk2(bflo(w1.w) * e, bfhi(w1.w) * e);
          *(LAS v4u*)xr = w0; *(LAS v4u*)(xr + 16) = w1; }
        __syncthreads();
#pragma unroll
        for (int i = 0; i < 2; ++i) { const int idx = tid + 512 * i, q = idx >> 3, c8 = idx & 7; const int pos = 128 * c + q; const size_t t = tb0 + (z ? (SEQ - 1 - pos) : pos);
            *(GAS v4u*)(YA + ((size_t)z * T + t) * 512 + h * 64 + 8 * c8) = *(const LAS v4u*)(lds + SS_CM + q * SS_YP + 16 * c8); }
        { const float dl = __builtin_amdgcn_exp2f(clast);
#pragma unroll
          for (int r = 0; r < 16; ++r) accS[r] *= dl;
          { const int rq = 8 * hi + ((lane & 15) >> 2), cg = 16 * ((lane >> 4) & 1) + 4 * (lane & 3);
            const unsigned xa = (unsigned)(uintptr_t)(lds + SS_XN) + (unsigned)(rq * SS_XP + (32 * pt + cg) * 2), ba = (unsigned)(uintptr_t)(lds + SS_BM) + (unsigned)(rq * SS_RP + (32 * qt + cg) * 2);
            v2u al[8], ah[8], bl[8], bh[8];
#pragma unroll
            for (int s = 0; s < 8; ++s) { al[s] = ss_tr(xa + 16 * s * SS_XP); ah[s] = ss_tr(xa + (16 * s + 4) * SS_XP); bl[s] = ss_tr(ba + 16 * s * SS_RP); bh[s] = ss_tr(ba + (16 * s + 4) * SS_RP); }
#pragma unroll
            for (int s = 0; s < 8; ++s) ss_wait4(al[s], ah[s], bl[s], bh[s]);
#pragma unroll
            for (int s = 0; s < 8; ++s) { v4u av; av.x = al[s].x; av.y = al[s].y; av.z = ah[s].x; av.w = ah[s].y; v4u bv; bv.x = bl[s].x; bv.y = bl[s].y; bv.z = bh[s].x; bv.w = bh[s].y;
                accS = __builtin_amdgcn_mfma_f32_32x32x16_bf16(__builtin_bit_cast(bf16x8, av), __builtin_bit_cast(bf16x8, bv), accS, 0, 0, 0); } }
          LAS unsigned char* sb = lds + SS_SB + (32 * qt + r32) * SS_XP + (32 * pt + 4 * hi) * 2;
#pragma unroll
          for (int g4 = 0; g4 < 4; ++g4) { v2u o; o.x = pk2(accS[4 * g4], accS[4 * g4 + 1]); o.y = pk2(accS[4 * g4 + 2], accS[4 * g4 + 3]); *(LAS v2u*)(sb + 16 * g4) = o; } }
    }
#undef SS_LOAD
    __syncthreads();
}
__device__ __forceinline__ void ph_ssd(LAS unsigned char* lds, const bf16* XC, const float* DT, const float* a_log, bf16* YA, int T, int nb, int tid, int bid, int nblk, int blk0) {
#pragma unroll 1
    for (int it = (bid - blk0 + nblk) % nblk; it < nb * 16; it += nblk) { const int z = it & 1, h = (it >> 1) & 7, b = it >> 4; ssd_item(lds, XC, DT, a_log, YA, T, z, b, h, tid); }
}
}
namespace mk {
#define XB_TMO      128
#define XB_XCNT(j)  (256  + 64 * (j))
#define XB_XSUB(j)  (1280 + 64 * (j))
#define XB_XGEN(j)  (2304 + 64 * (j))
#define XB_TOP      3328
#define XB_TOPGEN   3392
#define XCD_BAR_WORDS 3456
#define XB_SPIN_CAP (1u << 18)

__device__ __forceinline__ unsigned xb_ld(unsigned* p)              { return __hip_atomic_load(p, __ATOMIC_RELAXED, __HIP_MEMORY_SCOPE_AGENT); }
__device__ __forceinline__ unsigned xb_add(unsigned* p, unsigned v) { return __hip_atomic_fetch_add(p, v, __ATOMIC_RELAXED, __HIP_MEMORY_SCOPE_AGENT); }
__device__ __forceinline__ unsigned xb_xcc_id() { return (unsigned)__builtin_amdgcn_s_getreg((3 << 11) | 20) & 0xFu; }
#define XB_SPIN(cond, bar) do { unsigned _sp = 0; while (cond) { __builtin_amdgcn_s_sleep(1); \
    if ((++_sp & 255u) == 0u) { if (xb_ld(&(bar)[XB_TMO])) break; if (_sp > XB_SPIN_CAP) { atomicAdd(&(bar)[XB_TMO], 1u); break; } } } } while (0)

struct XcdBarrier {
    unsigned* bar; unsigned x;
    volatile LAS unsigned* st;
};

__device__ __forceinline__ XcdBarrier xcd_barrier_post(unsigned* bar, volatile LAS unsigned* st) {
    XcdBarrier b; b.bar = bar; b.x = xb_xcc_id(); b.st = st;
    if (threadIdx.x == 0) (void)xb_add(&bar[XB_XCNT(b.x)], 1u);
    return b;
}
__device__ __forceinline__ void xcd_barrier_complete(unsigned* bar, unsigned x, unsigned& nloc, unsigned& nx) {
    const unsigned G = gridDim.x * gridDim.y * gridDim.z;
    unsigned sum, cnt, mine, sp = 0u;
    for (;;) {
        sum = 0u; cnt = 0u; mine = 0u;
#pragma unroll
        for (unsigned j = 0; j < 16; ++j) { const unsigned c = xb_ld(&bar[XB_XCNT(j)]); sum += c; cnt += (c > 0u) ? 1u : 0u; mine = (j == x) ? c : mine; }
        if (sum == G) break;
        __builtin_amdgcn_s_sleep(1);
        if ((++sp & 255u) == 0u) { if (xb_ld(&bar[XB_TMO])) break; if (sp > XB_SPIN_CAP) { atomicAdd(&bar[XB_TMO], 1u); break; } }
    }
    nloc = mine > 0u ? mine : 1u; nx = cnt > 0u ? cnt : 1u;
}

__device__ __forceinline__ void xcd_barrier(const XcdBarrier& b) {
    asm volatile("s_waitcnt vmcnt(0)" ::: "memory");
    __syncthreads();
    if (threadIdx.x == 0) {
        unsigned* bar = b.bar;
        __builtin_amdgcn_s_waitcnt(0);
        unsigned nloc = b.st[0], nx = b.st[1];
        if (nloc == 0u) { xcd_barrier_complete(bar, b.x, nloc, nx); b.st[0] = nloc; b.st[1] = nx; }
        const unsigned old = xb_add(&bar[XB_XSUB(b.x)], 1u);
        const unsigned gen = old / nloc;
        if (old + 1u == (gen + 1u) * nloc) {
            __builtin_amdgcn_fence(__ATOMIC_RELEASE, "agent");
            asm volatile("s_waitcnt vmcnt(0)" ::: "memory");
            const unsigned og = xb_add(&bar[XB_TOP], 1u);
            const unsigned tg = og / nx;
            if (og + 1u == (tg + 1u) * nx) xb_add(&bar[XB_TOPGEN], 1u);
            else XB_SPIN(xb_ld(&bar[XB_TOPGEN]) == tg, bar);
            __builtin_amdgcn_fence(__ATOMIC_ACQUIRE, "agent");
            xb_add(&bar[XB_XGEN(b.x)], 1u);
            asm volatile("s_waitcnt vmcnt(0)" ::: "memory");
        } else {
            XB_SPIN(xb_ld(&bar[XB_XGEN(b.x)]) == gen, bar);
            __builtin_amdgcn_fence(__ATOMIC_ACQUIRE, "agent");
            asm volatile("s_waitcnt vmcnt(0)" ::: "memory");
        }
    }
    __syncthreads();
}


}
#include <hip/hip_cooperative_groups.h>
namespace mk {
namespace cg = cooperative_groups;
constexpr int LDS_BYTES = 163840;
constexpr int NB_HALF = 8, TH = NB_HALF * SEQ;
constexpr size_t al256(size_t x) { return (x + 255) / 256 * 256; }
constexpr size_t WS_CTL = 0, CTL_BYTES = 65536, WS_W = CTL_BYTES, WS_ROPE = al256(WS_W + 2 * W_LAYER_ELEMS * 2), WS_H = al256(WS_ROPE + 2ull * SEQ * 32 * 4), WS_P = al256(WS_H + (size_t)TH * 1024 * 2), WS_X = al256(WS_P + (size_t)TH * LDP * 2);
constexpr size_t X_XC = 0, X_DT = al256(X_XC + (size_t)TH * 1024 * 2), X_QN = al256(X_DT + (size_t)TH * 16 * 4), X_KN = al256(X_QN + (size_t)TH * 512 * 2), X_YA = al256(X_KN + (size_t)TH * 128 * 2),
                 X_YB = al256(X_YA + 2ull * TH * 512 * 2), X_CB = al256(X_YB + 2ull * TH * 512 * 2), X_VB = al256(X_CB + 2ull * TH * 8 * 4), X_RS = al256(X_VB + (size_t)TH * 512 * 2), X_END1 = al256(X_RS + 9ull * SEQ * 512 * 4);
constexpr size_t X_MF = 0, X_MB = al256(X_MF + (size_t)TH * 1024 * 4), X_OF = al256(X_MB + (size_t)TH * 1024 * 2), X_END2 = al256(X_OF + (size_t)TH * 1024 * 4);
constexpr size_t WS_NEED = WS_X + (X_END1 > X_END2 ? X_END1 : X_END2);
static_assert(WS_NEED <= 536870912ull, "workspace map exceeds 512 MiB");
struct MegaArgs { const float* in[25]; float* out; unsigned char* ws; };
__global__ __launch_bounds__(512, 2) void k_mega(MegaArgs a) {
    extern __shared__ __attribute__((aligned(16))) unsigned char lds_[];
    LAS unsigned char* const lds = (LAS unsigned char*)(unsigned)0;
    cg::grid_group grid = cg::this_grid();
    volatile LAS unsigned* xbst = (volatile LAS unsigned*)(lds + LDS_BYTES - 16);
    if (threadIdx.x < 4) xbst[threadIdx.x] = 0u;
    __syncthreads();
    XcdBarrier xbar = xcd_barrier_post((unsigned*)(a.ws + WS_CTL), xbst);
#define GSYNC() xcd_barrier(xbar)
    const int wave0 = __builtin_amdgcn_readfirstlane((int)threadIdx.x >> 6);
#define PV int bid = blockIdx.x, wv_ = wave0; unsigned mk_ = ~0u; unsigned char* ws = a.ws; asm volatile("" : "+s"(bid), "+s"(wv_), "+s"(mk_), "+s"(ws)); int tid = wv_ * 64 + (int)__builtin_amdgcn_mbcnt_hi(mk_, __builtin_amdgcn_mbcnt_lo(mk_, 0u)); asm volatile("" : "+v"(tid)); const int lane = tid & 63, wave = wv_; const int gw = bid * 8 + wave, ngw = gridDim.x * 8, gtid = bid * 512 + tid, nthr = gridDim.x * 512; (void)lane; (void)wave; (void)gw; (void)ngw; (void)gtid; (void)nthr; bf16* Wall = (bf16*)(ws + WS_W); float* rope = (float*)(ws + WS_ROPE); bf16* H = (bf16*)(ws + WS_H); bf16* P = (bf16*)(ws + WS_P); unsigned char* X = ws + WS_X; bf16* XC = (bf16*)(X + X_XC); float* DT = (float*)(X + X_DT); bf16* Qn = (bf16*)(X + X_QN); bf16* Kn = (bf16*)(X + X_KN); bf16* YA = (bf16*)(X + X_YA); bf16* YB = (bf16*)(X + X_YB); float* CB = (float*)(X + X_CB); bf16* VB = (bf16*)(X + X_VB); float* Mf = (float*)(X + X_MF); bf16* Mb = (bf16*)(X + X_MB); float* OF = (float*)(X + X_OF); const bf16* W = Wall + (size_t)l * W_LAYER_ELEMS; (void)rope; (void)H; (void)P; (void)XC; (void)DT; (void)Qn; (void)Kn; (void)YA; (void)YB; (void)CB; (void)VB; (void)Mf; (void)Mb; (void)OF; (void)W;
    { const int l = 0; PV; ph_wconv(a.in[2], a.in[22], a.in[23], Wall, lds, gw, ngw, wave, lane); }
    { const int l = 0; PV; ph_rope_table(rope, gtid, nthr); }
    { const int l = 0; PV; ph_rmsnorm(a.in[0], a.in[1], H, TH, gw, ngw, lane); }
    grid.sync();
#pragma unroll 1
    for (int hf = 0; hf < 2; ++hf) {
#pragma unroll 1
        for (int l = 0; l < 2; ++l) {
            const size_t ro = (size_t)hf * TH * 1024; const float* xin = (l == 0 ? a.in[0] : a.out) + ro; float* xout = a.out + ro;
            { PV; ph_gemm_bf16out_range(lds, H, 1024, W + WOFF_W1, TH, (int)W1T_N, 1024, P, LDP, 0, 7, tid, bid); }
            GSYNC();
            { const int G_ = (int)gridDim.x, nwg_ = (TH / 256) * ((int)W1T_N / 256); int nb8 = nwg_ - 7 * G_; nb8 = nb8 < 0 ? 0 : (nb8 > G_ ? G_ : nb8);
              const bool ov = (7 * G_ >= 960) && (nb8 < G_);
              if (!ov || (int)blockIdx.x < nb8) { PV; ph_gemm_bf16out_range(lds, H, 1024, W + WOFF_W1, TH, (int)W1T_N, 1024, P, LDP, 7, 1 << 20, tid, bid); }
              if (!ov) GSYNC();
              if (!ov || (int)blockIdx.x >= nb8) { PV; const int off = ov ? nb8 * 512 : 0; ph_prep_conv(P, TH, a.in[3] + l * 5 * 1024, a.in[4] + l * 1024, a.in[5] + l * 16, XC, DT, gtid - off, nthr - off); } }
            { PV; ph_prep_gqa(P, TH, a.in[19] + l * 64, a.in[20] + l * 64, rope, Qn, Kn, gtid, nthr); }
            GSYNC();
            { PV; ph_rwkv(lds, P, TH, NB_HALF, a.in[9] + l * 2 * 1792, a.in[10] + l * 1024, a.in[11] + (size_t)l * 2 * 64 * 512, a.in[12] + l * 1024, a.in[13] + (size_t)l * 2 * 64 * 512, a.in[14] + l * 512, a.in[15] + l * 512, a.in[16] + l * 512, YB, CB, VB, tid, bid, (int)gridDim.x); }
            { PV; ph_ssd(lds, XC, DT, a.in[6] + l * 16, YA, TH, NB_HALF, tid, bid, (int)gridDim.x, 128); }
            { PV; ph_attn((char*)lds_, P, Qn, Kn, a.in[21] + l * 8 * 465, NB_HALF, tid, (unsigned*)(ws + WS_CTL) + 8192 + 64 * (2 * l + hf), (volatile LAS unsigned*)(lds + LDS_BYTES - 8)); }
            GSYNC();
            { PV; ph_post(P, TH, XC, YA, a.in[7] + l * 8, a.in[8] + l * 512, YB, CB, VB, a.in[17] + l * 512, a.in[18] + l * 512, gw, ngw, lane); }
            { PV; ph_gemm_rsigout(lds, H, 1024, W + WOFF_W2, TH, (int)W2T_N, 1024, P, LDP, tid, bid); }
            GSYNC();
            { PV; EpiMergeF E{Mb, P, LDP}; run_gemm(lds, P + PC_Y, LDP, W + WOFF_WB, TH, 1024, 2048, E, tid, bid); }
            GSYNC();
            { PV; EpiF32 E{OF, 1024}; run_gemm(lds, Mb, 1024, W + WOFF_WO, TH, 1024, 1024, E, tid, bid); }
            GSYNC();
            { PV; ph_fin(xin, OF, a.in[24] + l * 1024, xout, l == 0 ? a.in[1] + 1024 : nullptr, H, TH, gw, ngw, lane); }
            if (l == 1 && hf == 0) { PV; ph_rmsnorm(a.in[0] + (size_t)TH * 1024, a.in[1], H, TH, gw, ngw, lane); }
            GSYNC();
        }
    }
}
}
extern "C" void kernel_launch(void* const* d_in, const int* in_sizes, int n_in, void* d_out, int out_size, void* d_ws, size_t ws_size, hipStream_t stream) {
    static int grid_blocks = 0;
    if (!grid_blocks) {
        if (ws_size < mk::WS_NEED) { fprintf(stderr, "ws too small: need %zu have %zu\n", (size_t)mk::WS_NEED, ws_size); grid_blocks = -1; return; }
        int dev = 0, cus = 0, per_cu = 0; (void)hipGetDevice(&dev); (void)hipDeviceGetAttribute(&cus, hipDeviceAttributeMultiprocessorCount, dev);
        (void)hipFuncSetAttribute((const void*)mk::k_mega, hipFuncAttributeMaxDynamicSharedMemorySize, mk::LDS_BYTES);
        (void)hipOccupancyMaxActiveBlocksPerMultiprocessor(&per_cu, (const void*)mk::k_mega, 512, mk::LDS_BYTES);
        if (per_cu < 1) { fprintf(stderr, "occupancy query says %d blocks/CU\n", per_cu); per_cu = 1; }
        grid_blocks = cus;
        fprintf(stderr, "k_mega: cus %d per_cu %d grid %d ws_need %zu ws %zu\n", cus, per_cu, grid_blocks, (size_t)mk::WS_NEED, ws_size);
    }
    if (grid_blocks < 0) return;
    mk::MegaArgs a{}; for (int i = 0; i < 25; ++i) a.in[i] = (const float*)d_in[i]; a.out = (float*)d_out; a.ws = (unsigned char*)d_ws;
    (void)hipMemsetAsync((char*)d_ws + mk::WS_CTL, 0, mk::CTL_BYTES, stream);
    void* args[] = {(void*)&a};
    hipError_t e = hipLaunchCooperativeKernel((const void*)mk::k_mega, dim3(grid_blocks), dim3(512), args, mk::LDS_BYTES, stream);
    if (e != hipSuccess) fprintf(stderr, "cooperative launch failed: %s (grid %d)\n", hipGetErrorString(e), grid_blocks);
}
```
